# Optimizing an MI355X kernel written in HIP

```python
import math
import jax, jax.numpy as jnp
from jax import lax
import numpy as np

D_MODEL = 1024
BATCH = 2
SEQ = 16384
DEPTH = 2

N_HEADS = 8
N_KV_HEADS = 2
HEAD_DIM = 64
GQA_GROUP = N_HEADS // N_KV_HEADS
WINDOW = 128
ATTN_BLOCK = WINDOW
Q_DIM = N_HEADS * HEAD_DIM
KV_DIM = N_KV_HEADS * HEAD_DIM
N_BUCKETS = 32
MAX_DISTANCE = 128
POOL_WINDOWS = (2, 4, 8, 16)
POOL_GROUPS = 4
POOL_GROUP_DIM = 128
POOL_DIM = POOL_GROUPS * POOL_GROUP_DIM
GMLP_CHUNK = 128
GMLP_GROUPS = 4
GMLP_DIM = 512
GMLP_GROUP_DIM = GMLP_DIM // GMLP_GROUPS
N_BRANCHES = 3
GATE_DIM = N_BRANCHES * D_MODEL
SPLIT_POINTS = (Q_DIM, Q_DIM + KV_DIM, Q_DIM + 2 * KV_DIM, Q_DIM + 2 * KV_DIM + POOL_DIM, Q_DIM + 2 * KV_DIM + POOL_DIM + GMLP_DIM, Q_DIM + 2 * KV_DIM + POOL_DIM + 2 * GMLP_DIM)
IN_DIM = Q_DIM + 2 * KV_DIM + POOL_DIM + 2 * GMLP_DIM + GATE_DIM
PEER_HEADS = 8
N_KEYS = 128
N_EXPERTS = N_KEYS * N_KEYS
PEER_TOPK = 16
PEER_QDIM = 256
PEER_HALF = PEER_QDIM // 2
PEER_BLOCK = 128
EPS = 1e-6
NEG_INF = -1e30

kernel_name = "hybrid_gated_swa_pool_gmlp_peer"


def rmsnorm(x, gain):
    xf = x.astype(jnp.float32)
    y = xf * lax.rsqrt(jnp.mean(xf * xf, axis=-1, keepdims=True) + EPS)
    return (y * gain.astype(jnp.float32)).astype(x.dtype)


def t5_causal_bucket(dist):
    n = jnp.maximum(dist, 0)
    max_exact = N_BUCKETS // 2
    nf = jnp.maximum(n, 1).astype(jnp.float32)
    large = max_exact + (jnp.log(nf / max_exact) / math.log(MAX_DISTANCE / max_exact) * (N_BUCKETS - max_exact)).astype(jnp.int32)
    large = jnp.minimum(large, N_BUCKETS - 1)
    return jnp.where(n < max_exact, n, large)


def sliding_window_attention(q, k, v, sinks, rel_bias):
    B, S, _ = q.shape
    nb = S // ATTN_BLOCK
    q = q.reshape(B, nb, ATTN_BLOCK, N_KV_HEADS, GQA_GROUP, HEAD_DIM)
    k = k.reshape(B, nb, ATTN_BLOCK, N_KV_HEADS, HEAD_DIM)
    v = v.reshape(B, nb, ATTN_BLOCK, N_KV_HEADS, HEAD_DIM)

    def with_prev(t):
        prev = jnp.pad(t, ((0, 0), (1, 0), (0, 0), (0, 0), (0, 0)))[:, :-1]
        return jnp.concatenate([prev, t], axis=2)

    kk, vv = with_prev(k), with_prev(v)
    logits = jnp.einsum('bnqhgd,bnshd->bnhgqs', q, kk).astype(jnp.float32) * (HEAD_DIM ** -0.5)
    qi = jnp.arange(ATTN_BLOCK)[:, None]
    kj = jnp.arange(2 * ATTN_BLOCK)[None, :]
    dist = qi + ATTN_BLOCK - kj
    band = (dist >= 0) & (dist < WINDOW)
    bias = rel_bias[t5_causal_bucket(dist)].astype(jnp.float32)
    bias = bias.transpose(2, 0, 1).reshape(N_KV_HEADS, GQA_GROUP, ATTN_BLOCK, 2 * ATTN_BLOCK)
    before_start = (jnp.arange(nb) == 0)[:, None, None] & (kj < ATTN_BLOCK)[None]
    mask = band[None] & ~before_start
    logits = jnp.where(mask[None, :, None, None], logits + bias, NEG_INF)
    sink = sinks.astype(jnp.float32).reshape(N_KV_HEADS, GQA_GROUP)[:, :, None, None]
    m = jnp.maximum(jnp.max(logits, axis=-1, keepdims=True), sink)
    p = jnp.exp(logits - m)
    p = p / (jnp.sum(p, axis=-1, keepdims=True) + jnp.exp(sink - m))
    out = jnp.einsum('bnhgqs,bnshd->bnqhgd', p.astype(v.dtype), vv)
    return out.reshape(B, S, Q_DIM)


def multiscale_pool(z, w_pool, pool_scale):
    B, S, _ = z.shape
    zg = z.astype(jnp.float32).reshape(B, S, POOL_GROUPS, POOL_GROUP_DIM)
    csum = jnp.cumsum(zg, axis=1)
    count = jnp.arange(1, S + 1, dtype=jnp.float32)
    outs = []
    for gi, w in enumerate(POOL_WINDOWS):
        c = csum[:, :, gi]
        lagged = jnp.pad(c, ((0, 0), (w, 0), (0, 0)))[:, :S]
        mean = (c - lagged) / jnp.minimum(count, float(w))[None, :, None]
        outs.append(mean - zg[:, :, gi])
    d = jnp.stack(outs, axis=2).astype(z.dtype)
    y = jnp.einsum('bsgc,gcd->bsgd', d, w_pool)
    return y.reshape(B, S, POOL_DIM) * pool_scale


def chunked_spatial_gating(u, v, v_gain, w_s, b_s):
    B, S, _ = u.shape
    u = jax.nn.gelu(u)
    v = rmsnorm(jax.nn.gelu(v), v_gain)
    nc = S // GMLP_CHUNK
    v = v.reshape(B, nc, GMLP_CHUNK, GMLP_GROUPS, GMLP_GROUP_DIM)
    causal = jnp.tril(jnp.ones((GMLP_CHUNK, GMLP_CHUNK), dtype=bool))
    w = jnp.where(causal[None], w_s, jnp.zeros_like(w_s))
    mixed = jnp.einsum('gts,bcsgd->bctgd', w, v) + b_s.T[:, :, None]
    return u * mixed.reshape(B, S, GMLP_DIM)


def peer_ffn(h, w_query, sub_keys1, sub_keys2, expert_u, expert_v):
    B, S, D = h.shape
    tokens = h.reshape(-1, PEER_BLOCK, D)

    def block(xb):
        q = (xb @ w_query).reshape(PEER_BLOCK, PEER_HEADS, 2, PEER_HALF)
        s1 = jnp.einsum('thd,kd->thk', q[:, :, 0], sub_keys1).astype(jnp.float32)
        s2 = jnp.einsum('thd,kd->thk', q[:, :, 1], sub_keys2).astype(jnp.float32)
        v1, i1 = lax.top_k(s1, PEER_TOPK)
        v2, i2 = lax.top_k(s2, PEER_TOPK)
        cand = (v1[..., :, None] + v2[..., None, :]).reshape(PEER_BLOCK, PEER_HEADS, PEER_TOPK * PEER_TOPK)
        top, ci = lax.top_k(cand, PEER_TOPK)
        idx = jnp.take_along_axis(i1, ci // PEER_TOPK, axis=-1) * N_KEYS + jnp.take_along_axis(i2, ci % PEER_TOPK, axis=-1)
        gate = jax.nn.softmax(top, axis=-1)
        idx = idx.reshape(PEER_BLOCK, PEER_HEADS * PEER_TOPK)
        gate = gate.reshape(PEER_BLOCK, PEER_HEADS * PEER_TOPK)
        u_sel = expert_u[idx]
        act = jax.nn.gelu(jnp.einsum('td,tkd->tk', xb, u_sel).astype(jnp.float32))
        coeff = (gate * act).astype(xb.dtype)
        return jnp.einsum('tk,tkd->td', coeff, expert_v[idx])

    return lax.map(block, tokens).reshape(B, S, D)


def setup_inputs(seed: int = 0) -> dict:
    key = jax.random.key(seed)
    ks = jax.random.split(key, 24)
    f32 = jnp.float32
    L, D = DEPTH, D_MODEL

    def nrm(k, shape, scale):
        return jax.random.normal(k, shape, f32) * scale

    return {
        "x": nrm(ks[0], (BATCH, SEQ, D), 1.0),
        "rel_bias": nrm(ks[1], (N_BUCKETS, N_HEADS), 0.5),
        "final_gain": 1.0 + nrm(ks[2], (D,), 0.02),
        "attn_norm_gain": 1.0 + nrm(ks[3], (L, D), 0.02),
        "w_in": nrm(ks[4], (L, D, IN_DIM), D ** -0.5),
        "b_gate": nrm(ks[5], (L, GATE_DIM), 0.02),
        "attn_sinks": nrm(ks[6], (L, N_HEADS), 0.5),
        "w_pool": nrm(ks[7], (L, POOL_GROUPS, POOL_GROUP_DIM, POOL_GROUP_DIM), POOL_GROUP_DIM ** -0.5),
        "pool_scale": 1.0 + nrm(ks[8], (L, POOL_DIM), 0.02),
        "gmlp_v_gain": 1.0 + nrm(ks[9], (L, GMLP_DIM), 0.02),
        "w_spatial": nrm(ks[10], (L, GMLP_GROUPS, GMLP_CHUNK, GMLP_CHUNK), GMLP_CHUNK ** -0.5),
        "b_spatial": 1.0 + nrm(ks[11], (L, GMLP_GROUPS, GMLP_CHUNK), 0.02),
        "w_branch_a": nrm(ks[12], (L, Q_DIM, D), Q_DIM ** -0.5),
        "w_branch_b": nrm(ks[13], (L, POOL_DIM, D), POOL_DIM ** -0.5),
        "w_branch_c": nrm(ks[14], (L, GMLP_DIM, D), GMLP_DIM ** -0.5),
        "w_out": nrm(ks[15], (L, D, D), D ** -0.5),
        "ffn_norm_gain": 1.0 + nrm(ks[16], (L, D), 0.02),
        "peer_w_query": nrm(ks[17], (L, D, PEER_HEADS * PEER_QDIM), D ** -0.5),
        "peer_sub_keys1": nrm(ks[18], (L, N_KEYS, PEER_HALF), PEER_HALF ** -0.5),
        "peer_sub_keys2": nrm(ks[19], (L, N_KEYS, PEER_HALF), PEER_HALF ** -0.5),
        "peer_expert_u": nrm(ks[20], (L, N_EXPERTS, D), D ** -0.5),
        "peer_expert_v": nrm(ks[21], (L, N_EXPERTS, D), PEER_HEADS ** -0.5),
    }


def reference(x, rel_bias, final_gain, attn_norm_gain, w_in, b_gate, attn_sinks, w_pool, pool_scale, gmlp_v_gain, w_spatial, b_spatial, w_branch_a, w_branch_b, w_branch_c, w_out, ffn_norm_gain, peer_w_query, peer_sub_keys1, peer_sub_keys2, peer_expert_u, peer_expert_v):
    B, S, D = x.shape
    for l in range(DEPTH):
        h = rmsnorm(x, attn_norm_gain[l])
        proj = h @ w_in[l]
        q, k, v, pz, gu, gv, g = jnp.split(proj, SPLIT_POINTS, axis=-1)
        gates = jax.nn.sigmoid((g + b_gate[l]).astype(jnp.float32)).astype(x.dtype).reshape(B, S, N_BRANCHES, D)
        ya = sliding_window_attention(q, k, v, attn_sinks[l], rel_bias) @ w_branch_a[l]
        yb = multiscale_pool(pz, w_pool[l], pool_scale[l]) @ w_branch_b[l]
        yc = chunked_spatial_gating(gu, gv, gmlp_v_gain[l], w_spatial[l], b_spatial[l]) @ w_branch_c[l]
        merged = gates[:, :, 0] * ya + gates[:, :, 1] * yb + gates[:, :, 2] * yc
        x = x + merged @ w_out[l]
        h2 = rmsnorm(x, ffn_norm_gain[l])
        x = x + peer_ffn(h2, peer_w_query[l], peer_sub_keys1[l], peer_sub_keys2[l], peer_expert_u[l], peer_expert_v[l])
    return rmsnorm(x, final_gain)
```

```cpp
#include <hip/hip_runtime.h>
#include <cstdio>
#include <cstdint>
#include <cstring>

#ifndef MK_N_LAUNCHES
#define MK_N_LAUNCHES 0
#endif

#define LAS __attribute__((address_space(3)))
typedef unsigned short bf16_t;
typedef short bf16x8 __attribute__((ext_vector_type(8)));
typedef float f32x4 __attribute__((ext_vector_type(4)));
typedef float f32x2 __attribute__((ext_vector_type(2)));
typedef unsigned u32x4 __attribute__((ext_vector_type(4)));
typedef unsigned u32x2 __attribute__((ext_vector_type(2)));
typedef __bf16 bf16x2_t __attribute__((ext_vector_type(2)));

constexpr int NTOK = 32768, DM = 1024, SEQ = 16384, DEPTH = 2;
constexpr int NA = 2304, NG = 3072, NIN = 5376;
constexpr int COL_K = 512, COL_V = 640, COL_PZ = 768, COL_GU = 1280, COL_GV = 1792;
constexpr int MIXW = 1536;
constexpr int NEXP = 16384, PQ = 2048;
constexpr float EPS = 1e-6f;
constexpr int NWAVES = 8, NTHREADS = 512;

constexpr size_t MiB = 1u << 20;
constexpr size_t WS_CTL = 0, CTL_ZERO_BYTES = 1 * MiB;
constexpr size_t CTL_BAR_WORD = 4096;
constexpr size_t CTL_ROWSQ = 256 * 1024;
constexpr size_t WS_RSTD = 1 * MiB;
constexpr size_t WS_WTIN = 2 * MiB;
constexpr size_t WS_WTBR = 23 * MiB;
constexpr size_t WS_WTOUT = 29 * MiB;
constexpr size_t WS_WEFF = 33 * MiB;
constexpr size_t WS_ROWSQP = 42 * MiB;
constexpr size_t WS_EXPU = 48 * MiB, WS_EXPV = 80 * MiB;
constexpr size_t WS_XB = 112 * MiB;
constexpr size_t WS_PROJA = 176 * MiB;
constexpr size_t WS_GATES = 176 * MiB;
constexpr size_t WS_MIX = 368 * MiB;
constexpr size_t WS_SCORES = 176 * MiB;
constexpr size_t WS_SELI = 464 * MiB, WS_SELG = 480 * MiB;
constexpr size_t WS_END = 496 * MiB;

constexpr int LDS_BYTES = 163840;
constexpr int LDS_MISC = LDS_BYTES - 256;

__device__ __forceinline__ unsigned cvt_pk_bf16(float lo, float hi) { unsigned r; asm volatile("v_cvt_pk_bf16_f32 %0, %1, %2" : "=v"(r) : "v"(lo), "v"(hi)); return r; }
__device__ __forceinline__ float bf_lo(unsigned u) { return __uint_as_float(u << 16); }
__device__ __forceinline__ float bf_hi(unsigned u) { return __uint_as_float(u & 0xffff0000u); }
__device__ __forceinline__ float bf1(bf16_t u) { return __uint_as_float(((unsigned)u) << 16); }
__device__ __forceinline__ float wave_sum(float v) {
#pragma unroll
    for (int o = 1; o < 64; o <<= 1) v += __shfl_xor(v, o);
    return v;
}
__device__ __forceinline__ float gelu_tanh(float x) {
    const float u = 0.7978845608028654f * (x + 0.044715f * x * x * x);
    const float e = __builtin_amdgcn_exp2f(-2.0f * 1.4426950408889634f * u);
    return x * __builtin_amdgcn_rcpf(1.0f + e);
}
__device__ __forceinline__ float row_sumsq(const float* part, int row) { const f32x4* q = (const f32x4*)(part + (size_t)row * 16); const f32x4 a = q[0], b = q[1], c = q[2], d = q[3];
    return (((a[0] + a[1]) + (a[2] + a[3])) + ((b[0] + b[1]) + (b[2] + b[3]))) + (((c[0] + c[1]) + (c[2] + c[3])) + ((d[0] + d[1]) + (d[2] + d[3]))); }
__device__ __forceinline__ float sigmoidf_(float x) { return __builtin_amdgcn_rcpf(1.0f + __builtin_amdgcn_exp2f(-1.4426950408889634f * x)); }

#define XB_TMO      128
#define XB_XCNT(j)  (256  + 64 * (j))
#define XB_XSUB(j)  (1280 + 64 * (j))
#define XB_XGEN(j)  (2304 + 64 * (j))
#define XB_TOP      3328
#define XB_TOPGEN   3392
#define XCD_BAR_WORDS 3456
#define XB_SPIN_CAP (1u << 18)
__device__ __forceinline__ unsigned xb_ld(unsigned* p)              { return __hip_atomic_load(p, __ATOMIC_RELAXED, __HIP_MEMORY_SCOPE_AGENT); }
__device__ __forceinline__ unsigned xb_add(unsigned* p, unsigned v) { return __hip_atomic_fetch_add(p, v, __ATOMIC_RELAXED, __HIP_MEMORY_SCOPE_AGENT); }
__device__ __forceinline__ unsigned xb_xcc_id() { return (unsigned)__builtin_amdgcn_s_getreg((3 << 11) | 20) & 0xFu; }
#define XB_SPIN(cond, bar) do { unsigned _sp = 0; while (cond) { __builtin_amdgcn_s_sleep(1); \
    if ((++_sp & 255u) == 0u) { if (xb_ld(&(bar)[XB_TMO])) break; if (_sp > XB_SPIN_CAP) { atomicAdd(&(bar)[XB_TMO], 1u); break; } } } } while (0)
struct XcdBarrier { unsigned* bar; unsigned x; volatile LAS unsigned* st; };
__device__ __forceinline__ XcdBarrier xcd_barrier_post(unsigned* bar, volatile LAS unsigned* st) {
    XcdBarrier b; b.bar = bar; b.x = xb_xcc_id(); b.st = st;
    if (threadIdx.x == 0) (void)xb_add(&bar[XB_XCNT(b.x)], 1u);
    return b;
}
__device__ __forceinline__ void xcd_barrier_complete(unsigned* bar, unsigned x, unsigned& nloc, unsigned& nx) {
    const unsigned G = gridDim.x * gridDim.y * gridDim.z;
    unsigned sum, cnt, mine, sp = 0u;
    for (;;) {
        sum = 0u; cnt = 0u; mine = 0u;
#pragma unroll
        for (unsigned j = 0; j < 16; ++j) { const unsigned c = xb_ld(&bar[XB_XCNT(j)]); sum += c; cnt += (c > 0u) ? 1u : 0u; mine = (j == x) ? c : mine; }
        if (sum == G) break;
        __builtin_amdgcn_s_sleep(1);
        if ((++sp & 255u) == 0u) { if (xb_ld(&bar[XB_TMO])) break; if (sp > XB_SPIN_CAP) { atomicAdd(&bar[XB_TMO], 1u); break; } }
    }
    nloc = mine > 0u ? mine : 1u; nx = cnt > 0u ? cnt : 1u;
}
__device__ __forceinline__ void xcd_barrier(const XcdBarrier& b) {
    asm volatile("s_waitcnt vmcnt(0)" ::: "memory");
    __syncthreads();
    if (threadIdx.x == 0) {
        unsigned* bar = b.bar;
        __builtin_amdgcn_s_waitcnt(0);
        unsigned nloc = b.st[0], nx = b.st[1];
        if (nloc == 0u) { xcd_barrier_complete(bar, b.x, nloc, nx); b.st[0] = nloc; b.st[1] = nx; }
        const unsigned old = xb_add(&bar[XB_XSUB(b.x)], 1u);
        const unsigned gen = old / nloc;
        if (old + 1u == (gen + 1u) * nloc) {
            __builtin_amdgcn_fence(__ATOMIC_RELEASE, "agent");
            asm volatile("s_waitcnt vmcnt(0)" ::: "memory");
            const unsigned og = xb_add(&bar[XB_TOP], 1u);
            const unsigned tg = og / nx;
            if (og + 1u == (tg + 1u) * nx) xb_add(&bar[XB_TOPGEN], 1u);
            else XB_SPIN(xb_ld(&bar[XB_TOPGEN]) == tg, bar);
            __builtin_amdgcn_fence(__ATOMIC_ACQUIRE, "agent");
            xb_add(&bar[XB_XGEN(b.x)], 1u);
            asm volatile("s_waitcnt vmcnt(0)" ::: "memory");
        } else {
            XB_SPIN(xb_ld(&bar[XB_XGEN(b.x)]) == gen, bar);
            __builtin_amdgcn_fence(__ATOMIC_ACQUIRE, "agent");
            asm volatile("s_waitcnt vmcnt(0)" ::: "memory");
        }
    }
    __syncthreads();
}

namespace pg8 {
constexpr int BM = 256, BK = 64, HALF = 128, HTB = HALF * BK * 2, STAGE_BYTES = 8 * HTB, NXCD = 8, WGM = 8;
__host__ __device__ __forceinline__ int lds_byte(int r, int c) { const int st = (r >> 4) * 2 + (c >> 5), rr = r & 15, cc = c & 31, ob = rr * 64 + cc * 2; return st * 1024 + (ob ^ (((ob >> 9) & 1) << 5)); }
__host__ __device__ __forceinline__ void stage_rc(int b, int& R, int& C) { const int st = b / 1024, sb = b % 1024, swz = sb ^ (((sb >> 9) & 1) << 5); R = (st >> 1) * 16 + swz / 64; C = (st & 1) * 32 + (swz % 64) / 2; }
__host__ __device__ __forceinline__ int perm32(int rho) { const int n = rho >> 4, i = rho & 15; return 8 * (i >> 2) + 4 * n + (i & 3); }

struct Unit { int pm, pn, z; };
struct Gemm { const bf16_t* A; const bf16_t* Bt; int lda, ldb, K; size_t az, bz; };

template <int ZN> struct TileOrder {
    int nM, nN, nwg, G, c;
    __device__ void init(int M, int N, int G_, int c_) { nM = M / BM; nN = N / BM; nwg = nM * nN; G = G_; c = c_; }
    __device__ bool next(int i, Unit& u) const {
        const long L = (long)(i / ZN) * G + c; if (L >= nwg) return false;
        int wgid = (int)L; { const int q = nwg / NXCD, r = nwg % NXCD, xcd = wgid % NXCD, off = wgid / NXCD; wgid = (xcd < r ? xcd * (q + 1) : r * (q + 1) + (xcd - r) * q) + off; }
        const int nig = WGM * nN, gid = wgid / nig, fm = gid * WGM, gsz = (nM - fm) < WGM ? (nM - fm) : WGM;
        u.pm = fm + ((wgid % nig) % gsz); u.pn = (wgid % nig) / gsz; u.z = i % ZN; return true;
    }
};

template <class Epi, class Sched>
__device__ __forceinline__ void gemm_phase(LAS unsigned char* lds, const Gemm g, const Sched& S, const Epi& E) {
    int tid_ = threadIdx.x; asm volatile("" : "+v"(tid_));
    const int tid = tid_, wid = __builtin_amdgcn_readfirstlane(tid >> 6), lane = tid & 63, wr = wid >> 2, wc = wid & 3, fr = lane & 15, fq = lane >> 4;
    const int K = g.K, nt = K / BK;
    unsigned voffA[2], voffB[2];
#pragma unroll
    for (int i = 0; i < 2; ++i) { int R, C; stage_rc(tid * 16 + i * 8192, R, C); const int Rb = Epi::PERM ? ((R & ~31) + perm32(R & 31)) : R;
        voffA[i] = (unsigned)(R * g.lda + C) * 2u; voffB[i] = (unsigned)(Rb * g.ldb + C) * 2u; }
    const size_t kstep = (size_t)(BK * 2);
    const size_t hstepA = (size_t)HALF * g.lda * 2, hstepB = (size_t)HALF * g.ldb * 2;
    const size_t tstepA = 2 * hstepA, tstepB = 2 * hstepB;
    const unsigned ldsw = (unsigned)wid * 1024u;
    const int aoff = lds_byte(wr * 64 + fr, fq * 8), boff = lds_byte(wc * 32 + fr, fq * 8);
#define PG8_SA(b, h) (((b) * 2 + (h)) * HTB)
#define PG8_SB(b, h) ((4 + (b) * 2 + (h)) * HTB)
#define PG8_STAGE(bufoff, gbase, voff) do { _Pragma("unroll") for (int _i = 0; _i < 2; ++_i) \
        __builtin_amdgcn_global_load_lds((const unsigned*)((const char*)(gbase) + (voff)[_i]), (LAS unsigned*)(lds + (bufoff) + ldsw + _i * 8192), 16, 0, 0); } while (0)
#define PG8_LDA(dst, b, h) do { _Pragma("unroll") for (int m = 0; m < 4; ++m) _Pragma("unroll") for (int k = 0; k < 2; ++k) dst[m][k] = *(const LAS bf16x8*)(lds + PG8_SA(b, h) + aoff + m * 2048 + k * 1024); } while (0)
#define PG8_LDB(dst, b, h) do { _Pragma("unroll") for (int n = 0; n < 2; ++n) _Pragma("unroll") for (int k = 0; k < 2; ++k) dst[n][k] = *(const LAS bf16x8*)(lds + PG8_SB(b, h) + boff + n * 2048 + k * 1024); } while (0)
#define PG8_MMA(ai, bj, At, Bt) do { __builtin_amdgcn_s_setprio(1); _Pragma("unroll") for (int m = 0; m < 4; ++m) _Pragma("unroll") for (int n = 0; n < 2; ++n) _Pragma("unroll") for (int k = 0; k < 2; ++k) \
        acc[ai][bj][m][n] = __builtin_amdgcn_mfma_f32_16x16x32_bf16(Bt[n][k], At[m][k], acc[ai][bj][m][n], 0, 0, 0); __builtin_amdgcn_s_setprio(0); } while (0)
#define PG8_WAIT_V(n) asm volatile("s_waitcnt vmcnt(" #n ")" ::: "memory")
#define PG8_WAIT_L(n) asm volatile("s_waitcnt lgkmcnt(" #n ")" ::: "memory")
#define PG8_BAR __builtin_amdgcn_s_barrier()
#define PG8_SCHED __builtin_amdgcn_sched_barrier(0)
    Unit cur, nxt; int ui = 0;
    if (!S.next(0, cur)) return;
    f32x4 acc[2][2][4][2];
#pragma unroll
    for (int a = 0; a < 2; ++a)
#pragma unroll
        for (int b = 0; b < 2; ++b)
#pragma unroll
            for (int m = 0; m < 4; ++m)
#pragma unroll
                for (int n = 0; n < 2; ++n) acc[a][b][m][n] = (f32x4){0.f, 0.f, 0.f, 0.f};
    bf16x8 At[4][2], B0[2][2], B1[2][2];
    const char* cA = (const char*)g.A + (size_t)cur.pm * tstepA + (size_t)cur.z * g.az; const char* cB = (const char*)g.Bt + (size_t)cur.pn * tstepB + (size_t)cur.z * g.bz;
    PG8_STAGE(PG8_SB(0, 0), cB, voffB); PG8_STAGE(PG8_SB(0, 1), cB + hstepB, voffB); PG8_STAGE(PG8_SA(0, 0), cA, voffA); PG8_STAGE(PG8_SA(0, 1), cA + hstepA, voffA);
    if (wr == 1) PG8_BAR;
    PG8_WAIT_V(2); PG8_BAR;
    PG8_STAGE(PG8_SB(1, 0), cB + kstep, voffB); PG8_STAGE(PG8_SA(1, 0), cA + kstep, voffA); PG8_STAGE(PG8_SB(1, 1), cB + hstepB + kstep, voffB);
    PG8_WAIT_V(6); PG8_BAR;
    for (;;) {
        const bool has_next = S.next(ui + 1, nxt);
        const char* nA = has_next ? (const char*)g.A + (size_t)nxt.pm * tstepA + (size_t)nxt.z * g.az : cA;
        const char* nB = has_next ? (const char*)g.Bt + (size_t)nxt.pn * tstepB + (size_t)nxt.z * g.bz : cB;
        for (int t = 0; t < nt; t += 2) {
            const bool last = (t == nt - 2);
            const char* a1 = cA + (size_t)(t + 1) * kstep;
            const char* a2 = last ? nA : cA + (size_t)(t + 2) * kstep; const char* b2 = last ? nB : cB + (size_t)(t + 2) * kstep;
            const char* a3 = a2 + kstep; const char* b3 = b2 + kstep;
            PG8_LDB(B0, 0, 0); PG8_LDB(B1, 0, 1); PG8_SCHED; PG8_LDA(At, 0, 0); PG8_STAGE(PG8_SA(1, 1), a1 + hstepA, voffA);
            PG8_WAIT_V(8); PG8_WAIT_L(0); PG8_BAR; PG8_MMA(0, 0, At, B0); PG8_MMA(0, 1, At, B1); PG8_BAR; PG8_SCHED;
            PG8_LDA(At, 0, 1); PG8_STAGE(PG8_SB(0, 0), b2, voffB); PG8_STAGE(PG8_SB(0, 1), b2 + hstepB, voffB); PG8_STAGE(PG8_SA(0, 0), a2, voffA);
            PG8_WAIT_V(8); PG8_WAIT_L(0); PG8_BAR; PG8_MMA(1, 0, At, B0); PG8_MMA(1, 1, At, B1); PG8_BAR; PG8_SCHED;
            PG8_LDB(B0, 1, 0); PG8_LDB(B1, 1, 1); PG8_SCHED; PG8_LDA(At, 1, 0); PG8_STAGE(PG8_SA(0, 1), a2 + hstepA, voffA);
            PG8_WAIT_V(8); PG8_WAIT_L(0); PG8_BAR; PG8_MMA(0, 0, At, B0); PG8_MMA(0, 1, At, B1); PG8_BAR; PG8_SCHED;
            PG8_LDA(At, 1, 1); PG8_STAGE(PG8_SB(1, 0), b3, voffB); PG8_STAGE(PG8_SB(1, 1), b3 + hstepB, voffB); PG8_STAGE(PG8_SA(1, 0), a3, voffA);
            PG8_WAIT_V(8); PG8_WAIT_L(0); PG8_BAR; PG8_MMA(1, 0, At, B0); PG8_MMA(1, 1, At, B1); PG8_BAR; PG8_SCHED;
        }
        if (wr == 0) PG8_BAR;
        E(acc, cur, wr, wc, fr, fq);
        if (!has_next) break;
        if (!E.keep(cur)) {
#pragma unroll
            for (int a = 0; a < 2; ++a)
#pragma unroll
                for (int b = 0; b < 2; ++b)
#pragma unroll
                    for (int m = 0; m < 4; ++m)
#pragma unroll
                        for (int n = 0; n < 2; ++n) acc[a][b][m][n] = (f32x4){0.f, 0.f, 0.f, 0.f};
        }
        cur = nxt; cA = nA; cB = nB; ++ui;
        if (wr == 1) PG8_BAR;
    }
    PG8_WAIT_V(0);
    PG8_BAR;
#undef PG8_SA
#undef PG8_SB
#undef PG8_STAGE
#undef PG8_LDA
#undef PG8_LDB
#undef PG8_MMA
#undef PG8_WAIT_V
#undef PG8_WAIT_L
#undef PG8_BAR
#undef PG8_SCHED
}
}
typedef pg8::Unit Unit;
typedef f32x4 AccT[2][2][4][2];

struct EpiProjA {
    static constexpr bool PERM = true;
    bf16_t* O; const float* rstd;
    __device__ __forceinline__ bool keep(const Unit&) const { return false; }
    __device__ __forceinline__ void operator()(AccT& acc, const Unit& u, int wr, int wc, int fr, int fq) const {
        const int row0 = u.pm * 256 + wr * 64 + fr, col0 = u.pn * 256 + wc * 32 + 8 * fq;
        const bool act = (u.pn >= 5);
#pragma unroll
        for (int ai = 0; ai < 2; ++ai)
#pragma unroll
            for (int m = 0; m < 4; ++m) { const int row = row0 + ai * 128 + m * 16; const float rs = rstd[row]; bf16_t* rowp = O + (size_t)row * NA + col0;
#pragma unroll
                for (int bj = 0; bj < 2; ++bj) { f32x4 v0 = acc[ai][bj][m][0] * rs, v1 = acc[ai][bj][m][1] * rs;
                    if (act) {
#pragma unroll
                        for (int j = 0; j < 4; ++j) { v0[j] = gelu_tanh(v0[j]); v1[j] = gelu_tanh(v1[j]); } }
                    u32x4 w; w.x = cvt_pk_bf16(v0[0], v0[1]); w.y = cvt_pk_bf16(v0[2], v0[3]); w.z = cvt_pk_bf16(v1[0], v1[1]); w.w = cvt_pk_bf16(v1[2], v1[3]);
                    *(u32x4*)(rowp + bj * 128) = w; } }
    }
};
struct EpiGates {
    static constexpr bool PERM = true;
    bf16_t* O; const float* rstd; const float* bias;
    __device__ __forceinline__ bool keep(const Unit&) const { return false; }
    __device__ __forceinline__ void operator()(AccT& acc, const Unit& u, int wr, int wc, int fr, int fq) const {
        const int row0 = u.pm * 256 + wr * 64 + fr, col0 = u.pn * 256 + wc * 32 + 8 * fq;
        f32x4 bv[2][2];
#pragma unroll
        for (int bj = 0; bj < 2; ++bj)
#pragma unroll
            for (int n = 0; n < 2; ++n) bv[bj][n] = *(const f32x4*)(bias + col0 + bj * 128 + 4 * n);
#pragma unroll
        for (int ai = 0; ai < 2; ++ai)
#pragma unroll
            for (int m = 0; m < 4; ++m) { const int row = row0 + ai * 128 + m * 16; const float rs = rstd[row]; bf16_t* rowp = O + (size_t)row * NG + col0;
#pragma unroll
                for (int bj = 0; bj < 2; ++bj) { f32x4 v0 = acc[ai][bj][m][0] * rs + bv[bj][0], v1 = acc[ai][bj][m][1] * rs + bv[bj][1];
#pragma unroll
                    for (int j = 0; j < 4; ++j) { v0[j] = sigmoidf_(v0[j]); v1[j] = sigmoidf_(v1[j]); }
                    u32x4 w; w.x = cvt_pk_bf16(v0[0], v0[1]); w.y = cvt_pk_bf16(v0[2], v0[3]); w.z = cvt_pk_bf16(v1[0], v1[1]); w.w = cvt_pk_bf16(v1[2], v1[3]);
                    *(u32x4*)(rowp + bj * 128) = w; } }
    }
};
struct EpiMerge {
    static constexpr bool PERM = true;
    const bf16_t* gates; bf16_t* O;
    __device__ __forceinline__ bool keep(const Unit& u) const { return u.z < 2; }
    __device__ __forceinline__ void operator()(AccT& acc, const Unit& u, int wr, int wc, int fr, int fq) const {
        const int row0 = u.pm * 256 + wr * 64 + fr, col0 = u.pn * 256 + wc * 32 + 8 * fq;
        const int z = u.z;
#pragma unroll
        for (int ai = 0; ai < 2; ++ai)
#pragma unroll
            for (int m = 0; m < 4; ++m) { const int row = row0 + ai * 128 + m * 16;
#pragma unroll
                for (int bj = 0; bj < 2; ++bj) { const int col = col0 + bj * 128; const bf16_t* gp = gates + (size_t)row * NG + col;
                    float f[8];
                    if (z == 2) { const u32x4 a = *(const u32x4*)(gp + 2048);
                        f[0] = bf_lo(a.x); f[1] = bf_hi(a.x); f[2] = bf_lo(a.y); f[3] = bf_hi(a.y); f[4] = bf_lo(a.z); f[5] = bf_hi(a.z); f[6] = bf_lo(a.w); f[7] = bf_hi(a.w);
#pragma unroll
                        for (int j = 0; j < 8; ++j) f[j] = fmaxf(f[j], 1e-20f);
                    } else { const u32x4 a = *(const u32x4*)(gp + z * 1024), b = *(const u32x4*)(gp + (z + 1) * 1024);
                        float ga[8], gb[8];
                        ga[0] = bf_lo(a.x); ga[1] = bf_hi(a.x); ga[2] = bf_lo(a.y); ga[3] = bf_hi(a.y); ga[4] = bf_lo(a.z); ga[5] = bf_hi(a.z); ga[6] = bf_lo(a.w); ga[7] = bf_hi(a.w);
                        gb[0] = bf_lo(b.x); gb[1] = bf_hi(b.x); gb[2] = bf_lo(b.y); gb[3] = bf_hi(b.y); gb[4] = bf_lo(b.z); gb[5] = bf_hi(b.z); gb[6] = bf_lo(b.w); gb[7] = bf_hi(b.w);
#pragma unroll
                        for (int j = 0; j < 8; ++j) { const float num = (z == 0) ? ga[j] : fmaxf(ga[j], 1e-20f); f[j] = num * __builtin_amdgcn_rcpf(fmaxf(gb[j], 1e-20f)); } }
                    f32x4 v0 = acc[ai][bj][m][0], v1 = acc[ai][bj][m][1];
                    v0[0] *= f[0]; v0[1] *= f[1]; v0[2] *= f[2]; v0[3] *= f[3]; v1[0] *= f[4]; v1[1] *= f[5]; v1[2] *= f[6]; v1[3] *= f[7];
                    acc[ai][bj][m][0] = v0; acc[ai][bj][m][1] = v1;
                    if (z == 2) { u32x4 w; w.x = cvt_pk_bf16(v0[0], v0[1]); w.y = cvt_pk_bf16(v0[2], v0[3]); w.z = cvt_pk_bf16(v1[0], v1[1]); w.w = cvt_pk_bf16(v1[2], v1[3]);
                        *(u32x4*)(O + (size_t)row * DM + col) = w; } } }
    }
};
struct EpiResid {
    static constexpr bool PERM = true;
    bf16_t* X; float* rowsq;
    __device__ __forceinline__ bool keep(const Unit&) const { return false; }
    __device__ __forceinline__ void operator()(AccT& acc, const Unit& u, int wr, int wc, int fr, int fq) const {
        const int row0 = u.pm * 256 + wr * 64 + fr, col0 = u.pn * 256 + wc * 32 + 8 * fq;
#pragma unroll
        for (int ai = 0; ai < 2; ++ai)
#pragma unroll
            for (int m = 0; m < 4; ++m) { const int row = row0 + ai * 128 + m * 16; bf16_t* rowp = X + (size_t)row * DM + col0; float ss = 0.f;
#pragma unroll
                for (int bj = 0; bj < 2; ++bj) { const u32x4 x = *(const u32x4*)(rowp + bj * 128);
                    f32x4 v0 = acc[ai][bj][m][0], v1 = acc[ai][bj][m][1];
                    v0[0] += bf_lo(x.x); v0[1] += bf_hi(x.x); v0[2] += bf_lo(x.y); v0[3] += bf_hi(x.y); v1[0] += bf_lo(x.z); v1[1] += bf_hi(x.z); v1[2] += bf_lo(x.w); v1[3] += bf_hi(x.w);
                    ss += (v0[0] * v0[0] + v0[1] * v0[1]) + (v0[2] * v0[2] + v0[3] * v0[3]) + (v1[0] * v1[0] + v1[1] * v1[1]) + (v1[2] * v1[2] + v1[3] * v1[3]);
                    u32x4 w; w.x = cvt_pk_bf16(v0[0], v0[1]); w.y = cvt_pk_bf16(v0[2], v0[3]); w.z = cvt_pk_bf16(v1[0], v1[1]); w.w = cvt_pk_bf16(v1[2], v1[3]);
                    *(u32x4*)(rowp + bj * 128) = w; }
                ss += __shfl_xor(ss, 16); ss += __shfl_xor(ss, 32);
                if (fq == 0) rowsq[(size_t)row * 16 + u.pn * 4 + wc] = ss; }
    }
};
struct EpiScores {
    static constexpr bool PERM = false;
    float* C;
    __device__ __forceinline__ bool keep(const Unit&) const { return false; }
    __device__ __forceinline__ void operator()(AccT& acc, const Unit& u, int wr, int wc, int fr, int fq) const {
        const int row0 = u.pm * 256 + wr * 64 + fr, col0 = u.pn * 256 + wc * 32 + 4 * fq;
#pragma unroll
        for (int ai = 0; ai < 2; ++ai)
#pragma unroll
            for (int m = 0; m < 4; ++m) { float* rowp = C + (size_t)(row0 + ai * 128 + m * 16) * PQ + col0;
#pragma unroll
                for (int bj = 0; bj < 2; ++bj)
#pragma unroll
                    for (int n = 0; n < 2; ++n) *(f32x4*)(rowp + bj * 128 + n * 16) = acc[ai][bj][m][n]; }
    }
};

struct Params {
    const float* in[22];
    float* out; unsigned char* ws;
    int ph_lo, ph_hi, li, pad;
};
enum { I_X = 0, I_RELB, I_FGAIN, I_AGAIN, I_WIN, I_BGATE, I_SINK, I_WPOOL, I_PSCALE, I_VGAIN, I_WSP, I_BSP, I_WA, I_WB, I_WC, I_WOUT, I_FFGAIN, I_WQ, I_K1, I_K2, I_EU, I_EV };

struct Frame { LAS unsigned char* lds; int tid, lane, wave, G, vcu; };
__device__ __forceinline__ Frame local_frame(const Frame& F0) { Frame F = F0; int t = threadIdx.x; asm volatile("" : "+v"(t)); F.tid = t; F.lane = t & 63; F.wave = __builtin_amdgcn_readfirstlane(t >> 6); return F; }

__device__ __forceinline__ void p0_transpose_item(const float* W, int N, bf16_t* WT, int ldo, const float* kscale, LAS float* scr, int item, int lane) {
    const int nblk = N / 32, kb = item / nblk, nb = item % nblk, k0 = 64 * kb, n0 = 32 * nb;
#pragma unroll 8
    for (int i = 0; i < 32; ++i) { const int kk = 2 * i + (lane >> 5); float v = W[(size_t)(k0 + kk) * N + n0 + (lane & 31)]; if (kscale) v *= kscale[k0 + kk]; scr[kk * 33 + (lane & 31)] = v; }
    asm volatile("s_waitcnt lgkmcnt(0)" ::: "memory");
    const int c = lane & 7;
#pragma unroll
    for (int j = 0; j < 4; ++j) { const int n = (lane >> 3) + 8 * j; const LAS float* s = scr + (8 * c) * 33 + n;
        u32x4 o; o.x = cvt_pk_bf16(s[0 * 33], s[1 * 33]); o.y = cvt_pk_bf16(s[2 * 33], s[3 * 33]); o.z = cvt_pk_bf16(s[4 * 33], s[5 * 33]); o.w = cvt_pk_bf16(s[6 * 33], s[7 * 33]);
        *(u32x4*)(WT + (size_t)(n0 + n) * ldo + k0 + 8 * c) = o; }
    asm volatile("s_waitcnt lgkmcnt(0)" ::: "memory");
}
__device__ __forceinline__ void convert_experts(const Params& p, const Frame& F, int l) {
    const size_t n8 = (size_t)NEXP * DM / 8, stride = (size_t)F.G * NTHREADS;
    const f32x4* su = (const f32x4*)(p.in[I_EU] + (size_t)l * NEXP * DM); const f32x4* sv = (const f32x4*)(p.in[I_EV] + (size_t)l * NEXP * DM);
    u32x4* du = (u32x4*)(p.ws + WS_EXPU); u32x4* dv = (u32x4*)(p.ws + WS_EXPV);
    for (size_t i = (size_t)blockIdx.x * NTHREADS + F.tid; i < n8; i += stride) {
        const f32x4 a = su[2 * i], b = su[2 * i + 1], c = sv[2 * i], d = sv[2 * i + 1];
        u32x4 w; w.x = cvt_pk_bf16(a[0], a[1]); w.y = cvt_pk_bf16(a[2], a[3]); w.z = cvt_pk_bf16(b[0], b[1]); w.w = cvt_pk_bf16(b[2], b[3]); du[i] = w;
        u32x4 y; y.x = cvt_pk_bf16(c[0], c[1]); y.y = cvt_pk_bf16(c[2], c[3]); y.z = cvt_pk_bf16(d[0], d[1]); y.w = cvt_pk_bf16(d[2], d[3]); dv[i] = y;
    }
}
__device__ __forceinline__ void phase_prologue(const Params& p, const Frame& F0) {
    const Frame F = local_frame(F0);
    const int gw = F.vcu * NWAVES + F.wave, NGW = F.G * NWAVES, lane = F.lane;
    LAS float* scr = (LAS float*)(F.lds + F.wave * 16384);
    constexpr int I_IN = (DM / 64) * (NIN / 32), I_BR = (512 / 64) * (DM / 32), I_OUT = (DM / 64) * (DM / 32);
    constexpr int PER_L = I_IN + 2 * I_BR + I_OUT;
    for (int it = gw; it < DEPTH * PER_L; it += NGW) {
        const int l = it / PER_L; int r = it % PER_L;
        if (r < I_IN) { p0_transpose_item(p.in[I_WIN] + (size_t)l * DM * NIN, NIN, (bf16_t*)(p.ws + WS_WTIN) + (size_t)l * NIN * DM, DM, p.in[I_AGAIN] + l * DM, scr, r, lane); continue; } r -= I_IN;
        if (r < I_BR) { p0_transpose_item(p.in[I_WA] + (size_t)l * 512 * DM, DM, (bf16_t*)(p.ws + WS_WTBR) + (size_t)(l * 3 + 0) * DM * 512, 512, nullptr, scr, r, lane); continue; } r -= I_BR;
        if (r < I_BR) { p0_transpose_item(p.in[I_WC] + (size_t)l * 512 * DM, DM, (bf16_t*)(p.ws + WS_WTBR) + (size_t)(l * 3 + 2) * DM * 512, 512, nullptr, scr, r, lane); continue; } r -= I_BR;
        p0_transpose_item(p.in[I_WOUT] + (size_t)l * DM * DM, DM, (bf16_t*)(p.ws + WS_WTOUT) + (size_t)l * DM * DM, DM, nullptr, scr, r, lane);
    }
    {
        float* rstd = (float*)(p.ws + WS_RSTD);
        for (int m = gw; m < NTOK; m += NGW) {
            const f32x4* xr = (const f32x4*)(p.in[I_X] + (size_t)m * DM) + lane; f32x4 v[4]; float s = 0.f;
#pragma unroll
            for (int j = 0; j < 4; ++j) { v[j] = xr[64 * j]; s += (v[j][0] * v[j][0] + v[j][1] * v[j][1]) + (v[j][2] * v[j][2] + v[j][3] * v[j][3]); }
            s = wave_sum(s);
            u32x2* o = (u32x2*)((bf16_t*)(p.ws + WS_XB) + (size_t)m * DM) + lane;
#pragma unroll
            for (int j = 0; j < 4; ++j) { u32x2 w; w.x = cvt_pk_bf16(v[j][0], v[j][1]); w.y = cvt_pk_bf16(v[j][2], v[j][3]); o[64 * j] = w; }
            if (lane == 0) rstd[m] = 1.0f / sqrtf(s * (1.0f / DM) + EPS);
        }
    }
    convert_experts(p, F, 0);
    __syncthreads();
    {
        LAS float* coef = (LAS float*)F.lds;
        for (int u = blockIdx.x; u < DEPTH * 4 * 16; u += F.G) {
            const int l = u / 64, g = (u / 16) % 4, c0 = (u % 16) * 8;
            __syncthreads();
            for (int i = F.tid; i < 1024; i += NTHREADS) { const int cc = i >> 7, j = i & 127;
                coef[i] = p.in[I_WPOOL][(((size_t)l * 4 + g) * 128 + c0 + cc) * 128 + j] * p.in[I_PSCALE][l * 512 + g * 128 + j]; }
            __syncthreads();
            const float* wb = p.in[I_WB] + ((size_t)l * 512 + g * 128) * DM;
            float a0[8], a1[8];
#pragma unroll
            for (int cc = 0; cc < 8; ++cc) { a0[cc] = 0.f; a1[cc] = 0.f; }
            for (int j = 0; j < 128; ++j) { const float w0 = wb[(size_t)j * DM + F.tid], w1 = wb[(size_t)j * DM + F.tid + 512];
#pragma unroll
                for (int cc = 0; cc < 8; ++cc) { const float cf = coef[cc * 128 + j]; a0[cc] += cf * w0; a1[cc] += cf * w1; } }
            bf16_t* dst = (bf16_t*)(p.ws + WS_WTBR) + (size_t)(l * 3 + 1) * DM * 512 + g * 128 + c0;
            u32x4 w; w.x = cvt_pk_bf16(a0[0], a0[1]); w.y = cvt_pk_bf16(a0[2], a0[3]); w.z = cvt_pk_bf16(a0[4], a0[5]); w.w = cvt_pk_bf16(a0[6], a0[7]);
            *(u32x4*)(dst + (size_t)F.tid * 512) = w;
            u32x4 y; y.x = cvt_pk_bf16(a1[0], a1[1]); y.y = cvt_pk_bf16(a1[2], a1[3]); y.z = cvt_pk_bf16(a1[4], a1[5]); y.w = cvt_pk_bf16(a1[6], a1[7]);
            *(u32x4*)(dst + (size_t)(F.tid + 512) * 512) = y;
        }
    }
    {
        LAS float* kl = (LAS float*)F.lds;
        LAS float* wl = kl + 128 * 132;
        for (int u = blockIdx.x; u < DEPTH * 16 * 16; u += F.G) {
            const int l = u / 256, s = (u / 16) % 16, c0 = (u % 16) * 64;
            const float* keys = ((s & 1) ? p.in[I_K2] : p.in[I_K1]) + (size_t)l * 128 * 128;
            const float* wq = p.in[I_WQ] + (size_t)l * DM * PQ;
            __syncthreads();
            for (int i = F.tid; i < 128 * 32; i += NTHREADS) { const int r = i >> 5, q = i & 31; *(LAS f32x4*)(kl + r * 132 + q * 4) = *(const f32x4*)(keys + r * 128 + q * 4); }
            for (int i = F.tid; i < 64 * 32; i += NTHREADS) { const int r = i >> 5, q = i & 31; *(LAS f32x4*)(wl + r * 132 + q * 4) = *(const f32x4*)(wq + (size_t)(c0 + r) * PQ + s * 128 + q * 4); }
            __syncthreads();
            const int c = F.tid & 63, kq = F.wave;
            float acc[16];
#pragma unroll
            for (int i = 0; i < 16; ++i) acc[i] = 0.f;
            for (int d4 = 0; d4 < 32; ++d4) { const f32x4 w4 = *(const LAS f32x4*)(wl + c * 132 + d4 * 4);
#pragma unroll
                for (int i = 0; i < 16; ++i) { const f32x4 k4 = *(const LAS f32x4*)(kl + (kq * 16 + i) * 132 + d4 * 4); acc[i] += (k4[0] * w4[0] + k4[1] * w4[1]) + (k4[2] * w4[2] + k4[3] * w4[3]); } }
            const float gn = p.in[I_FFGAIN][l * DM + c0 + c];
            bf16_t* dst = (bf16_t*)(p.ws + WS_WEFF) + ((size_t)l * PQ + s * 128 + kq * 16) * DM + c0 + c;
#pragma unroll
            for (int i = 0; i < 16; ++i) dst[(size_t)i * DM] = (bf16_t)(cvt_pk_bf16(acc[i] * gn, 0.f) & 0xffffu);
        }
    }
}

__device__ __forceinline__ int t5_bucket(int n) {
    if (n < 16) return n;
    const float v = logf((float)n / 16.0f) / 2.0794415416798357f * 16.0f;
    const int b = 16 + (int)v; return b < 31 ? b : 31;
}
__device__ __forceinline__ void phase_mix_simple(const Params& p, const Frame& F0, int l) {
    const Frame F = local_frame(F0);
    const int tid = F.tid, lane = F.lane, wave = F.wave;
    LAS float* Kf = (LAS float*)F.lds;
    LAS float* Vf = Kf + 256 * 64;
    LAS float* biasT = Vf + 256 * 64;
    LAS float* rs = biasT + 1024;
    const bf16_t* proj = (const bf16_t*)(p.ws + WS_PROJA);
    bf16_t* mix = (bf16_t*)(p.ws + WS_MIX);
    for (int nb = blockIdx.x; nb < NTOK / 128; nb += F.G) {
        const int t0 = nb * 128; const bool first = (nb % (SEQ / 128)) == 0;
        __syncthreads();
        for (int i = tid; i < 1024; i += NTHREADS) { const int h = i >> 7, dist = i & 127; biasT[i] = p.in[I_RELB][t5_bucket(dist) * 8 + h]; }
        for (int kvh = 0; kvh < 2; ++kvh) {
            __syncthreads();
            for (int c = tid; c < 2048; c += NTHREADS) { const int row = c >> 3, ch = c & 7; const int tok = t0 - 128 + row;
                u32x4 kv = (u32x4){0u, 0u, 0u, 0u}, vv = (u32x4){0u, 0u, 0u, 0u};
                if (row >= 128 || !first) { kv = *(const u32x4*)(proj + (size_t)tok * NA + COL_K + kvh * 64 + ch * 8); vv = *(const u32x4*)(proj + (size_t)tok * NA + COL_V + kvh * 64 + ch * 8); }
                LAS float* kd = Kf + row * 64 + ch * 8; LAS float* vd = Vf + row * 64 + ch * 8;
                kd[0] = bf_lo(kv.x); kd[1] = bf_hi(kv.x); kd[2] = bf_lo(kv.y); kd[3] = bf_hi(kv.y); kd[4] = bf_lo(kv.z); kd[5] = bf_hi(kv.z); kd[6] = bf_lo(kv.w); kd[7] = bf_hi(kv.w);
                vd[0] = bf_lo(vv.x); vd[1] = bf_hi(vv.x); vd[2] = bf_lo(vv.y); vd[3] = bf_hi(vv.y); vd[4] = bf_lo(vv.z); vd[5] = bf_hi(vv.z); vd[6] = bf_lo(vv.w); vd[7] = bf_hi(vv.w); }
            __syncthreads();
            const int hq = tid >> 7, qi = tid & 127, head = kvh * 4 + hq;
            float q[64], o[64];
            { const u32x4* qp = (const u32x4*)(proj + (size_t)(t0 + qi) * NA + head * 64);
#pragma unroll
              for (int j = 0; j < 8; ++j) { const u32x4 w = qp[j]; q[8 * j + 0] = bf_lo(w.x) * 0.125f; q[8 * j + 1] = bf_hi(w.x) * 0.125f; q[8 * j + 2] = bf_lo(w.y) * 0.125f; q[8 * j + 3] = bf_hi(w.y) * 0.125f;
                  q[8 * j + 4] = bf_lo(w.z) * 0.125f; q[8 * j + 5] = bf_hi(w.z) * 0.125f; q[8 * j + 6] = bf_lo(w.w) * 0.125f; q[8 * j + 7] = bf_hi(w.w) * 0.125f; } }
#pragma unroll
            for (int d = 0; d < 64; ++d) o[d] = 0.f;
            const float sink = p.in[I_SINK][l * 8 + head];
            float mrun = sink, lsum = 0.f;
            const int qb = qi & ~63, kmin = qb + 1, kmax = qb + 63 + 128;
            for (int kj = kmin; kj <= kmax; ++kj) {
                const LAS float* kr = Kf + kj * 64; float s = 0.f;
#pragma unroll
                for (int d4 = 0; d4 < 16; ++d4) { const f32x4 k4 = *(const LAS f32x4*)(kr + d4 * 4); s += (q[4 * d4] * k4[0] + q[4 * d4 + 1] * k4[1]) + (q[4 * d4 + 2] * k4[2] + q[4 * d4 + 3] * k4[3]); }
                const int dist = qi + 128 - kj; const bool valid = (dist >= 0) && (dist < 128) && (kj >= 128 || !first);
                const float logit = s + biasT[head * 128 + (dist & 127)];
                const float mnew = valid ? fmaxf(mrun, logit) : mrun;
                const float corr = __expf(mrun - mnew), pp = valid ? __expf(logit - mnew) : 0.f;
                lsum = lsum * corr + pp; mrun = mnew;
                const LAS float* vr = Vf + kj * 64;
#pragma unroll
                for (int d4 = 0; d4 < 16; ++d4) { const f32x4 v4 = *(const LAS f32x4*)(vr + d4 * 4);
                    o[4 * d4] = o[4 * d4] * corr + pp * v4[0]; o[4 * d4 + 1] = o[4 * d4 + 1] * corr + pp * v4[1]; o[4 * d4 + 2] = o[4 * d4 + 2] * corr + pp * v4[2]; o[4 * d4 + 3] = o[4 * d4 + 3] * corr + pp * v4[3]; }
            }
            const float inv = 1.0f / (lsum + __expf(sink - mrun));
            u32x4* op = (u32x4*)(mix + (size_t)(t0 + qi) * MIXW + head * 64);
#pragma unroll
            for (int j = 0; j < 8; ++j) { u32x4 w; w.x = cvt_pk_bf16(o[8 * j] * inv, o[8 * j + 1] * inv); w.y = cvt_pk_bf16(o[8 * j + 2] * inv, o[8 * j + 3] * inv);
                w.z = cvt_pk_bf16(o[8 * j + 4] * inv, o[8 * j + 5] * inv); w.w = cvt_pk_bf16(o[8 * j + 6] * inv, o[8 * j + 7] * inv); op[j] = w; }
        }
        LAS float* Zs = Kf;
        for (int g = 0; g < 4; ++g) {
            const int w = 2 << g;
            __syncthreads();
            for (int i = tid; i < 143 * 16; i += NTHREADS) { const int row = i >> 4, ch = i & 15; const int tok = t0 - 15 + row;
                u32x4 zv = (u32x4){0u, 0u, 0u, 0u};
                if (row >= 15 || !first) zv = *(const u32x4*)(proj + (size_t)tok * NA + COL_PZ + g * 128 + ch * 8);
                LAS float* zd = Zs + row * 128 + ch * 8;
                zd[0] = bf_lo(zv.x); zd[1] = bf_hi(zv.x); zd[2] = bf_lo(zv.y); zd[3] = bf_hi(zv.y); zd[4] = bf_lo(zv.z); zd[5] = bf_hi(zv.z); zd[6] = bf_lo(zv.w); zd[7] = bf_hi(zv.w); }
            __syncthreads();
            const int c = tid & 127, seg = tid >> 7;
            for (int tt = 0; tt < 32; ++tt) { const int t = seg * 32 + tt, r = t + 15; float sum = 0.f;
                for (int j = 0; j < w; ++j) sum += Zs[(r - j) * 128 + c];
                const int pos = (nb % (SEQ / 128)) * 128 + t; const int cnt = (pos + 1 < w) ? pos + 1 : w;
                const float d = sum / (float)cnt - Zs[r * 128 + c];
                mix[(size_t)(t0 + t) * MIXW + 512 + g * 128 + c] = (bf16_t)(cvt_pk_bf16(d, 0.f) & 0xffffu); }
        }
        __syncthreads();
        for (int tt = 0; tt < 16; ++tt) { const int t = wave * 16 + tt; const u32x4 g4 = *(const u32x4*)(proj + (size_t)(t0 + t) * NA + COL_GV + lane * 8);
            float a[8] = {bf_lo(g4.x), bf_hi(g4.x), bf_lo(g4.y), bf_hi(g4.y), bf_lo(g4.z), bf_hi(g4.z), bf_lo(g4.w), bf_hi(g4.w)}; float ss = 0.f;
#pragma unroll
            for (int j = 0; j < 8; ++j) ss += a[j] * a[j];
            ss = wave_sum(ss); if (lane == 0) rs[t] = 1.0f / sqrtf(ss * (1.0f / 512.0f) + EPS); }
        LAS float* Vn = Kf;
        for (int g = 0; g < 4; ++g) {
            __syncthreads();
            for (int i = tid; i < 128 * 16; i += NTHREADS) { const int s = i >> 4, ch = i & 15; const u32x4 g4 = *(const u32x4*)(proj + (size_t)(t0 + s) * NA + COL_GV + g * 128 + ch * 8);
                const float r = rs[s]; const float* gn = p.in[I_VGAIN] + l * 512 + g * 128 + ch * 8; LAS float* vd = Vn + s * 128 + ch * 8;
                vd[0] = bf_lo(g4.x) * r * gn[0]; vd[1] = bf_hi(g4.x) * r * gn[1]; vd[2] = bf_lo(g4.y) * r * gn[2]; vd[3] = bf_hi(g4.y) * r * gn[3];
                vd[4] = bf_lo(g4.z) * r * gn[4]; vd[5] = bf_hi(g4.z) * r * gn[5]; vd[6] = bf_lo(g4.w) * r * gn[6]; vd[7] = bf_hi(g4.w) * r * gn[7]; }
            __syncthreads();
            const int c = tid & 127, tq = tid >> 7;
            for (int t = tq; t < 128; t += 4) { const float* wrow = p.in[I_WSP] + (((size_t)l * 4 + g) * 128 + t) * 128; float acc = 0.f;
                for (int s = 0; s <= t; ++s) acc += wrow[s] * Vn[s * 128 + c];
                const float mixed = acc + p.in[I_BSP][(l * 4 + g) * 128 + t];
                const float uu = bf1(proj[(size_t)(t0 + t) * NA + COL_GU + g * 128 + c]);
                mix[(size_t)(t0 + t) * MIXW + 1024 + g * 128 + c] = (bf16_t)(cvt_pk_bf16(uu * mixed, 0.f) & 0xffffu); }
        }
    }
}

__device__ __forceinline__ unsigned ordkey(unsigned bits) { return bits ^ ((unsigned)((int)bits >> 31) | 0x80000000u); }
__device__ __forceinline__ unsigned unord(unsigned k) { return (k & 0x80000000u) ? (k ^ 0x80000000u) : ~k; }
__device__ __forceinline__ void phase_topk(const Params& p, const Frame& F0, int l) {
    const Frame F = local_frame(F0);
    const int lane = F.lane, wave = F.wave;
    LAS float* tile = (LAS float*)(F.lds + wave * 8448);
    LAS unsigned char* itab = (LAS unsigned char*)(F.lds + 8 * 8448 + wave * 64 * 36 + lane * 36);
    const float* scores = (const float*)(p.ws + WS_SCORES);
    const float* rowsq = (const float*)(p.ws + WS_ROWSQP) + (size_t)l * NTOK * 16;
    unsigned* seli = (unsigned*)(p.ws + WS_SELI); float* selg = (float*)(p.ws + WS_SELG);
    const int gw = blockIdx.x * NWAVES + wave, NGW = F.G * NWAVES;
    for (int grp = gw; grp < NTOK * 8 / 64; grp += NGW) {
        const size_t item0 = (size_t)grp * 64;
        unsigned L1[16], L2[16];
#pragma unroll
        for (int j = 0; j < 16; ++j) { L1[j] = 0u; L2[j] = 0u; }
#pragma unroll 1
        for (int ch = 0; ch < 8; ++ch) {
#pragma unroll
            for (int i = 0; i < 8; ++i) { const int row = 8 * i + (lane >> 3), cg = lane & 7;
                const f32x4 v = *(const f32x4*)(scores + (item0 + row) * 256 + ch * 32 + cg * 4);
                LAS float* d = tile + row * 33 + cg * 4; d[0] = v[0]; d[1] = v[1]; d[2] = v[2]; d[3] = v[3]; }
            __builtin_amdgcn_wave_barrier(); asm volatile("s_waitcnt lgkmcnt(0)" ::: "memory");
            if (ch < 4) {
#pragma unroll
                for (int j = 0; j < 32; ++j) { unsigned x = ordkey((__float_as_uint(tile[lane * 33 + j]) & 0xffffff80u) | (unsigned)(ch * 32 + j));
#pragma unroll
                    for (int k = 0; k < 16; ++k) { const unsigned hi = max(L1[k], x); x = min(L1[k], x); L1[k] = hi; } }
            } else {
#pragma unroll
                for (int j = 0; j < 32; ++j) { unsigned x = ordkey((__float_as_uint(tile[lane * 33 + j]) & 0xffffff80u) | (unsigned)((ch - 4) * 32 + j));
#pragma unroll
                    for (int k = 0; k < 16; ++k) { const unsigned hi = max(L2[k], x); x = min(L2[k], x); L2[k] = hi; } }
            }
            __builtin_amdgcn_wave_barrier(); asm volatile("s_waitcnt lgkmcnt(0)" ::: "memory");
        }
        float f1[16], f2[16];
#pragma unroll
        for (int k = 0; k < 16; ++k) { const unsigned b1 = unord(L1[k]), b2 = unord(L2[k]); f1[k] = __uint_as_float(b1); f2[k] = __uint_as_float(b2); itab[k] = (unsigned char)(b1 & 127u); itab[16 + k] = (unsigned char)(b2 & 127u); }
        unsigned T[16];
#pragma unroll
        for (int j = 0; j < 16; ++j) T[j] = 0u;
#pragma unroll
        for (int i = 0; i < 16; ++i)
#pragma unroll
            for (int j = 0; j < 16; ++j) if ((i + 1) * (j + 1) <= 16) {
                unsigned x = ordkey((__float_as_uint(f1[i] + f2[j]) & 0xffffff00u) | (unsigned)(i * 16 + j));
#pragma unroll
                for (int k = 0; k < 16; ++k) { const unsigned hi = max(T[k], x); x = min(T[k], x); T[k] = hi; } }
        asm volatile("s_waitcnt lgkmcnt(0)" ::: "memory");
        const size_t item = item0 + lane; const int tok = (int)(item >> 3);
        const float rstd = 1.0f / sqrtf(row_sumsq(rowsq, tok) * (1.0f / DM) + EPS);
        float e[16], se = 0.f; unsigned P[16];
        const float t0v = __uint_as_float(unord(T[0]));
#pragma unroll
        for (int k = 0; k < 16; ++k) { const unsigned b = unord(T[k]); e[k] = __expf((__uint_as_float(b) - t0v) * rstd); se += e[k];
            const unsigned code = b & 255u; P[k] = ((unsigned)itab[code >> 4] << 7) | (unsigned)itab[16 + (code & 15u)]; }
        const float inv = 1.0f / se;
        u32x4* di = (u32x4*)(seli + item * 16); f32x4* dg = (f32x4*)(selg + item * 16);
#pragma unroll
        for (int k4 = 0; k4 < 4; ++k4) { di[k4] = (u32x4){P[4 * k4], P[4 * k4 + 1], P[4 * k4 + 2], P[4 * k4 + 3]};
            dg[k4] = (f32x4){e[4 * k4] * inv, e[4 * k4 + 1] * inv, e[4 * k4 + 2] * inv, e[4 * k4 + 3] * inv}; }
        asm volatile("s_waitcnt lgkmcnt(0)" ::: "memory");
    }
}

__device__ __forceinline__ void phase_gather(const Params& p, const Frame& F0, int l) {
    const Frame F = local_frame(F0);
    const int lane = F.lane;
    const bf16_t* EU = (const bf16_t*)(p.ws + WS_EXPU); const bf16_t* EV = (const bf16_t*)(p.ws + WS_EXPV);
    bf16_t* xb = (bf16_t*)(p.ws + WS_XB);
    const float* rowsq = (const float*)(p.ws + WS_ROWSQP) + (size_t)l * NTOK * 16;
    const unsigned* seli = (const unsigned*)(p.ws + WS_SELI); const float* selg = (const float*)(p.ws + WS_SELG);
    const float* gain = p.in[I_FFGAIN] + l * DM;
    float gn[16];
#pragma unroll
    for (int j = 0; j < 2; ++j)
#pragma unroll
        for (int i = 0; i < 8; ++i) gn[j * 8 + i] = gain[j * 512 + lane * 8 + i];
    const int gw = blockIdx.x * NWAVES + F.wave, NGW = F.G * NWAVES;
    for (int tok = gw; tok < NTOK; tok += NGW) {
        float x1[16], h2[16], o[16];
        const float rstd = 1.0f / sqrtf(row_sumsq(rowsq, tok) * (1.0f / DM) + EPS);
#pragma unroll
        for (int j = 0; j < 2; ++j) { const u32x4 w = *(const u32x4*)(xb + (size_t)tok * DM + j * 512 + lane * 8);
            x1[8 * j + 0] = bf_lo(w.x); x1[8 * j + 1] = bf_hi(w.x); x1[8 * j + 2] = bf_lo(w.y); x1[8 * j + 3] = bf_hi(w.y); x1[8 * j + 4] = bf_lo(w.z); x1[8 * j + 5] = bf_hi(w.z); x1[8 * j + 6] = bf_lo(w.w); x1[8 * j + 7] = bf_hi(w.w); }
#pragma unroll
        for (int i = 0; i < 16; ++i) { h2[i] = x1[i] * rstd * gn[i]; o[i] = 0.f; }
        const unsigned myi0 = seli[(size_t)tok * 128 + lane], myi1 = seli[(size_t)tok * 128 + 64 + lane];
        const float myg0 = selg[(size_t)tok * 128 + lane], myg1 = selg[(size_t)tok * 128 + 64 + lane];
#pragma unroll 1
        for (int kb = 0; kb < 32; ++kb) {
            unsigned e[4]; float gt[4];
#pragma unroll
            for (int i = 0; i < 4; ++i) { const int k = kb * 4 + i;
                e[i] = (k < 64) ? __builtin_amdgcn_readlane(myi0, k & 63) : __builtin_amdgcn_readlane(myi1, k & 63);
                gt[i] = (k < 64) ? __uint_as_float(__builtin_amdgcn_readlane(__float_as_uint(myg0), k & 63)) : __uint_as_float(__builtin_amdgcn_readlane(__float_as_uint(myg1), k & 63)); }
            u32x4 uu[4][2], vv[4][2];
#pragma unroll
            for (int i = 0; i < 4; ++i)
#pragma unroll
                for (int j = 0; j < 2; ++j) { uu[i][j] = *(const u32x4*)(EU + (size_t)e[i] * DM + j * 512 + lane * 8); vv[i][j] = *(const u32x4*)(EV + (size_t)e[i] * DM + j * 512 + lane * 8); }
#pragma unroll
            for (int i = 0; i < 4; ++i) {
                float d = 0.f;
#pragma unroll
                for (int j = 0; j < 2; ++j) { const u32x4 w = uu[i][j];
                    d += (h2[8 * j + 0] * bf_lo(w.x) + h2[8 * j + 1] * bf_hi(w.x)) + (h2[8 * j + 2] * bf_lo(w.y) + h2[8 * j + 3] * bf_hi(w.y))
                       + (h2[8 * j + 4] * bf_lo(w.z) + h2[8 * j + 5] * bf_hi(w.z)) + (h2[8 * j + 6] * bf_lo(w.w) + h2[8 * j + 7] * bf_hi(w.w)); }
                d = wave_sum(d);
                const float cf = gt[i] * gelu_tanh(d);
#pragma unroll
                for (int j = 0; j < 2; ++j) { const u32x4 w = vv[i][j];
                    o[8 * j + 0] += cf * bf_lo(w.x); o[8 * j + 1] += cf * bf_hi(w.x); o[8 * j + 2] += cf * bf_lo(w.y); o[8 * j + 3] += cf * bf_hi(w.y);
                    o[8 * j + 4] += cf * bf_lo(w.z); o[8 * j + 5] += cf * bf_hi(w.z); o[8 * j + 6] += cf * bf_lo(w.w); o[8 * j + 7] += cf * bf_hi(w.w); }
            }
        }
        float ss = 0.f;
#pragma unroll
        for (int i = 0; i < 16; ++i) { o[i] += x1[i]; ss += o[i] * o[i]; }
        ss = wave_sum(ss);
        const float r2 = 1.0f / sqrtf(ss * (1.0f / DM) + EPS);
        if (l + 1 < DEPTH) {
#pragma unroll
            for (int j = 0; j < 2; ++j) { u32x4 w; w.x = cvt_pk_bf16(o[8 * j], o[8 * j + 1]); w.y = cvt_pk_bf16(o[8 * j + 2], o[8 * j + 3]); w.z = cvt_pk_bf16(o[8 * j + 4], o[8 * j + 5]); w.w = cvt_pk_bf16(o[8 * j + 6], o[8 * j + 7]);
                *(u32x4*)(xb + (size_t)tok * DM + j * 512 + lane * 8) = w; }
            if (lane == 0) ((float*)(p.ws + WS_RSTD))[(size_t)(l + 1) * NTOK + tok] = r2;
        } else {
            const float* fg = p.in[I_FGAIN];
#pragma unroll
            for (int j = 0; j < 2; ++j) { float* dst = p.out + (size_t)tok * DM + j * 512 + lane * 8; const f32x4 g0 = *(const f32x4*)(fg + j * 512 + lane * 8), g1 = *(const f32x4*)(fg + j * 512 + lane * 8 + 4);
                *(f32x4*)dst = (f32x4){o[8 * j] * r2 * g0[0], o[8 * j + 1] * r2 * g0[1], o[8 * j + 2] * r2 * g0[2], o[8 * j + 3] * r2 * g0[3]};
                *(f32x4*)(dst + 4) = (f32x4){o[8 * j + 4] * r2 * g1[0], o[8 * j + 5] * r2 * g1[1], o[8 * j + 6] * r2 * g1[2], o[8 * j + 7] * r2 * g1[3]}; }
        }
    }
}

constexpr int PH_PER_LAYER = 8, N_PHASES = 1 + DEPTH * PH_PER_LAYER;
__global__ void __launch_bounds__(NTHREADS, 2) mk_fwd(Params p) {
    extern __shared__ __attribute__((aligned(16))) unsigned char lds_raw[];
    Frame F; F.lds = (LAS unsigned char*)lds_raw; F.tid = threadIdx.x; F.lane = F.tid & 63; F.wave = __builtin_amdgcn_readfirstlane(F.tid >> 6);
    F.G = gridDim.x; { const int bx = blockIdx.x; F.vcu = (F.G % 8 == 0) ? (bx % 8) * (F.G / 8) + bx / 8 : bx; }
    volatile LAS unsigned* misc = (volatile LAS unsigned*)(F.lds + LDS_MISC);
    if (F.tid < 64) misc[F.tid] = 0u;
    __syncthreads();
    unsigned* ctl = (unsigned*)(p.ws + WS_CTL);
    XcdBarrier bar; bar.bar = ctl + CTL_BAR_WORD; bar.x = 0; bar.st = nullptr;
    const bool one_launch = (p.ph_hi - p.ph_lo) > 1;
    if (one_launch) bar = xcd_barrier_post(ctl + CTL_BAR_WORD, misc);
    const int lo = p.ph_lo, hi = p.ph_hi;
#define IN(k) (lo <= (k) && (k) < hi)
#define SEAM(k) do { if (IN(k) && IN((k) + 1)) xcd_barrier(bar); } while (0)
    bf16_t* xb = (bf16_t*)(p.ws + WS_XB);
    if (IN(0)) { phase_prologue(p, F); SEAM(0); }
    for (int l = 0; l < DEPTH; ++l) {
        const int b = 1 + l * PH_PER_LAYER;
        const float* rstd_a = (const float*)(p.ws + WS_RSTD) + (size_t)l * NTOK;
        if (IN(b + 0)) {
            pg8::Gemm g{xb, (const bf16_t*)(p.ws + WS_WTIN) + (size_t)l * NIN * DM, DM, DM, DM, 0, 0};
            pg8::TileOrder<1> S; S.init(NTOK, NA, F.G, (int)blockIdx.x);
            EpiProjA E{(bf16_t*)(p.ws + WS_PROJA), rstd_a};
            pg8::gemm_phase(F.lds, g, S, E); SEAM(b + 0);
        }
        if (IN(b + 1)) {
            phase_mix_simple(p, F, l);
            if (l > 0) convert_experts(p, F, l);
            SEAM(b + 1);
        }
        if (IN(b + 2)) {
            pg8::Gemm g{xb, (const bf16_t*)(p.ws + WS_WTIN) + ((size_t)l * NIN + NA) * DM, DM, DM, DM, 0, 0};
            pg8::TileOrder<1> S; S.init(NTOK, NG, F.G, (int)blockIdx.x);
            EpiGates E{(bf16_t*)(p.ws + WS_GATES), rstd_a, p.in[I_BGATE] + l * NG};
            pg8::gemm_phase(F.lds, g, S, E); SEAM(b + 2);
        }
        if (IN(b + 3)) {
            pg8::Gemm g{(const bf16_t*)(p.ws + WS_MIX), (const bf16_t*)(p.ws + WS_WTBR) + (size_t)l * 3 * DM * 512, MIXW, 512, 512, (size_t)512 * 2, (size_t)DM * 512 * 2};
            pg8::TileOrder<3> S; S.init(NTOK, DM, F.G, (int)blockIdx.x);
            EpiMerge E{(const bf16_t*)(p.ws + WS_GATES), (bf16_t*)p.out};
            pg8::gemm_phase(F.lds, g, S, E); SEAM(b + 3);
        }
        if (IN(b + 4)) {
            pg8::Gemm g{(const bf16_t*)p.out, (const bf16_t*)(p.ws + WS_WTOUT) + (size_t)l * DM * DM, DM, DM, DM, 0, 0};
            pg8::TileOrder<1> S; S.init(NTOK, DM, F.G, (int)blockIdx.x);
            EpiResid E{xb, (float*)(p.ws + WS_ROWSQP) + (size_t)l * NTOK * 16};
            pg8::gemm_phase(F.lds, g, S, E); SEAM(b + 4);
        }
        if (IN(b + 5)) {
            pg8::Gemm g{xb, (const bf16_t*)(p.ws + WS_WEFF) + (size_t)l * PQ * DM, DM, DM, DM, 0, 0};
            pg8::TileOrder<1> S; S.init(NTOK, PQ, F.G, (int)blockIdx.x);
            EpiScores E{(float*)(p.ws + WS_SCORES)};
            pg8::gemm_phase(F.lds, g, S, E); SEAM(b + 5);
        }
        if (IN(b + 6)) { phase_topk(p, F, l); SEAM(b + 6); }
        if (IN(b + 7)) { phase_gather(p, F, l); SEAM(b + 7); }
    }
#undef IN
#undef SEAM
}

extern "C" void kernel_launch(void* const* d_in, const int* in_sizes, int n_in, void* d_out, int out_size, void* d_ws, size_t ws_size, hipStream_t stream) {
    static int grid = 0;
    if (grid == 0) {
        if (n_in != 22 || out_size != NTOK * DM || ws_size < WS_END) { fprintf(stderr, "kernel_launch: unexpected shapes (n_in %d, out %d, ws %zu)\n", n_in, out_size, ws_size); grid = -1; return; }
        int dev = 0, cus = 0, per_cu = 0;
        if (hipGetDevice(&dev) != hipSuccess || hipDeviceGetAttribute(&cus, hipDeviceAttributeMultiprocessorCount, dev) != hipSuccess) { grid = -1; return; }
        if (hipFuncSetAttribute((const void*)mk_fwd, hipFuncAttributeMaxDynamicSharedMemorySize, LDS_BYTES) != hipSuccess) { fprintf(stderr, "kernel_launch: hipFuncSetAttribute failed\n"); grid = -1; return; }
        if (hipOccupancyMaxActiveBlocksPerMultiprocessor(&per_cu, (const void*)mk_fwd, NTHREADS, LDS_BYTES) != hipSuccess || per_cu < 1) { fprintf(stderr, "kernel_launch: occupancy query says %d\n", per_cu); }
        (void)hipGetLastError();
        grid = cus;
    }
    if (grid < 0) return;
    (void)hipMemsetAsync((char*)d_ws + WS_CTL, 0, CTL_ZERO_BYTES, stream);
    Params p; memset(&p, 0, sizeof(p));
    for (int i = 0; i < 22; ++i) p.in[i] = (const float*)d_in[i];
    p.out = (float*)d_out; p.ws = (unsigned char*)d_ws;
#if MK_N_LAUNCHES == 1
    p.ph_lo = 0; p.ph_hi = N_PHASES; p.li = 0;
    hipLaunchKernelGGL(mk_fwd, dim3(grid), dim3(NTHREADS), LDS_BYTES, stream, p);
#else
    for (int ph = 0; ph < N_PHASES; ++ph) { p.ph_lo = ph; p.ph_hi = ph + 1; p.li = ph; hipLaunchKernelGGL(mk_fwd, dim3(grid), dim3(NTHREADS), LDS_BYTES, stream, p); }
#endif
}
```

```cpp
#include <hip/hip_runtime.h>
#include <cstdio>
#include <cstdint>
#include <cstring>

#ifndef MK_N_LAUNCHES
#define MK_N_LAUNCHES 1
#endif

#define LAS __attribute__((address_space(3)))
typedef unsigned short bf16_t;
typedef short bf16x8 __attribute__((ext_vector_type(8)));
typedef float f32x4 __attribute__((ext_vector_type(4)));
typedef float f32x2 __attribute__((ext_vector_type(2)));
typedef unsigned u32x4 __attribute__((ext_vector_type(4)));
typedef unsigned u32x2 __attribute__((ext_vector_type(2)));
typedef __bf16 bf16x2_t __attribute__((ext_vector_type(2)));

constexpr int NTOK = 32768, DM = 1024, SEQ = 16384, DEPTH = 2;
constexpr int NA = 2304, NG = 3072, NIN = 5376;
constexpr int COL_K = 512, COL_V = 640, COL_PZ = 768, COL_GU = 1280, COL_GV = 1792;
constexpr int MIXW = 1536;
constexpr int NEXP = 16384, PQ = 2048;
constexpr float EPS = 1e-6f;
constexpr int NWAVES = 8, NTHREADS = 512;

constexpr size_t MiB = 1u << 20;
constexpr size_t WS_CTL = 0, CTL_ZERO_BYTES = 1 * MiB;
constexpr size_t CTL_BAR_WORD = 4096;
constexpr size_t CTL_ROWSQ = 256 * 1024;
constexpr size_t WS_RSTD = 1 * MiB;
constexpr size_t WS_WTIN = 2 * MiB;
constexpr size_t WS_WTBR = 23 * MiB;
constexpr size_t WS_WTOUT = 29 * MiB;
constexpr size_t WS_WEFF = 33 * MiB;
constexpr size_t WS_ROWSQP = 42 * MiB;
constexpr size_t WS_EXPU = 48 * MiB, WS_EXPV = 80 * MiB;
constexpr size_t WS_XB = 112 * MiB;
constexpr size_t WS_PROJA = 176 * MiB;
constexpr size_t WS_GATES = 176 * MiB;
constexpr size_t WS_MIX = 368 * MiB;
constexpr size_t WS_SCORES = 176 * MiB;
constexpr size_t WS_SELI = 464 * MiB, WS_SELG = 480 * MiB;
constexpr size_t WS_END = 496 * MiB;

constexpr int LDS_BYTES = 163840;
constexpr int LDS_MISC = LDS_BYTES - 256;

__device__ __forceinline__ unsigned cvt_pk_bf16(float lo, float hi) { unsigned r; asm volatile("v_cvt_pk_bf16_f32 %0, %1, %2" : "=v"(r) : "v"(lo), "v"(hi)); return r; }
__device__ __forceinline__ float bf_lo(unsigned u) { return __uint_as_float(u << 16); }
__device__ __forceinline__ float bf_hi(unsigned u) { return __uint_as_float(u & 0xffff0000u); }
__device__ __forceinline__ float bf1(bf16_t u) { return __uint_as_float(((unsigned)u) << 16); }
__device__ __forceinline__ float wave_sum(float v) {
#pragma unroll
    for (int o = 1; o < 64; o <<= 1) v += __shfl_xor(v, o);
    return v;
}
__device__ __forceinline__ float gelu_tanh(float x) {
    const float u = 0.7978845608028654f * (x + 0.044715f * x * x * x);
    const float e = __builtin_amdgcn_exp2f(-2.0f * 1.4426950408889634f * u);
    return x * __builtin_amdgcn_rcpf(1.0f + e);
}
__device__ __forceinline__ float row_sumsq(const float* part, int row) { const f32x4* q = (const f32x4*)(part + (size_t)row * 16); const f32x4 a = q[0], b = q[1], c = q[2], d = q[3];
    return (((a[0] + a[1]) + (a[2] + a[3])) + ((b[0] + b[1]) + (b[2] + b[3]))) + (((c[0] + c[1]) + (c[2] + c[3])) + ((d[0] + d[1]) + (d[2] + d[3]))); }
__device__ __forceinline__ float sigmoidf_(float x) { return __builtin_amdgcn_rcpf(1.0f + __builtin_amdgcn_exp2f(-1.4426950408889634f * x)); }

#define XB_TMO      128
#define XB_XCNT(j)  (256  + 64 * (j))
#define XB_XSUB(j)  (1280 + 64 * (j))
#define XB_XGEN(j)  (2304 + 64 * (j))
#define XB_TOP      3328
#define XB_TOPGEN   3392
#define XCD_BAR_WORDS 3456
#define XB_SPIN_CAP (1u << 18)
__device__ __forceinline__ unsigned xb_ld(unsigned* p)              { return __hip_atomic_load(p, __ATOMIC_RELAXED, __HIP_MEMORY_SCOPE_AGENT); }
__device__ __forceinline__ unsigned xb_add(unsigned* p, unsigned v) { return __hip_atomic_fetch_add(p, v, __ATOMIC_RELAXED, __HIP_MEMORY_SCOPE_AGENT); }
__device__ __forceinline__ unsigned xb_xcc_id() { return (unsigned)__builtin_amdgcn_s_getreg((3 << 11) | 20) & 0xFu; }
#define XB_SPIN(cond, bar) do { unsigned _sp = 0; while (cond) { __builtin_amdgcn_s_sleep(1); \
    if ((++_sp & 255u) == 0u) { if (xb_ld(&(bar)[XB_TMO])) break; if (_sp > XB_SPIN_CAP) { atomicAdd(&(bar)[XB_TMO], 1u); break; } } } } while (0)
struct XcdBarrier { unsigned* bar; unsigned x; volatile LAS unsigned* st; };
__device__ __forceinline__ XcdBarrier xcd_barrier_post(unsigned* bar, volatile LAS unsigned* st) {
    XcdBarrier b; b.bar = bar; b.x = xb_xcc_id(); b.st = st;
    if (threadIdx.x == 0) (void)xb_add(&bar[XB_XCNT(b.x)], 1u);
    return b;
}
__device__ __forceinline__ void xcd_barrier_complete(unsigned* bar, unsigned x, unsigned& nloc, unsigned& nx) {
    const unsigned G = gridDim.x * gridDim.y * gridDim.z;
    unsigned sum, cnt, mine, sp = 0u;
    for (;;) {
        sum = 0u; cnt = 0u; mine = 0u;
#pragma unroll
        for (unsigned j = 0; j < 16; ++j) { const unsigned c = xb_ld(&bar[XB_XCNT(j)]); sum += c; cnt += (c > 0u) ? 1u : 0u; mine = (j == x) ? c : mine; }
        if (sum == G) break;
        __builtin_amdgcn_s_sleep(1);
        if ((++sp & 255u) == 0u) { if (xb_ld(&bar[XB_TMO])) break; if (sp > XB_SPIN_CAP) { atomicAdd(&bar[XB_TMO], 1u); break; } }
    }
    nloc = mine > 0u ? mine : 1u; nx = cnt > 0u ? cnt : 1u;
}
__device__ __forceinline__ void xcd_barrier(const XcdBarrier& b) {
    asm volatile("s_waitcnt vmcnt(0)" ::: "memory");
    __syncthreads();
    if (threadIdx.x == 0) {
        unsigned* bar = b.bar;
        __builtin_amdgcn_s_waitcnt(0);
        unsigned nloc = b.st[0], nx = b.st[1];
        if (nloc == 0u) { xcd_barrier_complete(bar, b.x, nloc, nx); b.st[0] = nloc; b.st[1] = nx; }
        const unsigned old = xb_add(&bar[XB_XSUB(b.x)], 1u);
        const unsigned gen = old / nloc;
        if (old + 1u == (gen + 1u) * nloc) {
            __builtin_amdgcn_fence(__ATOMIC_RELEASE, "agent");
            asm volatile("s_waitcnt vmcnt(0)" ::: "memory");
            const unsigned og = xb_add(&bar[XB_TOP], 1u);
            const unsigned tg = og / nx;
            if (og + 1u == (tg + 1u) * nx) xb_add(&bar[XB_TOPGEN], 1u);
            else XB_SPIN(xb_ld(&bar[XB_TOPGEN]) == tg, bar);
            __builtin_amdgcn_fence(__ATOMIC_ACQUIRE, "agent");
            xb_add(&bar[XB_XGEN(b.x)], 1u);
            asm volatile("s_waitcnt vmcnt(0)" ::: "memory");
        } else {
            XB_SPIN(xb_ld(&bar[XB_XGEN(b.x)]) == gen, bar);
            __builtin_amdgcn_fence(__ATOMIC_ACQUIRE, "agent");
            asm volatile("s_waitcnt vmcnt(0)" ::: "memory");
        }
    }
    __syncthreads();
}

namespace pg8 {
constexpr int BM = 256, BK = 64, HALF = 128, HTB = HALF * BK * 2, STAGE_BYTES = 8 * HTB, NXCD = 8, WGM = 8;
__host__ __device__ __forceinline__ int lds_byte(int r, int c) { const int st = (r >> 4) * 2 + (c >> 5), rr = r & 15, cc = c & 31, ob = rr * 64 + cc * 2; return st * 1024 + (ob ^ (((ob >> 9) & 1) << 5)); }
__host__ __device__ __forceinline__ void stage_rc(int b, int& R, int& C) { const int st = b / 1024, sb = b % 1024, swz = sb ^ (((sb >> 9) & 1) << 5); R = (st >> 1) * 16 + swz / 64; C = (st & 1) * 32 + (swz % 64) / 2; }
__host__ __device__ __forceinline__ int perm32(int rho) { const int n = rho >> 4, i = rho & 15; return 8 * (i >> 2) + 4 * n + (i & 3); }

struct Unit { int pm, pn, z; };
struct Gemm { const bf16_t* A; const bf16_t* Bt; int lda, ldb, K; size_t az, bz; };

template <int ZN> struct TileOrder {
    int nM, nN, nwg, G, c;
    __device__ void init(int M, int N, int G_, int c_) { nM = M / BM; nN = N / BM; nwg = nM * nN; G = G_; c = c_; }
    __device__ bool next(int i, Unit& u) const {
        const long L = (long)(i / ZN) * G + c; if (L >= nwg) return false;
        int wgid = (int)L; { const int q = nwg / NXCD, r = nwg % NXCD, xcd = wgid % NXCD, off = wgid / NXCD; wgid = (xcd < r ? xcd * (q + 1) : r * (q + 1) + (xcd - r) * q) + off; }
        const int nig = WGM * nN, gid = wgid / nig, fm = gid * WGM, gsz = (nM - fm) < WGM ? (nM - fm) : WGM;
        u.pm = fm + ((wgid % nig) % gsz); u.pn = (wgid % nig) / gsz; u.z = i % ZN; return true;
    }
};

template <class Epi, class Sched>
__device__ __forceinline__ void gemm_phase(LAS unsigned char* lds, const Gemm g, const Sched& S, const Epi& E) {
    int tid_ = threadIdx.x; asm volatile("" : "+v"(tid_));
    const int tid = tid_, wid = __builtin_amdgcn_readfirstlane(tid >> 6), lane = tid & 63, wr = wid >> 2, wc = wid & 3, fr = lane & 15, fq = lane >> 4;
    const int K = g.K, nt = K / BK;
    unsigned voffA[2], voffB[2];
#pragma unroll
    for (int i = 0; i < 2; ++i) { int R, C; stage_rc(tid * 16 + i * 8192, R, C); const int Rb = Epi::PERM ? ((R & ~31) + perm32(R & 31)) : R;
        voffA[i] = (unsigned)(R * g.lda + C) * 2u; voffB[i] = (unsigned)(Rb * g.ldb + C) * 2u; }
    const size_t kstep = (size_t)(BK * 2);
    const size_t hstepA = (size_t)HALF * g.lda * 2, hstepB = (size_t)HALF * g.ldb * 2;
    const size_t tstepA = 2 * hstepA, tstepB = 2 * hstepB;
    const unsigned ldsw = (unsigned)wid * 1024u;
    const int aoff = lds_byte(wr * 64 + fr, fq * 8), boff = lds_byte(wc * 32 + fr, fq * 8);
#define PG8_SA(b, h) (((b) * 2 + (h)) * HTB)
#define PG8_SB(b, h) ((4 + (b) * 2 + (h)) * HTB)
#define PG8_STAGE(bufoff, gbase, voff) do { _Pragma("unroll") for (int _i = 0; _i < 2; ++_i) \
        __builtin_amdgcn_global_load_lds((const unsigned*)((const char*)(gbase) + (voff)[_i]), (LAS unsigned*)(lds + (bufoff) + ldsw + _i * 8192), 16, 0, 0); } while (0)
#define PG8_LDA(dst, b, h) do { _Pragma("unroll") for (int m = 0; m < 4; ++m) _Pragma("unroll") for (int k = 0; k < 2; ++k) dst[m][k] = *(const LAS bf16x8*)(lds + PG8_SA(b, h) + aoff + m * 2048 + k * 1024); } while (0)
#define PG8_LDB(dst, b, h) do { _Pragma("unroll") for (int n = 0; n < 2; ++n) _Pragma("unroll") for (int k = 0; k < 2; ++k) dst[n][k] = *(const LAS bf16x8*)(lds + PG8_SB(b, h) + boff + n * 2048 + k * 1024); } while (0)
#define PG8_MMA(ai, bj, At, Bt) do { __builtin_amdgcn_s_setprio(1); _Pragma("unroll") for (int m = 0; m < 4; ++m) _Pragma("unroll") for (int n = 0; n < 2; ++n) _Pragma("unroll") for (int k = 0; k < 2; ++k) \
        acc[ai][bj][m][n] = __builtin_amdgcn_mfma_f32_16x16x32_bf16(Bt[n][k], At[m][k], acc[ai][bj][m][n], 0, 0, 0); __builtin_amdgcn_s_setprio(0); } while (0)
#define PG8_WAIT_V(n) asm volatile("s_waitcnt vmcnt(" #n ")" ::: "memory")
#define PG8_WAIT_L(n) asm volatile("s_waitcnt lgkmcnt(" #n ")" ::: "memory")
#define PG8_BAR __builtin_amdgcn_s_barrier()
#define PG8_SCHED __builtin_amdgcn_sched_barrier(0)
    Unit cur, nxt; int ui = 0;
    if (!S.next(0, cur)) return;
    f32x4 acc[2][2][4][2];
#pragma unroll
    for (int a = 0; a < 2; ++a)
#pragma unroll
        for (int b = 0; b < 2; ++b)
#pragma unroll
            for (int m = 0; m < 4; ++m)
#pragma unroll
                for (int n = 0; n < 2; ++n) acc[a][b][m][n] = (f32x4){0.f, 0.f, 0.f, 0.f};
    bf16x8 At[4][2], B0[2][2], B1[2][2];
    const char* cA = (const char*)g.A + (size_t)cur.pm * tstepA + (size_t)cur.z * g.az; const char* cB = (const char*)g.Bt + (size_t)cur.pn * tstepB + (size_t)cur.z * g.bz;
    PG8_STAGE(PG8_SB(0, 0), cB, voffB); PG8_STAGE(PG8_SB(0, 1), cB + hstepB, voffB); PG8_STAGE(PG8_SA(0, 0), cA, voffA); PG8_STAGE(PG8_SA(0, 1), cA + hstepA, voffA);
    if (wr == 1) PG8_BAR;
    PG8_WAIT_V(2); PG8_BAR;
    PG8_STAGE(PG8_SB(1, 0), cB + kstep, voffB); PG8_STAGE(PG8_SA(1, 0), cA + kstep, voffA); PG8_STAGE(PG8_SB(1, 1), cB + hstepB + kstep, voffB);
    PG8_WAIT_V(6); PG8_BAR;
    for (;;) {
        const bool has_next = S.next(ui + 1, nxt);
        const char* nA = has_next ? (const char*)g.A + (size_t)nxt.pm * tstepA + (size_t)nxt.z * g.az : cA;
        const char* nB = has_next ? (const char*)g.Bt + (size_t)nxt.pn * tstepB + (size_t)nxt.z * g.bz : cB;
        for (int t = 0; t < nt; t += 2) {
            const bool last = (t == nt - 2);
            const char* a1 = cA + (size_t)(t + 1) * kstep;
            const char* a2 = last ? nA : cA + (size_t)(t + 2) * kstep; const char* b2 = last ? nB : cB + (size_t)(t + 2) * kstep;
            const char* a3 = a2 + kstep; const char* b3 = b2 + kstep;
            PG8_LDB(B0, 0, 0); PG8_LDB(B1, 0, 1); PG8_SCHED; PG8_LDA(At, 0, 0); PG8_STAGE(PG8_SA(1, 1), a1 + hstepA, voffA);
            PG8_WAIT_V(8); PG8_WAIT_L(0); PG8_BAR; PG8_MMA(0, 0, At, B0); PG8_MMA(0, 1, At, B1); PG8_BAR; PG8_SCHED;
            PG8_LDA(At, 0, 1); PG8_STAGE(PG8_SB(0, 0), b2, voffB); PG8_STAGE(PG8_SB(0, 1), b2 + hstepB, voffB); PG8_STAGE(PG8_SA(0, 0), a2, voffA);
            PG8_WAIT_V(8); PG8_WAIT_L(0); PG8_BAR; PG8_MMA(1, 0, At, B0); PG8_MMA(1, 1, At, B1); PG8_BAR; PG8_SCHED;
            PG8_LDB(B0, 1, 0); PG8_LDB(B1, 1, 1); PG8_SCHED; PG8_LDA(At, 1, 0); PG8_STAGE(PG8_SA(0, 1), a2 + hstepA, voffA);
            PG8_WAIT_V(8); PG8_WAIT_L(0); PG8_BAR; PG8_MMA(0, 0, At, B0); PG8_MMA(0, 1, At, B1); PG8_BAR; PG8_SCHED;
            PG8_LDA(At, 1, 1); PG8_STAGE(PG8_SB(1, 0), b3, voffB); PG8_STAGE(PG8_SB(1, 1), b3 + hstepB, voffB); PG8_STAGE(PG8_SA(1, 0), a3, voffA);
            PG8_WAIT_V(8); PG8_WAIT_L(0); PG8_BAR; PG8_MMA(1, 0, At, B0); PG8_MMA(1, 1, At, B1); PG8_BAR; PG8_SCHED;
        }
        if (wr == 0) PG8_BAR;
        E(acc, cur, wr, wc, fr, fq);
        if (!has_next) break;
        if (!E.keep(cur)) {
#pragma unroll
            for (int a = 0; a < 2; ++a)
#pragma unroll
                for (int b = 0; b < 2; ++b)
#pragma unroll
                    for (int m = 0; m < 4; ++m)
#pragma unroll
                        for (int n = 0; n < 2; ++n) acc[a][b][m][n] = (f32x4){0.f, 0.f, 0.f, 0.f};
        }
        cur = nxt; cA = nA; cB = nB; ++ui;
        if (wr == 1) PG8_BAR;
    }
    PG8_WAIT_V(0);
    PG8_BAR;
#undef PG8_SA
#undef PG8_SB
#undef PG8_STAGE
#undef PG8_LDA
#undef PG8_LDB
#undef PG8_MMA
#undef PG8_WAIT_V
#undef PG8_WAIT_L
#undef PG8_BAR
#undef PG8_SCHED
}
}
typedef pg8::Unit Unit;
typedef f32x4 AccT[2][2][4][2];

struct EpiProjA {
    static constexpr bool PERM = true;
    bf16_t* O; const float* rstd;
    __device__ __forceinline__ bool keep(const Unit&) const { return false; }
    __device__ __forceinline__ void operator()(AccT& acc, const Unit& u, int wr, int wc, int fr, int fq) const {
        const int row0 = u.pm * 256 + wr * 64 + fr, col0 = u.pn * 256 + wc * 32 + 8 * fq;
        const bool act = (u.pn >= 5);
#pragma unroll
        for (int ai = 0; ai < 2; ++ai)
#pragma unroll
            for (int m = 0; m < 4; ++m) { const int row = row0 + ai * 128 + m * 16; const float rs = rstd[row]; bf16_t* rowp = O + (size_t)row * NA + col0;
#pragma unroll
                for (int bj = 0; bj < 2; ++bj) { f32x4 v0 = acc[ai][bj][m][0] * rs, v1 = acc[ai][bj][m][1] * rs;
                    if (act) {
#pragma unroll
                        for (int j = 0; j < 4; ++j) { v0[j] = gelu_tanh(v0[j]); v1[j] = gelu_tanh(v1[j]); } }
                    u32x4 w; w.x = cvt_pk_bf16(v0[0], v0[1]); w.y = cvt_pk_bf16(v0[2], v0[3]); w.z = cvt_pk_bf16(v1[0], v1[1]); w.w = cvt_pk_bf16(v1[2], v1[3]);
                    *(u32x4*)(rowp + bj * 128) = w; } }
    }
};
struct EpiGates {
    static constexpr bool PERM = true;
    bf16_t* O; const float* rstd; const float* bias;
    __device__ __forceinline__ bool keep(const Unit&) const { return false; }
    __device__ __forceinline__ void operator()(AccT& acc, const Unit& u, int wr, int wc, int fr, int fq) const {
        const int row0 = u.pm * 256 + wr * 64 + fr, col0 = u.pn * 256 + wc * 32 + 8 * fq;
        f32x4 bv[2][2];
#pragma unroll
        for (int bj = 0; bj < 2; ++bj)
#pragma unroll
            for (int n = 0; n < 2; ++n) bv[bj][n] = *(const f32x4*)(bias + col0 + bj * 128 + 4 * n);
#pragma unroll
        for (int ai = 0; ai < 2; ++ai)
#pragma unroll
            for (int m = 0; m < 4; ++m) { const int row = row0 + ai * 128 + m * 16; const float rs = rstd[row]; bf16_t* rowp = O + (size_t)row * NG + col0;
#pragma unroll
                for (int bj = 0; bj < 2; ++bj) { f32x4 v0 = acc[ai][bj][m][0] * rs + bv[bj][0], v1 = acc[ai][bj][m][1] * rs + bv[bj][1];
#pragma unroll
                    for (int j = 0; j < 4; ++j) { v0[j] = sigmoidf_(v0[j]); v1[j] = sigmoidf_(v1[j]); }
                    u32x4 w; w.x = cvt_pk_bf16(v0[0], v0[1]); w.y = cvt_pk_bf16(v0[2], v0[3]); w.z = cvt_pk_bf16(v1[0], v1[1]); w.w = cvt_pk_bf16(v1[2], v1[3]);
                    *(u32x4*)(rowp + bj * 128) = w; } }
    }
};
struct EpiMerge {
    static constexpr bool PERM = true;
    const bf16_t* gates; bf16_t* O;
    __device__ __forceinline__ bool keep(const Unit& u) const { return u.z < 2; }
    __device__ __forceinline__ void operator()(AccT& acc, const Unit& u, int wr, int wc, int fr, int fq) const {
        const int row0 = u.pm * 256 + wr * 64 + fr, col0 = u.pn * 256 + wc * 32 + 8 * fq;
        const int z = u.z;
#pragma unroll
        for (int ai = 0; ai < 2; ++ai)
#pragma unroll
            for (int m = 0; m < 4; ++m) { const int row = row0 + ai * 128 + m * 16;
#pragma unroll
                for (int bj = 0; bj < 2; ++bj) { const int col = col0 + bj * 128; const bf16_t* gp = gates + (size_t)row * NG + col;
                    float f[8];
                    if (z == 2) { const u32x4 a = *(const u32x4*)(gp + 2048);
                        f[0] = bf_lo(a.x); f[1] = bf_hi(a.x); f[2] = bf_lo(a.y); f[3] = bf_hi(a.y); f[4] = bf_lo(a.z); f[5] = bf_hi(a.z); f[6] = bf_lo(a.w); f[7] = bf_hi(a.w);
#pragma unroll
                        for (int j = 0; j < 8; ++j) f[j] = fmaxf(f[j], 1e-20f);
                    } else { const u32x4 a = *(const u32x4*)(gp + z * 1024), b = *(const u32x4*)(gp + (z + 1) * 1024);
                        float ga[8], gb[8];
                        ga[0] = bf_lo(a.x); ga[1] = bf_hi(a.x); ga[2] = bf_lo(a.y); ga[3] = bf_hi(a.y); ga[4] = bf_lo(a.z); ga[5] = bf_hi(a.z); ga[6] = bf_lo(a.w); ga[7] = bf_hi(a.w);
                        gb[0] = bf_lo(b.x); gb[1] = bf_hi(b.x); gb[2] = bf_lo(b.y); gb[3] = bf_hi(b.y); gb[4] = bf_lo(b.z); gb[5] = bf_hi(b.z); gb[6] = bf_lo(b.w); gb[7] = bf_hi(b.w);
#pragma unroll
                        for (int j = 0; j < 8; ++j) { const float num = (z == 0) ? ga[j] : fmaxf(ga[j], 1e-20f); f[j] = num * __builtin_amdgcn_rcpf(fmaxf(gb[j], 1e-20f)); } }
                    f32x4 v0 = acc[ai][bj][m][0], v1 = acc[ai][bj][m][1];
                    v0[0] *= f[0]; v0[1] *= f[1]; v0[2] *= f[2]; v0[3] *= f[3]; v1[0] *= f[4]; v1[1] *= f[5]; v1[2] *= f[6]; v1[3] *= f[7];
                    acc[ai][bj][m][0] = v0; acc[ai][bj][m][1] = v1;
                    if (z == 2) { u32x4 w; w.x = cvt_pk_bf16(v0[0], v0[1]); w.y = cvt_pk_bf16(v0[2], v0[3]); w.z = cvt_pk_bf16(v1[0], v1[1]); w.w = cvt_pk_bf16(v1[2], v1[3]);
                        *(u32x4*)(O + (size_t)row * DM + col) = w; } } }
    }
};
struct EpiResid {
    static constexpr bool PERM = true;
    bf16_t* X; float* rowsq;
    __device__ __forceinline__ bool keep(const Unit&) const { return false; }
    __device__ __forceinline__ void operator()(AccT& acc, const Unit& u, int wr, int wc, int fr, int fq) const {
        const int row0 = u.pm * 256 + wr * 64 + fr, col0 = u.pn * 256 + wc * 32 + 8 * fq;
#pragma unroll
        for (int ai = 0; ai < 2; ++ai)
#pragma unroll
            for (int m = 0; m < 4; ++m) { const int row = row0 + ai * 128 + m * 16; bf16_t* rowp = X + (size_t)row * DM + col0; float ss = 0.f;
#pragma unroll
                for (int bj = 0; bj < 2; ++bj) { const u32x4 x = *(const u32x4*)(rowp + bj * 128);
                    f32x4 v0 = acc[ai][bj][m][0], v1 = acc[ai][bj][m][1];
                    v0[0] += bf_lo(x.x); v0[1] += bf_hi(x.x); v0[2] += bf_lo(x.y); v0[3] += bf_hi(x.y); v1[0] += bf_lo(x.z); v1[1] += bf_hi(x.z); v1[2] += bf_lo(x.w); v1[3] += bf_hi(x.w);
                    ss += (v0[0] * v0[0] + v0[1] * v0[1]) + (v0[2] * v0[2] + v0[3] * v0[3]) + (v1[0] * v1[0] + v1[1] * v1[1]) + (v1[2] * v1[2] + v1[3] * v1[3]);
                    u32x4 w; w.x = cvt_pk_bf16(v0[0], v0[1]); w.y = cvt_pk_bf16(v0[2], v0[3]); w.z = cvt_pk_bf16(v1[0], v1[1]); w.w = cvt_pk_bf16(v1[2], v1[3]);
                    *(u32x4*)(rowp + bj * 128) = w; }
                ss += __shfl_xor(ss, 16); ss += __shfl_xor(ss, 32);
                if (fq == 0) rowsq[(size_t)row * 16 + u.pn * 4 + wc] = ss; }
    }
};
struct EpiScores {
    static constexpr bool PERM = false;
    float* C;
    __device__ __forceinline__ bool keep(const Unit&) const { return false; }
    __device__ __forceinline__ void operator()(AccT& acc, const Unit& u, int wr, int wc, int fr, int fq) const {
        const int row0 = u.pm * 256 + wr * 64 + fr, col0 = u.pn * 256 + wc * 32 + 4 * fq;
#pragma unroll
        for (int ai = 0; ai < 2; ++ai)
#pragma unroll
            for (int m = 0; m < 4; ++m) { float* rowp = C + (size_t)(row0 + ai * 128 + m * 16) * PQ + col0;
#pragma unroll
                for (int bj = 0; bj < 2; ++bj)
#pragma unroll
                    for (int n = 0; n < 2; ++n) *(f32x4*)(rowp + bj * 128 + n * 16) = acc[ai][bj][m][n]; }
    }
};

struct Params {
    const float* in[22];
    float* out; unsigned char* ws;
    int ph_lo, ph_hi, li, pad;
};
enum { I_X = 0, I_RELB, I_FGAIN, I_AGAIN, I_WIN, I_BGATE, I_SINK, I_WPOOL, I_PSCALE, I_VGAIN, I_WSP, I_BSP, I_WA, I_WB, I_WC, I_WOUT, I_FFGAIN, I_WQ, I_K1, I_K2, I_EU, I_EV };

struct Frame { LAS unsigned char* lds; int tid, lane, wave, G, vcu; };
__device__ __forceinline__ Frame local_frame(const Frame& F0) { Frame F = F0; int t = threadIdx.x; asm volatile("" : "+v"(t)); F.tid = t; F.lane = t & 63; F.wave = __builtin_amdgcn_readfirstlane(t >> 6); return F; }

__device__ __forceinline__ void p0_transpose_item(const float* W, int N, bf16_t* WT, int ldo, const float* kscale, LAS float* scr, int item, int lane) {
    const int nblk = N / 32, kb = item / nblk, nb = item % nblk, k0 = 64 * kb, n0 = 32 * nb;
#pragma unroll 8
    for (int i = 0; i < 32; ++i) { const int kk = 2 * i + (lane >> 5); float v = W[(size_t)(k0 + kk) * N + n0 + (lane & 31)]; if (kscale) v *= kscale[k0 + kk]; scr[kk * 33 + (lane & 31)] = v; }
    asm volatile("s_waitcnt lgkmcnt(0)" ::: "memory");
    const int c = lane & 7;
#pragma unroll
    for (int j = 0; j < 4; ++j) { const int n = (lane >> 3) + 8 * j; const LAS float* s = scr + (8 * c) * 33 + n;
        u32x4 o; o.x = cvt_pk_bf16(s[0 * 33], s[1 * 33]); o.y = cvt_pk_bf16(s[2 * 33], s[3 * 33]); o.z = cvt_pk_bf16(s[4 * 33], s[5 * 33]); o.w = cvt_pk_bf16(s[6 * 33], s[7 * 33]);
        *(u32x4*)(WT + (size_t)(n0 + n) * ldo + k0 + 8 * c) = o; }
    asm volatile("s_waitcnt lgkmcnt(0)" ::: "memory");
}
__device__ __forceinline__ void convert_experts(const Params& p, const Frame& F, int l) {
    const size_t n8 = (size_t)NEXP * DM / 8, stride = (size_t)F.G * NTHREADS;
    const f32x4* su = (const f32x4*)(p.in[I_EU] + (size_t)l * NEXP * DM); const f32x4* sv = (const f32x4*)(p.in[I_EV] + (size_t)l * NEXP * DM);
    u32x4* du = (u32x4*)(p.ws + WS_EXPU); u32x4* dv = (u32x4*)(p.ws + WS_EXPV);
    for (size_t i = (size_t)blockIdx.x * NTHREADS + F.tid; i < n8; i += stride) {
        const f32x4 a = su[2 * i], b = su[2 * i + 1], c = sv[2 * i], d = sv[2 * i + 1];
        u32x4 w; w.x = cvt_pk_bf16(a[0], a[1]); w.y = cvt_pk_bf16(a[2], a[3]); w.z = cvt_pk_bf16(b[0], b[1]); w.w = cvt_pk_bf16(b[2], b[3]); du[i] = w;
        u32x4 y; y.x = cvt_pk_bf16(c[0], c[1]); y.y = cvt_pk_bf16(c[2], c[3]); y.z = cvt_pk_bf16(d[0], d[1]); y.w = cvt_pk_bf16(d[2], d[3]); dv[i] = y;
    }
}
__device__ __forceinline__ void phase_prologue(const Params& p, const Frame& F0) {
    const Frame F = local_frame(F0);
    const int gw = F.vcu * NWAVES + F.wave, NGW = F.G * NWAVES, lane = F.lane;
    LAS float* scr = (LAS float*)(F.lds + F.wave * 16384);
    constexpr int I_IN = (DM / 64) * (NIN / 32), I_BR = (512 / 64) * (DM / 32), I_OUT = (DM / 64) * (DM / 32);
    constexpr int PER_L = I_IN + 2 * I_BR + I_OUT;
    for (int it = gw; it < DEPTH * PER_L; it += NGW) {
        const int l = it / PER_L; int r = it % PER_L;
        if (r < I_IN) { p0_transpose_item(p.in[I_WIN] + (size_t)l * DM * NIN, NIN, (bf16_t*)(p.ws + WS_WTIN) + (size_t)l * NIN * DM, DM, p.in[I_AGAIN] + l * DM, scr, r, lane); continue; } r -= I_IN;
        if (r < I_BR) { p0_transpose_item(p.in[I_WA] + (size_t)l * 512 * DM, DM, (bf16_t*)(p.ws + WS_WTBR) + (size_t)(l * 3 + 0) * DM * 512, 512, nullptr, scr, r, lane); continue; } r -= I_BR;
        if (r < I_BR) { p0_transpose_item(p.in[I_WC] + (size_t)l * 512 * DM, DM, (bf16_t*)(p.ws + WS_WTBR) + (size_t)(l * 3 + 2) * DM * 512, 512, nullptr, scr, r, lane); continue; } r -= I_BR;
        p0_transpose_item(p.in[I_WOUT] + (size_t)l * DM * DM, DM, (bf16_t*)(p.ws + WS_WTOUT) + (size_t)l * DM * DM, DM, nullptr, scr, r, lane);
    }
    {
        float* rstd = (float*)(p.ws + WS_RSTD);
        for (int m = gw; m < NTOK; m += NGW) {
            const f32x4* xr = (const f32x4*)(p.in[I_X] + (size_t)m * DM) + lane; f32x4 v[4]; float s = 0.f;
#pragma unroll
            for (int j = 0; j < 4; ++j) { v[j] = xr[64 * j]; s += (v[j][0] * v[j][0] + v[j][1] * v[j][1]) + (v[j][2] * v[j][2] + v[j][3] * v[j][3]); }
            s = wave_sum(s);
            u32x2* o = (u32x2*)((bf16_t*)(p.ws + WS_XB) + (size_t)m * DM) + lane;
#pragma unroll
            for (int j = 0; j < 4; ++j) { u32x2 w; w.x = cvt_pk_bf16(v[j][0], v[j][1]); w.y = cvt_pk_bf16(v[j][2], v[j][3]); o[64 * j] = w; }
            if (lane == 0) rstd[m] = 1.0f / sqrtf(s * (1.0f / DM) + EPS);
        }
    }
    convert_experts(p, F, 0);
    __syncthreads();
    {
        LAS float* coef = (LAS float*)F.lds;
        for (int u = blockIdx.x; u < DEPTH * 4 * 16; u += F.G) {
            const int l = u / 64, g = (u / 16) % 4, c0 = (u % 16) * 8;
            __syncthreads();
            for (int i = F.tid; i < 1024; i += NTHREADS) { const int cc = i >> 7, j = i & 127;
                coef[i] = p.in[I_WPOOL][(((size_t)l * 4 + g) * 128 + c0 + cc) * 128 + j] * p.in[I_PSCALE][l * 512 + g * 128 + j]; }
            __syncthreads();
            const float* wb = p.in[I_WB] + ((size_t)l * 512 + g * 128) * DM;
            float a0[8], a1[8];
#pragma unroll
            for (int cc = 0; cc < 8; ++cc) { a0[cc] = 0.f; a1[cc] = 0.f; }
            for (int j = 0; j < 128; ++j) { const float w0 = wb[(size_t)j * DM + F.tid], w1 = wb[(size_t)j * DM + F.tid + 512];
#pragma unroll
                for (int cc = 0; cc < 8; ++cc) { const float cf = coef[cc * 128 + j]; a0[cc] += cf * w0; a1[cc] += cf * w1; } }
            bf16_t* dst = (bf16_t*)(p.ws + WS_WTBR) + (size_t)(l * 3 + 1) * DM * 512 + g * 128 + c0;
            u32x4 w; w.x = cvt_pk_bf16(a0[0], a0[1]); w.y = cvt_pk_bf16(a0[2], a0[3]); w.z = cvt_pk_bf16(a0[4], a0[5]); w.w = cvt_pk_bf16(a0[6], a0[7]);
            *(u32x4*)(dst + (size_t)F.tid * 512) = w;
            u32x4 y; y.x = cvt_pk_bf16(a1[0], a1[1]); y.y = cvt_pk_bf16(a1[2], a1[3]); y.z = cvt_pk_bf16(a1[4], a1[5]); y.w = cvt_pk_bf16(a1[6], a1[7]);
            *(u32x4*)(dst + (size_t)(F.tid + 512) * 512) = y;
        }
    }
    {
        LAS float* kl = (LAS float*)F.lds;
        LAS float* wl = kl + 128 * 132;
        for (int u = blockIdx.x; u < DEPTH * 16 * 16; u += F.G) {
            const int l = u / 256, s = (u / 16) % 16, c0 = (u % 16) * 64;
            const float* keys = ((s & 1) ? p.in[I_K2] : p.in[I_K1]) + (size_t)l * 128 * 128;
            const float* wq = p.in[I_WQ] + (size_t)l * DM * PQ;
            __syncthreads();
            for (int i = F.tid; i < 128 * 32; i += NTHREADS) { const int r = i >> 5, q = i & 31; *(LAS f32x4*)(kl + r * 132 + q * 4) = *(const f32x4*)(keys + r * 128 + q * 4); }
            for (int i = F.tid; i < 64 * 32; i += NTHREADS) { const int r = i >> 5, q = i & 31; *(LAS f32x4*)(wl + r * 132 + q * 4) = *(const f32x4*)(wq + (size_t)(c0 + r) * PQ + s * 128 + q * 4); }
            __syncthreads();
            const int c = F.tid & 63, kq = F.wave;
            float acc[16];
#pragma unroll
            for (int i = 0; i < 16; ++i) acc[i] = 0.f;
            for (int d4 = 0; d4 < 32; ++d4) { const f32x4 w4 = *(const LAS f32x4*)(wl + c * 132 + d4 * 4);
#pragma unroll
                for (int i = 0; i < 16; ++i) { const f32x4 k4 = *(const LAS f32x4*)(kl + (kq * 16 + i) * 132 + d4 * 4); acc[i] += (k4[0] * w4[0] + k4[1] * w4[1]) + (k4[2] * w4[2] + k4[3] * w4[3]); } }
            const float gn = p.in[I_FFGAIN][l * DM + c0 + c];
            bf16_t* dst = (bf16_t*)(p.ws + WS_WEFF) + ((size_t)l * PQ + s * 128 + kq * 16) * DM + c0 + c;
#pragma unroll
            for (int i = 0; i < 16; ++i) dst[(size_t)i * DM] = (bf16_t)(cvt_pk_bf16(acc[i] * gn, 0.f) & 0xffffu);
        }
    }
}

__device__ __forceinline__ int t5_bucket(int n) {
    if (n < 16) return n;
    const float v = logf((float)n / 16.0f) / 2.0794415416798357f * 16.0f;
    const int b = 16 + (int)v; return b < 31 ? b : 31;
}
__device__ __forceinline__ void phase_mix_simple(const Params& p, const Frame& F0, int l) {
    const Frame F = local_frame(F0);
    const int tid = F.tid, lane = F.lane, wave = F.wave;
    LAS float* Kf = (LAS float*)F.lds;
    LAS float* Vf = Kf + 256 * 64;
    LAS float* biasT = Vf + 256 * 64;
    LAS float* rs = biasT + 1024;
    const bf16_t* proj = (const bf16_t*)(p.ws + WS_PROJA);
    bf16_t* mix = (bf16_t*)(p.ws + WS_MIX);
    for (int nb = blockIdx.x; nb < NTOK / 128; nb += F.G) {
        const int t0 = nb * 128; const bool first = (nb % (SEQ / 128)) == 0;
        __syncthreads();
        for (int i = tid; i < 1024; i += NTHREADS) { const int h = i >> 7, dist = i & 127; biasT[i] = p.in[I_RELB][t5_bucket(dist) * 8 + h]; }
        for (int kvh = 0; kvh < 2; ++kvh) {
            __syncthreads();
            for (int c = tid; c < 2048; c += NTHREADS) { const int row = c >> 3, ch = c & 7; const int tok = t0 - 128 + row;
                u32x4 kv = (u32x4){0u, 0u, 0u, 0u}, vv = (u32x4){0u, 0u, 0u, 0u};
                if (row >= 128 || !first) { kv = *(const u32x4*)(proj + (size_t)tok * NA + COL_K + kvh * 64 + ch * 8); vv = *(const u32x4*)(proj + (size_t)tok * NA + COL_V + kvh * 64 + ch * 8); }
                LAS float* kd = Kf + row * 64 + ch * 8; LAS float* vd = Vf + row * 64 + ch * 8;
                kd[0] = bf_lo(kv.x); kd[1] = bf_hi(kv.x); kd[2] = bf_lo(kv.y); kd[3] = bf_hi(kv.y); kd[4] = bf_lo(kv.z); kd[5] = bf_hi(kv.z); kd[6] = bf_lo(kv.w); kd[7] = bf_hi(kv.w);
                vd[0] = bf_lo(vv.x); vd[1] = bf_hi(vv.x); vd[2] = bf_lo(vv.y); vd[3] = bf_hi(vv.y); vd[4] = bf_lo(vv.z); vd[5] = bf_hi(vv.z); vd[6] = bf_lo(vv.w); vd[7] = bf_hi(vv.w); }
            __syncthreads();
            const int hq = tid >> 7, qi = tid & 127, head = kvh * 4 + hq;
            float q[64], o[64];
            { const u32x4* qp = (const u32x4*)(proj + (size_t)(t0 + qi) * NA + head * 64);
#pragma unroll
              for (int j = 0; j < 8; ++j) { const u32x4 w = qp[j]; q[8 * j + 0] = bf_lo(w.x) * 0.125f; q[8 * j + 1] = bf_hi(w.x) * 0.125f; q[8 * j + 2] = bf_lo(w.y) * 0.125f; q[8 * j + 3] = bf_hi(w.y) * 0.125f;
                  q[8 * j + 4] = bf_lo(w.z) * 0.125f; q[8 * j + 5] = bf_hi(w.z) * 0.125f; q[8 * j + 6] = bf_lo(w.w) * 0.125f; q[8 * j + 7] = bf_hi(w.w) * 0.125f; } }
#pragma unroll
            for (int d = 0; d < 64; ++d) o[d] = 0.f;
            const float sink = p.in[I_SINK][l * 8 + head];
            float mrun = sink, lsum = 0.f;
            const int qb = qi & ~63, kmin = qb + 1, kmax = qb + 63 + 128;
            for (int kj = kmin; kj <= kmax; ++kj) {
                const LAS float* kr = Kf + kj * 64; float s = 0.f;
#pragma unroll
                for (int d4 = 0; d4 < 16; ++d4) { const f32x4 k4 = *(const LAS f32x4*)(kr + d4 * 4); s += (q[4 * d4] * k4[0] + q[4 * d4 + 1] * k4[1]) + (q[4 * d4 + 2] * k4[2] + q[4 * d4 + 3] * k4[3]); }
                const int dist = qi + 128 - kj; const bool valid = (dist >= 0) && (dist < 128) && (kj >= 128 || !first);
                const float logit = s + biasT[head * 128 + (dist & 127)];
                const float mnew = valid ? fmaxf(mrun, logit) : mrun;
                const float corr = __expf(mrun - mnew), pp = valid ? __expf(logit - mnew) : 0.f;
                lsum = lsum * corr + pp; mrun = mnew;
                const LAS float* vr = Vf + kj * 64;
#pragma unroll
                for (int d4 = 0; d4 < 16; ++d4) { const f32x4 v4 = *(const LAS f32x4*)(vr + d4 * 4);
                    o[4 * d4] = o[4 * d4] * corr + pp * v4[0]; o[4 * d4 + 1] = o[4 * d4 + 1] * corr + pp * v4[1]; o[4 * d4 + 2] = o[4 * d4 + 2] * corr + pp * v4[2]; o[4 * d4 + 3] = o[4 * d4 + 3] * corr + pp * v4[3]; }
            }
            const float inv = 1.0f / (lsum + __expf(sink - mrun));
            u32x4* op = (u32x4*)(mix + (size_t)(t0 + qi) * MIXW + head * 64);
#pragma unroll
            for (int j = 0; j < 8; ++j) { u32x4 w; w.x = cvt_pk_bf16(o[8 * j] * inv, o[8 * j + 1] * inv); w.y = cvt_pk_bf16(o[8 * j + 2] * inv, o[8 * j + 3] * inv);
                w.z = cvt_pk_bf16(o[8 * j + 4] * inv, o[8 * j + 5] * inv); w.w = cvt_pk_bf16(o[8 * j + 6] * inv, o[8 * j + 7] * inv); op[j] = w; }
        }
        LAS float* Zs = Kf;
        for (int g = 0; g < 4; ++g) {
            const int w = 2 << g;
            __syncthreads();
            for (int i = tid; i < 143 * 16; i += NTHREADS) { const int row = i >> 4, ch = i & 15; const int tok = t0 - 15 + row;
                u32x4 zv = (u32x4){0u, 0u, 0u, 0u};
                if (row >= 15 || !first) zv = *(const u32x4*)(proj + (size_t)tok * NA + COL_PZ + g * 128 + ch * 8);
                LAS float* zd = Zs + row * 128 + ch * 8;
                zd[0] = bf_lo(zv.x); zd[1] = bf_hi(zv.x); zd[2] = bf_lo(zv.y); zd[3] = bf_hi(zv.y); zd[4] = bf_lo(zv.z); zd[5] = bf_hi(zv.z); zd[6] = bf_lo(zv.w); zd[7] = bf_hi(zv.w); }
            __syncthreads();
            const int c = tid & 127, seg = tid >> 7;
            for (int tt = 0; tt < 32; ++tt) { const int t = seg * 32 + tt, r = t + 15; float sum = 0.f;
                for (int j = 0; j < w; ++j) sum += Zs[(r - j) * 128 + c];
                const int pos = (nb % (SEQ / 128)) * 128 + t; const int cnt = (pos + 1 < w) ? pos + 1 : w;
                const float d = sum / (float)cnt - Zs[r * 128 + c];
                mix[(size_t)(t0 + t) * MIXW + 512 + g * 128 + c] = (bf16_t)(cvt_pk_bf16(d, 0.f) & 0xffffu); }
        }
        __syncthreads();
        for (int tt = 0; tt < 16; ++tt) { const int t = wave * 16 + tt; const u32x4 g4 = *(const u32x4*)(proj + (size_t)(t0 + t) * NA + COL_GV + lane * 8);
            float a[8] = {bf_lo(g4.x), bf_hi(g4.x), bf_lo(g4.y), bf_hi(g4.y), bf_lo(g4.z), bf_hi(g4.z), bf_lo(g4.w), bf_hi(g4.w)}; float ss = 0.f;
#pragma unroll
            for (int j = 0; j < 8; ++j) ss += a[j] * a[j];
            ss = wave_sum(ss); if (lane == 0) rs[t] = 1.0f / sqrtf(ss * (1.0f / 512.0f) + EPS); }
        LAS float* Vn = Kf;
        for (int g = 0; g < 4; ++g) {
            __syncthreads();
            for (int i = tid; i < 128 * 16; i += NTHREADS) { const int s = i >> 4, ch = i & 15; const u32x4 g4 = *(const u32x4*)(proj + (size_t)(t0 + s) * NA + COL_GV + g * 128 + ch * 8);
                const float r = rs[s]; const float* gn = p.in[I_VGAIN] + l * 512 + g * 128 + ch * 8; LAS float* vd = Vn + s * 128 + ch * 8;
                vd[0] = bf_lo(g4.x) * r * gn[0]; vd[1] = bf_hi(g4.x) * r * gn[1]; vd[2] = bf_lo(g4.y) * r * gn[2]; vd[3] = bf_hi(g4.y) * r * gn[3];
                vd[4] = bf_lo(g4.z) * r * gn[4]; vd[5] = bf_hi(g4.z) * r * gn[5]; vd[6] = bf_lo(g4.w) * r * gn[6]; vd[7] = bf_hi(g4.w) * r * gn[7]; }
            __syncthreads();
            const int c = tid & 127, tq = tid >> 7;
            for (int t = tq; t < 128; t += 4) { const float* wrow = p.in[I_WSP] + (((size_t)l * 4 + g) * 128 + t) * 128; float acc = 0.f;
                for (int s = 0; s <= t; ++s) acc += wrow[s] * Vn[s * 128 + c];
                const float mixed = acc + p.in[I_BSP][(l * 4 + g) * 128 + t];
                const float uu = bf1(proj[(size_t)(t0 + t) * NA + COL_GU + g * 128 + c]);
                mix[(size_t)(t0 + t) * MIXW + 1024 + g * 128 + c] = (bf16_t)(cvt_pk_bf16(uu * mixed, 0.f) & 0xffffu); }
        }
    }
}

__device__ __forceinline__ unsigned ordkey(unsigned bits) { return bits ^ ((unsigned)((int)bits >> 31) | 0x80000000u); }
__device__ __forceinline__ unsigned unord(unsigned k) { return (k & 0x80000000u) ? (k ^ 0x80000000u) : ~k; }
__device__ __forceinline__ void phase_topk(const Params& p, const Frame& F0, int l) {
    const Frame F = local_frame(F0);
    const int lane = F.lane, wave = F.wave;
    LAS float* tile = (LAS float*)(F.lds + wave * 8448);
    LAS unsigned char* itab = (LAS unsigned char*)(F.lds + 8 * 8448 + wave * 64 * 36 + lane * 36);
    const float* scores = (const float*)(p.ws + WS_SCORES);
    const float* rowsq = (const float*)(p.ws + WS_ROWSQP) + (size_t)l * NTOK * 16;
    unsigned* seli = (unsigned*)(p.ws + WS_SELI); float* selg = (float*)(p.ws + WS_SELG);
    const int gw = blockIdx.x * NWAVES + wave, NGW = F.G * NWAVES;
    for (int grp = gw; grp < NTOK * 8 / 64; grp += NGW) {
        const size_t item0 = (size_t)grp * 64;
        unsigned L1[16], L2[16];
#pragma unroll
        for (int j = 0; j < 16; ++j) { L1[j] = 0u; L2[j] = 0u; }
#pragma unroll 1
        for (int ch = 0; ch < 8; ++ch) {
#pragma unroll
            for (int i = 0; i < 8; ++i) { const int row = 8 * i + (lane >> 3), cg = lane & 7;
                const f32x4 v = *(const f32x4*)(scores + (item0 + row) * 256 + ch * 32 + cg * 4);
                LAS float* d = tile + row * 33 + cg * 4; d[0] = v[0]; d[1] = v[1]; d[2] = v[2]; d[3] = v[3]; }
            __builtin_amdgcn_wave_barrier(); asm volatile("s_waitcnt lgkmcnt(0)" ::: "memory");
            if (ch < 4) {
#pragma unroll
                for (int j = 0; j < 32; ++j) { unsigned x = ordkey((__float_as_uint(tile[lane * 33 + j]) & 0xffffff80u) | (unsigned)(ch * 32 + j));
#pragma unroll
                    for (int k = 0; k < 16; ++k) { const unsigned hi = max(L1[k], x); x = min(L1[k], x); L1[k] = hi; } }
            } else {
#pragma unroll
                for (int j = 0; j < 32; ++j) { unsigned x = ordkey((__float_as_uint(tile[lane * 33 + j]) & 0xffffff80u) | (unsigned)((ch - 4) * 32 + j));
#pragma unroll
                    for (int k = 0; k < 16; ++k) { const unsigned hi = max(L2[k], x); x = min(L2[k], x); L2[k] = hi; } }
            }
            __builtin_amdgcn_wave_barrier(); asm volatile("s_waitcnt lgkmcnt(0)" ::: "memory");
        }
        float f1[16], f2[16];
#pragma unroll
        for (int k = 0; k < 16; ++k) { const unsigned b1 = unord(L1[k]), b2 = unord(L2[k]); f1[k] = __uint_as_float(b1); f2[k] = __uint_as_float(b2); itab[k] = (unsigned char)(b1 & 127u); itab[16 + k] = (unsigned char)(b2 & 127u); }
        unsigned T[16];
#pragma unroll
        for (int j = 0; j < 16; ++j) T[j] = 0u;
#pragma unroll
        for (int i = 0; i < 16; ++i)
#pragma unroll
            for (int j = 0; j < 16; ++j) if ((i + 1) * (j + 1) <= 16) {
                unsigned x = ordkey((__float_as_uint(f1[i] + f2[j]) & 0xffffff00u) | (unsigned)(i * 16 + j));
#pragma unroll
                for (int k = 0; k < 16; ++k) { const unsigned hi = max(T[k], x); x = min(T[k], x); T[k] = hi; } }
        asm volatile("s_waitcnt lgkmcnt(0)" ::: "memory");
        const size_t item = item0 + lane; const int tok = (int)(item >> 3);
        const float rstd = 1.0f / sqrtf(row_sumsq(rowsq, tok) * (1.0f / DM) + EPS);
        float e[16], se = 0.f; unsigned P[16];
        const float t0v = __uint_as_float(unord(T[0]));
#pragma unroll
        for (int k = 0; k < 16; ++k) { const unsigned b = unord(T[k]); e[k] = __expf((__uint_as_float(b) - t0v) * rstd); se += e[k];
            const unsigned code = b & 255u; P[k] = ((unsigned)itab[code >> 4] << 7) | (unsigned)itab[16 + (code & 15u)]; }
        const float inv = 1.0f / se;
        u32x4* di = (u32x4*)(seli + item * 16); f32x4* dg = (f32x4*)(selg + item * 16);
#pragma unroll
        for (int k4 = 0; k4 < 4; ++k4) { di[k4] = (u32x4){P[4 * k4], P[4 * k4 + 1], P[4 * k4 + 2], P[4 * k4 + 3]};
            dg[k4] = (f32x4){e[4 * k4] * inv, e[4 * k4 + 1] * inv, e[4 * k4 + 2] * inv, e[4 * k4 + 3] * inv}; }
        asm volatile("s_waitcnt lgkmcnt(0)" ::: "memory");
    }
}

__device__ __forceinline__ void phase_gather(const Params& p, const Frame& F0, int l) {
    const Frame F = local_frame(F0);
    const int lane = F.lane;
    const bf16_t* EU = (const bf16_t*)(p.ws + WS_EXPU); const bf16_t* EV = (const bf16_t*)(p.ws + WS_EXPV);
    bf16_t* xb = (bf16_t*)(p.ws + WS_XB);
    const float* rowsq = (const float*)(p.ws + WS_ROWSQP) + (size_t)l * NTOK * 16;
    const unsigned* seli = (const unsigned*)(p.ws + WS_SELI); const float* selg = (const float*)(p.ws + WS_SELG);
    const float* gain = p.in[I_FFGAIN] + l * DM;
    float gn[16];
#pragma unroll
    for (int j = 0; j < 2; ++j)
#pragma unroll
        for (int i = 0; i < 8; ++i) gn[j * 8 + i] = gain[j * 512 + lane * 8 + i];
    const int gw = blockIdx.x * NWAVES + F.wave, NGW = F.G * NWAVES;
    for (int tok = gw; tok < NTOK; tok += NGW) {
        float x1[16], h2[16], o[16];
        const float rstd = 1.0f / sqrtf(row_sumsq(rowsq, tok) * (1.0f / DM) + EPS);
#pragma unroll
        for (int j = 0; j < 2; ++j) { const u32x4 w = *(const u32x4*)(xb + (size_t)tok * DM + j * 512 + lane * 8);
            x1[8 * j + 0] = bf_lo(w.x); x1[8 * j + 1] = bf_hi(w.x); x1[8 * j + 2] = bf_lo(w.y); x1[8 * j + 3] = bf_hi(w.y); x1[8 * j + 4] = bf_lo(w.z); x1[8 * j + 5] = bf_hi(w.z); x1[8 * j + 6] = bf_lo(w.w); x1[8 * j + 7] = bf_hi(w.w); }
#pragma unroll
        for (int i = 0; i < 16; ++i) { h2[i] = x1[i] * rstd * gn[i]; o[i] = 0.f; }
        const unsigned myi0 = seli[(size_t)tok * 128 + lane], myi1 = seli[(size_t)tok * 128 + 64 + lane];
        const float myg0 = selg[(size_t)tok * 128 + lane], myg1 = selg[(size_t)tok * 128 + 64 + lane];
#pragma unroll 1
        for (int kb = 0; kb < 32; ++kb) {
            unsigned e[4]; float gt[4];
#pragma unroll
            for (int i = 0; i < 4; ++i) { const int k = kb * 4 + i;
                e[i] = (k < 64) ? __builtin_amdgcn_readlane(myi0, k & 63) : __builtin_amdgcn_readlane(myi1, k & 63);
                gt[i] = (k < 64) ? __uint_as_float(__builtin_amdgcn_readlane(__float_as_uint(myg0), k & 63)) : __uint_as_float(__builtin_amdgcn_readlane(__float_as_uint(myg1), k & 63)); }
            u32x4 uu[4][2], vv[4][2];
#pragma unroll
            for (int i = 0; i < 4; ++i)
#pragma unroll
                for (int j = 0; j < 2; ++j) { uu[i][j] = *(const u32x4*)(EU + (size_t)e[i] * DM + j * 512 + lane * 8); vv[i][j] = *(const u32x4*)(EV + (size_t)e[i] * DM + j * 512 + lane * 8); }
#pragma unroll
            for (int i = 0; i < 4; ++i) {
                float d = 0.f;
#pragma unroll
                for (int j = 0; j < 2; ++j) { const u32x4 w = uu[i][j];
                    d += (h2[8 * j + 0] * bf_lo(w.x) + h2[8 * j + 1] * bf_hi(w.x)) + (h2[8 * j + 2] * bf_lo(w.y) + h2[8 * j + 3] * bf_hi(w.y))
                       + (h2[8 * j + 4] * bf_lo(w.z) + h2[8 * j + 5] * bf_hi(w.z)) + (h2[8 * j + 6] * bf_lo(w.w) + h2[8 * j + 7] * bf_hi(w.w)); }
                d = wave_sum(d);
                const float cf = gt[i] * gelu_tanh(d);
#pragma unroll
                for (int j = 0; j < 2; ++j) { const u32x4 w = vv[i][j];
                    o[8 * j + 0] += cf * bf_lo(w.x); o[8 * j + 1] += cf * bf_hi(w.x); o[8 * j + 2] += cf * bf_lo(w.y); o[8 * j + 3] += cf * bf_hi(w.y);
                    o[8 * j + 4] += cf * bf_lo(w.z); o[8 * j + 5] += cf * bf_hi(w.z); o[8 * j + 6] += cf * bf_lo(w.w); o[8 * j + 7] += cf * bf_hi(w.w); }
            }
        }
        float ss = 0.f;
#pragma unroll
        for (int i = 0; i < 16; ++i) { o[i] += x1[i]; ss += o[i] * o[i]; }
        ss = wave_sum(ss);
        const float r2 = 1.0f / sqrtf(ss * (1.0f / DM) + EPS);
        if (l + 1 < DEPTH) {
#pragma unroll
            for (int j = 0; j < 2; ++j) { u32x4 w; w.x = cvt_pk_bf16(o[8 * j], o[8 * j + 1]); w.y = cvt_pk_bf16(o[8 * j + 2], o[8 * j + 3]); w.z = cvt_pk_bf16(o[8 * j + 4], o[8 * j + 5]); w.w = cvt_pk_bf16(o[8 * j + 6], o[8 * j + 7]);
                *(u32x4*)(xb + (size_t)tok * DM + j * 512 + lane * 8) = w; }
            if (lane == 0) ((float*)(p.ws + WS_RSTD))[(size_t)(l + 1) * NTOK + tok] = r2;
        } else {
            const float* fg = p.in[I_FGAIN];
#pragma unroll
            for (int j = 0; j < 2; ++j) { float* dst = p.out + (size_t)tok * DM + j * 512 + lane * 8; const f32x4 g0 = *(const f32x4*)(fg + j * 512 + lane * 8), g1 = *(const f32x4*)(fg + j * 512 + lane * 8 + 4);
                *(f32x4*)dst = (f32x4){o[8 * j] * r2 * g0[0], o[8 * j + 1] * r2 * g0[1], o[8 * j + 2] * r2 * g0[2], o[8 * j + 3] * r2 * g0[3]};
                *(f32x4*)(dst + 4) = (f32x4){o[8 * j + 4] * r2 * g1[0], o[8 * j + 5] * r2 * g1[1], o[8 * j + 6] * r2 * g1[2], o[8 * j + 7] * r2 * g1[3]}; }
        }
    }
}

constexpr int PH_PER_LAYER = 8, N_PHASES = 1 + DEPTH * PH_PER_LAYER;
__global__ void __launch_bounds__(NTHREADS, 2) mk_fwd(Params p) {
    extern __shared__ __attribute__((aligned(16))) unsigned char lds_raw[];
    Frame F; F.lds = (LAS unsigned char*)lds_raw; F.tid = threadIdx.x; F.lane = F.tid & 63; F.wave = __builtin_amdgcn_readfirstlane(F.tid >> 6);
    F.G = gridDim.x; { const int bx = blockIdx.x; F.vcu = (F.G % 8 == 0) ? (bx % 8) * (F.G / 8) + bx / 8 : bx; }
    volatile LAS unsigned* misc = (volatile LAS unsigned*)(F.lds + LDS_MISC);
    if (F.tid < 64) misc[F.tid] = 0u;
    __syncthreads();
    unsigned* ctl = (unsigned*)(p.ws + WS_CTL);
    XcdBarrier bar; bar.bar = ctl + CTL_BAR_WORD; bar.x = 0; bar.st = nullptr;
    const bool one_launch = (p.ph_hi - p.ph_lo) > 1;
    if (one_launch) bar = xcd_barrier_post(ctl + CTL_BAR_WORD, misc);
    const int lo = p.ph_lo, hi = p.ph_hi;
#define IN(k) (lo <= (k) && (k) < hi)
#define SEAM(k) do { if (IN(k) && IN((k) + 1)) xcd_barrier(bar); } while (0)
    bf16_t* xb = (bf16_t*)(p.ws + WS_XB);
    if (IN(0)) { phase_prologue(p, F); SEAM(0); }
    for (int l = 0; l < DEPTH; ++l) {
        const int b = 1 + l * PH_PER_LAYER;
        const float* rstd_a = (const float*)(p.ws + WS_RSTD) + (size_t)l * NTOK;
        if (IN(b + 0)) {
            pg8::Gemm g{xb, (const bf16_t*)(p.ws + WS_WTIN) + (size_t)l * NIN * DM, DM, DM, DM, 0, 0};
            pg8::TileOrder<1> S; S.init(NTOK, NA, F.G, (int)blockIdx.x);
            EpiProjA E{(bf16_t*)(p.ws + WS_PROJA), rstd_a};
            pg8::gemm_phase(F.lds, g, S, E); SEAM(b + 0);
        }
        if (IN(b + 1)) {
            phase_mix_simple(p, F, l);
            if (l > 0) convert_experts(p, F, l);
            SEAM(b + 1);
        }
        if (IN(b + 2)) {
            pg8::Gemm g{xb, (const bf16_t*)(p.ws + WS_WTIN) + ((size_t)l * NIN + NA) * DM, DM, DM, DM, 0, 0};
            pg8::TileOrder<1> S; S.init(NTOK, NG, F.G, (int)blockIdx.x);
            EpiGates E{(bf16_t*)(p.ws + WS_GATES), rstd_a, p.in[I_BGATE] + l * NG};
            pg8::gemm_phase(F.lds, g, S, E); SEAM(b + 2);
        }
        if (IN(b + 3)) {
            pg8::Gemm g{(const bf16_t*)(p.ws + WS_MIX), (const bf16_t*)(p.ws + WS_WTBR) + (size_t)l * 3 * DM * 512, MIXW, 512, 512, (size_t)512 * 2, (size_t)DM * 512 * 2};
            pg8::TileOrder<3> S; S.init(NTOK, DM, F.G, (int)blockIdx.x);
            EpiMerge E{(const bf16_t*)(p.ws + WS_GATES), (bf16_t*)p.out};
            pg8::gemm_phase(F.lds, g, S, E); SEAM(b + 3);
        }
        if (IN(b + 4)) {
            pg8::Gemm g{(const bf16_t*)p.out, (const bf16_t*)(p.ws + WS_WTOUT) + (size_t)l * DM * DM, DM, DM, DM, 0, 0};
            pg8::TileOrder<1> S; S.init(NTOK, DM, F.G, (int)blockIdx.x);
            EpiResid E{xb, (float*)(p.ws + WS_ROWSQP) + (size_t)l * NTOK * 16};
            pg8::gemm_phase(F.lds, g, S, E); SEAM(b + 4);
        }
        if (IN(b + 5)) {
            pg8::Gemm g{xb, (const bf16_t*)(p.ws + WS_WEFF) + (size_t)l * PQ * DM, DM, DM, DM, 0, 0};
            pg8::TileOrder<1> S; S.init(NTOK, PQ, F.G, (int)blockIdx.x);
            EpiScores E{(float*)(p.ws + WS_SCORES)};
            pg8::gemm_phase(F.lds, g, S, E); SEAM(b + 5);
        }
        if (IN(b + 6)) { phase_topk(p, F, l); SEAM(b + 6); }
        if (IN(b + 7)) { phase_gather(p, F, l); SEAM(b + 7); }
    }
#undef IN
#undef SEAM
}

extern "C" void kernel_launch(void* const* d_in, const int* in_sizes, int n_in, void* d_out, int out_size, void* d_ws, size_t ws_size, hipStream_t stream) {
    static int grid = 0;
    if (grid == 0) {
        if (n_in != 22 || out_size != NTOK * DM || ws_size < WS_END) { fprintf(stderr, "kernel_launch: unexpected shapes (n_in %d, out %d, ws %zu)\n", n_in, out_size, ws_size); grid = -1; return; }
        int dev = 0, cus = 0, per_cu = 0;
        if (hipGetDevice(&dev) != hipSuccess || hipDeviceGetAttribute(&cus, hipDeviceAttributeMultiprocessorCount, dev) != hipSuccess) { grid = -1; return; }
        if (hipFuncSetAttribute((const void*)mk_fwd, hipFuncAttributeMaxDynamicSharedMemorySize, LDS_BYTES) != hipSuccess) { fprintf(stderr, "kernel_launch: hipFuncSetAttribute failed\n"); grid = -1; return; }
        if (hipOccupancyMaxActiveBlocksPerMultiprocessor(&per_cu, (const void*)mk_fwd, NTHREADS, LDS_BYTES) != hipSuccess || per_cu < 1) { fprintf(stderr, "kernel_launch: occupancy query says %d\n", per_cu); }
        (void)hipGetLastError();
        grid = cus;
    }
    if (grid < 0) return;
    (void)hipMemsetAsync((char*)d_ws + WS_CTL, 0, CTL_ZERO_BYTES, stream);
    Params p; memset(&p, 0, sizeof(p));
    for (int i = 0; i < 22; ++i) p.in[i] = (const float*)d_in[i];
    p.out = (float*)d_out; p.ws = (unsigned char*)d_ws;
#if MK_N_LAUNCHES == 1
    p.ph_lo = 0; p.ph_hi = N_PHASES; p.li = 0;
    hipLaunchKernelGGL(mk_fwd, dim3(grid), dim3(NTHREADS), LDS_BYTES, stream, p);
#else
    for (int ph = 0; ph < N_PHASES; ++ph) { p.ph_lo = ph; p.ph_hi = ph + 1; p.li = ph; hipLaunchKernelGGL(mk_fwd, dim3(grid), dim3(NTHREADS), LDS_BYTES, stream, p); }
#endif
}
```

```cpp
#include <hip/hip_runtime.h>
#include <cstdio>
#include <cstdint>
#include <cstring>

#ifndef MK_N_LAUNCHES
#define MK_N_LAUNCHES 1
#endif

#ifndef PROBE_DOUBLE
#define PROBE_DOUBLE -1
#endif
#define PD(k) (PROBE_DOUBLE == (k) || (PROBE_DOUBLE == 100 && ((k) == 0 || ((k) >= 2 && (k) <= 5))))

#define LAS __attribute__((address_space(3)))
typedef unsigned short bf16_t;
typedef short bf16x8 __attribute__((ext_vector_type(8)));
typedef float f32x4 __attribute__((ext_vector_type(4)));
typedef float f32x2 __attribute__((ext_vector_type(2)));
typedef unsigned u32x4 __attribute__((ext_vector_type(4)));
typedef unsigned u32x2 __attribute__((ext_vector_type(2)));
typedef __bf16 bf16x2_t __attribute__((ext_vector_type(2)));

constexpr int NTOK = 32768, DM = 1024, SEQ = 16384, DEPTH = 2;
constexpr int NA = 2304, NG = 3072, NIN = 5376;
constexpr int COL_K = 512, COL_V = 640, COL_PZ = 768, COL_GU = 1280, COL_GV = 1792;
constexpr int MIXW = 1536;
constexpr int NEXP = 16384, PQ = 2048;
constexpr float EPS = 1e-6f;
constexpr int NWAVES = 8, NTHREADS = 512;

constexpr size_t MiB = 1u << 20;
constexpr size_t WS_CTL = 0, CTL_ZERO_BYTES = 1 * MiB;
constexpr size_t CTL_BAR_WORD = 4096;
constexpr size_t CTL_ROWSQ = 256 * 1024;
constexpr size_t WS_RSTD = 1 * MiB;
constexpr size_t WS_WTIN = 2 * MiB;
constexpr size_t WS_WTBR = 23 * MiB;
constexpr size_t WS_WTOUT = 29 * MiB;
constexpr size_t WS_WEFF = 33 * MiB;
constexpr size_t WS_WSP = 41 * MiB;
constexpr size_t WS_ROWSQP = 42 * MiB;
constexpr size_t WS_ESCALE = 46 * MiB;
constexpr size_t WS_EXP = 48 * MiB;
constexpr size_t WS_XB = 112 * MiB;
constexpr size_t WS_PROJA = 176 * MiB;
constexpr size_t WS_GATES = 176 * MiB;
constexpr size_t WS_MIX = 368 * MiB;
constexpr size_t WS_SCORES = 176 * MiB;
constexpr size_t WS_SELI = 464 * MiB, WS_SELG = 480 * MiB;
constexpr size_t WS_END = 496 * MiB;

constexpr int LDS_BYTES = 163840;
constexpr int LDS_MISC = LDS_BYTES - 256;

#define NEG_INF_F (__uint_as_float(0xff800000u))
__device__ __forceinline__ unsigned cvt_pk_bf16(float lo, float hi) { unsigned r; asm volatile("v_cvt_pk_bf16_f32 %0, %1, %2" : "=v"(r) : "v"(lo), "v"(hi)); return r; }
__device__ __forceinline__ float bf_lo(unsigned u) { return __uint_as_float(u << 16); }
__device__ __forceinline__ float bf_hi(unsigned u) { return __uint_as_float(u & 0xffff0000u); }
__device__ __forceinline__ float bf1(bf16_t u) { return __uint_as_float(((unsigned)u) << 16); }
__device__ __forceinline__ float wave_sum(float v) {
#pragma unroll
    for (int o = 1; o < 64; o <<= 1) v += __shfl_xor(v, o);
    return v;
}
__device__ __forceinline__ float gelu_tanh(float x) {
    const float u = 0.7978845608028654f * (x + 0.044715f * x * x * x);
    const float e = __builtin_amdgcn_exp2f(-2.0f * 1.4426950408889634f * u);
    return x * __builtin_amdgcn_rcpf(1.0f + e);
}
__device__ __forceinline__ float row_sumsq(const float* part, int row) { const f32x4* q = (const f32x4*)(part + (size_t)row * 16); const f32x4 a = q[0], b = q[1], c = q[2], d = q[3];
    return (((a[0] + a[1]) + (a[2] + a[3])) + ((b[0] + b[1]) + (b[2] + b[3]))) + (((c[0] + c[1]) + (c[2] + c[3])) + ((d[0] + d[1]) + (d[2] + d[3]))); }
__device__ __forceinline__ float sigmoidf_(float x) { return __builtin_amdgcn_rcpf(1.0f + __builtin_amdgcn_exp2f(-1.4426950408889634f * x)); }

#define XB_TMO      128
#define XB_XCNT(j)  (256  + 64 * (j))
#define XB_XSUB(j)  (1280 + 64 * (j))
#define XB_XGEN(j)  (2304 + 64 * (j))
#define XB_TOP      3328
#define XB_TOPGEN   3392
#define XCD_BAR_WORDS 3456
#define XB_SPIN_CAP (1u << 18)
__device__ __forceinline__ unsigned xb_ld(unsigned* p)              { return __hip_atomic_load(p, __ATOMIC_RELAXED, __HIP_MEMORY_SCOPE_AGENT); }
__device__ __forceinline__ unsigned xb_add(unsigned* p, unsigned v) { return __hip_atomic_fetch_add(p, v, __ATOMIC_RELAXED, __HIP_MEMORY_SCOPE_AGENT); }
__device__ __forceinline__ unsigned xb_xcc_id() { return (unsigned)__builtin_amdgcn_s_getreg((3 << 11) | 20) & 0xFu; }
#define XB_SPIN(cond, bar) do { unsigned _sp = 0; while (cond) { __builtin_amdgcn_s_sleep(1); \
    if ((++_sp & 255u) == 0u) { if (xb_ld(&(bar)[XB_TMO])) break; if (_sp > XB_SPIN_CAP) { atomicAdd(&(bar)[XB_TMO], 1u); break; } } } } while (0)
struct XcdBarrier { unsigned* bar; unsigned x; volatile LAS unsigned* st; };
__device__ __forceinline__ XcdBarrier xcd_barrier_post(unsigned* bar, volatile LAS unsigned* st) {
    XcdBarrier b; b.bar = bar; b.x = xb_xcc_id(); b.st = st;
    if (threadIdx.x == 0) (void)xb_add(&bar[XB_XCNT(b.x)], 1u);
    return b;
}
__device__ __forceinline__ void xcd_barrier_complete(unsigned* bar, unsigned x, unsigned& nloc, unsigned& nx) {
    const unsigned G = gridDim.x * gridDim.y * gridDim.z;
    unsigned sum, cnt, mine, sp = 0u;
    for (;;) {
        sum = 0u; cnt = 0u; mine = 0u;
#pragma unroll
        for (unsigned j = 0; j < 16; ++j) { const unsigned c = xb_ld(&bar[XB_XCNT(j)]); sum += c; cnt += (c > 0u) ? 1u : 0u; mine = (j == x) ? c : mine; }
        if (sum == G) break;
        __builtin_amdgcn_s_sleep(1);
        if ((++sp & 255u) == 0u) { if (xb_ld(&bar[XB_TMO])) break; if (sp > XB_SPIN_CAP) { atomicAdd(&bar[XB_TMO], 1u); break; } }
    }
    nloc = mine > 0u ? mine : 1u; nx = cnt > 0u ? cnt : 1u;
}
__device__ __forceinline__ void xcd_barrier(const XcdBarrier& b) {
    asm volatile("s_waitcnt vmcnt(0)" ::: "memory");
    __syncthreads();
    if (threadIdx.x == 0) {
        unsigned* bar = b.bar;
        __builtin_amdgcn_s_waitcnt(0);
        unsigned nloc = b.st[0], nx = b.st[1];
        if (nloc == 0u) { xcd_barrier_complete(bar, b.x, nloc, nx); b.st[0] = nloc; b.st[1] = nx; }
        const unsigned old = xb_add(&bar[XB_XSUB(b.x)], 1u);
        const unsigned gen = old / nloc;
        if (old + 1u == (gen + 1u) * nloc) {
            __builtin_amdgcn_fence(__ATOMIC_RELEASE, "agent");
            asm volatile("s_waitcnt vmcnt(0)" ::: "memory");
            const unsigned og = xb_add(&bar[XB_TOP], 1u);
            const unsigned tg = og / nx;
            if (og + 1u == (tg + 1u) * nx) xb_add(&bar[XB_TOPGEN], 1u);
            else XB_SPIN(xb_ld(&bar[XB_TOPGEN]) == tg, bar);
            __builtin_amdgcn_fence(__ATOMIC_ACQUIRE, "agent");
            xb_add(&bar[XB_XGEN(b.x)], 1u);
            asm volatile("s_waitcnt vmcnt(0)" ::: "memory");
        } else {
            XB_SPIN(xb_ld(&bar[XB_XGEN(b.x)]) == gen, bar);
            __builtin_amdgcn_fence(__ATOMIC_ACQUIRE, "agent");
            asm volatile("s_waitcnt vmcnt(0)" ::: "memory");
        }
    }
    __syncthreads();
}

namespace pg8 {
constexpr int BM = 256, BK = 64, HALF = 128, HTB = HALF * BK * 2, STAGE_BYTES = 8 * HTB, NXCD = 8, WGM = 8;
__host__ __device__ __forceinline__ int lds_byte(int r, int c) { const int st = (r >> 4) * 2 + (c >> 5), rr = r & 15, cc = c & 31, ob = rr * 64 + cc * 2; return st * 1024 + (ob ^ (((ob >> 9) & 1) << 5)); }
__host__ __device__ __forceinline__ void stage_rc(int b, int& R, int& C) { const int st = b / 1024, sb = b % 1024, swz = sb ^ (((sb >> 9) & 1) << 5); R = (st >> 1) * 16 + swz / 64; C = (st & 1) * 32 + (swz % 64) / 2; }
__host__ __device__ __forceinline__ int perm32(int rho) { const int n = rho >> 4, i = rho & 15; return 8 * (i >> 2) + 4 * n + (i & 3); }

struct Unit { int pm, pn, z; };
struct Gemm { const bf16_t* A; const bf16_t* Bt; int lda, ldb, K; size_t az, bz; };

template <int ZN> struct TileOrder {
    int nM, nN, nwg, G, c;
    __device__ void init(int M, int N, int G_, int c_) { nM = M / BM; nN = N / BM; nwg = nM * nN; G = G_; c = c_; }
    __device__ bool next(int i, Unit& u) const {
        const long L = (long)(i / ZN) * G + c; if (L >= nwg) return false;
        int wgid = (int)L; { const int q = nwg / NXCD, r = nwg % NXCD, xcd = wgid % NXCD, off = wgid / NXCD; wgid = (xcd < r ? xcd * (q + 1) : r * (q + 1) + (xcd - r) * q) + off; }
        const int nig = WGM * nN, gid = wgid / nig, fm = gid * WGM, gsz = (nM - fm) < WGM ? (nM - fm) : WGM;
        u.pm = fm + ((wgid % nig) % gsz); u.pn = (wgid % nig) / gsz; u.z = i % ZN; return true;
    }
};

template <class Epi, class Sched>
__device__ __forceinline__ void gemm_phase(LAS unsigned char* lds, const Gemm g, const Sched& S, const Epi& E) {
    int tid_ = threadIdx.x; asm volatile("" : "+v"(tid_));
    const int tid = tid_, wid = __builtin_amdgcn_readfirstlane(tid >> 6), lane = tid & 63, wr = wid >> 2, wc = wid & 3, fr = lane & 15, fq = lane >> 4;
    const int K = g.K, nt = K / BK;
    unsigned voffA[2], voffB[2];
#pragma unroll
    for (int i = 0; i < 2; ++i) { int R, C; stage_rc(tid * 16 + i * 8192, R, C); const int Rb = Epi::PERM ? ((R & ~31) + perm32(R & 31)) : R;
        voffA[i] = (unsigned)(R * g.lda + C) * 2u; voffB[i] = (unsigned)(Rb * g.ldb + C) * 2u; }
    const size_t kstep = (size_t)(BK * 2);
    const size_t hstepA = (size_t)HALF * g.lda * 2, hstepB = (size_t)HALF * g.ldb * 2;
    const size_t tstepA = 2 * hstepA, tstepB = 2 * hstepB;
    const unsigned ldsw = (unsigned)wid * 1024u;
    const int aoff = lds_byte(wr * 64 + fr, fq * 8), boff = lds_byte(wc * 32 + fr, fq * 8);
#define PG8_SA(b, h) (((b) * 2 + (h)) * HTB)
#define PG8_SB(b, h) ((4 + (b) * 2 + (h)) * HTB)
#define PG8_STAGE(bufoff, gbase, voff) do { _Pragma("unroll") for (int _i = 0; _i < 2; ++_i) \
        __builtin_amdgcn_global_load_lds((const unsigned*)((const char*)(gbase) + (voff)[_i]), (LAS unsigned*)(lds + (bufoff) + ldsw + _i * 8192), 16, 0, 0); } while (0)
#define PG8_LDA(dst, b, h) do { _Pragma("unroll") for (int m = 0; m < 4; ++m) _Pragma("unroll") for (int k = 0; k < 2; ++k) dst[m][k] = *(const LAS bf16x8*)(lds + PG8_SA(b, h) + aoff + m * 2048 + k * 1024); } while (0)
#define PG8_LDB(dst, b, h) do { _Pragma("unroll") for (int n = 0; n < 2; ++n) _Pragma("unroll") for (int k = 0; k < 2; ++k) dst[n][k] = *(const LAS bf16x8*)(lds + PG8_SB(b, h) + boff + n * 2048 + k * 1024); } while (0)
#define PG8_MMA(ai, bj, At, Bt) do { __builtin_amdgcn_s_setprio(1); _Pragma("unroll") for (int m = 0; m < 4; ++m) _Pragma("unroll") for (int n = 0; n < 2; ++n) _Pragma("unroll") for (int k = 0; k < 2; ++k) \
        acc[ai][bj][m][n] = __builtin_amdgcn_mfma_f32_16x16x32_bf16(Bt[n][k], At[m][k], acc[ai][bj][m][n], 0, 0, 0); __builtin_amdgcn_s_setprio(0); } while (0)
#define PG8_WAIT_V(n) asm volatile("s_waitcnt vmcnt(" #n ")" ::: "memory")
#define PG8_WAIT_L(n) asm volatile("s_waitcnt lgkmcnt(" #n ")" ::: "memory")
#define PG8_BAR __builtin_amdgcn_s_barrier()
#define PG8_SCHED __builtin_amdgcn_sched_barrier(0)
    Unit cur, nxt; int ui = 0;
    if (!S.next(0, cur)) return;
    f32x4 acc[2][2][4][2];
#pragma unroll
    for (int a = 0; a < 2; ++a)
#pragma unroll
        for (int b = 0; b < 2; ++b)
#pragma unroll
            for (int m = 0; m < 4; ++m)
#pragma unroll
                for (int n = 0; n < 2; ++n) acc[a][b][m][n] = (f32x4){0.f, 0.f, 0.f, 0.f};
    bf16x8 At[4][2], B0[2][2], B1[2][2];
    const char* cA = (const char*)g.A + (size_t)cur.pm * tstepA + (size_t)cur.z * g.az; const char* cB = (const char*)g.Bt + (size_t)cur.pn * tstepB + (size_t)cur.z * g.bz;
    PG8_STAGE(PG8_SB(0, 0), cB, voffB); PG8_STAGE(PG8_SB(0, 1), cB + hstepB, voffB); PG8_STAGE(PG8_SA(0, 0), cA, voffA); PG8_STAGE(PG8_SA(0, 1), cA + hstepA, voffA);
    if (wr == 1) PG8_BAR;
    PG8_WAIT_V(2); PG8_BAR;
    PG8_STAGE(PG8_SB(1, 0), cB + kstep, voffB); PG8_STAGE(PG8_SA(1, 0), cA + kstep, voffA); PG8_STAGE(PG8_SB(1, 1), cB + hstepB + kstep, voffB);
    PG8_WAIT_V(6); PG8_BAR;
    for (;;) {
        const bool has_next = S.next(ui + 1, nxt);
        const char* nA = has_next ? (const char*)g.A + (size_t)nxt.pm * tstepA + (size_t)nxt.z * g.az : cA;
        const char* nB = has_next ? (const char*)g.Bt + (size_t)nxt.pn * tstepB + (size_t)nxt.z * g.bz : cB;
        for (int t = 0; t < nt; t += 2) {
            const bool last = (t == nt - 2);
            const char* a1 = cA + (size_t)(t + 1) * kstep;
            const char* a2 = last ? nA : cA + (size_t)(t + 2) * kstep; const char* b2 = last ? nB : cB + (size_t)(t + 2) * kstep;
            const char* a3 = a2 + kstep; const char* b3 = b2 + kstep;
            PG8_LDB(B0, 0, 0); PG8_LDB(B1, 0, 1); PG8_SCHED; PG8_LDA(At, 0, 0); PG8_STAGE(PG8_SA(1, 1), a1 + hstepA, voffA);
            PG8_WAIT_V(8); PG8_WAIT_L(0); PG8_BAR; PG8_MMA(0, 0, At, B0); PG8_MMA(0, 1, At, B1); PG8_BAR; PG8_SCHED;
            PG8_LDA(At, 0, 1); PG8_STAGE(PG8_SB(0, 0), b2, voffB); PG8_STAGE(PG8_SB(0, 1), b2 + hstepB, voffB); PG8_STAGE(PG8_SA(0, 0), a2, voffA);
            PG8_WAIT_V(8); PG8_WAIT_L(0); PG8_BAR; PG8_MMA(1, 0, At, B0); PG8_MMA(1, 1, At, B1); PG8_BAR; PG8_SCHED;
            PG8_LDB(B0, 1, 0); PG8_LDB(B1, 1, 1); PG8_SCHED; PG8_LDA(At, 1, 0); PG8_STAGE(PG8_SA(0, 1), a2 + hstepA, voffA);
            PG8_WAIT_V(8); PG8_WAIT_L(0); PG8_BAR; PG8_MMA(0, 0, At, B0); PG8_MMA(0, 1, At, B1); PG8_BAR; PG8_SCHED;
            PG8_LDA(At, 1, 1); PG8_STAGE(PG8_SB(1, 0), b3, voffB); PG8_STAGE(PG8_SB(1, 1), b3 + hstepB, voffB); PG8_STAGE(PG8_SA(1, 0), a3, voffA);
            PG8_WAIT_V(8); PG8_WAIT_L(0); PG8_BAR; PG8_MMA(1, 0, At, B0); PG8_MMA(1, 1, At, B1); PG8_BAR; PG8_SCHED;
        }
        if (wr == 0) PG8_BAR;
        E(acc, cur, wr, wc, fr, fq);
        if (!has_next) break;
        if (!E.keep(cur)) {
#pragma unroll
            for (int a = 0; a < 2; ++a)
#pragma unroll
                for (int b = 0; b < 2; ++b)
#pragma unroll
                    for (int m = 0; m < 4; ++m)
#pragma unroll
                        for (int n = 0; n < 2; ++n) acc[a][b][m][n] = (f32x4){0.f, 0.f, 0.f, 0.f};
        }
        cur = nxt; cA = nA; cB = nB; ++ui;
        if (wr == 1) PG8_BAR;
    }
    PG8_WAIT_V(0);
    PG8_BAR;
#undef PG8_SA
#undef PG8_SB
#undef PG8_STAGE
#undef PG8_LDA
#undef PG8_LDB
#undef PG8_MMA
#undef PG8_WAIT_V
#undef PG8_WAIT_L
#undef PG8_BAR
#undef PG8_SCHED
}
}
typedef pg8::Unit Unit;
typedef f32x4 AccT[2][2][4][2];

struct EpiProjA {
    static constexpr bool PERM = true;
    bf16_t* O; const float* rstd;
    __device__ __forceinline__ bool keep(const Unit&) const { return false; }
    __device__ __forceinline__ void operator()(AccT& acc, const Unit& u, int wr, int wc, int fr, int fq) const {
        const int row0 = u.pm * 256 + wr * 64 + fr, col0 = u.pn * 256 + wc * 32 + 8 * fq;
        const bool act = (u.pn >= 5);
#pragma unroll
        for (int ai = 0; ai < 2; ++ai)
#pragma unroll
            for (int m = 0; m < 4; ++m) { const int row = row0 + ai * 128 + m * 16; const float rs = rstd[row]; bf16_t* rowp = O + (size_t)row * NA + col0;
#pragma unroll
                for (int bj = 0; bj < 2; ++bj) { f32x4 v0 = acc[ai][bj][m][0] * rs, v1 = acc[ai][bj][m][1] * rs;
                    if (act) {
#pragma unroll
                        for (int j = 0; j < 4; ++j) { v0[j] = gelu_tanh(v0[j]); v1[j] = gelu_tanh(v1[j]); } }
                    u32x4 w; w.x = cvt_pk_bf16(v0[0], v0[1]); w.y = cvt_pk_bf16(v0[2], v0[3]); w.z = cvt_pk_bf16(v1[0], v1[1]); w.w = cvt_pk_bf16(v1[2], v1[3]);
                    *(u32x4*)(rowp + bj * 128) = w; } }
    }
};
struct EpiGates {
    static constexpr bool PERM = true;
    bf16_t* O; const float* rstd; const float* bias;
    __device__ __forceinline__ bool keep(const Unit&) const { return false; }
    __device__ __forceinline__ void operator()(AccT& acc, const Unit& u, int wr, int wc, int fr, int fq) const {
        const int row0 = u.pm * 256 + wr * 64 + fr, col0 = u.pn * 256 + wc * 32 + 8 * fq;
        f32x4 bv[2][2];
#pragma unroll
        for (int bj = 0; bj < 2; ++bj)
#pragma unroll
            for (int n = 0; n < 2; ++n) bv[bj][n] = *(const f32x4*)(bias + col0 + bj * 128 + 4 * n);
#pragma unroll
        for (int ai = 0; ai < 2; ++ai)
#pragma unroll
            for (int m = 0; m < 4; ++m) { const int row = row0 + ai * 128 + m * 16; const float rs = rstd[row]; bf16_t* rowp = O + (size_t)row * NG + col0;
#pragma unroll
                for (int bj = 0; bj < 2; ++bj) { f32x4 v0 = acc[ai][bj][m][0] * rs + bv[bj][0], v1 = acc[ai][bj][m][1] * rs + bv[bj][1];
#pragma unroll
                    for (int j = 0; j < 4; ++j) { v0[j] = sigmoidf_(v0[j]); v1[j] = sigmoidf_(v1[j]); }
                    u32x4 w; w.x = cvt_pk_bf16(v0[0], v0[1]); w.y = cvt_pk_bf16(v0[2], v0[3]); w.z = cvt_pk_bf16(v1[0], v1[1]); w.w = cvt_pk_bf16(v1[2], v1[3]);
                    *(u32x4*)(rowp + bj * 128) = w; } }
    }
};
struct EpiMerge {
    static constexpr bool PERM = true;
    const bf16_t* gates; bf16_t* O;
    __device__ __forceinline__ bool keep(const Unit& u) const { return u.z < 2; }
    __device__ __forceinline__ void operator()(AccT& acc, const Unit& u, int wr, int wc, int fr, int fq) const {
        const int row0 = u.pm * 256 + wr * 64 + fr, col0 = u.pn * 256 + wc * 32 + 8 * fq;
        const int z = u.z;
#pragma unroll
        for (int ai = 0; ai < 2; ++ai)
#pragma unroll
            for (int m = 0; m < 4; ++m) { const int row = row0 + ai * 128 + m * 16;
#pragma unroll
                for (int bj = 0; bj < 2; ++bj) { const int col = col0 + bj * 128; const bf16_t* gp = gates + (size_t)row * NG + col;
                    float f[8];
                    if (z == 2) { const u32x4 a = *(const u32x4*)(gp + 2048);
                        f[0] = bf_lo(a.x); f[1] = bf_hi(a.x); f[2] = bf_lo(a.y); f[3] = bf_hi(a.y); f[4] = bf_lo(a.z); f[5] = bf_hi(a.z); f[6] = bf_lo(a.w); f[7] = bf_hi(a.w);
#pragma unroll
                        for (int j = 0; j < 8; ++j) f[j] = fmaxf(f[j], 1e-20f);
                    } else { const u32x4 a = *(const u32x4*)(gp + z * 1024), b = *(const u32x4*)(gp + (z + 1) * 1024);
                        float ga[8], gb[8];
                        ga[0] = bf_lo(a.x); ga[1] = bf_hi(a.x); ga[2] = bf_lo(a.y); ga[3] = bf_hi(a.y); ga[4] = bf_lo(a.z); ga[5] = bf_hi(a.z); ga[6] = bf_lo(a.w); ga[7] = bf_hi(a.w);
                        gb[0] = bf_lo(b.x); gb[1] = bf_hi(b.x); gb[2] = bf_lo(b.y); gb[3] = bf_hi(b.y); gb[4] = bf_lo(b.z); gb[5] = bf_hi(b.z); gb[6] = bf_lo(b.w); gb[7] = bf_hi(b.w);
#pragma unroll
                        for (int j = 0; j < 8; ++j) { const float num = (z == 0) ? ga[j] : fmaxf(ga[j], 1e-20f); f[j] = num * __builtin_amdgcn_rcpf(fmaxf(gb[j], 1e-20f)); } }
                    f32x4 v0 = acc[ai][bj][m][0], v1 = acc[ai][bj][m][1];
                    v0[0] *= f[0]; v0[1] *= f[1]; v0[2] *= f[2]; v0[3] *= f[3]; v1[0] *= f[4]; v1[1] *= f[5]; v1[2] *= f[6]; v1[3] *= f[7];
                    acc[ai][bj][m][0] = v0; acc[ai][bj][m][1] = v1;
                    if (z == 2) { u32x4 w; w.x = cvt_pk_bf16(v0[0], v0[1]); w.y = cvt_pk_bf16(v0[2], v0[3]); w.z = cvt_pk_bf16(v1[0], v1[1]); w.w = cvt_pk_bf16(v1[2], v1[3]);
                        *(u32x4*)(O + (size_t)row * DM + col) = w; } } }
    }
};
struct EpiResid {
    static constexpr bool PERM = true;
    bf16_t* X; float* rowsq; bf16_t* XO;
    __device__ __forceinline__ bool keep(const Unit&) const { return false; }
    __device__ __forceinline__ void operator()(AccT& acc, const Unit& u, int wr, int wc, int fr, int fq) const {
        const int row0 = u.pm * 256 + wr * 64 + fr, col0 = u.pn * 256 + wc * 32 + 8 * fq;
#pragma unroll
        for (int ai = 0; ai < 2; ++ai)
#pragma unroll
            for (int m = 0; m < 4; ++m) { const int row = row0 + ai * 128 + m * 16; bf16_t* rowp = X + (size_t)row * DM + col0; float ss = 0.f;
#pragma unroll
                for (int bj = 0; bj < 2; ++bj) { const u32x4 x = *(const u32x4*)(rowp + bj * 128);
                    f32x4 v0 = acc[ai][bj][m][0], v1 = acc[ai][bj][m][1];
                    v0[0] += bf_lo(x.x); v0[1] += bf_hi(x.x); v0[2] += bf_lo(x.y); v0[3] += bf_hi(x.y); v1[0] += bf_lo(x.z); v1[1] += bf_hi(x.z); v1[2] += bf_lo(x.w); v1[3] += bf_hi(x.w);
                    ss += (v0[0] * v0[0] + v0[1] * v0[1]) + (v0[2] * v0[2] + v0[3] * v0[3]) + (v1[0] * v1[0] + v1[1] * v1[1]) + (v1[2] * v1[2] + v1[3] * v1[3]);
                    u32x4 w; w.x = cvt_pk_bf16(v0[0], v0[1]); w.y = cvt_pk_bf16(v0[2], v0[3]); w.z = cvt_pk_bf16(v1[0], v1[1]); w.w = cvt_pk_bf16(v1[2], v1[3]);
                    *(u32x4*)(XO + (size_t)row * DM + col0 + bj * 128) = w; }
                ss += __shfl_xor(ss, 16); ss += __shfl_xor(ss, 32);
                if (fq == 0) rowsq[(size_t)row * 16 + u.pn * 4 + wc] = ss; }
    }
};
struct EpiScores {
    static constexpr bool PERM = false;
    float* C;
    __device__ __forceinline__ bool keep(const Unit&) const { return false; }
    __device__ __forceinline__ void operator()(AccT& acc, const Unit& u, int wr, int wc, int fr, int fq) const {
        const int row0 = u.pm * 256 + wr * 64 + fr, col0 = u.pn * 256 + wc * 32 + 4 * fq;
#pragma unroll
        for (int ai = 0; ai < 2; ++ai)
#pragma unroll
            for (int m = 0; m < 4; ++m) { float* rowp = C + (size_t)(row0 + ai * 128 + m * 16) * PQ + col0;
#pragma unroll
                for (int bj = 0; bj < 2; ++bj)
#pragma unroll
                    for (int n = 0; n < 2; ++n) *(f32x4*)(rowp + bj * 128 + n * 16) = acc[ai][bj][m][n]; }
    }
};

struct Params {
    const float* in[22];
    float* out; unsigned char* ws;
    int ph_lo, ph_hi, li, pad;
};
enum { I_X = 0, I_RELB, I_FGAIN, I_AGAIN, I_WIN, I_BGATE, I_SINK, I_WPOOL, I_PSCALE, I_VGAIN, I_WSP, I_BSP, I_WA, I_WB, I_WC, I_WOUT, I_FFGAIN, I_WQ, I_K1, I_K2, I_EU, I_EV };

struct Frame { LAS unsigned char* lds; int tid, lane, wave, G, vcu; };
__device__ __forceinline__ Frame local_frame(const Frame& F0) { Frame F = F0; int t = threadIdx.x; asm volatile("" : "+v"(t)); F.tid = t; F.lane = t & 63; F.wave = __builtin_amdgcn_readfirstlane(t >> 6); return F; }

__device__ __forceinline__ void p0_transpose_item(const float* W, int N, bf16_t* WT, int ldo, const float* kscale, LAS float* scr, int item, int lane) {
    const int nblk = N / 32, kb = item / nblk, nb = item % nblk, k0 = 64 * kb, n0 = 32 * nb;
#pragma unroll 8
    for (int i = 0; i < 32; ++i) { const int kk = 2 * i + (lane >> 5); float v = W[(size_t)(k0 + kk) * N + n0 + (lane & 31)]; if (kscale) v *= kscale[k0 + kk]; scr[kk * 33 + (lane & 31)] = v; }
    asm volatile("s_waitcnt lgkmcnt(0)" ::: "memory");
    const int c = lane & 7;
#pragma unroll
    for (int j = 0; j < 4; ++j) { const int n = (lane >> 3) + 8 * j; const LAS float* s = scr + (8 * c) * 33 + n;
        u32x4 o; o.x = cvt_pk_bf16(s[0 * 33], s[1 * 33]); o.y = cvt_pk_bf16(s[2 * 33], s[3 * 33]); o.z = cvt_pk_bf16(s[4 * 33], s[5 * 33]); o.w = cvt_pk_bf16(s[6 * 33], s[7 * 33]);
        *(u32x4*)(WT + (size_t)(n0 + n) * ldo + k0 + 8 * c) = o; }
    asm volatile("s_waitcnt lgkmcnt(0)" ::: "memory");
}
__device__ __forceinline__ void convert_experts(const Params& p, const Frame& F) {
    const int gw = blockIdx.x * NWAVES + F.wave, NGW = F.G * NWAVES, lane = F.lane;
    for (int r = gw; r < DEPTH * 2 * NEXP; r += NGW) {
        const int l = r / (2 * NEXP), tb = (r / NEXP) & 1, row = r % NEXP;
        const float* src = (tb ? p.in[I_EV] : p.in[I_EU]) + ((size_t)l * NEXP + row) * DM + lane * 16;
        const f32x4 a = *(const f32x4*)src, b = *(const f32x4*)(src + 4), c = *(const f32x4*)(src + 8), d = *(const f32x4*)(src + 12);
        float mx = fmaxf(fmaxf(fmaxf(fabsf(a[0]), fabsf(a[1])), fmaxf(fabsf(a[2]), fabsf(a[3]))), fmaxf(fmaxf(fabsf(b[0]), fabsf(b[1])), fmaxf(fabsf(b[2]), fabsf(b[3]))));
        mx = fmaxf(mx, fmaxf(fmaxf(fmaxf(fabsf(c[0]), fabsf(c[1])), fmaxf(fabsf(c[2]), fabsf(c[3]))), fmaxf(fmaxf(fabsf(d[0]), fabsf(d[1])), fmaxf(fabsf(d[2]), fabsf(d[3])))));
#pragma unroll
        for (int o = 1; o < 64; o <<= 1) mx = fmaxf(mx, __shfl_xor(mx, o));
        const float inv = mx > 0.f ? 448.0f / mx : 0.f;
        int w0 = 0, w1 = 0, w2 = 0, w3 = 0;
        w0 = __builtin_amdgcn_cvt_pk_fp8_f32(a[0] * inv, a[1] * inv, w0, false); w0 = __builtin_amdgcn_cvt_pk_fp8_f32(a[2] * inv, a[3] * inv, w0, true);
        w1 = __builtin_amdgcn_cvt_pk_fp8_f32(b[0] * inv, b[1] * inv, w1, false); w1 = __builtin_amdgcn_cvt_pk_fp8_f32(b[2] * inv, b[3] * inv, w1, true);
        w2 = __builtin_amdgcn_cvt_pk_fp8_f32(c[0] * inv, c[1] * inv, w2, false); w2 = __builtin_amdgcn_cvt_pk_fp8_f32(c[2] * inv, c[3] * inv, w2, true);
        w3 = __builtin_amdgcn_cvt_pk_fp8_f32(d[0] * inv, d[1] * inv, w3, false); w3 = __builtin_amdgcn_cvt_pk_fp8_f32(d[2] * inv, d[3] * inv, w3, true);
        *(u32x4*)(p.ws + WS_EXP + ((size_t)(l * 2 + tb) * NEXP + row) * DM + lane * 16) = (u32x4){(unsigned)w0, (unsigned)w1, (unsigned)w2, (unsigned)w3};
        if (lane == 0) ((float*)(p.ws + WS_ESCALE))[(size_t)(l * 2 + tb) * NEXP + row] = mx * (1.0f / 448.0f);
    }
}
__device__ __forceinline__ void phase_prologue(const Params& p, const Frame& F0) {
    const Frame F = local_frame(F0);
    const int gw = F.vcu * NWAVES + F.wave, NGW = F.G * NWAVES, lane = F.lane;
    LAS float* scr = (LAS float*)(F.lds + F.wave * 16384);
    constexpr int I_IN = (DM / 64) * (NIN / 32), I_BR = (512 / 64) * (DM / 32), I_OUT = (DM / 64) * (DM / 32);
    constexpr int PER_L = I_IN + 2 * I_BR + I_OUT;
    for (int it = gw; it < DEPTH * PER_L; it += NGW) {
        const int l = it / PER_L; int r = it % PER_L;
        if (r < I_IN) { p0_transpose_item(p.in[I_WIN] + (size_t)l * DM * NIN, NIN, (bf16_t*)(p.ws + WS_WTIN) + (size_t)l * NIN * DM, DM, p.in[I_AGAIN] + l * DM, scr, r, lane); continue; } r -= I_IN;
        if (r < I_BR) { p0_transpose_item(p.in[I_WA] + (size_t)l * 512 * DM, DM, (bf16_t*)(p.ws + WS_WTBR) + (size_t)(l * 3 + 0) * DM * 512, 512, nullptr, scr, r, lane); continue; } r -= I_BR;
        if (r < I_BR) { p0_transpose_item(p.in[I_WC] + (size_t)l * 512 * DM, DM, (bf16_t*)(p.ws + WS_WTBR) + (size_t)(l * 3 + 2) * DM * 512, 512, nullptr, scr, r, lane); continue; } r -= I_BR;
        p0_transpose_item(p.in[I_WOUT] + (size_t)l * DM * DM, DM, (bf16_t*)(p.ws + WS_WTOUT) + (size_t)l * DM * DM, DM, nullptr, scr, r, lane);
    }
    {
        float* rstd = (float*)(p.ws + WS_RSTD);
        for (int m = gw; m < NTOK; m += NGW) {
            const f32x4* xr = (const f32x4*)(p.in[I_X] + (size_t)m * DM) + lane; f32x4 v[4]; float s = 0.f;
#pragma unroll
            for (int j = 0; j < 4; ++j) { v[j] = xr[64 * j]; s += (v[j][0] * v[j][0] + v[j][1] * v[j][1]) + (v[j][2] * v[j][2] + v[j][3] * v[j][3]); }
            s = wave_sum(s);
            u32x2* o = (u32x2*)((bf16_t*)(p.ws + WS_XB) + (size_t)m * DM) + lane;
#pragma unroll
            for (int j = 0; j < 4; ++j) { u32x2 w; w.x = cvt_pk_bf16(v[j][0], v[j][1]); w.y = cvt_pk_bf16(v[j][2], v[j][3]); o[64 * j] = w; }
            if (lane == 0) rstd[m] = 1.0f / sqrtf(s * (1.0f / DM) + EPS);
        }
    }
    for (int i = blockIdx.x * NTHREADS + F.tid; i < DEPTH * 4 * 128 * 128; i += F.G * NTHREADS) { const int t = (i >> 7) & 127, s = i & 127;
        ((bf16_t*)(p.ws + WS_WSP))[i] = (bf16_t)(cvt_pk_bf16(s <= t ? p.in[I_WSP][i] : 0.f, 0.f) & 0xffffu); }
    convert_experts(p, F);
    __syncthreads();
    {
        LAS float* coef = (LAS float*)F.lds;
        for (int u = blockIdx.x; u < DEPTH * 4 * 16; u += F.G) {
            const int l = u / 64, g = (u / 16) % 4, c0 = (u % 16) * 8;
            __syncthreads();
            for (int i = F.tid; i < 1024; i += NTHREADS) { const int cc = i >> 7, j = i & 127;
                coef[i] = p.in[I_WPOOL][(((size_t)l * 4 + g) * 128 + c0 + cc) * 128 + j] * p.in[I_PSCALE][l * 512 + g * 128 + j]; }
            __syncthreads();
            const float* wb = p.in[I_WB] + ((size_t)l * 512 + g * 128) * DM;
            float a0[8], a1[8];
#pragma unroll
            for (int cc = 0; cc < 8; ++cc) { a0[cc] = 0.f; a1[cc] = 0.f; }
            for (int j = 0; j < 128; ++j) { const float w0 = wb[(size_t)j * DM + F.tid], w1 = wb[(size_t)j * DM + F.tid + 512];
#pragma unroll
                for (int cc = 0; cc < 8; ++cc) { const float cf = coef[cc * 128 + j]; a0[cc] += cf * w0; a1[cc] += cf * w1; } }
            bf16_t* dst = (bf16_t*)(p.ws + WS_WTBR) + (size_t)(l * 3 + 1) * DM * 512 + g * 128 + c0;
            u32x4 w; w.x = cvt_pk_bf16(a0[0], a0[1]); w.y = cvt_pk_bf16(a0[2], a0[3]); w.z = cvt_pk_bf16(a0[4], a0[5]); w.w = cvt_pk_bf16(a0[6], a0[7]);
            *(u32x4*)(dst + (size_t)F.tid * 512) = w;
            u32x4 y; y.x = cvt_pk_bf16(a1[0], a1[1]); y.y = cvt_pk_bf16(a1[2], a1[3]); y.z = cvt_pk_bf16(a1[4], a1[5]); y.w = cvt_pk_bf16(a1[6], a1[7]);
            *(u32x4*)(dst + (size_t)(F.tid + 512) * 512) = y;
        }
    }
    {
        LAS float* kl = (LAS float*)F.lds;
        LAS float* wl = kl + 128 * 132;
        for (int u = blockIdx.x; u < DEPTH * 16 * 16; u += F.G) {
            const int l = u / 256, s = (u / 16) % 16, c0 = (u % 16) * 64;
            const float* keys = ((s & 1) ? p.in[I_K2] : p.in[I_K1]) + (size_t)l * 128 * 128;
            const float* wq = p.in[I_WQ] + (size_t)l * DM * PQ;
            __syncthreads();
            for (int i = F.tid; i < 128 * 32; i += NTHREADS) { const int r = i >> 5, q = i & 31; *(LAS f32x4*)(kl + r * 132 + q * 4) = *(const f32x4*)(keys + r * 128 + q * 4); }
            for (int i = F.tid; i < 64 * 32; i += NTHREADS) { const int r = i >> 5, q = i & 31; *(LAS f32x4*)(wl + r * 132 + q * 4) = *(const f32x4*)(wq + (size_t)(c0 + r) * PQ + s * 128 + q * 4); }
            __syncthreads();
            const int c = F.tid & 63, kq = F.wave;
            float acc[16];
#pragma unroll
            for (int i = 0; i < 16; ++i) acc[i] = 0.f;
            for (int d4 = 0; d4 < 32; ++d4) { const f32x4 w4 = *(const LAS f32x4*)(wl + c * 132 + d4 * 4);
#pragma unroll
                for (int i = 0; i < 16; ++i) { const f32x4 k4 = *(const LAS f32x4*)(kl + (kq * 16 + i) * 132 + d4 * 4); acc[i] += (k4[0] * w4[0] + k4[1] * w4[1]) + (k4[2] * w4[2] + k4[3] * w4[3]); } }
            const float gn = p.in[I_FFGAIN][l * DM + c0 + c];
            bf16_t* dst = (bf16_t*)(p.ws + WS_WEFF) + ((size_t)l * PQ + s * 128 + kq * 16) * DM + c0 + c;
#pragma unroll
            for (int i = 0; i < 16; ++i) dst[(size_t)i * DM] = (bf16_t)(cvt_pk_bf16(acc[i] * gn, 0.f) & 0xffffu);
        }
    }
}

__device__ __forceinline__ int t5_bucket(int n) {
    if (n < 16) return n;
    const float v = logf((float)n / 16.0f) / 2.0794415416798357f * 16.0f;
    const int b = 16 + (int)v; return b < 31 ? b : 31;
}
__device__ __forceinline__ void phase_mix_simple(const Params& p, const Frame& F0, int l) {
    const Frame F = local_frame(F0);
    const int tid = F.tid, lane = F.lane, wave = F.wave;
    LAS float* Kf = (LAS float*)F.lds;
    LAS float* Vf = Kf + 256 * 64;
    LAS float* biasT = Vf + 256 * 64;
    LAS float* rs = biasT + 1024;
    const bf16_t* proj = (const bf16_t*)(p.ws + WS_PROJA);
    bf16_t* mix = (bf16_t*)(p.ws + WS_MIX);
    for (int nb = blockIdx.x; nb < NTOK / 128; nb += F.G) {
        const int t0 = nb * 128; const bool first = (nb % (SEQ / 128)) == 0;
        __syncthreads();
        for (int i = tid; i < 1024; i += NTHREADS) { const int h = i >> 7, dist = i & 127; biasT[i] = p.in[I_RELB][t5_bucket(dist) * 8 + h]; }
        for (int kvh = 0; kvh < 2; ++kvh) {
            __syncthreads();
            for (int c = tid; c < 2048; c += NTHREADS) { const int row = c >> 3, ch = c & 7; const int tok = t0 - 128 + row;
                u32x4 kv = (u32x4){0u, 0u, 0u, 0u}, vv = (u32x4){0u, 0u, 0u, 0u};
                if (row >= 128 || !first) { kv = *(const u32x4*)(proj + (size_t)tok * NA + COL_K + kvh * 64 + ch * 8); vv = *(const u32x4*)(proj + (size_t)tok * NA + COL_V + kvh * 64 + ch * 8); }
                LAS float* kd = Kf + row * 64 + ch * 8; LAS float* vd = Vf + row * 64 + ch * 8;
                kd[0] = bf_lo(kv.x); kd[1] = bf_hi(kv.x); kd[2] = bf_lo(kv.y); kd[3] = bf_hi(kv.y); kd[4] = bf_lo(kv.z); kd[5] = bf_hi(kv.z); kd[6] = bf_lo(kv.w); kd[7] = bf_hi(kv.w);
                vd[0] = bf_lo(vv.x); vd[1] = bf_hi(vv.x); vd[2] = bf_lo(vv.y); vd[3] = bf_hi(vv.y); vd[4] = bf_lo(vv.z); vd[5] = bf_hi(vv.z); vd[6] = bf_lo(vv.w); vd[7] = bf_hi(vv.w); }
            __syncthreads();
            const int hq = tid >> 7, qi = tid & 127, head = kvh * 4 + hq;
            float q[64], o[64];
            { const u32x4* qp = (const u32x4*)(proj + (size_t)(t0 + qi) * NA + head * 64);
#pragma unroll
              for (int j = 0; j < 8; ++j) { const u32x4 w = qp[j]; q[8 * j + 0] = bf_lo(w.x) * 0.125f; q[8 * j + 1] = bf_hi(w.x) * 0.125f; q[8 * j + 2] = bf_lo(w.y) * 0.125f; q[8 * j + 3] = bf_hi(w.y) * 0.125f;
                  q[8 * j + 4] = bf_lo(w.z) * 0.125f; q[8 * j + 5] = bf_hi(w.z) * 0.125f; q[8 * j + 6] = bf_lo(w.w) * 0.125f; q[8 * j + 7] = bf_hi(w.w) * 0.125f; } }
#pragma unroll
            for (int d = 0; d < 64; ++d) o[d] = 0.f;
            const float sink = p.in[I_SINK][l * 8 + head];
            float mrun = sink, lsum = 0.f;
            const int qb = qi & ~63, kmin = qb + 1, kmax = qb + 63 + 128;
            for (int kj = kmin; kj <= kmax; ++kj) {
                const LAS float* kr = Kf + kj * 64; float s = 0.f;
#pragma unroll
                for (int d4 = 0; d4 < 16; ++d4) { const f32x4 k4 = *(const LAS f32x4*)(kr + d4 * 4); s += (q[4 * d4] * k4[0] + q[4 * d4 + 1] * k4[1]) + (q[4 * d4 + 2] * k4[2] + q[4 * d4 + 3] * k4[3]); }
                const int dist = qi + 128 - kj; const bool valid = (dist >= 0) && (dist < 128) && (kj >= 128 || !first);
                const float logit = s + biasT[head * 128 + (dist & 127)];
                const float mnew = valid ? fmaxf(mrun, logit) : mrun;
                const float corr = __expf(mrun - mnew), pp = valid ? __expf(logit - mnew) : 0.f;
                lsum = lsum * corr + pp; mrun = mnew;
                const LAS float* vr = Vf + kj * 64;
#pragma unroll
                for (int d4 = 0; d4 < 16; ++d4) { const f32x4 v4 = *(const LAS f32x4*)(vr + d4 * 4);
                    o[4 * d4] = o[4 * d4] * corr + pp * v4[0]; o[4 * d4 + 1] = o[4 * d4 + 1] * corr + pp * v4[1]; o[4 * d4 + 2] = o[4 * d4 + 2] * corr + pp * v4[2]; o[4 * d4 + 3] = o[4 * d4 + 3] * corr + pp * v4[3]; }
            }
            const float inv = 1.0f / (lsum + __expf(sink - mrun));
            u32x4* op = (u32x4*)(mix + (size_t)(t0 + qi) * MIXW + head * 64);
#pragma unroll
            for (int j = 0; j < 8; ++j) { u32x4 w; w.x = cvt_pk_bf16(o[8 * j] * inv, o[8 * j + 1] * inv); w.y = cvt_pk_bf16(o[8 * j + 2] * inv, o[8 * j + 3] * inv);
                w.z = cvt_pk_bf16(o[8 * j + 4] * inv, o[8 * j + 5] * inv); w.w = cvt_pk_bf16(o[8 * j + 6] * inv, o[8 * j + 7] * inv); op[j] = w; }
        }
        LAS float* Zs = Kf;
        for (int g = 0; g < 4; ++g) {
            const int w = 2 << g;
            __syncthreads();
            for (int i = tid; i < 143 * 16; i += NTHREADS) { const int row = i >> 4, ch = i & 15; const int tok = t0 - 15 + row;
                u32x4 zv = (u32x4){0u, 0u, 0u, 0u};
                if (row >= 15 || !first) zv = *(const u32x4*)(proj + (size_t)tok * NA + COL_PZ + g * 128 + ch * 8);
                LAS float* zd = Zs + row * 128 + ch * 8;
                zd[0] = bf_lo(zv.x); zd[1] = bf_hi(zv.x); zd[2] = bf_lo(zv.y); zd[3] = bf_hi(zv.y); zd[4] = bf_lo(zv.z); zd[5] = bf_hi(zv.z); zd[6] = bf_lo(zv.w); zd[7] = bf_hi(zv.w); }
            __syncthreads();
            const int c = tid & 127, seg = tid >> 7;
            for (int tt = 0; tt < 32; ++tt) { const int t = seg * 32 + tt, r = t + 15; float sum = 0.f;
                for (int j = 0; j < w; ++j) sum += Zs[(r - j) * 128 + c];
                const int pos = (nb % (SEQ / 128)) * 128 + t; const int cnt = (pos + 1 < w) ? pos + 1 : w;
                const float d = sum / (float)cnt - Zs[r * 128 + c];
                mix[(size_t)(t0 + t) * MIXW + 512 + g * 128 + c] = (bf16_t)(cvt_pk_bf16(d, 0.f) & 0xffffu); }
        }
        __syncthreads();
        for (int tt = 0; tt < 16; ++tt) { const int t = wave * 16 + tt; const u32x4 g4 = *(const u32x4*)(proj + (size_t)(t0 + t) * NA + COL_GV + lane * 8);
            float a[8] = {bf_lo(g4.x), bf_hi(g4.x), bf_lo(g4.y), bf_hi(g4.y), bf_lo(g4.z), bf_hi(g4.z), bf_lo(g4.w), bf_hi(g4.w)}; float ss = 0.f;
#pragma unroll
            for (int j = 0; j < 8; ++j) ss += a[j] * a[j];
            ss = wave_sum(ss); if (lane == 0) rs[t] = 1.0f / sqrtf(ss * (1.0f / 512.0f) + EPS); }
        LAS float* Vn = Kf;
        for (int g = 0; g < 4; ++g) {
            __syncthreads();
            for (int i = tid; i < 128 * 16; i += NTHREADS) { const int s = i >> 4, ch = i & 15; const u32x4 g4 = *(const u32x4*)(proj + (size_t)(t0 + s) * NA + COL_GV + g * 128 + ch * 8);
                const float r = rs[s]; const float* gn = p.in[I_VGAIN] + l * 512 + g * 128 + ch * 8; LAS float* vd = Vn + s * 128 + ch * 8;
                vd[0] = bf_lo(g4.x) * r * gn[0]; vd[1] = bf_hi(g4.x) * r * gn[1]; vd[2] = bf_lo(g4.y) * r * gn[2]; vd[3] = bf_hi(g4.y) * r * gn[3];
                vd[4] = bf_lo(g4.z) * r * gn[4]; vd[5] = bf_hi(g4.z) * r * gn[5]; vd[6] = bf_lo(g4.w) * r * gn[6]; vd[7] = bf_hi(g4.w) * r * gn[7]; }
            __syncthreads();
            const int c = tid & 127, tq = tid >> 7;
            for (int t = tq; t < 128; t += 4) { const float* wrow = p.in[I_WSP] + (((size_t)l * 4 + g) * 128 + t) * 128; float acc = 0.f;
                for (int s = 0; s <= t; ++s) acc += wrow[s] * Vn[s * 128 + c];
                const float mixed = acc + p.in[I_BSP][(l * 4 + g) * 128 + t];
                const float uu = bf1(proj[(size_t)(t0 + t) * NA + COL_GU + g * 128 + c]);
                mix[(size_t)(t0 + t) * MIXW + 1024 + g * 128 + c] = (bf16_t)(cvt_pk_bf16(uu * mixed, 0.f) & 0xffffu); }
        }
    }
}

typedef short s16x4 __attribute__((ext_vector_type(4)));
__device__ __forceinline__ void tr_read8(unsigned addrA, unsigned addrB, s16x4 (&lo)[4], s16x4 (&hi)[4]) {
    asm volatile("ds_read_b64_tr_b16 %0, %8\n\tds_read_b64_tr_b16 %1, %8 offset:32\n\tds_read_b64_tr_b16 %2, %8 offset:64\n\tds_read_b64_tr_b16 %3, %8 offset:96\n\t"
                 "ds_read_b64_tr_b16 %4, %9\n\tds_read_b64_tr_b16 %5, %9 offset:32\n\tds_read_b64_tr_b16 %6, %9 offset:64\n\tds_read_b64_tr_b16 %7, %9 offset:96\n\ts_waitcnt lgkmcnt(0)"
                 : "=&v"(lo[0]), "=&v"(lo[1]), "=&v"(lo[2]), "=&v"(lo[3]), "=&v"(hi[0]), "=&v"(hi[1]), "=&v"(hi[2]), "=&v"(hi[3]) : "v"(addrA), "v"(addrB) : "memory");
}
__device__ __forceinline__ void tr_read4(unsigned addrA, s16x4 (&lo)[4]) {
    asm volatile("ds_read_b64_tr_b16 %0, %4\n\tds_read_b64_tr_b16 %1, %4 offset:32\n\tds_read_b64_tr_b16 %2, %4 offset:64\n\tds_read_b64_tr_b16 %3, %4 offset:96\n\ts_waitcnt lgkmcnt(0)"
                 : "=&v"(lo[0]), "=&v"(lo[1]), "=&v"(lo[2]), "=&v"(lo[3]) : "v"(addrA) : "memory");
}
__device__ __forceinline__ bf16x8 cat44(s16x4 a, s16x4 b) { return (bf16x8){a[0], a[1], a[2], a[3], b[0], b[1], b[2], b[3]}; }
constexpr int KVSTR = 144, VNSTR = 272;
__device__ __forceinline__ void phase_mix(const Params& p, const Frame& F0, int l) {
    const Frame F = local_frame(F0);
    const int tid = F.tid, lane = F.lane, wave = F.wave, fr = lane & 15, fq = lane >> 4;
    LAS unsigned char* Kl = F.lds;
    LAS unsigned char* Vl = F.lds + 256 * KVSTR;
    LAS float* biasT = (LAS float*)(F.lds + 2 * 256 * KVSTR);
    LAS float* rs = biasT + 1024;
    const bf16_t* proj = (const bf16_t*)(p.ws + WS_PROJA);
    bf16_t* mix = (bf16_t*)(p.ws + WS_MIX);
    const float LOG2E = 1.4426950408889634f;
    for (int nb = blockIdx.x; nb < NTOK / 128; nb += F.G) {
        const int t0 = nb * 128; const bool first = (nb % (SEQ / 128)) == 0;
        __syncthreads();
        for (int i = tid; i < 1024; i += NTHREADS) { const int h = i >> 7, dist = i & 127; biasT[i] = p.in[I_RELB][t5_bucket(dist) * 8 + h] * LOG2E; }
        for (int kvh = 0; kvh < 2; ++kvh) {
            __syncthreads();
            for (int c = tid; c < 2048; c += NTHREADS) { const int row = c >> 3, ch = c & 7; const int tok = t0 - 128 + row;
                u32x4 kv = (u32x4){0u, 0u, 0u, 0u}, vv = (u32x4){0u, 0u, 0u, 0u};
                if (row >= 128 || !first) { kv = *(const u32x4*)(proj + (size_t)tok * NA + COL_K + kvh * 64 + ch * 8); vv = *(const u32x4*)(proj + (size_t)tok * NA + COL_V + kvh * 64 + ch * 8); }
                *(LAS u32x4*)(Kl + row * KVSTR + ch * 16) = kv; *(LAS u32x4*)(Vl + row * KVSTR + ch * 16) = vv; }
            __syncthreads();
            const int hq = wave >> 1, qh = wave & 1, head = kvh * 4 + hq;
            float br[9][4];
#pragma unroll
            for (int tt = 0; tt < 9; ++tt)
#pragma unroll
                for (int i = 0; i < 4; ++i) { const int dist = 128 + fr - 4 * fq - 16 * tt - i; br[tt][i] = (dist >= 0 && dist < 128) ? biasT[head * 128 + (dist & 127)] : NEG_INF_F; }
            const float sink2 = p.in[I_SINK][l * 8 + head] * LOG2E;
            const unsigned vbase = (unsigned)(size_t)Vl;
#pragma unroll 1
            for (int r = 0; r < 4; ++r) {
                const int R = qh * 4 + r, q0 = 16 * R;
                bf16x8 qf[2];
#pragma unroll
                for (int s = 0; s < 2; ++s) qf[s] = *(const bf16x8*)(proj + (size_t)(t0 + q0 + fr) * NA + head * 64 + 32 * s + 8 * fq);
                f32x4 sacc[9];
#pragma unroll
                for (int tt = 0; tt < 9; ++tt) { sacc[tt] = (f32x4){0.f, 0.f, 0.f, 0.f};
#pragma unroll
                    for (int s = 0; s < 2; ++s) { const bf16x8 kf = *(const LAS bf16x8*)(Kl + (16 * (R + tt) + fr) * KVSTR + s * 64 + fq * 16);
                        sacc[tt] = __builtin_amdgcn_mfma_f32_16x16x32_bf16(kf, qf[s], sacc[tt], 0, 0, 0); } }
                float mx = sink2;
#pragma unroll
                for (int tt = 0; tt < 9; ++tt) { const bool dead = first && (R + tt < 8);
#pragma unroll
                    for (int i = 0; i < 4; ++i) { const float lg = dead ? NEG_INF_F : (sacc[tt][i] * (0.125f * LOG2E) + br[tt][i]); sacc[tt][i] = lg; mx = fmaxf(mx, lg); } }
                mx = fmaxf(mx, __shfl_xor(mx, 16)); mx = fmaxf(mx, __shfl_xor(mx, 32));
                float ls = 0.f;
#pragma unroll
                for (int tt = 0; tt < 9; ++tt)
#pragma unroll
                    for (int i = 0; i < 4; ++i) { const float pv = __builtin_amdgcn_exp2f(sacc[tt][i] - mx); sacc[tt][i] = pv; ls += pv; }
                ls += __shfl_xor(ls, 16); ls += __shfl_xor(ls, 32);
                const float inv = 1.0f / (ls + __builtin_amdgcn_exp2f(sink2 - mx));
                f32x4 oacc[4];
#pragma unroll
                for (int c = 0; c < 4; ++c) oacc[c] = (f32x4){0.f, 0.f, 0.f, 0.f};
#pragma unroll
                for (int u = 0; u < 5; ++u) {
                    u32x4 pw; pw.x = cvt_pk_bf16(sacc[2 * u][0], sacc[2 * u][1]); pw.y = cvt_pk_bf16(sacc[2 * u][2], sacc[2 * u][3]);
                    if (u < 4) { pw.z = cvt_pk_bf16(sacc[2 * u + 1][0], sacc[2 * u + 1][1]); pw.w = cvt_pk_bf16(sacc[2 * u + 1][2], sacc[2 * u + 1][3]); } else { pw.z = 0u; pw.w = 0u; }
                    const bf16x8 pf = __builtin_bit_cast(bf16x8, pw);
                    const unsigned addrA = vbase + (unsigned)((16 * (R + 2 * u) + 4 * fq + (fr >> 2)) * KVSTR + (4 * (fr & 3)) * 2);
                    s16x4 lo[4], hi[4];
                    if (u < 4) tr_read8(addrA, addrA + 16 * KVSTR, lo, hi);
                    else { tr_read4(addrA, lo);
#pragma unroll
                        for (int c = 0; c < 4; ++c) hi[c] = (s16x4){0, 0, 0, 0}; }
#pragma unroll
                    for (int c = 0; c < 4; ++c) oacc[c] = __builtin_amdgcn_mfma_f32_16x16x32_bf16(cat44(lo[c], hi[c]), pf, oacc[c], 0, 0, 0);
                }
                bf16_t* op = mix + (size_t)(t0 + q0 + fr) * MIXW + head * 64 + 4 * fq;
#pragma unroll
                for (int c = 0; c < 4; ++c) { u32x2 w; w.x = cvt_pk_bf16(oacc[c][0] * inv, oacc[c][1] * inv); w.y = cvt_pk_bf16(oacc[c][2] * inv, oacc[c][3] * inv); *(u32x2*)(op + 16 * c) = w; }
            }
        }
        LAS float* Zs = (LAS float*)F.lds;
        for (int g = 0; g < 4; ++g) {
            const int w = 2 << g;
            __syncthreads();
            for (int i = tid; i < 143 * 16; i += NTHREADS) { const int row = i >> 4, ch = i & 15; const int tok = t0 - 15 + row;
                u32x4 zv = (u32x4){0u, 0u, 0u, 0u};
                if (row >= 15 || !first) zv = *(const u32x4*)(proj + (size_t)tok * NA + COL_PZ + g * 128 + ch * 8);
                LAS float* zd = Zs + row * 128 + ch * 8;
                *(LAS f32x4*)zd = (f32x4){bf_lo(zv.x), bf_hi(zv.x), bf_lo(zv.y), bf_hi(zv.y)}; *(LAS f32x4*)(zd + 4) = (f32x4){bf_lo(zv.z), bf_hi(zv.z), bf_lo(zv.w), bf_hi(zv.w)}; }
            __syncthreads();
            const int c2 = tid & 63, seg = tid >> 6;
            const int tb = seg * 16; float sa = 0.f, sb = 0.f;
            for (int j = 1; j < w; ++j) { const f32x2 z = *(const LAS f32x2*)(Zs + (tb + 15 - j) * 128 + 2 * c2); sa += z[0]; sb += z[1]; }
            const int posb = (nb % (SEQ / 128)) * 128;
            for (int tt = 0; tt < 16; ++tt) { const int t = tb + tt, r = t + 15;
                const f32x2 z = *(const LAS f32x2*)(Zs + r * 128 + 2 * c2); sa += z[0]; sb += z[1];
                const int pos = posb + t; const float icnt = 1.0f / (float)((pos + 1 < w) ? pos + 1 : w);
                *(unsigned*)(mix + (size_t)(t0 + t) * MIXW + 512 + g * 128 + 2 * c2) = cvt_pk_bf16(sa * icnt - z[0], sb * icnt - z[1]);
                const f32x2 zo = *(const LAS f32x2*)(Zs + (r - w + 1) * 128 + 2 * c2); sa -= zo[0]; sb -= zo[1]; }
        }
        __syncthreads();
        for (int tt = 0; tt < 16; ++tt) { const int t = wave * 16 + tt; const u32x4 g4 = *(const u32x4*)(proj + (size_t)(t0 + t) * NA + COL_GV + lane * 8);
            const float a[8] = {bf_lo(g4.x), bf_hi(g4.x), bf_lo(g4.y), bf_hi(g4.y), bf_lo(g4.z), bf_hi(g4.z), bf_lo(g4.w), bf_hi(g4.w)}; float ss = 0.f;
#pragma unroll
            for (int j = 0; j < 8; ++j) ss += a[j] * a[j];
            ss = wave_sum(ss); if (lane == 0) rs[t] = 1.0f / sqrtf(ss * (1.0f / 512.0f) + EPS); }
        LAS unsigned char* Vn = F.lds;
        const bf16_t* Wsp = (const bf16_t*)(p.ws + WS_WSP);
        for (int g = 0; g < 4; ++g) {
            __syncthreads();
            for (int i = tid; i < 128 * 16; i += NTHREADS) { const int s = i >> 4, ch = i & 15; const u32x4 g4 = *(const u32x4*)(proj + (size_t)(t0 + s) * NA + COL_GV + g * 128 + ch * 8);
                const float r = rs[s]; const float* gn = p.in[I_VGAIN] + l * 512 + g * 128 + ch * 8; const f32x4 ga = *(const f32x4*)gn, gb = *(const f32x4*)(gn + 4);
                u32x4 w; w.x = cvt_pk_bf16(bf_lo(g4.x) * r * ga[0], bf_hi(g4.x) * r * ga[1]); w.y = cvt_pk_bf16(bf_lo(g4.y) * r * ga[2], bf_hi(g4.y) * r * ga[3]);
                w.z = cvt_pk_bf16(bf_lo(g4.z) * r * gb[0], bf_hi(g4.z) * r * gb[1]); w.w = cvt_pk_bf16(bf_lo(g4.w) * r * gb[2], bf_hi(g4.w) * r * gb[3]);
                *(LAS u32x4*)(Vn + s * VNSTR + ch * 16) = w; }
            __syncthreads();
            const int T = wave; f32x4 acc[8];
#pragma unroll
            for (int c = 0; c < 8; ++c) acc[c] = (f32x4){0.f, 0.f, 0.f, 0.f};
            const bf16_t* wrow = Wsp + (((size_t)l * 4 + g) * 128 + 16 * T + fr) * 128 + 8 * fq;
            const unsigned vnb = (unsigned)(size_t)Vn;
#pragma unroll 1
            for (int u = 0; u <= (T >> 1); ++u) {
                const bf16x8 wf = *(const bf16x8*)(wrow + 32 * u);
                const unsigned addrA = vnb + (unsigned)((32 * u + 8 * fq + (fr >> 2)) * VNSTR + (4 * (fr & 3)) * 2);
#pragma unroll
                for (int hf = 0; hf < 2; ++hf) { s16x4 lo[4], hi[4]; tr_read8(addrA + hf * 128, addrA + hf * 128 + 4 * VNSTR, lo, hi);
#pragma unroll
                    for (int c = 0; c < 4; ++c) acc[hf * 4 + c] = __builtin_amdgcn_mfma_f32_16x16x32_bf16(cat44(lo[c], hi[c]), wf, acc[hf * 4 + c], 0, 0, 0); }
            }
            const int t = 16 * T + fr; const float bs = p.in[I_BSP][(l * 4 + g) * 128 + t];
            const bf16_t* up = proj + (size_t)(t0 + t) * NA + COL_GU + g * 128 + 4 * fq; bf16_t* op = mix + (size_t)(t0 + t) * MIXW + 1024 + g * 128 + 4 * fq;
#pragma unroll
            for (int c = 0; c < 8; ++c) { const u32x2 uw = *(const u32x2*)(up + 16 * c);
                u32x2 w; w.x = cvt_pk_bf16(bf_lo(uw.x) * (acc[c][0] + bs), bf_hi(uw.x) * (acc[c][1] + bs)); w.y = cvt_pk_bf16(bf_lo(uw.y) * (acc[c][2] + bs), bf_hi(uw.y) * (acc[c][3] + bs));
                *(u32x2*)(op + 16 * c) = w; }
        }
    }
}

__device__ __forceinline__ unsigned ordkey(unsigned bits) { return bits ^ ((unsigned)((int)bits >> 31) | 0x80000000u); }
__device__ __forceinline__ unsigned unord(unsigned k) { return (k & 0x80000000u) ? (k ^ 0x80000000u) : ~k; }
__device__ __forceinline__ void phase_topk(const Params& p, const Frame& F0, int l) {
    const Frame F = local_frame(F0);
    const int lane = F.lane, wave = F.wave;
    LAS float* tile = (LAS float*)(F.lds + wave * 8448);
    LAS unsigned char* itab = (LAS unsigned char*)(F.lds + 8 * 8448 + wave * 64 * 36 + lane * 36);
    const float* scores = (const float*)(p.ws + WS_SCORES);
    const float* rowsq = (const float*)(p.ws + WS_ROWSQP) + (size_t)l * NTOK * 16;
    unsigned* seli = (unsigned*)(p.ws + WS_SELI); float* selg = (float*)(p.ws + WS_SELG);
    const int gw = blockIdx.x * NWAVES + wave, NGW = F.G * NWAVES;
    for (int grp = gw; grp < NTOK * 8 / 64; grp += NGW) {
        const size_t item0 = (size_t)grp * 64;
        unsigned L1[16], L2[16];
#pragma unroll
        for (int j = 0; j < 16; ++j) { L1[j] = 0u; L2[j] = 0u; }
#pragma unroll 1
        for (int ch = 0; ch < 8; ++ch) {
#pragma unroll
            for (int i = 0; i < 8; ++i) { const int row = 8 * i + (lane >> 3), cg = lane & 7;
                const f32x4 v = *(const f32x4*)(scores + (item0 + row) * 256 + ch * 32 + cg * 4);
                LAS float* d = tile + row * 33 + cg * 4; d[0] = v[0]; d[1] = v[1]; d[2] = v[2]; d[3] = v[3]; }
            __builtin_amdgcn_wave_barrier(); asm volatile("s_waitcnt lgkmcnt(0)" ::: "memory");
            if (ch < 4) {
#pragma unroll
                for (int j = 0; j < 32; ++j) { unsigned x = ordkey((__float_as_uint(tile[lane * 33 + j]) & 0xffffff80u) | (unsigned)(ch * 32 + j));
#pragma unroll
                    for (int k = 0; k < 16; ++k) { const unsigned hi = max(L1[k], x); x = min(L1[k], x); L1[k] = hi; } }
            } else {
#pragma unroll
                for (int j = 0; j < 32; ++j) { unsigned x = ordkey((__float_as_uint(tile[lane * 33 + j]) & 0xffffff80u) | (unsigned)((ch - 4) * 32 + j));
#pragma unroll
                    for (int k = 0; k < 16; ++k) { const unsigned hi = max(L2[k], x); x = min(L2[k], x); L2[k] = hi; } }
            }
            __builtin_amdgcn_wave_barrier(); asm volatile("s_waitcnt lgkmcnt(0)" ::: "memory");
        }
        float f1[16], f2[16];
#pragma unroll
        for (int k = 0; k < 16; ++k) { const unsigned b1 = unord(L1[k]), b2 = unord(L2[k]); f1[k] = __uint_as_float(b1); f2[k] = __uint_as_float(b2); itab[k] = (unsigned char)(b1 & 127u); itab[16 + k] = (unsigned char)(b2 & 127u); }
        unsigned T[16];
#pragma unroll
        for (int j = 0; j < 16; ++j) T[j] = 0u;
#pragma unroll
        for (int i = 0; i < 16; ++i)
#pragma unroll
            for (int j = 0; j < 16; ++j) if ((i + 1) * (j + 1) <= 16) {
                unsigned x = ordkey((__float_as_uint(f1[i] + f2[j]) & 0xffffff00u) | (unsigned)(i * 16 + j));
#pragma unroll
                for (int k = 0; k < 16; ++k) { const unsigned hi = max(T[k], x); x = min(T[k], x); T[k] = hi; } }
        asm volatile("s_waitcnt lgkmcnt(0)" ::: "memory");
        const size_t item = item0 + lane; const int tok = (int)(item >> 3);
        const float rstd = 1.0f / sqrtf(row_sumsq(rowsq, tok) * (1.0f / DM) + EPS);
        float e[16], se = 0.f; unsigned P[16];
        const float t0v = __uint_as_float(unord(T[0]));
#pragma unroll
        for (int k = 0; k < 16; ++k) { const unsigned b = unord(T[k]); e[k] = __expf((__uint_as_float(b) - t0v) * rstd); se += e[k];
            const unsigned code = b & 255u; P[k] = ((unsigned)itab[code >> 4] << 7) | (unsigned)itab[16 + (code & 15u)]; }
        const float inv = 1.0f / se;
        u32x4* di = (u32x4*)(seli + item * 16); f32x4* dg = (f32x4*)(selg + item * 16);
#pragma unroll
        for (int k4 = 0; k4 < 4; ++k4) { di[k4] = (u32x4){P[4 * k4], P[4 * k4 + 1], P[4 * k4 + 2], P[4 * k4 + 3]};
            dg[k4] = (f32x4){e[4 * k4] * inv, e[4 * k4 + 1] * inv, e[4 * k4 + 2] * inv, e[4 * k4 + 3] * inv}; }
        asm volatile("s_waitcnt lgkmcnt(0)" ::: "memory");
    }
}

__device__ __forceinline__ void fp8x16_to_f32(const u32x4 w, float (&f)[16]) {
#pragma unroll
    for (int q = 0; q < 4; ++q) { const f32x2 lo = __builtin_amdgcn_cvt_pk_f32_fp8((int)w[q], false), hi = __builtin_amdgcn_cvt_pk_f32_fp8((int)w[q], true);
        f[4 * q] = lo[0]; f[4 * q + 1] = lo[1]; f[4 * q + 2] = hi[0]; f[4 * q + 3] = hi[1]; }
}
__device__ __forceinline__ void phase_gather(const Params& p, const Frame& F0, int l, bool dry = false) {
    const Frame F = local_frame(F0);
    const int lane = F.lane;
    const unsigned char* EU = p.ws + WS_EXP + (size_t)(l * 2 + 0) * NEXP * DM; const unsigned char* EV = p.ws + WS_EXP + (size_t)(l * 2 + 1) * NEXP * DM;
    const float* SU = (const float*)(p.ws + WS_ESCALE) + (size_t)(l * 2 + 0) * NEXP; const float* SV = SU + NEXP;
    const bf16_t* xb = (const bf16_t*)(p.ws + WS_XB);
    bf16_t* xbo = dry ? (bf16_t*)(p.ws + WS_GATES) : (bf16_t*)(p.ws + WS_XB);
    float* outp = dry ? (float*)(p.ws + WS_GATES) : p.out;
    float* rstdo = dry ? (float*)(p.ws + WS_GATES + 160 * MiB) : (float*)(p.ws + WS_RSTD);
    const float* rowsq = (const float*)(p.ws + WS_ROWSQP) + (size_t)l * NTOK * 16;
    const unsigned* seli = (const unsigned*)(p.ws + WS_SELI); const float* selg = (const float*)(p.ws + WS_SELG);
    const float* gain = p.in[I_FFGAIN] + l * DM + lane * 16;
    const bool hi32 = (lane & 32) != 0, hi16 = (lane & 16) != 0, hi8 = (lane & 8) != 0;
    const int mym = (hi32 ? 4 : 0) + (hi16 ? 2 : 0) + (hi8 ? 1 : 0);
    const int gw = blockIdx.x * NWAVES + F.wave, NGW = F.G * NWAVES;
    for (int tok = gw; tok < NTOK; tok += NGW) {
        float h2[16], o[16];
        const float rstd = 1.0f / sqrtf(row_sumsq(rowsq, tok) * (1.0f / DM) + EPS);
        const u32x4 xw0 = *(const u32x4*)(xb + (size_t)tok * DM + lane * 16), xw1 = *(const u32x4*)(xb + (size_t)tok * DM + lane * 16 + 8);
        {   const f32x4 g0 = *(const f32x4*)gain, g1 = *(const f32x4*)(gain + 4), g2 = *(const f32x4*)(gain + 8), g3 = *(const f32x4*)(gain + 12);
            h2[0] = bf_lo(xw0.x) * rstd * g0[0]; h2[1] = bf_hi(xw0.x) * rstd * g0[1]; h2[2] = bf_lo(xw0.y) * rstd * g0[2]; h2[3] = bf_hi(xw0.y) * rstd * g0[3];
            h2[4] = bf_lo(xw0.z) * rstd * g1[0]; h2[5] = bf_hi(xw0.z) * rstd * g1[1]; h2[6] = bf_lo(xw0.w) * rstd * g1[2]; h2[7] = bf_hi(xw0.w) * rstd * g1[3];
            h2[8] = bf_lo(xw1.x) * rstd * g2[0]; h2[9] = bf_hi(xw1.x) * rstd * g2[1]; h2[10] = bf_lo(xw1.y) * rstd * g2[2]; h2[11] = bf_hi(xw1.y) * rstd * g2[3];
            h2[12] = bf_lo(xw1.z) * rstd * g3[0]; h2[13] = bf_hi(xw1.z) * rstd * g3[1]; h2[14] = bf_lo(xw1.w) * rstd * g3[2]; h2[15] = bf_hi(xw1.w) * rstd * g3[3]; }
#pragma unroll
        for (int i = 0; i < 16; ++i) o[i] = 0.f;
        const unsigned myi0 = seli[(size_t)tok * 128 + lane], myi1 = seli[(size_t)tok * 128 + 64 + lane];
        const float myg0 = selg[(size_t)tok * 128 + lane], myg1 = selg[(size_t)tok * 128 + 64 + lane];
#pragma unroll 1
        for (int kb = 0; kb < 16; ++kb) {
            const unsigned isrc = (kb < 8) ? myi0 : myi1; const float gsrc = (kb < 8) ? myg0 : myg1; const int kl = (kb & 7) * 8;
            u32x4 uu[8], vv[8];
#pragma unroll
            for (int i = 0; i < 8; ++i) { const unsigned e = __builtin_amdgcn_readlane(isrc, kl + i);
                uu[i] = *(const u32x4*)(EU + (size_t)e * DM + lane * 16); vv[i] = *(const u32x4*)(EV + (size_t)e * DM + lane * 16); }
            const unsigned mye = __shfl(isrc, kl + mym); const float myg = __shfl(gsrc, kl + mym);
            const float su = SU[mye], sv = SV[mye];
            float d[8];
#pragma unroll
            for (int i = 0; i < 8; ++i) { float f[16]; fp8x16_to_f32(uu[i], f); float s0 = 0.f, s1 = 0.f;
#pragma unroll
                for (int j = 0; j < 8; ++j) { s0 += h2[2 * j] * f[2 * j]; s1 += h2[2 * j + 1] * f[2 * j + 1]; }
                d[i] = s0 + s1; }
            float a4[4], b2[2];
#pragma unroll
            for (int j = 0; j < 4; ++j) { const float keep = hi32 ? d[j + 4] : d[j], send = hi32 ? d[j] : d[j + 4]; a4[j] = keep + __shfl_xor(send, 32); }
#pragma unroll
            for (int j = 0; j < 2; ++j) { const float keep = hi16 ? a4[j + 2] : a4[j], send = hi16 ? a4[j] : a4[j + 2]; b2[j] = keep + __shfl_xor(send, 16); }
            float dm; { const float keep = hi8 ? b2[1] : b2[0], send = hi8 ? b2[0] : b2[1]; dm = keep + __shfl_xor(send, 8); }
            dm += __shfl_xor(dm, 4); dm += __shfl_xor(dm, 2); dm += __shfl_xor(dm, 1);
            const float cf = myg * gelu_tanh(dm * su) * sv;
#pragma unroll
            for (int i = 0; i < 8; ++i) { const float ci = __uint_as_float(__builtin_amdgcn_readlane(__float_as_uint(cf), ((i & 4) ? 32 : 0) + ((i & 2) ? 16 : 0) + ((i & 1) ? 8 : 0)));
                float f[16]; fp8x16_to_f32(vv[i], f);
#pragma unroll
                for (int j = 0; j < 16; ++j) o[j] += ci * f[j]; }
        }
        {   o[0] += bf_lo(xw0.x); o[1] += bf_hi(xw0.x); o[2] += bf_lo(xw0.y); o[3] += bf_hi(xw0.y); o[4] += bf_lo(xw0.z); o[5] += bf_hi(xw0.z); o[6] += bf_lo(xw0.w); o[7] += bf_hi(xw0.w);
            o[8] += bf_lo(xw1.x); o[9] += bf_hi(xw1.x); o[10] += bf_lo(xw1.y); o[11] += bf_hi(xw1.y); o[12] += bf_lo(xw1.z); o[13] += bf_hi(xw1.z); o[14] += bf_lo(xw1.w); o[15] += bf_hi(xw1.w); }
        float ss = 0.f;
#pragma unroll
        for (int i = 0; i < 16; ++i) ss += o[i] * o[i];
        ss = wave_sum(ss);
        const float r2 = 1.0f / sqrtf(ss * (1.0f / DM) + EPS);
        if (l + 1 < DEPTH) {
            u32x4 w0, w1; w0.x = cvt_pk_bf16(o[0], o[1]); w0.y = cvt_pk_bf16(o[2], o[3]); w0.z = cvt_pk_bf16(o[4], o[5]); w0.w = cvt_pk_bf16(o[6], o[7]);
            w1.x = cvt_pk_bf16(o[8], o[9]); w1.y = cvt_pk_bf16(o[10], o[11]); w1.z = cvt_pk_bf16(o[12], o[13]); w1.w = cvt_pk_bf16(o[14], o[15]);
            *(u32x4*)(xbo + (size_t)tok * DM + lane * 16) = w0; *(u32x4*)(xbo + (size_t)tok * DM + lane * 16 + 8) = w1;
            if (lane == 0) rstdo[(size_t)(l + 1) * NTOK + tok] = r2;
        } else {
            const float* fg = p.in[I_FGAIN] + lane * 16; float* dst = outp + (size_t)tok * DM + lane * 16;
#pragma unroll
            for (int q = 0; q < 4; ++q) { const f32x4 g = *(const f32x4*)(fg + 4 * q);
                *(f32x4*)(dst + 4 * q) = (f32x4){o[4 * q] * r2 * g[0], o[4 * q + 1] * r2 * g[1], o[4 * q + 2] * r2 * g[2], o[4 * q + 3] * r2 * g[3]}; }
        }
    }
}

constexpr int PH_PER_LAYER = 8, N_PHASES = 1 + DEPTH * PH_PER_LAYER;
__global__ void __launch_bounds__(NTHREADS, 2) mk_fwd(Params p) {
    extern __shared__ __attribute__((aligned(16))) unsigned char lds_raw[];
    Frame F; F.lds = (LAS unsigned char*)lds_raw; F.tid = threadIdx.x; F.lane = F.tid & 63; F.wave = __builtin_amdgcn_readfirstlane(F.tid >> 6);
    F.G = gridDim.x; { const int bx = blockIdx.x; F.vcu = (F.G % 8 == 0) ? (bx % 8) * (F.G / 8) + bx / 8 : bx; }
    volatile LAS unsigned* misc = (volatile LAS unsigned*)(F.lds + LDS_MISC);
    if (F.tid < 64) misc[F.tid] = 0u;
    __syncthreads();
    unsigned* ctl = (unsigned*)(p.ws + WS_CTL);
    XcdBarrier bar; bar.bar = ctl + CTL_BAR_WORD; bar.x = 0; bar.st = nullptr;
    const bool one_launch = (p.ph_hi - p.ph_lo) > 1;
    if (one_launch) bar = xcd_barrier_post(ctl + CTL_BAR_WORD, misc);
    const int lo = p.ph_lo, hi = p.ph_hi;
#define IN(k) (lo <= (k) && (k) < hi)
#define SEAM(k) do { if (IN(k) && IN((k) + 1)) xcd_barrier(bar); } while (0)
    bf16_t* xb = (bf16_t*)(p.ws + WS_XB);
    if (IN(0)) { if (PD(8)) phase_prologue(p, F); phase_prologue(p, F); SEAM(0); }
    for (int l = 0; l < DEPTH; ++l) {
        const int b = 1 + l * PH_PER_LAYER;
        const float* rstd_a = (const float*)(p.ws + WS_RSTD) + (size_t)l * NTOK;
        if (IN(b + 0)) {
            pg8::Gemm g{xb, (const bf16_t*)(p.ws + WS_WTIN) + (size_t)l * NIN * DM, DM, DM, DM, 0, 0};
            pg8::TileOrder<1> S; S.init(NTOK, NA, F.G, (int)blockIdx.x);
            EpiProjA E{(bf16_t*)(p.ws + WS_PROJA), rstd_a};
            if (PD(0)) pg8::gemm_phase(F.lds, g, S, E);
            pg8::gemm_phase(F.lds, g, S, E); SEAM(b + 0);
        }
        if (IN(b + 1)) {
#if defined(MIX_SIMPLE)
            phase_mix_simple(p, F, l);
#else
            if (PD(1)) phase_mix(p, F, l);
            phase_mix(p, F, l);
#endif
            SEAM(b + 1);
        }
        if (IN(b + 2)) {
            pg8::Gemm g{xb, (const bf16_t*)(p.ws + WS_WTIN) + ((size_t)l * NIN + NA) * DM, DM, DM, DM, 0, 0};
            pg8::TileOrder<1> S; S.init(NTOK, NG, F.G, (int)blockIdx.x);
            EpiGates E{(bf16_t*)(p.ws + WS_GATES), rstd_a, p.in[I_BGATE] + l * NG};
            if (PD(2)) pg8::gemm_phase(F.lds, g, S, E);
            pg8::gemm_phase(F.lds, g, S, E); SEAM(b + 2);
        }
        if (IN(b + 3)) {
            pg8::Gemm g{(const bf16_t*)(p.ws + WS_MIX), (const bf16_t*)(p.ws + WS_WTBR) + (size_t)l * 3 * DM * 512, MIXW, 512, 512, (size_t)512 * 2, (size_t)DM * 512 * 2};
            pg8::TileOrder<3> S; S.init(NTOK, DM, F.G, (int)blockIdx.x);
            EpiMerge E{(const bf16_t*)(p.ws + WS_GATES), (bf16_t*)p.out};
            if (PD(3)) pg8::gemm_phase(F.lds, g, S, E);
            pg8::gemm_phase(F.lds, g, S, E); SEAM(b + 3);
        }
        if (IN(b + 4)) {
            pg8::Gemm g{(const bf16_t*)p.out, (const bf16_t*)(p.ws + WS_WTOUT) + (size_t)l * DM * DM, DM, DM, DM, 0, 0};
            pg8::TileOrder<1> S; S.init(NTOK, DM, F.G, (int)blockIdx.x);
            EpiResid E{xb, (float*)(p.ws + WS_ROWSQP) + (size_t)l * NTOK * 16, xb};
            if (PD(4)) { EpiResid E2{xb, (float*)(p.ws + WS_ROWSQP) + (size_t)l * NTOK * 16, (bf16_t*)(p.ws + WS_GATES)}; pg8::gemm_phase(F.lds, g, S, E2); }
            pg8::gemm_phase(F.lds, g, S, E); SEAM(b + 4);
        }
        if (IN(b + 5)) {
            pg8::Gemm g{xb, (const bf16_t*)(p.ws + WS_WEFF) + (size_t)l * PQ * DM, DM, DM, DM, 0, 0};
            pg8::TileOrder<1> S; S.init(NTOK, PQ, F.G, (int)blockIdx.x);
            EpiScores E{(float*)(p.ws + WS_SCORES)};
            if (PD(5)) pg8::gemm_phase(F.lds, g, S, E);
            pg8::gemm_phase(F.lds, g, S, E); SEAM(b + 5);
        }
        if (IN(b + 6)) { if (PD(6)) phase_topk(p, F, l); phase_topk(p, F, l); SEAM(b + 6); }
        if (IN(b + 7)) { if (PD(7)) phase_gather(p, F, l, true); phase_gather(p, F, l); SEAM(b + 7); }
    }
#undef IN
#undef SEAM
}

extern "C" void kernel_launch(void* const* d_in, const int* in_sizes, int n_in, void* d_out, int out_size, void* d_ws, size_t ws_size, hipStream_t stream) {
    static int grid = 0;
    if (grid == 0) {
        if (n_in != 22 || out_size != NTOK * DM || ws_size < WS_END) { fprintf(stderr, "kernel_launch: unexpected shapes (n_in %d, out %d, ws %zu)\n", n_in, out_size, ws_size); grid = -1; return; }
        int dev = 0, cus = 0, per_cu = 0;
        if (hipGetDevice(&dev) != hipSuccess || hipDeviceGetAttribute(&cus, hipDeviceAttributeMultiprocessorCount, dev) != hipSuccess) { grid = -1; return; }
        if (hipFuncSetAttribute((const void*)mk_fwd, hipFuncAttributeMaxDynamicSharedMemorySize, LDS_BYTES) != hipSuccess) { fprintf(stderr, "kernel_launch: hipFuncSetAttribute failed\n"); grid = -1; return; }
        if (hipOccupancyMaxActiveBlocksPerMultiprocessor(&per_cu, (const void*)mk_fwd, NTHREADS, LDS_BYTES) != hipSuccess || per_cu < 1) { fprintf(stderr, "kernel_launch: occupancy query says %d\n", per_cu); }
        (void)hipGetLastError();
        grid = cus;
    }
    if (grid < 0) return;
    (void)hipMemsetAsync((char*)d_ws + WS_CTL, 0, CTL_ZERO_BYTES, stream);
    Params p; memset(&p, 0, sizeof(p));
    for (int i = 0; i < 22; ++i) p.in[i] = (const float*)d_in[i];
    p.out = (float*)d_out; p.ws = (unsigned char*)d_ws;
#if MK_N_LAUNCHES == 1
    p.ph_lo = 0; p.ph_hi = N_PHASES; p.li = 0;
    hipLaunchKernelGGL(mk_fwd, dim3(grid), dim3(NTHREADS), LDS_BYTES, stream, p);
#else
    for (int ph = 0; ph < N_PHASES; ++ph) { p.ph_lo = ph; p.ph_hi = ph + 1; p.li = ph; hipLaunchKernelGGL(mk_fwd, dim3(grid), dim3(NTHREADS), LDS_BYTES, stream, p); }
#endif
}
```

```cpp
#include <hip/hip_runtime.h>
#include <cstdio>
#include <cstdint>
#include <cstring>

#ifndef MK_N_LAUNCHES
#define MK_N_LAUNCHES 1
#endif

#ifndef PROBE_DOUBLE
#define PROBE_DOUBLE -1
#endif
#define PD(k) (PROBE_DOUBLE == (k) || (PROBE_DOUBLE == 100 && ((k) == 0 || ((k) >= 2 && (k) <= 5))))

#define LAS __attribute__((address_space(3)))
typedef unsigned short bf16_t;
typedef short bf16x8 __attribute__((ext_vector_type(8)));
typedef float f32x4 __attribute__((ext_vector_type(4)));
typedef float f32x2 __attribute__((ext_vector_type(2)));
typedef unsigned u32x4 __attribute__((ext_vector_type(4)));
typedef unsigned u32x2 __attribute__((ext_vector_type(2)));
typedef __bf16 bf16x2_t __attribute__((ext_vector_type(2)));

constexpr int NTOK = 32768, DM = 1024, SEQ = 16384, DEPTH = 2;
constexpr int NA = 2304, NG = 3072, NIN = 5376;
constexpr int COL_K = 512, COL_V = 640, COL_PZ = 768, COL_GU = 1280, COL_GV = 1792;
constexpr int MIXW = 1536;
constexpr int NEXP = 16384, PQ = 2048;
constexpr float EPS = 1e-6f;
constexpr int NWAVES = 8, NTHREADS = 512;

constexpr size_t MiB = 1u << 20;
constexpr size_t WS_CTL = 0, CTL_ZERO_BYTES = 1 * MiB;
constexpr size_t CTL_BAR_WORD = 4096;
constexpr size_t CTL_ROWSQ = 256 * 1024;
constexpr size_t WS_RSTD = 1 * MiB;
constexpr size_t WS_WTIN = 2 * MiB;
constexpr size_t WS_WTBR = 23 * MiB;
constexpr size_t WS_WTOUT = 29 * MiB;
constexpr size_t WS_WEFF = 33 * MiB;
constexpr size_t WS_WSP = 41 * MiB;
constexpr size_t WS_ROWSQP = 42 * MiB;
constexpr size_t WS_ESCALE = 46 * MiB;
constexpr size_t WS_EXP = 48 * MiB;
constexpr size_t WS_XB = 112 * MiB;
constexpr size_t WS_PROJA = 176 * MiB;
constexpr size_t WS_GATES = 176 * MiB;
constexpr size_t WS_MIX = 368 * MiB;
constexpr size_t WS_SCORES = 176 * MiB;
constexpr size_t WS_SELI = 464 * MiB, WS_SELG = 480 * MiB;
constexpr size_t WS_END = 496 * MiB;

constexpr int LDS_BYTES = 163840;
constexpr int LDS_MISC = LDS_BYTES - 256;

#define NEG_INF_F (__uint_as_float(0xff800000u))
__device__ __forceinline__ unsigned cvt_pk_bf16(float lo, float hi) { unsigned r; asm volatile("v_cvt_pk_bf16_f32 %0, %1, %2" : "=v"(r) : "v"(lo), "v"(hi)); return r; }
__device__ __forceinline__ float bf_lo(unsigned u) { return __uint_as_float(u << 16); }
__device__ __forceinline__ float bf_hi(unsigned u) { return __uint_as_float(u & 0xffff0000u); }
__device__ __forceinline__ float bf1(bf16_t u) { return __uint_as_float(((unsigned)u) << 16); }
__device__ __forceinline__ float wave_sum(float v) {
#pragma unroll
    for (int o = 1; o < 64; o <<= 1) v += __shfl_xor(v, o);
    return v;
}
__device__ __forceinline__ float gelu_tanh(float x) {
    const float u = 0.7978845608028654f * (x + 0.044715f * x * x * x);
    const float e = __builtin_amdgcn_exp2f(-2.0f * 1.4426950408889634f * u);
    return x * __builtin_amdgcn_rcpf(1.0f + e);
}
__device__ __forceinline__ float row_sumsq(const float* part, int row) { const f32x4* q = (const f32x4*)(part + (size_t)row * 16); const f32x4 a = q[0], b = q[1], c = q[2], d = q[3];
    return (((a[0] + a[1]) + (a[2] + a[3])) + ((b[0] + b[1]) + (b[2] + b[3]))) + (((c[0] + c[1]) + (c[2] + c[3])) + ((d[0] + d[1]) + (d[2] + d[3]))); }
__device__ __forceinline__ float sigmoidf_(float x) { return __builtin_amdgcn_rcpf(1.0f + __builtin_amdgcn_exp2f(-1.4426950408889634f * x)); }

#define XB_TMO      128
#define XB_XCNT(j)  (256  + 64 * (j))
#define XB_XSUB(j)  (1280 + 64 * (j))
#define XB_XGEN(j)  (2304 + 64 * (j))
#define XB_TOP      3328
#define XB_TOPGEN   3392
#define XCD_BAR_WORDS 3456
#define XB_SPIN_CAP (1u << 18)
__device__ __forceinline__ unsigned xb_ld(unsigned* p)              { return __hip_atomic_load(p, __ATOMIC_RELAXED, __HIP_MEMORY_SCOPE_AGENT); }
__device__ __forceinline__ unsigned xb_add(unsigned* p, unsigned v) { return __hip_atomic_fetch_add(p, v, __ATOMIC_RELAXED, __HIP_MEMORY_SCOPE_AGENT); }
__device__ __forceinline__ unsigned xb_xcc_id() { return (unsigned)__builtin_amdgcn_s_getreg((3 << 11) | 20) & 0xFu; }
#define XB_SPIN(cond, bar) do { unsigned _sp = 0; while (cond) { __builtin_amdgcn_s_sleep(1); \
    if ((++_sp & 255u) == 0u) { if (xb_ld(&(bar)[XB_TMO])) break; if (_sp > XB_SPIN_CAP) { atomicAdd(&(bar)[XB_TMO], 1u); break; } } } } while (0)
struct XcdBarrier { unsigned* bar; unsigned x; volatile LAS unsigned* st; };
__device__ __forceinline__ XcdBarrier xcd_barrier_post(unsigned* bar, volatile LAS unsigned* st) {
    XcdBarrier b; b.bar = bar; b.x = xb_xcc_id(); b.st = st;
    if (threadIdx.x == 0) (void)xb_add(&bar[XB_XCNT(b.x)], 1u);
    return b;
}
__device__ __forceinline__ void xcd_barrier_complete(unsigned* bar, unsigned x, unsigned& nloc, unsigned& nx) {
    const unsigned G = gridDim.x * gridDim.y * gridDim.z;
    unsigned sum, cnt, mine, sp = 0u;
    for (;;) {
        sum = 0u; cnt = 0u; mine = 0u;
#pragma unroll
        for (unsigned j = 0; j < 16; ++j) { const unsigned c = xb_ld(&bar[XB_XCNT(j)]); sum += c; cnt += (c > 0u) ? 1u : 0u; mine = (j == x) ? c : mine; }
        if (sum == G) break;
        __builtin_amdgcn_s_sleep(1);
        if ((++sp & 255u) == 0u) { if (xb_ld(&bar[XB_TMO])) break; if (sp > XB_SPIN_CAP) { atomicAdd(&bar[XB_TMO], 1u); break; } }
    }
    nloc = mine > 0u ? mine : 1u; nx = cnt > 0u ? cnt : 1u;
}
__device__ __forceinline__ void xcd_barrier(const XcdBarrier& b) {
    asm volatile("s_waitcnt vmcnt(0)" ::: "memory");
    __syncthreads();
    if (threadIdx.x == 0) {
        unsigned* bar = b.bar;
        __builtin_amdgcn_s_waitcnt(0);
        unsigned nloc = b.st[0], nx = b.st[1];
        if (nloc == 0u) { xcd_barrier_complete(bar, b.x, nloc, nx); b.st[0] = nloc; b.st[1] = nx; }
        const unsigned old = xb_add(&bar[XB_XSUB(b.x)], 1u);
        const unsigned gen = old / nloc;
        if (old + 1u == (gen + 1u) * nloc) {
            __builtin_amdgcn_fence(__ATOMIC_RELEASE, "agent");
            asm volatile("s_waitcnt vmcnt(0)" ::: "memory");
            const unsigned og = xb_add(&bar[XB_TOP], 1u);
            const unsigned tg = og / nx;
            if (og + 1u == (tg + 1u) * nx) xb_add(&bar[XB_TOPGEN], 1u);
            else XB_SPIN(xb_ld(&bar[XB_TOPGEN]) == tg, bar);
            __builtin_amdgcn_fence(__ATOMIC_ACQUIRE, "agent");
            xb_add(&bar[XB_XGEN(b.x)], 1u);
            asm volatile("s_waitcnt vmcnt(0)" ::: "memory");
        } else {
            XB_SPIN(xb_ld(&bar[XB_XGEN(b.x)]) == gen, bar);
            __builtin_amdgcn_fence(__ATOMIC_ACQUIRE, "agent");
            asm volatile("s_waitcnt vmcnt(0)" ::: "memory");
        }
    }
    __syncthreads();
}

namespace pg8 {
constexpr int BM = 256, BK = 64, HALF = 128, HTB = HALF * BK * 2, STAGE_BYTES = 8 * HTB, NXCD = 8, WGM = 8;
__host__ __device__ __forceinline__ int lds_byte(int r, int c) { const int st = (r >> 4) * 2 + (c >> 5), rr = r & 15, cc = c & 31, ob = rr * 64 + cc * 2; return st * 1024 + (ob ^ (((ob >> 9) & 1) << 5)); }
__host__ __device__ __forceinline__ void stage_rc(int b, int& R, int& C) { const int st = b / 1024, sb = b % 1024, swz = sb ^ (((sb >> 9) & 1) << 5); R = (st >> 1) * 16 + swz / 64; C = (st & 1) * 32 + (swz % 64) / 2; }
__host__ __device__ __forceinline__ int perm32(int rho) { const int n = rho >> 4, i = rho & 15; return 8 * (i >> 2) + 4 * n + (i & 3); }

struct Unit { int pm, pn, z; };
struct Gemm { const bf16_t* A; const bf16_t* Bt; int lda, ldb, K; size_t az, bz; };

template <int ZN> struct TileOrder {
    int nM, nN, nwg, G, c;
    __device__ void init(int M, int N, int G_, int c_) { nM = M / BM; nN = N / BM; nwg = nM * nN; G = G_; c = c_; }
    __device__ bool next(int i, Unit& u) const {
        const long L = (long)(i / ZN) * G + c; if (L >= nwg) return false;
        int wgid = (int)L; { const int q = nwg / NXCD, r = nwg % NXCD, xcd = wgid % NXCD, off = wgid / NXCD; wgid = (xcd < r ? xcd * (q + 1) : r * (q + 1) + (xcd - r) * q) + off; }
        const int nig = WGM * nN, gid = wgid / nig, fm = gid * WGM, gsz = (nM - fm) < WGM ? (nM - fm) : WGM;
        u.pm = fm + ((wgid % nig) % gsz); u.pn = (wgid % nig) / gsz; u.z = i % ZN; return true;
    }
};

template <class Epi, class Sched>
__device__ __forceinline__ void gemm_phase(LAS unsigned char* lds, const Gemm g, const Sched& S, const Epi& E, int wave_id) {
    int tid_l = (wave_id << 6) | (int)__builtin_amdgcn_mbcnt_hi(~0u, __builtin_amdgcn_mbcnt_lo(~0u, 0u)); asm volatile("" : "+v"(tid_l));
    const int tid = tid_l, wid = wave_id, lane = tid & 63, wr = wid >> 2, wc = wid & 3, fr = lane & 15, fq = lane >> 4;
    const int K = g.K, nt = K / BK;
    unsigned voffA[2], voffB[2];
#pragma unroll
    for (int i = 0; i < 2; ++i) { int R, C; stage_rc(tid * 16 + i * 8192, R, C); const int Rb = Epi::PERM ? ((R & ~31) + perm32(R & 31)) : R;
        voffA[i] = (unsigned)(R * g.lda + C) * 2u; voffB[i] = (unsigned)(Rb * g.ldb + C) * 2u; }
    const size_t kstep = (size_t)(BK * 2);
    const size_t hstepA = (size_t)HALF * g.lda * 2, hstepB = (size_t)HALF * g.ldb * 2;
    const size_t tstepA = 2 * hstepA, tstepB = 2 * hstepB;
    const unsigned ldsw = (unsigned)wid * 1024u;
    const int aoff = lds_byte(wr * 64 + fr, fq * 8), boff = lds_byte(wc * 32 + fr, fq * 8);
#define PG8_SA(b, h) (((b) * 2 + (h)) * HTB)
#define PG8_SB(b, h) ((4 + (b) * 2 + (h)) * HTB)
#define PG8_STAGE(bufoff, gbase, voff) do { _Pragma("unroll") for (int _i = 0; _i < 2; ++_i) \
        __builtin_amdgcn_global_load_lds((const unsigned*)((const char*)(gbase) + (voff)[_i]), (LAS unsigned*)(lds + (bufoff) + ldsw + _i * 8192), 16, 0, 0); } while (0)
#define PG8_LDA(dst, b, h) do { _Pragma("unroll") for (int m = 0; m < 4; ++m) _Pragma("unroll") for (int k = 0; k < 2; ++k) dst[m][k] = *(const LAS bf16x8*)(lds + PG8_SA(b, h) + aoff + m * 2048 + k * 1024); } while (0)
#define PG8_LDB(dst, b, h) do { _Pragma("unroll") for (int n = 0; n < 2; ++n) _Pragma("unroll") for (int k = 0; k < 2; ++k) dst[n][k] = *(const LAS bf16x8*)(lds + PG8_SB(b, h) + boff + n * 2048 + k * 1024); } while (0)
#define PG8_MMA(ai, bj, At, Bt) do { __builtin_amdgcn_s_setprio(1); _Pragma("unroll") for (int m = 0; m < 4; ++m) _Pragma("unroll") for (int n = 0; n < 2; ++n) _Pragma("unroll") for (int k = 0; k < 2; ++k) \
        acc[ai][bj][m][n] = __builtin_amdgcn_mfma_f32_16x16x32_bf16(Bt[n][k], At[m][k], acc[ai][bj][m][n], 0, 0, 0); __builtin_amdgcn_s_setprio(0); } while (0)
#define PG8_WAIT_V(n) asm volatile("s_waitcnt vmcnt(" #n ")" ::: "memory")
#define PG8_WAIT_L(n) asm volatile("s_waitcnt lgkmcnt(" #n ")" ::: "memory")
#define PG8_BAR __builtin_amdgcn_s_barrier()
#define PG8_SCHED __builtin_amdgcn_sched_barrier(0)
    Unit cur, nxt; int ui = 0;
    if (!S.next(0, cur)) return;
    f32x4 acc[2][2][4][2];
#pragma unroll
    for (int a = 0; a < 2; ++a)
#pragma unroll
        for (int b = 0; b < 2; ++b)
#pragma unroll
            for (int m = 0; m < 4; ++m)
#pragma unroll
                for (int n = 0; n < 2; ++n) acc[a][b][m][n] = (f32x4){0.f, 0.f, 0.f, 0.f};
    bf16x8 At[4][2], B0[2][2], B1[2][2];
    const char* cA = (const char*)g.A + (size_t)cur.pm * tstepA + (size_t)cur.z * g.az; const char* cB = (const char*)g.Bt + (size_t)cur.pn * tstepB + (size_t)cur.z * g.bz;
    PG8_STAGE(PG8_SB(0, 0), cB, voffB); PG8_STAGE(PG8_SB(0, 1), cB + hstepB, voffB); PG8_STAGE(PG8_SA(0, 0), cA, voffA); PG8_STAGE(PG8_SA(0, 1), cA + hstepA, voffA);
    if (wr == 1) PG8_BAR;
    PG8_WAIT_V(2); PG8_BAR;
    PG8_STAGE(PG8_SB(1, 0), cB + kstep, voffB); PG8_STAGE(PG8_SA(1, 0), cA + kstep, voffA); PG8_STAGE(PG8_SB(1, 1), cB + hstepB + kstep, voffB);
    PG8_WAIT_V(6); PG8_BAR;
    for (;;) {
        const bool has_next = S.next(ui + 1, nxt);
        const char* nA = has_next ? (const char*)g.A + (size_t)nxt.pm * tstepA + (size_t)nxt.z * g.az : cA;
        const char* nB = has_next ? (const char*)g.Bt + (size_t)nxt.pn * tstepB + (size_t)nxt.z * g.bz : cB;
        for (int t = 0; t < nt; t += 2) {
            const bool last = (t == nt - 2);
            const char* a1 = cA + (size_t)(t + 1) * kstep;
            const char* a2 = last ? nA : cA + (size_t)(t + 2) * kstep; const char* b2 = last ? nB : cB + (size_t)(t + 2) * kstep;
            const char* a3 = a2 + kstep; const char* b3 = b2 + kstep;
            PG8_LDB(B0, 0, 0); PG8_LDB(B1, 0, 1); PG8_SCHED; PG8_LDA(At, 0, 0); PG8_STAGE(PG8_SA(1, 1), a1 + hstepA, voffA);
            PG8_WAIT_V(8); PG8_WAIT_L(0); PG8_BAR; PG8_MMA(0, 0, At, B0); PG8_MMA(0, 1, At, B1); PG8_BAR; PG8_SCHED;
            PG8_LDA(At, 0, 1); PG8_STAGE(PG8_SB(0, 0), b2, voffB); PG8_STAGE(PG8_SB(0, 1), b2 + hstepB, voffB); PG8_STAGE(PG8_SA(0, 0), a2, voffA);
            PG8_WAIT_V(8); PG8_WAIT_L(0); PG8_BAR; PG8_MMA(1, 0, At, B0); PG8_MMA(1, 1, At, B1); PG8_BAR; PG8_SCHED;
            PG8_LDB(B0, 1, 0); PG8_LDB(B1, 1, 1); PG8_SCHED; PG8_LDA(At, 1, 0); PG8_STAGE(PG8_SA(0, 1), a2 + hstepA, voffA);
            PG8_WAIT_V(8); PG8_WAIT_L(0); PG8_BAR; PG8_MMA(0, 0, At, B0); PG8_MMA(0, 1, At, B1); PG8_BAR; PG8_SCHED;
            PG8_LDA(At, 1, 1); PG8_STAGE(PG8_SB(1, 0), b3, voffB); PG8_STAGE(PG8_SB(1, 1), b3 + hstepB, voffB); PG8_STAGE(PG8_SA(1, 0), a3, voffA);
            PG8_WAIT_V(8); PG8_WAIT_L(0); PG8_BAR; PG8_MMA(1, 0, At, B0); PG8_MMA(1, 1, At, B1); PG8_BAR; PG8_SCHED;
        }
        if (wr == 0) PG8_BAR;
        E(acc, cur, wr, wc, fr, fq);
        if (!has_next) break;
        if (!E.keep(cur)) {
#pragma unroll
            for (int a = 0; a < 2; ++a)
#pragma unroll
                for (int b = 0; b < 2; ++b)
#pragma unroll
                    for (int m = 0; m < 4; ++m)
#pragma unroll
                        for (int n = 0; n < 2; ++n) acc[a][b][m][n] = (f32x4){0.f, 0.f, 0.f, 0.f};
        }
        cur = nxt; cA = nA; cB = nB; ++ui;
        if (wr == 1) PG8_BAR;
    }
    PG8_WAIT_V(0);
    PG8_BAR;
#undef PG8_SA
#undef PG8_SB
#undef PG8_STAGE
#undef PG8_LDA
#undef PG8_LDB
#undef PG8_MMA
#undef PG8_WAIT_V
#undef PG8_WAIT_L
#undef PG8_BAR
#undef PG8_SCHED
}
}
typedef pg8::Unit Unit;
typedef f32x4 AccT[2][2][4][2];

struct EpiProjA {
    static constexpr bool PERM = true;
    bf16_t* O; const float* rstd;
    __device__ __forceinline__ bool keep(const Unit&) const { return false; }
    __device__ __forceinline__ void operator()(AccT& acc, const Unit& u, int wr, int wc, int fr, int fq) const {
        const int row0 = u.pm * 256 + wr * 64 + fr, col0 = u.pn * 256 + wc * 32 + 8 * fq;
        const bool act = (u.pn >= 5);
#pragma unroll
        for (int ai = 0; ai < 2; ++ai)
#pragma unroll
            for (int m = 0; m < 4; ++m) { const int row = row0 + ai * 128 + m * 16; const float rs = rstd[row]; bf16_t* rowp = O + (size_t)row * NA + col0;
#pragma unroll
                for (int bj = 0; bj < 2; ++bj) { f32x4 v0 = acc[ai][bj][m][0] * rs, v1 = acc[ai][bj][m][1] * rs;
                    if (act) {
#pragma unroll
                        for (int j = 0; j < 4; ++j) { v0[j] = gelu_tanh(v0[j]); v1[j] = gelu_tanh(v1[j]); } }
                    u32x4 w; w.x = cvt_pk_bf16(v0[0], v0[1]); w.y = cvt_pk_bf16(v0[2], v0[3]); w.z = cvt_pk_bf16(v1[0], v1[1]); w.w = cvt_pk_bf16(v1[2], v1[3]);
                    *(u32x4*)(rowp + bj * 128) = w; } }
    }
};
struct EpiGates {
    static constexpr bool PERM = true;
    bf16_t* O; const float* rstd; const float* bias;
    __device__ __forceinline__ bool keep(const Unit&) const { return false; }
    __device__ __forceinline__ void operator()(AccT& acc, const Unit& u, int wr, int wc, int fr, int fq) const {
        const int row0 = u.pm * 256 + wr * 64 + fr, col0 = u.pn * 256 + wc * 32 + 8 * fq;
        f32x4 bv[2][2];
#pragma unroll
        for (int bj = 0; bj < 2; ++bj)
#pragma unroll
            for (int n = 0; n < 2; ++n) bv[bj][n] = *(const f32x4*)(bias + col0 + bj * 128 + 4 * n);
#pragma unroll
        for (int ai = 0; ai < 2; ++ai)
#pragma unroll
            for (int m = 0; m < 4; ++m) { const int row = row0 + ai * 128 + m * 16; const float rs = rstd[row]; bf16_t* rowp = O + (size_t)row * NG + col0;
#pragma unroll
                for (int bj = 0; bj < 2; ++bj) { f32x4 v0 = acc[ai][bj][m][0] * rs + bv[bj][0], v1 = acc[ai][bj][m][1] * rs + bv[bj][1];
#pragma unroll
                    for (int j = 0; j < 4; ++j) { v0[j] = sigmoidf_(v0[j]); v1[j] = sigmoidf_(v1[j]); }
                    u32x4 w; w.x = cvt_pk_bf16(v0[0], v0[1]); w.y = cvt_pk_bf16(v0[2], v0[3]); w.z = cvt_pk_bf16(v1[0], v1[1]); w.w = cvt_pk_bf16(v1[2], v1[3]);
                    *(u32x4*)(rowp + bj * 128) = w; } }
    }
};
struct EpiMerge {
    static constexpr bool PERM = true;
    const bf16_t* gates; bf16_t* O;
    __device__ __forceinline__ bool keep(const Unit& u) const { return u.z < 2; }
    __device__ __forceinline__ void operator()(AccT& acc, const Unit& u, int wr, int wc, int fr, int fq) const {
        const int row0 = u.pm * 256 + wr * 64 + fr, col0 = u.pn * 256 + wc * 32 + 8 * fq;
        const int z = u.z;
#pragma unroll
        for (int ai = 0; ai < 2; ++ai)
#pragma unroll
            for (int m = 0; m < 4; ++m) { const int row = row0 + ai * 128 + m * 16;
#pragma unroll
                for (int bj = 0; bj < 2; ++bj) { const int col = col0 + bj * 128; const bf16_t* gp = gates + (size_t)row * NG + col;
                    float f[8];
                    if (z == 2) { const u32x4 a = *(const u32x4*)(gp + 2048);
                        f[0] = bf_lo(a.x); f[1] = bf_hi(a.x); f[2] = bf_lo(a.y); f[3] = bf_hi(a.y); f[4] = bf_lo(a.z); f[5] = bf_hi(a.z); f[6] = bf_lo(a.w); f[7] = bf_hi(a.w);
#pragma unroll
                        for (int j = 0; j < 8; ++j) f[j] = fmaxf(f[j], 1e-20f);
                    } else { const u32x4 a = *(const u32x4*)(gp + z * 1024), b = *(const u32x4*)(gp + (z + 1) * 1024);
                        float ga[8], gb[8];
                        ga[0] = bf_lo(a.x); ga[1] = bf_hi(a.x); ga[2] = bf_lo(a.y); ga[3] = bf_hi(a.y); ga[4] = bf_lo(a.z); ga[5] = bf_hi(a.z); ga[6] = bf_lo(a.w); ga[7] = bf_hi(a.w);
                        gb[0] = bf_lo(b.x); gb[1] = bf_hi(b.x); gb[2] = bf_lo(b.y); gb[3] = bf_hi(b.y); gb[4] = bf_lo(b.z); gb[5] = bf_hi(b.z); gb[6] = bf_lo(b.w); gb[7] = bf_hi(b.w);
#pragma unroll
                        for (int j = 0; j < 8; ++j) { const float num = (z == 0) ? ga[j] : fmaxf(ga[j], 1e-20f); f[j] = num * __builtin_amdgcn_rcpf(fmaxf(gb[j], 1e-20f)); } }
                    f32x4 v0 = acc[ai][bj][m][0], v1 = acc[ai][bj][m][1];
                    v0[0] *= f[0]; v0[1] *= f[1]; v0[2] *= f[2]; v0[3] *= f[3]; v1[0] *= f[4]; v1[1] *= f[5]; v1[2] *= f[6]; v1[3] *= f[7];
                    acc[ai][bj][m][0] = v0; acc[ai][bj][m][1] = v1;
                    if (z == 2) { u32x4 w; w.x = cvt_pk_bf16(v0[0], v0[1]); w.y = cvt_pk_bf16(v0[2], v0[3]); w.z = cvt_pk_bf16(v1[0], v1[1]); w.w = cvt_pk_bf16(v1[2], v1[3]);
                        *(u32x4*)(O + (size_t)row * DM + col) = w; } } }
    }
};
struct EpiResid {
    static constexpr bool PERM = true;
    bf16_t* X; float* rowsq; bf16_t* XO;
    __device__ __forceinline__ bool keep(const Unit&) const { return false; }
    __device__ __forceinline__ void operator()(AccT& acc, const Unit& u, int wr, int wc, int fr, int fq) const {
        const int row0 = u.pm * 256 + wr * 64 + fr, col0 = u.pn * 256 + wc * 32 + 8 * fq;
#pragma unroll
        for (int ai = 0; ai < 2; ++ai)
#pragma unroll
            for (int m = 0; m < 4; ++m) { const int row = row0 + ai * 128 + m * 16; bf16_t* rowp = X + (size_t)row * DM + col0; float ss = 0.f;
#pragma unroll
                for (int bj = 0; bj < 2; ++bj) { const u32x4 x = *(const u32x4*)(rowp + bj * 128);
                    f32x4 v0 = acc[ai][bj][m][0], v1 = acc[ai][bj][m][1];
                    v0[0] += bf_lo(x.x); v0[1] += bf_hi(x.x); v0[2] += bf_lo(x.y); v0[3] += bf_hi(x.y); v1[0] += bf_lo(x.z); v1[1] += bf_hi(x.z); v1[2] += bf_lo(x.w); v1[3] += bf_hi(x.w);
                    ss += (v0[0] * v0[0] + v0[1] * v0[1]) + (v0[2] * v0[2] + v0[3] * v0[3]) + (v1[0] * v1[0] + v1[1] * v1[1]) + (v1[2] * v1[2] + v1[3] * v1[3]);
                    u32x4 w; w.x = cvt_pk_bf16(v0[0], v0[1]); w.y = cvt_pk_bf16(v0[2], v0[3]); w.z = cvt_pk_bf16(v1[0], v1[1]); w.w = cvt_pk_bf16(v1[2], v1[3]);
                    *(u32x4*)(XO + (size_t)row * DM + col0 + bj * 128) = w; }
                ss += __shfl_xor(ss, 16); ss += __shfl_xor(ss, 32);
                if (fq == 0) rowsq[(size_t)row * 16 + u.pn * 4 + wc] = ss; }
    }
};
struct EpiScores {
    static constexpr bool PERM = false;
    float* C;
    __device__ __forceinline__ bool keep(const Unit&) const { return false; }
    __device__ __forceinline__ void operator()(AccT& acc, const Unit& u, int wr, int wc, int fr, int fq) const {
        const int row0 = u.pm * 256 + wr * 64 + fr, col0 = u.pn * 256 + wc * 32 + 4 * fq;
#pragma unroll
        for (int ai = 0; ai < 2; ++ai)
#pragma unroll
            for (int m = 0; m < 4; ++m) { float* rowp = C + (size_t)(row0 + ai * 128 + m * 16) * PQ + col0;
#pragma unroll
                for (int bj = 0; bj < 2; ++bj)
#pragma unroll
                    for (int n = 0; n < 2; ++n) *(f32x4*)(rowp + bj * 128 + n * 16) = acc[ai][bj][m][n]; }
    }
};

struct Params {
    const float* in[22];
    float* out; unsigned char* ws;
    int ph_lo, ph_hi, li, pad;
};
enum { I_X = 0, I_RELB, I_FGAIN, I_AGAIN, I_WIN, I_BGATE, I_SINK, I_WPOOL, I_PSCALE, I_VGAIN, I_WSP, I_BSP, I_WA, I_WB, I_WC, I_WOUT, I_FFGAIN, I_WQ, I_K1, I_K2, I_EU, I_EV };

struct Frame { LAS unsigned char* lds; int tid, lane, wave, G, vcu; };
__device__ __forceinline__ int tid_from_wave(int wave) { int t = (wave << 6) | (int)__builtin_amdgcn_mbcnt_hi(~0u, __builtin_amdgcn_mbcnt_lo(~0u, 0u)); asm volatile("" : "+v"(t)); return t; }
__device__ __forceinline__ Frame local_frame(const Frame& F0) { Frame F = F0; const int t = tid_from_wave(F0.wave); F.tid = t; F.lane = t & 63; return F; }

__device__ __forceinline__ void p0_transpose_item(const float* W, int N, bf16_t* WT, int ldo, const float* kscale, LAS float* scr, int item, int lane) {
    const int nblk = N / 32, kb = item / nblk, nb = item % nblk, k0 = 64 * kb, n0 = 32 * nb;
#pragma unroll 8
    for (int i = 0; i < 32; ++i) { const int kk = 2 * i + (lane >> 5); float v = W[(size_t)(k0 + kk) * N + n0 + (lane & 31)]; if (kscale) v *= kscale[k0 + kk]; scr[kk * 33 + (lane & 31)] = v; }
    asm volatile("s_waitcnt lgkmcnt(0)" ::: "memory");
    const int c = lane & 7;
#pragma unroll
    for (int j = 0; j < 4; ++j) { const int n = (lane >> 3) + 8 * j; const LAS float* s = scr + (8 * c) * 33 + n;
        u32x4 o; o.x = cvt_pk_bf16(s[0 * 33], s[1 * 33]); o.y = cvt_pk_bf16(s[2 * 33], s[3 * 33]); o.z = cvt_pk_bf16(s[4 * 33], s[5 * 33]); o.w = cvt_pk_bf16(s[6 * 33], s[7 * 33]);
        *(u32x4*)(WT + (size_t)(n0 + n) * ldo + k0 + 8 * c) = o; }
    asm volatile("s_waitcnt lgkmcnt(0)" ::: "memory");
}
__device__ __forceinline__ void convert_experts(const Params& p, const Frame& F) {
    const int gw = blockIdx.x * NWAVES + F.wave, NGW = F.G * NWAVES, lane = F.lane;
    for (int r = gw; r < DEPTH * 2 * NEXP; r += NGW) {
        const int l = r / (2 * NEXP), tb = (r / NEXP) & 1, row = r % NEXP;
        const float* src = (tb ? p.in[I_EV] : p.in[I_EU]) + ((size_t)l * NEXP + row) * DM + lane * 16;
        const f32x4 a = *(const f32x4*)src, b = *(const f32x4*)(src + 4), c = *(const f32x4*)(src + 8), d = *(const f32x4*)(src + 12);
        float mx = fmaxf(fmaxf(fmaxf(fabsf(a[0]), fabsf(a[1])), fmaxf(fabsf(a[2]), fabsf(a[3]))), fmaxf(fmaxf(fabsf(b[0]), fabsf(b[1])), fmaxf(fabsf(b[2]), fabsf(b[3]))));
        mx = fmaxf(mx, fmaxf(fmaxf(fmaxf(fabsf(c[0]), fabsf(c[1])), fmaxf(fabsf(c[2]), fabsf(c[3]))), fmaxf(fmaxf(fabsf(d[0]), fabsf(d[1])), fmaxf(fabsf(d[2]), fabsf(d[3])))));
#pragma unroll
        for (int o = 1; o < 64; o <<= 1) mx = fmaxf(mx, __shfl_xor(mx, o));
        const float inv = mx > 0.f ? 448.0f / mx : 0.f;
        int w0 = 0, w1 = 0, w2 = 0, w3 = 0;
        w0 = __builtin_amdgcn_cvt_pk_fp8_f32(a[0] * inv, a[1] * inv, w0, false); w0 = __builtin_amdgcn_cvt_pk_fp8_f32(a[2] * inv, a[3] * inv, w0, true);
        w1 = __builtin_amdgcn_cvt_pk_fp8_f32(b[0] * inv, b[1] * inv, w1, false); w1 = __builtin_amdgcn_cvt_pk_fp8_f32(b[2] * inv, b[3] * inv, w1, true);
        w2 = __builtin_amdgcn_cvt_pk_fp8_f32(c[0] * inv, c[1] * inv, w2, false); w2 = __builtin_amdgcn_cvt_pk_fp8_f32(c[2] * inv, c[3] * inv, w2, true);
        w3 = __builtin_amdgcn_cvt_pk_fp8_f32(d[0] * inv, d[1] * inv, w3, false); w3 = __builtin_amdgcn_cvt_pk_fp8_f32(d[2] * inv, d[3] * inv, w3, true);
        *(u32x4*)(p.ws + WS_EXP + (((size_t)l * NEXP + row) * 2 + tb) * DM + lane * 16) = (u32x4){(unsigned)w0, (unsigned)w1, (unsigned)w2, (unsigned)w3};
        if (lane == 0) ((float*)(p.ws + WS_ESCALE))[((size_t)l * NEXP + row) * 2 + tb] = mx * (1.0f / 448.0f);
    }
}
__device__ __forceinline__ void phase_prologue(const Params& p, const Frame& F0) {
    const Frame F = local_frame(F0);
    const int gw = F.vcu * NWAVES + F.wave, NGW = F.G * NWAVES, lane = F.lane;
    LAS float* scr = (LAS float*)(F.lds + F.wave * 16384);
    constexpr int I_IN = (DM / 64) * (NIN / 32), I_BR = (512 / 64) * (DM / 32), I_OUT = (DM / 64) * (DM / 32);
    constexpr int PER_L = I_IN + 2 * I_BR + I_OUT;
    for (int it = gw; it < DEPTH * PER_L; it += NGW) {
        const int l = it / PER_L; int r = it % PER_L;
        if (r < I_IN) { p0_transpose_item(p.in[I_WIN] + (size_t)l * DM * NIN, NIN, (bf16_t*)(p.ws + WS_WTIN) + (size_t)l * NIN * DM, DM, p.in[I_AGAIN] + l * DM, scr, r, lane); continue; } r -= I_IN;
        if (r < I_BR) { p0_transpose_item(p.in[I_WA] + (size_t)l * 512 * DM, DM, (bf16_t*)(p.ws + WS_WTBR) + (size_t)(l * 3 + 0) * DM * 512, 512, nullptr, scr, r, lane); continue; } r -= I_BR;
        if (r < I_BR) { p0_transpose_item(p.in[I_WC] + (size_t)l * 512 * DM, DM, (bf16_t*)(p.ws + WS_WTBR) + (size_t)(l * 3 + 2) * DM * 512, 512, nullptr, scr, r, lane); continue; } r -= I_BR;
        p0_transpose_item(p.in[I_WOUT] + (size_t)l * DM * DM, DM, (bf16_t*)(p.ws + WS_WTOUT) + (size_t)l * DM * DM, DM, nullptr, scr, r, lane);
    }
    {
        float* rstd = (float*)(p.ws + WS_RSTD);
        for (int m = gw; m < NTOK; m += NGW) {
            const f32x4* xr = (const f32x4*)(p.in[I_X] + (size_t)m * DM) + lane; f32x4 v[4]; float s = 0.f;
#pragma unroll
            for (int j = 0; j < 4; ++j) { v[j] = xr[64 * j]; s += (v[j][0] * v[j][0] + v[j][1] * v[j][1]) + (v[j][2] * v[j][2] + v[j][3] * v[j][3]); }
            s = wave_sum(s);
            u32x2* o = (u32x2*)((bf16_t*)(p.ws + WS_XB) + (size_t)m * DM) + lane;
#pragma unroll
            for (int j = 0; j < 4; ++j) { u32x2 w; w.x = cvt_pk_bf16(v[j][0], v[j][1]); w.y = cvt_pk_bf16(v[j][2], v[j][3]); o[64 * j] = w; }
            if (lane == 0) rstd[m] = 1.0f / sqrtf(s * (1.0f / DM) + EPS);
        }
    }
    for (int i = blockIdx.x * NTHREADS + F.tid; i < DEPTH * 4 * 128 * 128; i += F.G * NTHREADS) { const int t = (i >> 7) & 127, s = i & 127;
        ((bf16_t*)(p.ws + WS_WSP))[i] = (bf16_t)(cvt_pk_bf16(s <= t ? p.in[I_WSP][i] : 0.f, 0.f) & 0xffffu); }
    convert_experts(p, F);
    __syncthreads();
    {
        LAS float* coef = (LAS float*)F.lds;
        for (int u = blockIdx.x; u < DEPTH * 4 * 16; u += F.G) {
            const int l = u / 64, g = (u / 16) % 4, c0 = (u % 16) * 8;
            __syncthreads();
            for (int i = F.tid; i < 1024; i += NTHREADS) { const int cc = i >> 7, j = i & 127;
                coef[i] = p.in[I_WPOOL][(((size_t)l * 4 + g) * 128 + c0 + cc) * 128 + j] * p.in[I_PSCALE][l * 512 + g * 128 + j]; }
            __syncthreads();
            const float* wb = p.in[I_WB] + ((size_t)l * 512 + g * 128) * DM;
            float a0[8], a1[8];
#pragma unroll
            for (int cc = 0; cc < 8; ++cc) { a0[cc] = 0.f; a1[cc] = 0.f; }
            for (int j = 0; j < 128; ++j) { const float w0 = wb[(size_t)j * DM + F.tid], w1 = wb[(size_t)j * DM + F.tid + 512];
#pragma unroll
                for (int cc = 0; cc < 8; ++cc) { const float cf = coef[cc * 128 + j]; a0[cc] += cf * w0; a1[cc] += cf * w1; } }
            bf16_t* dst = (bf16_t*)(p.ws + WS_WTBR) + (size_t)(l * 3 + 1) * DM * 512 + g * 128 + c0;
            u32x4 w; w.x = cvt_pk_bf16(a0[0], a0[1]); w.y = cvt_pk_bf16(a0[2], a0[3]); w.z = cvt_pk_bf16(a0[4], a0[5]); w.w = cvt_pk_bf16(a0[6], a0[7]);
            *(u32x4*)(dst + (size_t)F.tid * 512) = w;
            u32x4 y; y.x = cvt_pk_bf16(a1[0], a1[1]); y.y = cvt_pk_bf16(a1[2], a1[3]); y.z = cvt_pk_bf16(a1[4], a1[5]); y.w = cvt_pk_bf16(a1[6], a1[7]);
            *(u32x4*)(dst + (size_t)(F.tid + 512) * 512) = y;
        }
    }
    {
        LAS float* kl = (LAS float*)F.lds;
        LAS float* wl = kl + 128 * 132;
        for (int u = blockIdx.x; u < DEPTH * 16 * 16; u += F.G) {
            const int l = u / 256, s = (u / 16) % 16, c0 = (u % 16) * 64;
            const float* keys = ((s & 1) ? p.in[I_K2] : p.in[I_K1]) + (size_t)l * 128 * 128;
            const float* wq = p.in[I_WQ] + (size_t)l * DM * PQ;
            __syncthreads();
            for (int i = F.tid; i < 128 * 32; i += NTHREADS) { const int r = i >> 5, q = i & 31; *(LAS f32x4*)(kl + r * 132 + q * 4) = *(const f32x4*)(keys + r * 128 + q * 4); }
            for (int i = F.tid; i < 64 * 32; i += NTHREADS) { const int r = i >> 5, q = i & 31; *(LAS f32x4*)(wl + r * 132 + q * 4) = *(const f32x4*)(wq + (size_t)(c0 + r) * PQ + s * 128 + q * 4); }
            __syncthreads();
            const int c = F.tid & 63, kq = F.wave;
            float acc[16];
#pragma unroll
            for (int i = 0; i < 16; ++i) acc[i] = 0.f;
            for (int d4 = 0; d4 < 32; ++d4) { const f32x4 w4 = *(const LAS f32x4*)(wl + c * 132 + d4 * 4);
#pragma unroll
                for (int i = 0; i < 16; ++i) { const f32x4 k4 = *(const LAS f32x4*)(kl + (kq * 16 + i) * 132 + d4 * 4); acc[i] += (k4[0] * w4[0] + k4[1] * w4[1]) + (k4[2] * w4[2] + k4[3] * w4[3]); } }
            const float gn = p.in[I_FFGAIN][l * DM + c0 + c];
            bf16_t* dst = (bf16_t*)(p.ws + WS_WEFF) + ((size_t)l * PQ + s * 128 + kq * 16) * DM + c0 + c;
#pragma unroll
            for (int i = 0; i < 16; ++i) dst[(size_t)i * DM] = (bf16_t)(cvt_pk_bf16(acc[i] * gn, 0.f) & 0xffffu);
        }
    }
}

__device__ __forceinline__ int t5_bucket(int n) {
    if (n < 16) return n;
    const float v = logf((float)n / 16.0f) / 2.0794415416798357f * 16.0f;
    const int b = 16 + (int)v; return b < 31 ? b : 31;
}
__device__ __forceinline__ void phase_mix_simple(const Params& p, const Frame& F0, int l) {
    const Frame F = local_frame(F0);
    const int tid = F.tid, lane = F.lane, wave = F.wave;
    LAS float* Kf = (LAS float*)F.lds;
    LAS float* Vf = Kf + 256 * 64;
    LAS float* biasT = Vf + 256 * 64;
    LAS float* rs = biasT + 1024;
    const bf16_t* proj = (const bf16_t*)(p.ws + WS_PROJA);
    bf16_t* mix = (bf16_t*)(p.ws + WS_MIX);
    for (int nb = blockIdx.x; nb < NTOK / 128; nb += F.G) {
        const int t0 = nb * 128; const bool first = (nb % (SEQ / 128)) == 0;
        __syncthreads();
        for (int i = tid; i < 1024; i += NTHREADS) { const int h = i >> 7, dist = i & 127; biasT[i] = p.in[I_RELB][t5_bucket(dist) * 8 + h]; }
        for (int kvh = 0; kvh < 2; ++kvh) {
            __syncthreads();
            for (int c = tid; c < 2048; c += NTHREADS) { const int row = c >> 3, ch = c & 7; const int tok = t0 - 128 + row;
                u32x4 kv = (u32x4){0u, 0u, 0u, 0u}, vv = (u32x4){0u, 0u, 0u, 0u};
                if (row >= 128 || !first) { kv = *(const u32x4*)(proj + (size_t)tok * NA + COL_K + kvh * 64 + ch * 8); vv = *(const u32x4*)(proj + (size_t)tok * NA + COL_V + kvh * 64 + ch * 8); }
                LAS float* kd = Kf + row * 64 + ch * 8; LAS float* vd = Vf + row * 64 + ch * 8;
                kd[0] = bf_lo(kv.x); kd[1] = bf_hi(kv.x); kd[2] = bf_lo(kv.y); kd[3] = bf_hi(kv.y); kd[4] = bf_lo(kv.z); kd[5] = bf_hi(kv.z); kd[6] = bf_lo(kv.w); kd[7] = bf_hi(kv.w);
                vd[0] = bf_lo(vv.x); vd[1] = bf_hi(vv.x); vd[2] = bf_lo(vv.y); vd[3] = bf_hi(vv.y); vd[4] = bf_lo(vv.z); vd[5] = bf_hi(vv.z); vd[6] = bf_lo(vv.w); vd[7] = bf_hi(vv.w); }
            __syncthreads();
            const int hq = tid >> 7, qi = tid & 127, head = kvh * 4 + hq;
            float q[64], o[64];
            { const u32x4* qp = (const u32x4*)(proj + (size_t)(t0 + qi) * NA + head * 64);
#pragma unroll
              for (int j = 0; j < 8; ++j) { const u32x4 w = qp[j]; q[8 * j + 0] = bf_lo(w.x) * 0.125f; q[8 * j + 1] = bf_hi(w.x) * 0.125f; q[8 * j + 2] = bf_lo(w.y) * 0.125f; q[8 * j + 3] = bf_hi(w.y) * 0.125f;
                  q[8 * j + 4] = bf_lo(w.z) * 0.125f; q[8 * j + 5] = bf_hi(w.z) * 0.125f; q[8 * j + 6] = bf_lo(w.w) * 0.125f; q[8 * j + 7] = bf_hi(w.w) * 0.125f; } }
#pragma unroll
            for (int d = 0; d < 64; ++d) o[d] = 0.f;
            const float sink = p.in[I_SINK][l * 8 + head];
            float mrun = sink, lsum = 0.f;
            const int qb = qi & ~63, kmin = qb + 1, kmax = qb + 63 + 128;
            for (int kj = kmin; kj <= kmax; ++kj) {
                const LAS float* kr = Kf + kj * 64; float s = 0.f;
#pragma unroll
                for (int d4 = 0; d4 < 16; ++d4) { const f32x4 k4 = *(const LAS f32x4*)(kr + d4 * 4); s += (q[4 * d4] * k4[0] + q[4 * d4 + 1] * k4[1]) + (q[4 * d4 + 2] * k4[2] + q[4 * d4 + 3] * k4[3]); }
                const int dist = qi + 128 - kj; const bool valid = (dist >= 0) && (dist < 128) && (kj >= 128 || !first);
                const float logit = s + biasT[head * 128 + (dist & 127)];
                const float mnew = valid ? fmaxf(mrun, logit) : mrun;
                const float corr = __expf(mrun - mnew), pp = valid ? __expf(logit - mnew) : 0.f;
                lsum = lsum * corr + pp; mrun = mnew;
                const LAS float* vr = Vf + kj * 64;
#pragma unroll
                for (int d4 = 0; d4 < 16; ++d4) { const f32x4 v4 = *(const LAS f32x4*)(vr + d4 * 4);
                    o[4 * d4] = o[4 * d4] * corr + pp * v4[0]; o[4 * d4 + 1] = o[4 * d4 + 1] * corr + pp * v4[1]; o[4 * d4 + 2] = o[4 * d4 + 2] * corr + pp * v4[2]; o[4 * d4 + 3] = o[4 * d4 + 3] * corr + pp * v4[3]; }
            }
            const float inv = 1.0f / (lsum + __expf(sink - mrun));
            u32x4* op = (u32x4*)(mix + (size_t)(t0 + qi) * MIXW + head * 64);
#pragma unroll
            for (int j = 0; j < 8; ++j) { u32x4 w; w.x = cvt_pk_bf16(o[8 * j] * inv, o[8 * j + 1] * inv); w.y = cvt_pk_bf16(o[8 * j + 2] * inv, o[8 * j + 3] * inv);
                w.z = cvt_pk_bf16(o[8 * j + 4] * inv, o[8 * j + 5] * inv); w.w = cvt_pk_bf16(o[8 * j + 6] * inv, o[8 * j + 7] * inv); op[j] = w; }
        }
        LAS float* Zs = Kf;
        for (int g = 0; g < 4; ++g) {
            const int w = 2 << g;
            __syncthreads();
            for (int i = tid; i < 143 * 16; i += NTHREADS) { const int row = i >> 4, ch = i & 15; const int tok = t0 - 15 + row;
                u32x4 zv = (u32x4){0u, 0u, 0u, 0u};
                if (row >= 15 || !first) zv = *(const u32x4*)(proj + (size_t)tok * NA + COL_PZ + g * 128 + ch * 8);
                LAS float* zd = Zs + row * 128 + ch * 8;
                zd[0] = bf_lo(zv.x); zd[1] = bf_hi(zv.x); zd[2] = bf_lo(zv.y); zd[3] = bf_hi(zv.y); zd[4] = bf_lo(zv.z); zd[5] = bf_hi(zv.z); zd[6] = bf_lo(zv.w); zd[7] = bf_hi(zv.w); }
            __syncthreads();
            const int c = tid & 127, seg = tid >> 7;
            for (int tt = 0; tt < 32; ++tt) { const int t = seg * 32 + tt, r = t + 15; float sum = 0.f;
                for (int j = 0; j < w; ++j) sum += Zs[(r - j) * 128 + c];
                const int pos = (nb % (SEQ / 128)) * 128 + t; const int cnt = (pos + 1 < w) ? pos + 1 : w;
                const float d = sum / (float)cnt - Zs[r * 128 + c];
                mix[(size_t)(t0 + t) * MIXW + 512 + g * 128 + c] = (bf16_t)(cvt_pk_bf16(d, 0.f) & 0xffffu); }
        }
        __syncthreads();
        for (int tt = 0; tt < 16; ++tt) { const int t = wave * 16 + tt; const u32x4 g4 = *(const u32x4*)(proj + (size_t)(t0 + t) * NA + COL_GV + lane * 8);
            float a[8] = {bf_lo(g4.x), bf_hi(g4.x), bf_lo(g4.y), bf_hi(g4.y), bf_lo(g4.z), bf_hi(g4.z), bf_lo(g4.w), bf_hi(g4.w)}; float ss = 0.f;
#pragma unroll
            for (int j = 0; j < 8; ++j) ss += a[j] * a[j];
            ss = wave_sum(ss); if (lane == 0) rs[t] = 1.0f / sqrtf(ss * (1.0f / 512.0f) + EPS); }
        LAS float* Vn = Kf;
        for (int g = 0; g < 4; ++g) {
            __syncthreads();
            for (int i = tid; i < 128 * 16; i += NTHREADS) { const int s = i >> 4, ch = i & 15; const u32x4 g4 = *(const u32x4*)(proj + (size_t)(t0 + s) * NA + COL_GV + g * 128 + ch * 8);
                const float r = rs[s]; const float* gn = p.in[I_VGAIN] + l * 512 + g * 128 + ch * 8; LAS float* vd = Vn + s * 128 + ch * 8;
                vd[0] = bf_lo(g4.x) * r * gn[0]; vd[1] = bf_hi(g4.x) * r * gn[1]; vd[2] = bf_lo(g4.y) * r * gn[2]; vd[3] = bf_hi(g4.y) * r * gn[3];
                vd[4] = bf_lo(g4.z) * r * gn[4]; vd[5] = bf_hi(g4.z) * r * gn[5]; vd[6] = bf_lo(g4.w) * r * gn[6]; vd[7] = bf_hi(g4.w) * r * gn[7]; }
            __syncthreads();
            const int c = tid & 127, tq = tid >> 7;
            for (int t = tq; t < 128; t += 4) { const float* wrow = p.in[I_WSP] + (((size_t)l * 4 + g) * 128 + t) * 128; float acc = 0.f;
                for (int s = 0; s <= t; ++s) acc += wrow[s] * Vn[s * 128 + c];
                const float mixed = acc + p.in[I_BSP][(l * 4 + g) * 128 + t];
                const float uu = bf1(proj[(size_t)(t0 + t) * NA + COL_GU + g * 128 + c]);
                mix[(size_t)(t0 + t) * MIXW + 1024 + g * 128 + c] = (bf16_t)(cvt_pk_bf16(uu * mixed, 0.f) & 0xffffu); }
        }
    }
}

typedef short s16x4 __attribute__((ext_vector_type(4)));
__device__ __forceinline__ void tr_read8(unsigned addrA, unsigned addrB, s16x4 (&lo)[4], s16x4 (&hi)[4]) {
    asm volatile("ds_read_b64_tr_b16 %0, %8\n\tds_read_b64_tr_b16 %1, %8 offset:32\n\tds_read_b64_tr_b16 %2, %8 offset:64\n\tds_read_b64_tr_b16 %3, %8 offset:96\n\t"
                 "ds_read_b64_tr_b16 %4, %9\n\tds_read_b64_tr_b16 %5, %9 offset:32\n\tds_read_b64_tr_b16 %6, %9 offset:64\n\tds_read_b64_tr_b16 %7, %9 offset:96\n\ts_waitcnt lgkmcnt(0)"
                 : "=&v"(lo[0]), "=&v"(lo[1]), "=&v"(lo[2]), "=&v"(lo[3]), "=&v"(hi[0]), "=&v"(hi[1]), "=&v"(hi[2]), "=&v"(hi[3]) : "v"(addrA), "v"(addrB) : "memory");
}
__device__ __forceinline__ void tr_read4(unsigned addrA, s16x4 (&lo)[4]) {
    asm volatile("ds_read_b64_tr_b16 %0, %4\n\tds_read_b64_tr_b16 %1, %4 offset:32\n\tds_read_b64_tr_b16 %2, %4 offset:64\n\tds_read_b64_tr_b16 %3, %4 offset:96\n\ts_waitcnt lgkmcnt(0)"
                 : "=&v"(lo[0]), "=&v"(lo[1]), "=&v"(lo[2]), "=&v"(lo[3]) : "v"(addrA) : "memory");
}
__device__ __forceinline__ bf16x8 cat44(s16x4 a, s16x4 b) { return (bf16x8){a[0], a[1], a[2], a[3], b[0], b[1], b[2], b[3]}; }
constexpr int KVSTR = 144, VNSTR = 272;
__device__ __forceinline__ void phase_mix(const Params& p, const Frame& F0, int l) {
    const Frame F = local_frame(F0);
    const int tid = F.tid, lane = F.lane, wave = F.wave, fr = lane & 15, fq = lane >> 4;
    LAS unsigned char* Kl = F.lds;
    LAS unsigned char* Vl = F.lds + 256 * KVSTR;
    LAS float* biasT = (LAS float*)(F.lds + 2 * 256 * KVSTR);
    LAS float* rs = biasT + 1024;
    const bf16_t* proj = (const bf16_t*)(p.ws + WS_PROJA);
    bf16_t* mix = (bf16_t*)(p.ws + WS_MIX);
    const float LOG2E = 1.4426950408889634f;
    for (int nb = blockIdx.x; nb < NTOK / 128; nb += F.G) {
        const int t0 = nb * 128; const bool first = (nb % (SEQ / 128)) == 0;
        __syncthreads();
        for (int i = tid; i < 1024; i += NTHREADS) { const int h = i >> 7, dist = i & 127; biasT[i] = p.in[I_RELB][t5_bucket(dist) * 8 + h] * LOG2E; }
        for (int kvh = 0; kvh < 2; ++kvh) {
            __syncthreads();
            for (int c = tid; c < 2048; c += NTHREADS) { const int row = c >> 3, ch = c & 7; const int tok = t0 - 128 + row;
                u32x4 kv = (u32x4){0u, 0u, 0u, 0u}, vv = (u32x4){0u, 0u, 0u, 0u};
                if (row >= 128 || !first) { kv = *(const u32x4*)(proj + (size_t)tok * NA + COL_K + kvh * 64 + ch * 8); vv = *(const u32x4*)(proj + (size_t)tok * NA + COL_V + kvh * 64 + ch * 8); }
                *(LAS u32x4*)(Kl + row * KVSTR + ch * 16) = kv; *(LAS u32x4*)(Vl + row * KVSTR + ch * 16) = vv; }
            __syncthreads();
            const int hq = wave >> 1, qh = wave & 1, head = kvh * 4 + hq;
            float br[9][4];
#pragma unroll
            for (int tt = 0; tt < 9; ++tt)
#pragma unroll
                for (int i = 0; i < 4; ++i) { const int dist = 128 + fr - 4 * fq - 16 * tt - i; br[tt][i] = (dist >= 0 && dist < 128) ? biasT[head * 128 + (dist & 127)] : NEG_INF_F; }
            const float sink2 = p.in[I_SINK][l * 8 + head] * LOG2E;
            const unsigned vbase = (unsigned)(size_t)Vl;
#pragma unroll 1
            for (int r = 0; r < 4; ++r) {
                const int R = qh * 4 + r, q0 = 16 * R;
                bf16x8 qf[2];
#pragma unroll
                for (int s = 0; s < 2; ++s) qf[s] = *(const bf16x8*)(proj + (size_t)(t0 + q0 + fr) * NA + head * 64 + 32 * s + 8 * fq);
                f32x4 sacc[9];
#pragma unroll
                for (int tt = 0; tt < 9; ++tt) { sacc[tt] = (f32x4){0.f, 0.f, 0.f, 0.f};
#pragma unroll
                    for (int s = 0; s < 2; ++s) { const bf16x8 kf = *(const LAS bf16x8*)(Kl + (16 * (R + tt) + fr) * KVSTR + s * 64 + fq * 16);
                        sacc[tt] = __builtin_amdgcn_mfma_f32_16x16x32_bf16(kf, qf[s], sacc[tt], 0, 0, 0); } }
                float mx = sink2;
#pragma unroll
                for (int tt = 0; tt < 9; ++tt) { const bool dead = first && (R + tt < 8);
#pragma unroll
                    for (int i = 0; i < 4; ++i) { const float lg = dead ? NEG_INF_F : (sacc[tt][i] * (0.125f * LOG2E) + br[tt][i]); sacc[tt][i] = lg; mx = fmaxf(mx, lg); } }
                mx = fmaxf(mx, __shfl_xor(mx, 16)); mx = fmaxf(mx, __shfl_xor(mx, 32));
                float ls = 0.f;
#pragma unroll
                for (int tt = 0; tt < 9; ++tt)
#pragma unroll
                    for (int i = 0; i < 4; ++i) { const float pv = __builtin_amdgcn_exp2f(sacc[tt][i] - mx); sacc[tt][i] = pv; ls += pv; }
                ls += __shfl_xor(ls, 16); ls += __shfl_xor(ls, 32);
                const float inv = 1.0f / (ls + __builtin_amdgcn_exp2f(sink2 - mx));
                f32x4 oacc[4];
#pragma unroll
                for (int c = 0; c < 4; ++c) oacc[c] = (f32x4){0.f, 0.f, 0.f, 0.f};
#pragma unroll
                for (int u = 0; u < 5; ++u) {
                    u32x4 pw; pw.x = cvt_pk_bf16(sacc[2 * u][0], sacc[2 * u][1]); pw.y = cvt_pk_bf16(sacc[2 * u][2], sacc[2 * u][3]);
                    if (u < 4) { pw.z = cvt_pk_bf16(sacc[2 * u + 1][0], sacc[2 * u + 1][1]); pw.w = cvt_pk_bf16(sacc[2 * u + 1][2], sacc[2 * u + 1][3]); } else { pw.z = 0u; pw.w = 0u; }
                    const bf16x8 pf = __builtin_bit_cast(bf16x8, pw);
                    const unsigned addrA = vbase + (unsigned)((16 * (R + 2 * u) + 4 * fq + (fr >> 2)) * KVSTR + (4 * (fr & 3)) * 2);
                    s16x4 lo[4], hi[4];
                    if (u < 4) tr_read8(addrA, addrA + 16 * KVSTR, lo, hi);
                    else { tr_read4(addrA, lo);
#pragma unroll
                        for (int c = 0; c < 4; ++c) hi[c] = (s16x4){0, 0, 0, 0}; }
#pragma unroll
                    for (int c = 0; c < 4; ++c) oacc[c] = __builtin_amdgcn_mfma_f32_16x16x32_bf16(cat44(lo[c], hi[c]), pf, oacc[c], 0, 0, 0);
                }
                bf16_t* op = mix + (size_t)(t0 + q0 + fr) * MIXW + head * 64 + 4 * fq;
#pragma unroll
                for (int c = 0; c < 4; ++c) { u32x2 w; w.x = cvt_pk_bf16(oacc[c][0] * inv, oacc[c][1] * inv); w.y = cvt_pk_bf16(oacc[c][2] * inv, oacc[c][3] * inv); *(u32x2*)(op + 16 * c) = w; }
            }
        }
        LAS float* Zs = (LAS float*)F.lds;
        for (int g = 0; g < 4; ++g) {
            const int w = 2 << g;
            __syncthreads();
            for (int i = tid; i < 143 * 16; i += NTHREADS) { const int row = i >> 4, ch = i & 15; const int tok = t0 - 15 + row;
                u32x4 zv = (u32x4){0u, 0u, 0u, 0u};
                if (row >= 15 || !first) zv = *(const u32x4*)(proj + (size_t)tok * NA + COL_PZ + g * 128 + ch * 8);
                LAS float* zd = Zs + row * 128 + ch * 8;
                *(LAS f32x4*)zd = (f32x4){bf_lo(zv.x), bf_hi(zv.x), bf_lo(zv.y), bf_hi(zv.y)}; *(LAS f32x4*)(zd + 4) = (f32x4){bf_lo(zv.z), bf_hi(zv.z), bf_lo(zv.w), bf_hi(zv.w)}; }
            __syncthreads();
            const int c2 = tid & 63, seg = tid >> 6;
            const int tb = seg * 16; float sa = 0.f, sb = 0.f;
            for (int j = 1; j < w; ++j) { const f32x2 z = *(const LAS f32x2*)(Zs + (tb + 15 - j) * 128 + 2 * c2); sa += z[0]; sb += z[1]; }
            const int posb = (nb % (SEQ / 128)) * 128;
            for (int tt = 0; tt < 16; ++tt) { const int t = tb + tt, r = t + 15;
                const f32x2 z = *(const LAS f32x2*)(Zs + r * 128 + 2 * c2); sa += z[0]; sb += z[1];
                const int pos = posb + t; const float icnt = 1.0f / (float)((pos + 1 < w) ? pos + 1 : w);
                *(unsigned*)(mix + (size_t)(t0 + t) * MIXW + 512 + g * 128 + 2 * c2) = cvt_pk_bf16(sa * icnt - z[0], sb * icnt - z[1]);
                const f32x2 zo = *(const LAS f32x2*)(Zs + (r - w + 1) * 128 + 2 * c2); sa -= zo[0]; sb -= zo[1]; }
        }
        __syncthreads();
        for (int tt = 0; tt < 16; ++tt) { const int t = wave * 16 + tt; const u32x4 g4 = *(const u32x4*)(proj + (size_t)(t0 + t) * NA + COL_GV + lane * 8);
            const float a[8] = {bf_lo(g4.x), bf_hi(g4.x), bf_lo(g4.y), bf_hi(g4.y), bf_lo(g4.z), bf_hi(g4.z), bf_lo(g4.w), bf_hi(g4.w)}; float ss = 0.f;
#pragma unroll
            for (int j = 0; j < 8; ++j) ss += a[j] * a[j];
            ss = wave_sum(ss); if (lane == 0) rs[t] = 1.0f / sqrtf(ss * (1.0f / 512.0f) + EPS); }
        LAS unsigned char* Vn = F.lds;
        const bf16_t* Wsp = (const bf16_t*)(p.ws + WS_WSP);
        for (int g = 0; g < 4; ++g) {
            __syncthreads();
            for (int i = tid; i < 128 * 16; i += NTHREADS) { const int s = i >> 4, ch = i & 15; const u32x4 g4 = *(const u32x4*)(proj + (size_t)(t0 + s) * NA + COL_GV + g * 128 + ch * 8);
                const float r = rs[s]; const float* gn = p.in[I_VGAIN] + l * 512 + g * 128 + ch * 8; const f32x4 ga = *(const f32x4*)gn, gb = *(const f32x4*)(gn + 4);
                u32x4 w; w.x = cvt_pk_bf16(bf_lo(g4.x) * r * ga[0], bf_hi(g4.x) * r * ga[1]); w.y = cvt_pk_bf16(bf_lo(g4.y) * r * ga[2], bf_hi(g4.y) * r * ga[3]);
                w.z = cvt_pk_bf16(bf_lo(g4.z) * r * gb[0], bf_hi(g4.z) * r * gb[1]); w.w = cvt_pk_bf16(bf_lo(g4.w) * r * gb[2], bf_hi(g4.w) * r * gb[3]);
                *(LAS u32x4*)(Vn + s * VNSTR + ch * 16) = w; }
            __syncthreads();
            const int T = wave; f32x4 acc[8];
#pragma unroll
            for (int c = 0; c < 8; ++c) acc[c] = (f32x4){0.f, 0.f, 0.f, 0.f};
            const bf16_t* wrow = Wsp + (((size_t)l * 4 + g) * 128 + 16 * T + fr) * 128 + 8 * fq;
            const unsigned vnb = (unsigned)(size_t)Vn;
#pragma unroll 1
            for (int u = 0; u <= (T >> 1); ++u) {
                const bf16x8 wf = *(const bf16x8*)(wrow + 32 * u);
                const unsigned addrA = vnb + (unsigned)((32 * u + 8 * fq + (fr >> 2)) * VNSTR + (4 * (fr & 3)) * 2);
#pragma unroll
                for (int hf = 0; hf < 2; ++hf) { s16x4 lo[4], hi[4]; tr_read8(addrA + hf * 128, addrA + hf * 128 + 4 * VNSTR, lo, hi);
#pragma unroll
                    for (int c = 0; c < 4; ++c) acc[hf * 4 + c] = __builtin_amdgcn_mfma_f32_16x16x32_bf16(cat44(lo[c], hi[c]), wf, acc[hf * 4 + c], 0, 0, 0); }
            }
            const int t = 16 * T + fr; const float bs = p.in[I_BSP][(l * 4 + g) * 128 + t];
            const bf16_t* up = proj + (size_t)(t0 + t) * NA + COL_GU + g * 128 + 4 * fq; bf16_t* op = mix + (size_t)(t0 + t) * MIXW + 1024 + g * 128 + 4 * fq;
#pragma unroll
            for (int c = 0; c < 8; ++c) { const u32x2 uw = *(const u32x2*)(up + 16 * c);
                u32x2 w; w.x = cvt_pk_bf16(bf_lo(uw.x) * (acc[c][0] + bs), bf_hi(uw.x) * (acc[c][1] + bs)); w.y = cvt_pk_bf16(bf_lo(uw.y) * (acc[c][2] + bs), bf_hi(uw.y) * (acc[c][3] + bs));
                *(u32x2*)(op + 16 * c) = w; }
        }
    }
}

__device__ __forceinline__ unsigned ordkey(unsigned bits) { return bits ^ ((unsigned)((int)bits >> 31) | 0x80000000u); }
__device__ __forceinline__ unsigned unord(unsigned k) { return (k & 0x80000000u) ? (k ^ 0x80000000u) : ~k; }
__device__ __forceinline__ void phase_topk(const Params& p, const Frame& F0, int l) {
    const Frame F = local_frame(F0);
    const int lane = F.lane, wave = F.wave;
    LAS float* tile = (LAS float*)(F.lds + wave * 8448);
    LAS unsigned char* itab = (LAS unsigned char*)(F.lds + 8 * 8448 + wave * 64 * 36 + lane * 36);
    const float* scores = (const float*)(p.ws + WS_SCORES);
    const float* rowsq = (const float*)(p.ws + WS_ROWSQP) + (size_t)l * NTOK * 16;
    unsigned* seli = (unsigned*)(p.ws + WS_SELI); float* selg = (float*)(p.ws + WS_SELG);
    const int gw = blockIdx.x * NWAVES + wave, NGW = F.G * NWAVES;
    const int row_l = lane >> 3, cg_l = lane & 7;
    f32x4 cur[8];
    if (gw < NTOK * 8 / 64) {
#pragma unroll
        for (int i = 0; i < 8; ++i) cur[i] = *(const f32x4*)(scores + ((size_t)gw * 64 + 8 * i + row_l) * 256 + cg_l * 4);
    }
    for (int grp = gw; grp < NTOK * 8 / 64; grp += NGW) {
        const size_t item0 = (size_t)grp * 64;
        unsigned L1[16], L2[16];
#pragma unroll
        for (int j = 0; j < 16; ++j) { L1[j] = 0u; L2[j] = 0u; }
#pragma unroll 1
        for (int ch = 0; ch < 8; ++ch) {
#pragma unroll
            for (int i = 0; i < 8; ++i) { LAS float* d = tile + (8 * i + row_l) * 33 + cg_l * 4; d[0] = cur[i][0]; d[1] = cur[i][1]; d[2] = cur[i][2]; d[3] = cur[i][3]; }
            {
                const bool more = (ch < 7) || (grp + NGW < NTOK * 8 / 64);
                const size_t nitem0 = (ch < 7) ? item0 : (size_t)(grp + NGW) * 64; const int nch = (ch < 7) ? ch + 1 : 0;
                if (more) {
#pragma unroll
                    for (int i = 0; i < 8; ++i) cur[i] = *(const f32x4*)(scores + (nitem0 + 8 * i + row_l) * 256 + nch * 32 + cg_l * 4);
                }
            }
            __builtin_amdgcn_wave_barrier(); asm volatile("s_waitcnt lgkmcnt(0)" ::: "memory");
            if (ch < 4) {
#pragma unroll
                for (int j = 0; j < 32; ++j) { unsigned x = ordkey((__float_as_uint(tile[lane * 33 + j]) & 0xffffff80u) | (unsigned)(ch * 32 + j));
#pragma unroll
                    for (int k = 0; k < 16; ++k) { const unsigned hi = max(L1[k], x); x = min(L1[k], x); L1[k] = hi; } }
            } else {
#pragma unroll
                for (int j = 0; j < 32; ++j) { unsigned x = ordkey((__float_as_uint(tile[lane * 33 + j]) & 0xffffff80u) | (unsigned)((ch - 4) * 32 + j));
#pragma unroll
                    for (int k = 0; k < 16; ++k) { const unsigned hi = max(L2[k], x); x = min(L2[k], x); L2[k] = hi; } }
            }
            __builtin_amdgcn_wave_barrier(); asm volatile("s_waitcnt lgkmcnt(0)" ::: "memory");
        }
        float f1[16], f2[16];
#pragma unroll
        for (int k = 0; k < 16; ++k) { const unsigned b1 = unord(L1[k]), b2 = unord(L2[k]); f1[k] = __uint_as_float(b1); f2[k] = __uint_as_float(b2); itab[k] = (unsigned char)(b1 & 127u); itab[16 + k] = (unsigned char)(b2 & 127u); }
        unsigned T[16];
#pragma unroll
        for (int j = 0; j < 16; ++j) T[j] = 0u;
#pragma unroll
        for (int i = 0; i < 16; ++i)
#pragma unroll
            for (int j = 0; j < 16; ++j) if ((i + 1) * (j + 1) <= 16) {
                unsigned x = ordkey((__float_as_uint(f1[i] + f2[j]) & 0xffffff00u) | (unsigned)(i * 16 + j));
#pragma unroll
                for (int k = 0; k < 16; ++k) { const unsigned hi = max(T[k], x); x = min(T[k], x); T[k] = hi; } }
        asm volatile("s_waitcnt lgkmcnt(0)" ::: "memory");
        const size_t item = item0 + lane; const int tok = (int)(item >> 3);
        const float rstd = 1.0f / sqrtf(row_sumsq(rowsq, tok) * (1.0f / DM) + EPS);
        float e[16], se = 0.f; unsigned P[16];
        const float t0v = __uint_as_float(unord(T[0]));
#pragma unroll
        for (int k = 0; k < 16; ++k) { const unsigned b = unord(T[k]); e[k] = __expf((__uint_as_float(b) - t0v) * rstd); se += e[k];
            const unsigned code = b & 255u; P[k] = ((unsigned)itab[code >> 4] << 7) | (unsigned)itab[16 + (code & 15u)]; }
        const float inv = 1.0f / se;
        u32x4* di = (u32x4*)(seli + item * 16); f32x4* dg = (f32x4*)(selg + item * 16);
#pragma unroll
        for (int k4 = 0; k4 < 4; ++k4) { di[k4] = (u32x4){P[4 * k4], P[4 * k4 + 1], P[4 * k4 + 2], P[4 * k4 + 3]};
            dg[k4] = (f32x4){e[4 * k4] * inv, e[4 * k4 + 1] * inv, e[4 * k4 + 2] * inv, e[4 * k4 + 3] * inv}; }
        asm volatile("s_waitcnt lgkmcnt(0)" ::: "memory");
    }
}

__device__ __forceinline__ void fp8x16_to_f32(const u32x4 w, float (&f)[16]) {
#pragma unroll
    for (int q = 0; q < 4; ++q) { const f32x2 lo = __builtin_amdgcn_cvt_pk_f32_fp8((int)w[q], false), hi = __builtin_amdgcn_cvt_pk_f32_fp8((int)w[q], true);
        f[4 * q] = lo[0]; f[4 * q + 1] = lo[1]; f[4 * q + 2] = hi[0]; f[4 * q + 3] = hi[1]; }
}
template <int CTRL> __device__ __forceinline__ float dpp_f(float v) { return __uint_as_float(__builtin_amdgcn_update_dpp(0u, __float_as_uint(v), CTRL, 0xF, 0xF, true)); }
constexpr int GT = 4;
__device__ __forceinline__ void phase_gather(const Params& p, const Frame& F0, int l, const XcdBarrier& bar, bool use_bar, bool dry = false, unsigned emask = 0xffffffffu) {
    const Frame F = local_frame(F0);
    const int lane = F.lane;
    const unsigned char* ET = p.ws + WS_EXP + (size_t)l * NEXP * 2 * DM;
    const f32x2* SC = (const f32x2*)(p.ws + WS_ESCALE) + (size_t)l * NEXP;
    const bf16_t* xb = (const bf16_t*)(p.ws + WS_XB);
    bf16_t* xbo = dry ? (bf16_t*)(p.ws + WS_GATES) : (bf16_t*)(p.ws + WS_XB);
    float* outp = dry ? (float*)(p.ws + WS_GATES) : p.out;
    float* rstdo = dry ? (float*)(p.ws + WS_GATES + 160 * MiB) : (float*)(p.ws + WS_RSTD);
    const float* rowsq = (const float*)(p.ws + WS_ROWSQP) + (size_t)l * NTOK * 16;
    const unsigned* seli = (const unsigned*)(p.ws + WS_SELI); const float* selg = (const float*)(p.ws + WS_SELG);
    const float* gain = p.in[I_FFGAIN] + l * DM + lane * 16;
    LAS u32x2* sortl = (LAS u32x2*)(F.lds + F.wave * (GT * 1024));
    const bool dsel0 = (lane & 1) != 0, dsel1 = (lane & 2) != 0, ondiag = (((lane & 15) >> 2) == (lane >> 4));
    const bool b2 = (lane & 4) != 0, b1 = (lane & 2) != 0, b0 = (lane & 1) != 0;
    const int mym = (b2 ? 4 : 0) + (b0 ? 2 : 0) + (b1 ? 1 : 0);
    const int gw = blockIdx.x * NWAVES + F.wave, NGW = F.G * NWAVES;
    const int nsweep = NTOK / (NGW * GT);
    for (int sw = 0; sw < nsweep; ++sw) {
        if (sw > 0 && use_bar) xcd_barrier(bar);
        const int tok0 = (sw * NGW + gw) * GT;
        float o[GT][16]; int cur[GT]; long h2lo[GT], h2hi[GT]; float h2s[GT];
#pragma unroll
        for (int tk = 0; tk < GT; ++tk) { const int tok = tok0 + tk;
            const float rstd = 1.0f / sqrtf(row_sumsq(rowsq, tok) * (1.0f / DM) + EPS);
            const u32x4 xw0 = *(const u32x4*)(xb + (size_t)tok * DM + lane * 16), xw1 = *(const u32x4*)(xb + (size_t)tok * DM + lane * 16 + 8);
            const f32x4 g0 = *(const f32x4*)gain, g1 = *(const f32x4*)(gain + 4), g2 = *(const f32x4*)(gain + 8), g3 = *(const f32x4*)(gain + 12);
            float hv[16] = {bf_lo(xw0.x) * rstd * g0[0], bf_hi(xw0.x) * rstd * g0[1], bf_lo(xw0.y) * rstd * g0[2], bf_hi(xw0.y) * rstd * g0[3], bf_lo(xw0.z) * rstd * g1[0], bf_hi(xw0.z) * rstd * g1[1], bf_lo(xw0.w) * rstd * g1[2], bf_hi(xw0.w) * rstd * g1[3],
                            bf_lo(xw1.x) * rstd * g2[0], bf_hi(xw1.x) * rstd * g2[1], bf_lo(xw1.y) * rstd * g2[2], bf_hi(xw1.y) * rstd * g2[3], bf_lo(xw1.z) * rstd * g3[0], bf_hi(xw1.z) * rstd * g3[1], bf_lo(xw1.w) * rstd * g3[2], bf_hi(xw1.w) * rstd * g3[3]};
            float hm = 0.f;
#pragma unroll
            for (int j = 0; j < 16; ++j) hm = fmaxf(hm, fabsf(hv[j]));
#pragma unroll
            for (int of = 1; of < 64; of <<= 1) hm = fmaxf(hm, __shfl_xor(hm, of));
            const float hinv = hm > 0.f ? 448.0f / hm : 0.f; h2s[tk] = hm * (1.0f / 448.0f);
            {   int w0 = 0, w1 = 0, w2 = 0, w3 = 0;
                w0 = __builtin_amdgcn_cvt_pk_fp8_f32(hv[0] * hinv, hv[1] * hinv, w0, false); w0 = __builtin_amdgcn_cvt_pk_fp8_f32(hv[2] * hinv, hv[3] * hinv, w0, true);
                w1 = __builtin_amdgcn_cvt_pk_fp8_f32(hv[4] * hinv, hv[5] * hinv, w1, false); w1 = __builtin_amdgcn_cvt_pk_fp8_f32(hv[6] * hinv, hv[7] * hinv, w1, true);
                w2 = __builtin_amdgcn_cvt_pk_fp8_f32(hv[8] * hinv, hv[9] * hinv, w2, false); w2 = __builtin_amdgcn_cvt_pk_fp8_f32(hv[10] * hinv, hv[11] * hinv, w2, true);
                w3 = __builtin_amdgcn_cvt_pk_fp8_f32(hv[12] * hinv, hv[13] * hinv, w3, false); w3 = __builtin_amdgcn_cvt_pk_fp8_f32(hv[14] * hinv, hv[15] * hinv, w3, true);
                h2lo[tk] = (long)(((unsigned long long)(unsigned)w1 << 32) | (unsigned)w0); h2hi[tk] = (long)(((unsigned long long)(unsigned)w3 << 32) | (unsigned)w2); }
            const unsigned i0 = seli[(size_t)tok * 128 + lane] & emask, i1 = seli[(size_t)tok * 128 + 64 + lane] & emask;
            const float q0 = selg[(size_t)tok * 128 + lane], q1 = selg[(size_t)tok * 128 + 64 + lane];
            const unsigned ep0 = i0 >> 10, ep1 = i1 >> 10; unsigned pos0 = 0, pos1 = 0, base = 0;
#pragma unroll
            for (unsigned ep = 0; ep < 16; ++ep) { const unsigned long long m0 = __ballot(ep0 == ep), m1 = __ballot(ep1 == ep);
                const unsigned c0 = __builtin_amdgcn_mbcnt_hi((unsigned)(m0 >> 32), __builtin_amdgcn_mbcnt_lo((unsigned)m0, 0u)), c1 = __builtin_amdgcn_mbcnt_hi((unsigned)(m1 >> 32), __builtin_amdgcn_mbcnt_lo((unsigned)m1, 0u));
                const unsigned n0 = (unsigned)__popcll(m0), n1 = (unsigned)__popcll(m1);
                pos0 = (ep0 == ep) ? base + c0 : pos0; pos1 = (ep1 == ep) ? base + n0 + c1 : pos1; base += n0 + n1; }
            sortl[tk * 128 + pos0] = (u32x2){i0, __float_as_uint(q0)}; sortl[tk * 128 + pos1] = (u32x2){i1, __float_as_uint(q1)}; cur[tk] = 0;
#pragma unroll
            for (int j = 0; j < 16; ++j) o[tk][j] = 0.f; }
        __builtin_amdgcn_wave_barrier(); asm volatile("s_waitcnt lgkmcnt(0)" ::: "memory");
#pragma unroll 1
        for (int r = 0; r < 16; ++r) {
#pragma unroll
            for (int tk = 0; tk < GT; ++tk) {
                while (cur[tk] < 16) {
                    const int b = cur[tk]; const u32x2 ent = sortl[tk * 128 + 8 * b + mym];
                    unsigned e[8];
                    e[0] = __builtin_amdgcn_readlane(ent.x, 0);
                    if ((int)(e[0] >> 10) > r) break;
                    cur[tk] = b + 1;
#pragma unroll
                    for (int i = 1; i < 8; ++i) e[i] = __builtin_amdgcn_readlane(ent.x, ((i & 4) ? 4 : 0) + ((i & 1) ? 2 : 0) + ((i & 2) ? 1 : 0));
                    u32x4 uu[8], vv[8];
#pragma unroll
                    for (int i = 0; i < 8; ++i) { const unsigned char* rp = ET + (size_t)e[i] * (2 * DM) + lane * 16; uu[i] = *(const u32x4*)rp; vv[i] = *(const u32x4*)(rp + DM); }
                    const unsigned mye = ent.x; const float myg = __uint_as_float(ent.y);
                    const f32x2 sc = SC[mye];
                    float d[8];
#pragma unroll
                    for (int hf = 0; hf < 2; ++hf) { f32x4 acc4[4];
#pragma unroll
                        for (int i = 0; i < 4; ++i) { const u32x4 w = uu[4 * hf + i]; acc4[i] = __builtin_amdgcn_mfma_f32_16x16x32_fp8_fp8((long)(((unsigned long long)w.y << 32) | w.x), h2lo[tk], (f32x4){0.f, 0.f, 0.f, 0.f}, 0, 0, 0); }
#pragma unroll
                        for (int i = 0; i < 4; ++i) { const u32x4 w = uu[4 * hf + i]; acc4[i] = __builtin_amdgcn_mfma_f32_16x16x32_fp8_fp8((long)(((unsigned long long)w.w << 32) | w.z), h2hi[tk], acc4[i], 0, 0, 0); }
#pragma unroll
                        for (int i = 0; i < 4; ++i) { const float lo2 = dsel0 ? acc4[i][1] : acc4[i][0], hi2 = dsel0 ? acc4[i][3] : acc4[i][2]; const float v = dsel1 ? hi2 : lo2; d[4 * hf + i] = ondiag ? v : 0.f; } }
                    float a4[4], c2[2];
#pragma unroll
                    for (int j = 0; j < 4; ++j) { const float keep = b2 ? d[j + 4] : d[j], send = b2 ? d[j] : d[j + 4]; a4[j] = keep + dpp_f<0x141>(send); }
#pragma unroll
                    for (int j = 0; j < 2; ++j) { const float keep = b0 ? a4[j + 2] : a4[j], send = b0 ? a4[j] : a4[j + 2]; c2[j] = keep + dpp_f<0xB1>(send); }
                    float dm; { const float keep = b1 ? c2[1] : c2[0], send = b1 ? c2[0] : c2[1]; dm = keep + dpp_f<0x4E>(send); }
                    dm += dpp_f<0x128>(dm);
                    { const auto s16 = __builtin_amdgcn_permlane16_swap(__float_as_uint(dm), __float_as_uint(dm), false, false); dm = __uint_as_float(s16[0]) + __uint_as_float(s16[1]); }
                    { const auto s32 = __builtin_amdgcn_permlane32_swap(__float_as_uint(dm), __float_as_uint(dm), false, false); dm = __uint_as_float(s32[0]) + __uint_as_float(s32[1]); }
                    const float cf = myg * gelu_tanh(dm * sc[0] * h2s[tk]) * sc[1];
#pragma unroll
                    for (int i = 0; i < 8; ++i) { const float ci = __uint_as_float(__builtin_amdgcn_readlane(__float_as_uint(cf), ((i & 4) ? 4 : 0) + ((i & 1) ? 2 : 0) + ((i & 2) ? 1 : 0)));
                        float f[16]; fp8x16_to_f32(vv[i], f);
#pragma unroll
                        for (int j = 0; j < 16; ++j) o[tk][j] += ci * f[j]; }
                }
            }
        }
#pragma unroll
        for (int tk = 0; tk < GT; ++tk) { const int tok = tok0 + tk;
            const u32x4 xw0 = *(const u32x4*)(xb + (size_t)tok * DM + lane * 16), xw1 = *(const u32x4*)(xb + (size_t)tok * DM + lane * 16 + 8);
            float* ot = o[tk];
            ot[0] += bf_lo(xw0.x); ot[1] += bf_hi(xw0.x); ot[2] += bf_lo(xw0.y); ot[3] += bf_hi(xw0.y); ot[4] += bf_lo(xw0.z); ot[5] += bf_hi(xw0.z); ot[6] += bf_lo(xw0.w); ot[7] += bf_hi(xw0.w);
            ot[8] += bf_lo(xw1.x); ot[9] += bf_hi(xw1.x); ot[10] += bf_lo(xw1.y); ot[11] += bf_hi(xw1.y); ot[12] += bf_lo(xw1.z); ot[13] += bf_hi(xw1.z); ot[14] += bf_lo(xw1.w); ot[15] += bf_hi(xw1.w);
            float ss = 0.f;
#pragma unroll
            for (int i = 0; i < 16; ++i) ss += ot[i] * ot[i];
            ss = wave_sum(ss);
            const float r2 = 1.0f / sqrtf(ss * (1.0f / DM) + EPS);
            if (l + 1 < DEPTH) {
                u32x4 w0, w1; w0.x = cvt_pk_bf16(ot[0], ot[1]); w0.y = cvt_pk_bf16(ot[2], ot[3]); w0.z = cvt_pk_bf16(ot[4], ot[5]); w0.w = cvt_pk_bf16(ot[6], ot[7]);
                w1.x = cvt_pk_bf16(ot[8], ot[9]); w1.y = cvt_pk_bf16(ot[10], ot[11]); w1.z = cvt_pk_bf16(ot[12], ot[13]); w1.w = cvt_pk_bf16(ot[14], ot[15]);
                *(u32x4*)(xbo + (size_t)tok * DM + lane * 16) = w0; *(u32x4*)(xbo + (size_t)tok * DM + lane * 16 + 8) = w1;
                if (lane == 0) rstdo[(size_t)(l + 1) * NTOK + tok] = r2;
            } else {
                const float* fg = p.in[I_FGAIN] + lane * 16; float* dst = outp + (size_t)tok * DM + lane * 16;
#pragma unroll
                for (int q = 0; q < 4; ++q) { const f32x4 gq = *(const f32x4*)(fg + 4 * q);
                    *(f32x4*)(dst + 4 * q) = (f32x4){ot[4 * q] * r2 * gq[0], ot[4 * q + 1] * r2 * gq[1], ot[4 * q + 2] * r2 * gq[2], ot[4 * q + 3] * r2 * gq[3]}; }
            }
        }
    }
}

constexpr int PH_PER_LAYER = 8, N_PHASES = 1 + DEPTH * PH_PER_LAYER;
__global__ void __launch_bounds__(NTHREADS, 2) mk_fwd(Params p) {
    extern __shared__ __attribute__((aligned(16))) unsigned char lds_raw[];
    Frame F; F.lds = (LAS unsigned char*)lds_raw; F.tid = threadIdx.x; F.lane = F.tid & 63; F.wave = __builtin_amdgcn_readfirstlane(F.tid >> 6);
    F.G = gridDim.x; { const int bx = blockIdx.x; F.vcu = (F.G % 8 == 0) ? (bx % 8) * (F.G / 8) + bx / 8 : bx; }
    volatile LAS unsigned* misc = (volatile LAS unsigned*)(F.lds + LDS_MISC);
    if (F.tid < 64) misc[F.tid] = 0u;
    __syncthreads();
    unsigned* ctl = (unsigned*)(p.ws + WS_CTL);
    XcdBarrier bar; bar.bar = ctl + CTL_BAR_WORD; bar.x = 0; bar.st = nullptr;
    const bool one_launch = (p.ph_hi - p.ph_lo) > 1;
    if (one_launch) bar = xcd_barrier_post(ctl + CTL_BAR_WORD, misc);
    const int lo = p.ph_lo, hi = p.ph_hi;
#define IN(k) (lo <= (k) && (k) < hi)
#define SEAM(k) do { if (IN(k) && IN((k) + 1)) xcd_barrier(bar); } while (0)
    bf16_t* xb = (bf16_t*)(p.ws + WS_XB);
    if (IN(0)) { if (PD(8)) phase_prologue(p, F); phase_prologue(p, F); SEAM(0); }
    for (int l = 0; l < DEPTH; ++l) {
        const int b = 1 + l * PH_PER_LAYER;
        const float* rstd_a = (const float*)(p.ws + WS_RSTD) + (size_t)l * NTOK;
        if (IN(b + 0)) {
            pg8::Gemm g{xb, (const bf16_t*)(p.ws + WS_WTIN) + (size_t)l * NIN * DM, DM, DM, DM, 0, 0};
            pg8::TileOrder<1> S; S.init(NTOK, NA, F.G, (int)blockIdx.x);
            EpiProjA E{(bf16_t*)(p.ws + WS_PROJA), rstd_a};
            if (PD(0)) pg8::gemm_phase(F.lds, g, S, E, F.wave);
            pg8::gemm_phase(F.lds, g, S, E, F.wave); SEAM(b + 0);
        }
        if (IN(b + 1)) {
#if defined(MIX_SIMPLE)
            phase_mix_simple(p, F, l);
#else
            if (PD(1)) phase_mix(p, F, l);
            phase_mix(p, F, l);
#endif
            SEAM(b + 1);
        }
        if (IN(b + 2)) {
            pg8::Gemm g{xb, (const bf16_t*)(p.ws + WS_WTIN) + ((size_t)l * NIN + NA) * DM, DM, DM, DM, 0, 0};
            pg8::TileOrder<1> S; S.init(NTOK, NG, F.G, (int)blockIdx.x);
            EpiGates E{(bf16_t*)(p.ws + WS_GATES), rstd_a, p.in[I_BGATE] + l * NG};
            if (PD(2)) pg8::gemm_phase(F.lds, g, S, E, F.wave);
            pg8::gemm_phase(F.lds, g, S, E, F.wave); SEAM(b + 2);
        }
        if (IN(b + 3)) {
            pg8::Gemm g{(const bf16_t*)(p.ws + WS_MIX), (const bf16_t*)(p.ws + WS_WTBR) + (size_t)l * 3 * DM * 512, MIXW, 512, 512, (size_t)512 * 2, (size_t)DM * 512 * 2};
            pg8::TileOrder<3> S; S.init(NTOK, DM, F.G, (int)blockIdx.x);
            EpiMerge E{(const bf16_t*)(p.ws + WS_GATES), (bf16_t*)p.out};
            if (PD(3)) pg8::gemm_phase(F.lds, g, S, E, F.wave);
            pg8::gemm_phase(F.lds, g, S, E, F.wave); SEAM(b + 3);
        }
        if (IN(b + 4)) {
            pg8::Gemm g{(const bf16_t*)p.out, (const bf16_t*)(p.ws + WS_WTOUT) + (size_t)l * DM * DM, DM, DM, DM, 0, 0};
            pg8::TileOrder<1> S; S.init(NTOK, DM, F.G, (int)blockIdx.x);
            EpiResid E{xb, (float*)(p.ws + WS_ROWSQP) + (size_t)l * NTOK * 16, xb};
            if (PD(4)) { EpiResid E2{xb, (float*)(p.ws + WS_ROWSQP) + (size_t)l * NTOK * 16, (bf16_t*)(p.ws + WS_GATES)}; pg8::gemm_phase(F.lds, g, S, E2, F.wave); }
            pg8::gemm_phase(F.lds, g, S, E, F.wave); SEAM(b + 4);
        }
        if (IN(b + 5)) {
            pg8::Gemm g{xb, (const bf16_t*)(p.ws + WS_WEFF) + (size_t)l * PQ * DM, DM, DM, DM, 0, 0};
            pg8::TileOrder<1> S; S.init(NTOK, PQ, F.G, (int)blockIdx.x);
            EpiScores E{(float*)(p.ws + WS_SCORES)};
            if (PD(5)) pg8::gemm_phase(F.lds, g, S, E, F.wave);
            pg8::gemm_phase(F.lds, g, S, E, F.wave); SEAM(b + 5);
        }
        if (IN(b + 6)) { if (PD(6)) phase_topk(p, F, l); phase_topk(p, F, l); SEAM(b + 6); }
        if (IN(b + 7)) { if (PD(7)) phase_gather(p, F, l, bar, one_launch, true); if (PD(9)) phase_gather(p, F, l, bar, one_launch, true, 1023u); phase_gather(p, F, l, bar, one_launch); SEAM(b + 7); }
    }
#undef IN
#undef SEAM
}

extern "C" void kernel_launch(void* const* d_in, const int* in_sizes, int n_in, void* d_out, int out_size, void* d_ws, size_t ws_size, hipStream_t stream) {
    static int grid = 0;
    if (grid == 0) {
        if (n_in != 22 || out_size != NTOK * DM || ws_size < WS_END) { fprintf(stderr, "kernel_launch: unexpected shapes (n_in %d, out %d, ws %zu)\n", n_in, out_size, ws_size); grid = -1; return; }
        int dev = 0, cus = 0, per_cu = 0;
        if (hipGetDevice(&dev) != hipSuccess || hipDeviceGetAttribute(&cus, hipDeviceAttributeMultiprocessorCount, dev) != hipSuccess) { grid = -1; return; }
        if (hipFuncSetAttribute((const void*)mk_fwd, hipFuncAttributeMaxDynamicSharedMemorySize, LDS_BYTES) != hipSuccess) { fprintf(stderr, "kernel_launch: hipFuncSetAttribute failed\n"); grid = -1; return; }
        if (hipOccupancyMaxActiveBlocksPerMultiprocessor(&per_cu, (const void*)mk_fwd, NTHREADS, LDS_BYTES) != hipSuccess || per_cu < 1) { fprintf(stderr, "kernel_launch: occupancy query says %d\n", per_cu); }
        (void)hipGetLastError();
        grid = cus;
    }
    if (grid < 0) return;
    (void)hipMemsetAsync((char*)d_ws + WS_CTL, 0, CTL_ZERO_BYTES, stream);
    Params p; memset(&p, 0, sizeof(p));
    for (int i = 0; i < 22; ++i) p.in[i] = (const float*)d_in[i];
    p.out = (float*)d_out; p.ws = (unsigned char*)d_ws;
#if MK_N_LAUNCHES == 1
    p.ph_lo = 0; p.ph_hi = N_PHASES; p.li = 0;
    hipLaunchKernelGGL(mk_fwd, dim3(grid), dim3(NTHREADS), LDS_BYTES, stream, p);
#else
    for (int ph = 0; ph < N_PHASES; ++ph) { p.ph_lo = ph; p.ph_hi = ph + 1; p.li = ph; hipLaunchKernelGGL(mk_fwd, dim3(grid), dim3(NTHREADS), LDS_BYTES, stream, p); }
#endif
}
```

```cpp
#include <hip/hip_runtime.h>
#include <cstdio>
#include <cstdint>
#include <cstring>

#ifndef MK_N_LAUNCHES
#define MK_N_LAUNCHES 1
#endif

#ifndef PROBE_DOUBLE
#define PROBE_DOUBLE -1
#endif
#define PD(k) (PROBE_DOUBLE == (k) || (PROBE_DOUBLE == 100 && ((k) == 0 || ((k) >= 2 && (k) <= 5))))

#define LAS __attribute__((address_space(3)))
typedef unsigned short bf16_t;
typedef short bf16x8 __attribute__((ext_vector_type(8)));
typedef float f32x4 __attribute__((ext_vector_type(4)));
typedef float f32x2 __attribute__((ext_vector_type(2)));
typedef unsigned u32x4 __attribute__((ext_vector_type(4)));
typedef unsigned u32x2 __attribute__((ext_vector_type(2)));
typedef __bf16 bf16x2_t __attribute__((ext_vector_type(2)));

constexpr int NTOK = 32768, DM = 1024, SEQ = 16384, DEPTH = 2;
constexpr int NA = 2304, NG = 3072, NIN = 5376;
constexpr int COL_K = 512, COL_V = 640, COL_PZ = 768, COL_GU = 1280, COL_GV = 1792;
constexpr int MIXW = 1536;
constexpr int NEXP = 16384, PQ = 2048;
constexpr float EPS = 1e-6f;
constexpr int NWAVES = 8, NTHREADS = 512;

constexpr size_t MiB = 1u << 20;
constexpr size_t WS_CTL = 0, CTL_ZERO_BYTES = 1 * MiB;
constexpr size_t CTL_BAR_WORD = 4096;
constexpr size_t CTL_ROWSQ = 256 * 1024;
constexpr size_t WS_RSTD = 1 * MiB;
constexpr size_t WS_WTIN = 2 * MiB;
constexpr size_t WS_WTBR = 23 * MiB;
constexpr size_t WS_WTOUT = 29 * MiB;
constexpr size_t WS_WEFF = 33 * MiB;
constexpr size_t WS_WSP = 41 * MiB;
constexpr size_t WS_ROWSQP = 42 * MiB;
constexpr size_t WS_ESCALE = 46 * MiB;
constexpr size_t WS_EXP = 48 * MiB;
constexpr size_t WS_XB = 112 * MiB;
constexpr size_t WS_PROJA = 176 * MiB;
constexpr size_t WS_GATES = 176 * MiB;
constexpr size_t WS_MIX = 368 * MiB;
constexpr size_t WS_SCORES = 176 * MiB;
constexpr size_t WS_SELI = 464 * MiB, WS_SELG = 480 * MiB;
constexpr size_t WS_END = 496 * MiB;

constexpr int LDS_BYTES = 163840;
constexpr int LDS_MISC = LDS_BYTES - 256;

#define NEG_INF_F (__uint_as_float(0xff800000u))
__device__ __forceinline__ unsigned cvt_pk_bf16(float lo, float hi) { unsigned r; asm volatile("v_cvt_pk_bf16_f32 %0, %1, %2" : "=v"(r) : "v"(lo), "v"(hi)); return r; }
__device__ __forceinline__ float bf_lo(unsigned u) { return __uint_as_float(u << 16); }
__device__ __forceinline__ float bf_hi(unsigned u) { return __uint_as_float(u & 0xffff0000u); }
__device__ __forceinline__ float bf1(bf16_t u) { return __uint_as_float(((unsigned)u) << 16); }
__device__ __forceinline__ float wave_sum(float v) {
#pragma unroll
    for (int o = 1; o < 64; o <<= 1) v += __shfl_xor(v, o);
    return v;
}
__device__ __forceinline__ float gelu_tanh(float x) {
    const float u = 0.7978845608028654f * (x + 0.044715f * x * x * x);
    const float e = __builtin_amdgcn_exp2f(-2.0f * 1.4426950408889634f * u);
    return x * __builtin_amdgcn_rcpf(1.0f + e);
}
__device__ __forceinline__ float row_sumsq(const float* part, int row) { const f32x4* q = (const f32x4*)(part + (size_t)row * 16); const f32x4 a = q[0], b = q[1], c = q[2], d = q[3];
    return (((a[0] + a[1]) + (a[2] + a[3])) + ((b[0] + b[1]) + (b[2] + b[3]))) + (((c[0] + c[1]) + (c[2] + c[3])) + ((d[0] + d[1]) + (d[2] + d[3]))); }
__device__ __forceinline__ float sigmoidf_(float x) { return __builtin_amdgcn_rcpf(1.0f + __builtin_amdgcn_exp2f(-1.4426950408889634f * x)); }

#define XB_TMO      128
#define XB_XCNT(j)  (256  + 64 * (j))
#define XB_XSUB(j)  (1280 + 64 * (j))
#define XB_XGEN(j)  (2304 + 64 * (j))
#define XB_TOP      3328
#define XB_TOPGEN   3392
#define XCD_BAR_WORDS 3456
#define XB_SPIN_CAP (1u << 18)
__device__ __forceinline__ unsigned xb_ld(unsigned* p)              { return __hip_atomic_load(p, __ATOMIC_RELAXED, __HIP_MEMORY_SCOPE_AGENT); }
__device__ __forceinline__ unsigned xb_add(unsigned* p, unsigned v) { return __hip_atomic_fetch_add(p, v, __ATOMIC_RELAXED, __HIP_MEMORY_SCOPE_AGENT); }
__device__ __forceinline__ unsigned xb_xcc_id() { return (unsigned)__builtin_amdgcn_s_getreg((3 << 11) | 20) & 0xFu; }
#define XB_SPIN(cond, bar) do { unsigned _sp = 0; while (cond) { __builtin_amdgcn_s_sleep(1); \
    if ((++_sp & 255u) == 0u) { if (xb_ld(&(bar)[XB_TMO])) break; if (_sp > XB_SPIN_CAP) { atomicAdd(&(bar)[XB_TMO], 1u); break; } } } } while (0)
struct XcdBarrier { unsigned* bar; unsigned x; volatile LAS unsigned* st; };
__device__ __forceinline__ XcdBarrier xcd_barrier_post(unsigned* bar, volatile LAS unsigned* st) {
    XcdBarrier b; b.bar = bar; b.x = xb_xcc_id(); b.st = st;
    if (threadIdx.x == 0) (void)xb_add(&bar[XB_XCNT(b.x)], 1u);
    return b;
}
__device__ __forceinline__ void xcd_barrier_complete(unsigned* bar, unsigned x, unsigned& nloc, unsigned& nx) {
    const unsigned G = gridDim.x * gridDim.y * gridDim.z;
    unsigned sum, cnt, mine, sp = 0u;
    for (;;) {
        sum = 0u; cnt = 0u; mine = 0u;
#pragma unroll
        for (unsigned j = 0; j < 16; ++j) { const unsigned c = xb_ld(&bar[XB_XCNT(j)]); sum += c; cnt += (c > 0u) ? 1u : 0u; mine = (j == x) ? c : mine; }
        if (sum == G) break;
        __builtin_amdgcn_s_sleep(1);
        if ((++sp & 255u) == 0u) { if (xb_ld(&bar[XB_TMO])) break; if (sp > XB_SPIN_CAP) { atomicAdd(&bar[XB_TMO], 1u); break; } }
    }
    nloc = mine > 0u ? mine : 1u; nx = cnt > 0u ? cnt : 1u;
}
__device__ __forceinline__ void xcd_barrier(const XcdBarrier& b) {
    asm volatile("s_waitcnt vmcnt(0)" ::: "memory");
    __syncthreads();
    if (threadIdx.x == 0) {
        unsigned* bar = b.bar;
        __builtin_amdgcn_s_waitcnt(0);
        unsigned nloc = b.st[0], nx = b.st[1];
        if (nloc == 0u) { xcd_barrier_complete(bar, b.x, nloc, nx); b.st[0] = nloc; b.st[1] = nx; }
        const unsigned old = xb_add(&bar[XB_XSUB(b.x)], 1u);
        const unsigned gen = old / nloc;
        if (old + 1u == (gen + 1u) * nloc) {
            __builtin_amdgcn_fence(__ATOMIC_RELEASE, "agent");
            asm volatile("s_waitcnt vmcnt(0)" ::: "memory");
            const unsigned og = xb_add(&bar[XB_TOP], 1u);
            const unsigned tg = og / nx;
            if (og + 1u == (tg + 1u) * nx) xb_add(&bar[XB_TOPGEN], 1u);
            else XB_SPIN(xb_ld(&bar[XB_TOPGEN]) == tg, bar);
            __builtin_amdgcn_fence(__ATOMIC_ACQUIRE, "agent");
            xb_add(&bar[XB_XGEN(b.x)], 1u);
            asm volatile("s_waitcnt vmcnt(0)" ::: "memory");
        } else {
            XB_SPIN(xb_ld(&bar[XB_XGEN(b.x)]) == gen, bar);
            __builtin_amdgcn_fence(__ATOMIC_ACQUIRE, "agent");
            asm volatile("s_waitcnt vmcnt(0)" ::: "memory");
        }
    }
    __syncthreads();
}

namespace pg8 {
constexpr int BM = 256, BK = 64, HALF = 128, HTB = HALF * BK * 2, STAGE_BYTES = 8 * HTB, NXCD = 8, WGM = 8;
__host__ __device__ __forceinline__ int lds_byte(int r, int c) { const int st = (r >> 4) * 2 + (c >> 5), rr = r & 15, cc = c & 31, ob = rr * 64 + cc * 2; return st * 1024 + (ob ^ (((ob >> 9) & 1) << 5)); }
__host__ __device__ __forceinline__ void stage_rc(int b, int& R, int& C) { const int st = b / 1024, sb = b % 1024, swz = sb ^ (((sb >> 9) & 1) << 5); R = (st >> 1) * 16 + swz / 64; C = (st & 1) * 32 + (swz % 64) / 2; }
__host__ __device__ __forceinline__ int perm32(int rho) { const int n = rho >> 4, i = rho & 15; return 8 * (i >> 2) + 4 * n + (i & 3); }

struct Unit { int pm, pn, z; };
struct Gemm { const bf16_t* A; const bf16_t* Bt; int lda, ldb, K; size_t az, bz; };

template <int ZN> struct TileOrder {
    int nM, nN, nwg, G, c;
    __device__ void init(int M, int N, int G_, int c_) { nM = M / BM; nN = N / BM; nwg = nM * nN; G = G_; c = c_; }
    __device__ bool next(int i, Unit& u) const {
        const long L = (long)(i / ZN) * G + c; if (L >= nwg) return false;
        int wgid = (int)L; { const int q = nwg / NXCD, r = nwg % NXCD, xcd = wgid % NXCD, off = wgid / NXCD; wgid = (xcd < r ? xcd * (q + 1) : r * (q + 1) + (xcd - r) * q) + off; }
        const int nig = WGM * nN, gid = wgid / nig, fm = gid * WGM, gsz = (nM - fm) < WGM ? (nM - fm) : WGM;
        u.pm = fm + ((wgid % nig) % gsz); u.pn = (wgid % nig) / gsz; u.z = i % ZN; return true;
    }
};

template <class Epi, class Sched>
__device__ __forceinline__ void gemm_phase(LAS unsigned char* lds, const Gemm g, const Sched& S, const Epi& E, int wave_id) {
    int tid_l = (wave_id << 6) | (int)__builtin_amdgcn_mbcnt_hi(~0u, __builtin_amdgcn_mbcnt_lo(~0u, 0u)); asm volatile("" : "+v"(tid_l));
    const int tid = tid_l, wid = wave_id, lane = tid & 63, wr = wid >> 2, wc = wid & 3, fr = lane & 15, fq = lane >> 4;
    const int K = g.K, nt = K / BK;
    unsigned voffA[2], voffB[2];
#pragma unroll
    for (int i = 0; i < 2; ++i) { int R, C; stage_rc(tid * 16 + i * 8192, R, C); const int Rb = Epi::PERM ? ((R & ~31) + perm32(R & 31)) : R;
        voffA[i] = (unsigned)(R * g.lda + C) * 2u; voffB[i] = (unsigned)(Rb * g.ldb + C) * 2u; }
    const size_t kstep = (size_t)(BK * 2);
    const size_t hstepA = (size_t)HALF * g.lda * 2, hstepB = (size_t)HALF * g.ldb * 2;
    const size_t tstepA = 2 * hstepA, tstepB = 2 * hstepB;
    const unsigned ldsw = (unsigned)wid * 1024u;
    const int aoff = lds_byte(wr * 64 + fr, fq * 8), boff = lds_byte(wc * 32 + fr, fq * 8);
#define PG8_SA(b, h) (((b) * 2 + (h)) * HTB)
#define PG8_SB(b, h) ((4 + (b) * 2 + (h)) * HTB)
#define PG8_STAGE(bufoff, gbase, voff) do { _Pragma("unroll") for (int _i = 0; _i < 2; ++_i) \
        __builtin_amdgcn_global_load_lds((const unsigned*)((const char*)(gbase) + (voff)[_i]), (LAS unsigned*)(lds + (bufoff) + ldsw + _i * 8192), 16, 0, 0); } while (0)
#define PG8_LDA(dst, b, h) do { _Pragma("unroll") for (int m = 0; m < 4; ++m) _Pragma("unroll") for (int k = 0; k < 2; ++k) dst[m][k] = *(const LAS bf16x8*)(lds + PG8_SA(b, h) + aoff + m * 2048 + k * 1024); } while (0)
#define PG8_LDB(dst, b, h) do { _Pragma("unroll") for (int n = 0; n < 2; ++n) _Pragma("unroll") for (int k = 0; k < 2; ++k) dst[n][k] = *(const LAS bf16x8*)(lds + PG8_SB(b, h) + boff + n * 2048 + k * 1024); } while (0)
#define PG8_MMA(ai, bj, At, Bt) do { __builtin_amdgcn_s_setprio(1); _Pragma("unroll") for (int m = 0; m < 4; ++m) _Pragma("unroll") for (int n = 0; n < 2; ++n) _Pragma("unroll") for (int k = 0; k < 2; ++k) \
        acc[ai][bj][m][n] = __builtin_amdgcn_mfma_f32_16x16x32_bf16(Bt[n][k], At[m][k], acc[ai][bj][m][n], 0, 0, 0); __builtin_amdgcn_s_setprio(0); } while (0)
#define PG8_WAIT_V(n) asm volatile("s_waitcnt vmcnt(" #n ")" ::: "memory")
#define PG8_WAIT_L(n) asm volatile("s_waitcnt lgkmcnt(" #n ")" ::: "memory")
#define PG8_BAR __builtin_amdgcn_s_barrier()
#define PG8_SCHED __builtin_amdgcn_sched_barrier(0)
    Unit cur, nxt; int ui = 0;
    if (!S.next(0, cur)) return;
    f32x4 acc[2][2][4][2];
#pragma unroll
    for (int a = 0; a < 2; ++a)
#pragma unroll
        for (int b = 0; b < 2; ++b)
#pragma unroll
            for (int m = 0; m < 4; ++m)
#pragma unroll
                for (int n = 0; n < 2; ++n) acc[a][b][m][n] = (f32x4){0.f, 0.f, 0.f, 0.f};
    bf16x8 At[4][2], B0[2][2], B1[2][2];
    const char* cA = (const char*)g.A + (size_t)cur.pm * tstepA + (size_t)cur.z * g.az; const char* cB = (const char*)g.Bt + (size_t)cur.pn * tstepB + (size_t)cur.z * g.bz;
    PG8_STAGE(PG8_SB(0, 0), cB, voffB); PG8_STAGE(PG8_SB(0, 1), cB + hstepB, voffB); PG8_STAGE(PG8_SA(0, 0), cA, voffA); PG8_STAGE(PG8_SA(0, 1), cA + hstepA, voffA);
    if (wr == 1) PG8_BAR;
    PG8_WAIT_V(2); PG8_BAR;
    PG8_STAGE(PG8_SB(1, 0), cB + kstep, voffB); PG8_STAGE(PG8_SA(1, 0), cA + kstep, voffA); PG8_STAGE(PG8_SB(1, 1), cB + hstepB + kstep, voffB);
    PG8_WAIT_V(6); PG8_BAR;
    for (;;) {
        const bool has_next = S.next(ui + 1, nxt);
        const char* nA = has_next ? (const char*)g.A + (size_t)nxt.pm * tstepA + (size_t)nxt.z * g.az : cA;
        const char* nB = has_next ? (const char*)g.Bt + (size_t)nxt.pn * tstepB + (size_t)nxt.z * g.bz : cB;
        for (int t = 0; t < nt; t += 2) {
            const bool last = (t == nt - 2);
            const char* a1 = cA + (size_t)(t + 1) * kstep;
            const char* a2 = last ? nA : cA + (size_t)(t + 2) * kstep; const char* b2 = last ? nB : cB + (size_t)(t + 2) * kstep;
            const char* a3 = a2 + kstep; const char* b3 = b2 + kstep;
            PG8_LDB(B0, 0, 0); PG8_LDB(B1, 0, 1); PG8_SCHED; PG8_LDA(At, 0, 0); PG8_STAGE(PG8_SA(1, 1), a1 + hstepA, voffA);
            PG8_WAIT_V(8); PG8_WAIT_L(0); PG8_BAR; PG8_MMA(0, 0, At, B0); PG8_MMA(0, 1, At, B1); PG8_BAR; PG8_SCHED;
            PG8_LDA(At, 0, 1); PG8_STAGE(PG8_SB(0, 0), b2, voffB); PG8_STAGE(PG8_SB(0, 1), b2 + hstepB, voffB); PG8_STAGE(PG8_SA(0, 0), a2, voffA);
            PG8_WAIT_V(8); PG8_WAIT_L(0); PG8_BAR; PG8_MMA(1, 0, At, B0); PG8_MMA(1, 1, At, B1); PG8_BAR; PG8_SCHED;
            PG8_LDB(B0, 1, 0); PG8_LDB(B1, 1, 1); PG8_SCHED; PG8_LDA(At, 1, 0); PG8_STAGE(PG8_SA(0, 1), a2 + hstepA, voffA);
            PG8_WAIT_V(8); PG8_WAIT_L(0); PG8_BAR; PG8_MMA(0, 0, At, B0); PG8_MMA(0, 1, At, B1); PG8_BAR; PG8_SCHED;
            PG8_LDA(At, 1, 1); PG8_STAGE(PG8_SB(1, 0), b3, voffB); PG8_STAGE(PG8_SB(1, 1), b3 + hstepB, voffB); PG8_STAGE(PG8_SA(1, 0), a3, voffA);
            PG8_WAIT_V(8); PG8_WAIT_L(0); PG8_BAR; PG8_MMA(1, 0, At, B0); PG8_MMA(1, 1, At, B1); PG8_BAR; PG8_SCHED;
        }
        if (wr == 0) PG8_BAR;
        E(acc, cur, wr, wc, fr, fq);
        if (!has_next) break;
        if (!E.keep(cur)) {
#pragma unroll
            for (int a = 0; a < 2; ++a)
#pragma unroll
                for (int b = 0; b < 2; ++b)
#pragma unroll
                    for (int m = 0; m < 4; ++m)
#pragma unroll
                        for (int n = 0; n < 2; ++n) acc[a][b][m][n] = (f32x4){0.f, 0.f, 0.f, 0.f};
        }
        cur = nxt; cA = nA; cB = nB; ++ui;
        if (wr == 1) PG8_BAR;
    }
    PG8_WAIT_V(0);
    PG8_BAR;
#undef PG8_SA
#undef PG8_SB
#undef PG8_STAGE
#undef PG8_LDA
#undef PG8_LDB
#undef PG8_MMA
#undef PG8_WAIT_V
#undef PG8_WAIT_L
#undef PG8_BAR
#undef PG8_SCHED
}
}
typedef pg8::Unit Unit;
typedef f32x4 AccT[2][2][4][2];

struct EpiProjA {
    static constexpr bool PERM = true;
    bf16_t* O; const float* rstd;
    __device__ __forceinline__ bool keep(const Unit&) const { return false; }
    __device__ __forceinline__ void operator()(AccT& acc, const Unit& u, int wr, int wc, int fr, int fq) const {
        const int row0 = u.pm * 256 + wr * 64 + fr, col0 = u.pn * 256 + wc * 32 + 8 * fq;
        const bool act = (u.pn >= 5);
#pragma unroll
        for (int ai = 0; ai < 2; ++ai)
#pragma unroll
            for (int m = 0; m < 4; ++m) { const int row = row0 + ai * 128 + m * 16; const float rs = rstd[row]; bf16_t* rowp = O + (size_t)row * NA + col0;
#pragma unroll
                for (int bj = 0; bj < 2; ++bj) { f32x4 v0 = acc[ai][bj][m][0] * rs, v1 = acc[ai][bj][m][1] * rs;
                    if (act) {
#pragma unroll
                        for (int j = 0; j < 4; ++j) { v0[j] = gelu_tanh(v0[j]); v1[j] = gelu_tanh(v1[j]); } }
                    u32x4 w; w.x = cvt_pk_bf16(v0[0], v0[1]); w.y = cvt_pk_bf16(v0[2], v0[3]); w.z = cvt_pk_bf16(v1[0], v1[1]); w.w = cvt_pk_bf16(v1[2], v1[3]);
                    *(u32x4*)(rowp + bj * 128) = w; } }
    }
};
struct EpiGates {
    static constexpr bool PERM = true;
    bf16_t* O; const float* rstd; const float* bias;
    __device__ __forceinline__ bool keep(const Unit&) const { return false; }
    __device__ __forceinline__ void operator()(AccT& acc, const Unit& u, int wr, int wc, int fr, int fq) const {
        const int row0 = u.pm * 256 + wr * 64 + fr, col0 = u.pn * 256 + wc * 32 + 8 * fq;
        f32x4 bv[2][2];
#pragma unroll
        for (int bj = 0; bj < 2; ++bj)
#pragma unroll
            for (int n = 0; n < 2; ++n) bv[bj][n] = *(const f32x4*)(bias + col0 + bj * 128 + 4 * n);
#pragma unroll
        for (int ai = 0; ai < 2; ++ai)
#pragma unroll
            for (int m = 0; m < 4; ++m) { const int row = row0 + ai * 128 + m * 16; const float rs = rstd[row]; bf16_t* rowp = O + (size_t)row * NG + col0;
#pragma unroll
                for (int bj = 0; bj < 2; ++bj) { f32x4 v0 = acc[ai][bj][m][0] * rs + bv[bj][0], v1 = acc[ai][bj][m][1] * rs + bv[bj][1];
#pragma unroll
                    for (int j = 0; j < 4; ++j) { v0[j] = sigmoidf_(v0[j]); v1[j] = sigmoidf_(v1[j]); }
                    u32x4 w; w.x = cvt_pk_bf16(v0[0], v0[1]); w.y = cvt_pk_bf16(v0[2], v0[3]); w.z = cvt_pk_bf16(v1[0], v1[1]); w.w = cvt_pk_bf16(v1[2], v1[3]);
                    *(u32x4*)(rowp + bj * 128) = w; } }
    }
};
struct EpiMerge {
    static constexpr bool PERM = true;
    const bf16_t* gates; bf16_t* O;
    __device__ __forceinline__ bool keep(const Unit& u) const { return u.z < 2; }
    __device__ __forceinline__ void operator()(AccT& acc, const Unit& u, int wr, int wc, int fr, int fq) const {
        const int row0 = u.pm * 256 + wr * 64 + fr, col0 = u.pn * 256 + wc * 32 + 8 * fq;
        const int z = u.z;
#pragma unroll
        for (int ai = 0; ai < 2; ++ai)
#pragma unroll
            for (int m = 0; m < 4; ++m) { const int row = row0 + ai * 128 + m * 16;
#pragma unroll
                for (int bj = 0; bj < 2; ++bj) { const int col = col0 + bj * 128; const bf16_t* gp = gates + (size_t)row * NG + col;
                    float f[8];
                    if (z == 2) { const u32x4 a = *(const u32x4*)(gp + 2048);
                        f[0] = bf_lo(a.x); f[1] = bf_hi(a.x); f[2] = bf_lo(a.y); f[3] = bf_hi(a.y); f[4] = bf_lo(a.z); f[5] = bf_hi(a.z); f[6] = bf_lo(a.w); f[7] = bf_hi(a.w);
#pragma unroll
                        for (int j = 0; j < 8; ++j) f[j] = fmaxf(f[j], 1e-20f);
                    } else { const u32x4 a = *(const u32x4*)(gp + z * 1024), b = *(const u32x4*)(gp + (z + 1) * 1024);
                        float ga[8], gb[8];
                        ga[0] = bf_lo(a.x); ga[1] = bf_hi(a.x); ga[2] = bf_lo(a.y); ga[3] = bf_hi(a.y); ga[4] = bf_lo(a.z); ga[5] = bf_hi(a.z); ga[6] = bf_lo(a.w); ga[7] = bf_hi(a.w);
                        gb[0] = bf_lo(b.x); gb[1] = bf_hi(b.x); gb[2] = bf_lo(b.y); gb[3] = bf_hi(b.y); gb[4] = bf_lo(b.z); gb[5] = bf_hi(b.z); gb[6] = bf_lo(b.w); gb[7] = bf_hi(b.w);
#pragma unroll
                        for (int j = 0; j < 8; ++j) { const float num = (z == 0) ? ga[j] : fmaxf(ga[j], 1e-20f); f[j] = num * __builtin_amdgcn_rcpf(fmaxf(gb[j], 1e-20f)); } }
                    f32x4 v0 = acc[ai][bj][m][0], v1 = acc[ai][bj][m][1];
                    v0[0] *= f[0]; v0[1] *= f[1]; v0[2] *= f[2]; v0[3] *= f[3]; v1[0] *= f[4]; v1[1] *= f[5]; v1[2] *= f[6]; v1[3] *= f[7];
                    acc[ai][bj][m][0] = v0; acc[ai][bj][m][1] = v1;
                    if (z == 2) { u32x4 w; w.x = cvt_pk_bf16(v0[0], v0[1]); w.y = cvt_pk_bf16(v0[2], v0[3]); w.z = cvt_pk_bf16(v1[0], v1[1]); w.w = cvt_pk_bf16(v1[2], v1[3]);
                        *(u32x4*)(O + (size_t)row * DM + col) = w; } } }
    }
};
struct EpiResid {
    static constexpr bool PERM = true;
    bf16_t* X; float* rowsq; bf16_t* XO;
    __device__ __forceinline__ bool keep(const Unit&) const { return false; }
    __device__ __forceinline__ void operator()(AccT& acc, const Unit& u, int wr, int wc, int fr, int fq) const {
        const int row0 = u.pm * 256 + wr * 64 + fr, col0 = u.pn * 256 + wc * 32 + 8 * fq;
#pragma unroll
        for (int ai = 0; ai < 2; ++ai)
#pragma unroll
            for (int m = 0; m < 4; ++m) { const int row = row0 + ai * 128 + m * 16; bf16_t* rowp = X + (size_t)row * DM + col0; float ss = 0.f;
#pragma unroll
                for (int bj = 0; bj < 2; ++bj) { const u32x4 x = *(const u32x4*)(rowp + bj * 128);
                    f32x4 v0 = acc[ai][bj][m][0], v1 = acc[ai][bj][m][1];
                    v0[0] += bf_lo(x.x); v0[1] += bf_hi(x.x); v0[2] += bf_lo(x.y); v0[3] += bf_hi(x.y); v1[0] += bf_lo(x.z); v1[1] += bf_hi(x.z); v1[2] += bf_lo(x.w); v1[3] += bf_hi(x.w);
                    ss += (v0[0] * v0[0] + v0[1] * v0[1]) + (v0[2] * v0[2] + v0[3] * v0[3]) + (v1[0] * v1[0] + v1[1] * v1[1]) + (v1[2] * v1[2] + v1[3] * v1[3]);
                    u32x4 w; w.x = cvt_pk_bf16(v0[0], v0[1]); w.y = cvt_pk_bf16(v0[2], v0[3]); w.z = cvt_pk_bf16(v1[0], v1[1]); w.w = cvt_pk_bf16(v1[2], v1[3]);
                    *(u32x4*)(XO + (size_t)row * DM + col0 + bj * 128) = w; }
                ss += __shfl_xor(ss, 16); ss += __shfl_xor(ss, 32);
                if (fq == 0) rowsq[(size_t)row * 16 + u.pn * 4 + wc] = ss; }
    }
};
struct EpiScores {
    static constexpr bool PERM = false;
    float* C;
    __device__ __forceinline__ bool keep(const Unit&) const { return false; }
    __device__ __forceinline__ void operator()(AccT& acc, const Unit& u, int wr, int wc, int fr, int fq) const {
        const int row0 = u.pm * 256 + wr * 64 + fr, col0 = u.pn * 256 + wc * 32 + 4 * fq;
#pragma unroll
        for (int ai = 0; ai < 2; ++ai)
#pragma unroll
            for (int m = 0; m < 4; ++m) { float* rowp = C + (size_t)(row0 + ai * 128 + m * 16) * PQ + col0;
#pragma unroll
                for (int bj = 0; bj < 2; ++bj)
#pragma unroll
                    for (int n = 0; n < 2; ++n) *(f32x4*)(rowp + bj * 128 + n * 16) = acc[ai][bj][m][n]; }
    }
};

struct Params {
    const float* in[22];
    float* out; unsigned char* ws;
    int ph_lo, ph_hi, li, pad;
};
enum { I_X = 0, I_RELB, I_FGAIN, I_AGAIN, I_WIN, I_BGATE, I_SINK, I_WPOOL, I_PSCALE, I_VGAIN, I_WSP, I_BSP, I_WA, I_WB, I_WC, I_WOUT, I_FFGAIN, I_WQ, I_K1, I_K2, I_EU, I_EV };

struct Frame { LAS unsigned char* lds; int tid, lane, wave, G, vcu; };
__device__ __forceinline__ int tid_from_wave(int wave) { int t = (wave << 6) | (int)__builtin_amdgcn_mbcnt_hi(~0u, __builtin_amdgcn_mbcnt_lo(~0u, 0u)); asm volatile("" : "+v"(t)); return t; }
__device__ __forceinline__ Frame local_frame(const Frame& F0) { Frame F = F0; const int t = tid_from_wave(F0.wave); F.tid = t; F.lane = t & 63; return F; }

__device__ __forceinline__ void p0_transpose_item(const float* W, int N, bf16_t* WT, int ldo, const float* kscale, LAS float* scr, int item, int lane) {
    const int nblk = N / 32, kb = item / nblk, nb = item % nblk, k0 = 64 * kb, n0 = 32 * nb;
#pragma unroll 8
    for (int i = 0; i < 32; ++i) { const int kk = 2 * i + (lane >> 5); float v = W[(size_t)(k0 + kk) * N + n0 + (lane & 31)]; if (kscale) v *= kscale[k0 + kk]; scr[kk * 33 + (lane & 31)] = v; }
    asm volatile("s_waitcnt lgkmcnt(0)" ::: "memory");
    const int c = lane & 7;
#pragma unroll
    for (int j = 0; j < 4; ++j) { const int n = (lane >> 3) + 8 * j; const LAS float* s = scr + (8 * c) * 33 + n;
        u32x4 o; o.x = cvt_pk_bf16(s[0 * 33], s[1 * 33]); o.y = cvt_pk_bf16(s[2 * 33], s[3 * 33]); o.z = cvt_pk_bf16(s[4 * 33], s[5 * 33]); o.w = cvt_pk_bf16(s[6 * 33], s[7 * 33]);
        *(u32x4*)(WT + (size_t)(n0 + n) * ldo + k0 + 8 * c) = o; }
    asm volatile("s_waitcnt lgkmcnt(0)" ::: "memory");
}
__device__ __forceinline__ void convert_experts(const Params& p, const Frame& F) {
    const int gw = blockIdx.x * NWAVES + F.wave, NGW = F.G * NWAVES, lane = F.lane;
    constexpr int RB = 4;
    for (int r0 = gw * RB; r0 < DEPTH * 2 * NEXP; r0 += NGW * RB) {
        f32x4 v[RB][4];
#pragma unroll
        for (int q = 0; q < RB; ++q) { const int r = r0 + q; const int l = r / (2 * NEXP), tb = (r / NEXP) & 1, row = r % NEXP;
            const float* src = (tb ? p.in[I_EV] : p.in[I_EU]) + ((size_t)l * NEXP + row) * DM + lane * 16;
            v[q][0] = *(const f32x4*)src; v[q][1] = *(const f32x4*)(src + 4); v[q][2] = *(const f32x4*)(src + 8); v[q][3] = *(const f32x4*)(src + 12); }
#pragma unroll
        for (int q = 0; q < RB; ++q) { const int r = r0 + q; const int l = r / (2 * NEXP), tb = (r / NEXP) & 1, row = r % NEXP;
            float mx = 0.f;
#pragma unroll
            for (int j = 0; j < 4; ++j) mx = fmaxf(mx, fmaxf(fmaxf(fabsf(v[q][j][0]), fabsf(v[q][j][1])), fmaxf(fabsf(v[q][j][2]), fabsf(v[q][j][3]))));
#pragma unroll
            for (int o = 1; o < 64; o <<= 1) mx = fmaxf(mx, __shfl_xor(mx, o));
            const float inv = mx > 0.f ? 448.0f / mx : 0.f;
            int w[4];
#pragma unroll
            for (int j = 0; j < 4; ++j) { w[j] = 0; w[j] = __builtin_amdgcn_cvt_pk_fp8_f32(v[q][j][0] * inv, v[q][j][1] * inv, w[j], false); w[j] = __builtin_amdgcn_cvt_pk_fp8_f32(v[q][j][2] * inv, v[q][j][3] * inv, w[j], true); }
            *(u32x4*)(p.ws + WS_EXP + (((size_t)l * NEXP + row) * 2 + tb) * DM + lane * 16) = (u32x4){(unsigned)w[0], (unsigned)w[1], (unsigned)w[2], (unsigned)w[3]};
            if (lane == 0) ((float*)(p.ws + WS_ESCALE))[((size_t)l * NEXP + row) * 2 + tb] = mx * (1.0f / 448.0f); }
    }
}
__device__ __forceinline__ void phase_prologue(const Params& p, const Frame& F0) {
    const Frame F = local_frame(F0);
    const int gw = F.vcu * NWAVES + F.wave, NGW = F.G * NWAVES, lane = F.lane;
    LAS float* scr = (LAS float*)(F.lds + F.wave * 16384);
    constexpr int I_IN = (DM / 64) * (NIN / 32), I_BR = (512 / 64) * (DM / 32), I_OUT = (DM / 64) * (DM / 32);
    constexpr int PER_L = I_IN + 2 * I_BR + I_OUT;
    for (int it = gw; it < DEPTH * PER_L; it += NGW) {
        const int l = it / PER_L; int r = it % PER_L;
        if (r < I_IN) { p0_transpose_item(p.in[I_WIN] + (size_t)l * DM * NIN, NIN, (bf16_t*)(p.ws + WS_WTIN) + (size_t)l * NIN * DM, DM, p.in[I_AGAIN] + l * DM, scr, r, lane); continue; } r -= I_IN;
        if (r < I_BR) { p0_transpose_item(p.in[I_WA] + (size_t)l * 512 * DM, DM, (bf16_t*)(p.ws + WS_WTBR) + (size_t)(l * 3 + 0) * DM * 512, 512, nullptr, scr, r, lane); continue; } r -= I_BR;
        if (r < I_BR) { p0_transpose_item(p.in[I_WC] + (size_t)l * 512 * DM, DM, (bf16_t*)(p.ws + WS_WTBR) + (size_t)(l * 3 + 2) * DM * 512, 512, nullptr, scr, r, lane); continue; } r -= I_BR;
        p0_transpose_item(p.in[I_WOUT] + (size_t)l * DM * DM, DM, (bf16_t*)(p.ws + WS_WTOUT) + (size_t)l * DM * DM, DM, nullptr, scr, r, lane);
    }
    {
        float* rstd = (float*)(p.ws + WS_RSTD);
        for (int m0 = gw * 4; m0 < NTOK; m0 += NGW * 4) {
            f32x4 v[4][4];
#pragma unroll
            for (int q = 0; q < 4; ++q) { const f32x4* xr = (const f32x4*)(p.in[I_X] + (size_t)(m0 + q) * DM) + lane;
#pragma unroll
                for (int j = 0; j < 4; ++j) v[q][j] = xr[64 * j]; }
#pragma unroll
            for (int q = 0; q < 4; ++q) { float s = 0.f;
#pragma unroll
                for (int j = 0; j < 4; ++j) s += (v[q][j][0] * v[q][j][0] + v[q][j][1] * v[q][j][1]) + (v[q][j][2] * v[q][j][2] + v[q][j][3] * v[q][j][3]);
                s = wave_sum(s);
                u32x2* o = (u32x2*)((bf16_t*)(p.ws + WS_XB) + (size_t)(m0 + q) * DM) + lane;
#pragma unroll
                for (int j = 0; j < 4; ++j) { u32x2 w; w.x = cvt_pk_bf16(v[q][j][0], v[q][j][1]); w.y = cvt_pk_bf16(v[q][j][2], v[q][j][3]); o[64 * j] = w; }
                if (lane == 0) rstd[m0 + q] = 1.0f / sqrtf(s * (1.0f / DM) + EPS); }
        }
    }
    for (int i = blockIdx.x * NTHREADS + F.tid; i < DEPTH * 4 * 128 * 128; i += F.G * NTHREADS) { const int t = (i >> 7) & 127, s = i & 127;
        ((bf16_t*)(p.ws + WS_WSP))[i] = (bf16_t)(cvt_pk_bf16(s <= t ? p.in[I_WSP][i] : 0.f, 0.f) & 0xffffu); }
    convert_experts(p, F);
    __syncthreads();
    {
        LAS float* coef = (LAS float*)F.lds;
        for (int u = blockIdx.x; u < DEPTH * 4 * 32; u += F.G) {
            const int l = u / 128, g = (u / 32) % 4, c0 = (u % 32) * 4;
            __syncthreads();
            for (int i = F.tid; i < 512; i += NTHREADS) { const int cc = i >> 7, j = i & 127;
                coef[i] = p.in[I_WPOOL][(((size_t)l * 4 + g) * 128 + c0 + cc) * 128 + j] * p.in[I_PSCALE][l * 512 + g * 128 + j]; }
            __syncthreads();
            const float* wb = p.in[I_WB] + ((size_t)l * 512 + g * 128) * DM;
            float a0[4], a1[4];
#pragma unroll
            for (int cc = 0; cc < 4; ++cc) { a0[cc] = 0.f; a1[cc] = 0.f; }
#pragma unroll 4
            for (int j = 0; j < 128; ++j) { const float w0 = wb[(size_t)j * DM + F.tid], w1 = wb[(size_t)j * DM + F.tid + 512];
#pragma unroll
                for (int cc = 0; cc < 4; ++cc) { const float cf = coef[cc * 128 + j]; a0[cc] += cf * w0; a1[cc] += cf * w1; } }
            bf16_t* dst = (bf16_t*)(p.ws + WS_WTBR) + (size_t)(l * 3 + 1) * DM * 512 + g * 128 + c0;
            u32x2 w; w.x = cvt_pk_bf16(a0[0], a0[1]); w.y = cvt_pk_bf16(a0[2], a0[3]); *(u32x2*)(dst + (size_t)F.tid * 512) = w;
            u32x2 y; y.x = cvt_pk_bf16(a1[0], a1[1]); y.y = cvt_pk_bf16(a1[2], a1[3]); *(u32x2*)(dst + (size_t)(F.tid + 512) * 512) = y;
        }
    }
    {
        const int fr = F.lane & 15, fq = F.lane >> 4;
        for (int u = blockIdx.x; u < DEPTH * 16 * 16; u += F.G) {
            const int l = u / 256, s = (u / 16) % 16, c0 = (u % 16) * 64;
            const float* keys = ((s & 1) ? p.in[I_K2] : p.in[I_K1]) + (size_t)l * 128 * 128 + (size_t)(16 * F.wave + fr) * 128 + 8 * fq;
            const float* wq = p.in[I_WQ] + (size_t)l * DM * PQ + (size_t)(c0 + fr) * PQ + s * 128 + 8 * fq;
            f32x4 acc[4];
#pragma unroll
            for (int ct = 0; ct < 4; ++ct) acc[ct] = (f32x4){0.f, 0.f, 0.f, 0.f};
#pragma unroll
            for (int ks = 0; ks < 4; ++ks) {
                const f32x4 k0 = *(const f32x4*)(keys + 32 * ks), k1 = *(const f32x4*)(keys + 32 * ks + 4);
                u32x4 kb; kb.x = cvt_pk_bf16(k0[0], k0[1]); kb.y = cvt_pk_bf16(k0[2], k0[3]); kb.z = cvt_pk_bf16(k1[0], k1[1]); kb.w = cvt_pk_bf16(k1[2], k1[3]);
#pragma unroll
                for (int ct = 0; ct < 4; ++ct) { const float* wp = wq + (size_t)(16 * ct) * PQ + 32 * ks; const f32x4 w0 = *(const f32x4*)wp, w1 = *(const f32x4*)(wp + 4);
                    u32x4 wb; wb.x = cvt_pk_bf16(w0[0], w0[1]); wb.y = cvt_pk_bf16(w0[2], w0[3]); wb.z = cvt_pk_bf16(w1[0], w1[1]); wb.w = cvt_pk_bf16(w1[2], w1[3]);
                    acc[ct] = __builtin_amdgcn_mfma_f32_16x16x32_bf16(__builtin_bit_cast(bf16x8, wb), __builtin_bit_cast(bf16x8, kb), acc[ct], 0, 0, 0); }
            }
            bf16_t* dst = (bf16_t*)(p.ws + WS_WEFF) + ((size_t)l * PQ + s * 128 + 16 * F.wave + fr) * DM + c0 + 4 * fq;
#pragma unroll
            for (int ct = 0; ct < 4; ++ct) { const f32x4 gn = *(const f32x4*)(p.in[I_FFGAIN] + l * DM + c0 + 16 * ct + 4 * fq);
                u32x2 w; w.x = cvt_pk_bf16(acc[ct][0] * gn[0], acc[ct][1] * gn[1]); w.y = cvt_pk_bf16(acc[ct][2] * gn[2], acc[ct][3] * gn[3]); *(u32x2*)(dst + 16 * ct) = w; }
        }
    }
}

__device__ __forceinline__ int t5_bucket(int n) {
    if (n < 16) return n;
    const float v = logf((float)n / 16.0f) / 2.0794415416798357f * 16.0f;
    const int b = 16 + (int)v; return b < 31 ? b : 31;
}
__device__ __forceinline__ void phase_mix_simple(const Params& p, const Frame& F0, int l) {
    const Frame F = local_frame(F0);
    const int tid = F.tid, lane = F.lane, wave = F.wave;
    LAS float* Kf = (LAS float*)F.lds;
    LAS float* Vf = Kf + 256 * 64;
    LAS float* biasT = Vf + 256 * 64;
    LAS float* rs = biasT + 1024;
    const bf16_t* proj = (const bf16_t*)(p.ws + WS_PROJA);
    bf16_t* mix = (bf16_t*)(p.ws + WS_MIX);
    for (int nb = blockIdx.x; nb < NTOK / 128; nb += F.G) {
        const int t0 = nb * 128; const bool first = (nb % (SEQ / 128)) == 0;
        __syncthreads();
        for (int i = tid; i < 1024; i += NTHREADS) { const int h = i >> 7, dist = i & 127; biasT[i] = p.in[I_RELB][t5_bucket(dist) * 8 + h]; }
        for (int kvh = 0; kvh < 2; ++kvh) {
            __syncthreads();
            for (int c = tid; c < 2048; c += NTHREADS) { const int row = c >> 3, ch = c & 7; const int tok = t0 - 128 + row;
                u32x4 kv = (u32x4){0u, 0u, 0u, 0u}, vv = (u32x4){0u, 0u, 0u, 0u};
                if (row >= 128 || !first) { kv = *(const u32x4*)(proj + (size_t)tok * NA + COL_K + kvh * 64 + ch * 8); vv = *(const u32x4*)(proj + (size_t)tok * NA + COL_V + kvh * 64 + ch * 8); }
                LAS float* kd = Kf + row * 64 + ch * 8; LAS float* vd = Vf + row * 64 + ch * 8;
                kd[0] = bf_lo(kv.x); kd[1] = bf_hi(kv.x); kd[2] = bf_lo(kv.y); kd[3] = bf_hi(kv.y); kd[4] = bf_lo(kv.z); kd[5] = bf_hi(kv.z); kd[6] = bf_lo(kv.w); kd[7] = bf_hi(kv.w);
                vd[0] = bf_lo(vv.x); vd[1] = bf_hi(vv.x); vd[2] = bf_lo(vv.y); vd[3] = bf_hi(vv.y); vd[4] = bf_lo(vv.z); vd[5] = bf_hi(vv.z); vd[6] = bf_lo(vv.w); vd[7] = bf_hi(vv.w); }
            __syncthreads();
            const int hq = tid >> 7, qi = tid & 127, head = kvh * 4 + hq;
            float q[64], o[64];
            { const u32x4* qp = (const u32x4*)(proj + (size_t)(t0 + qi) * NA + head * 64);
#pragma unroll
              for (int j = 0; j < 8; ++j) { const u32x4 w = qp[j]; q[8 * j + 0] = bf_lo(w.x) * 0.125f; q[8 * j + 1] = bf_hi(w.x) * 0.125f; q[8 * j + 2] = bf_lo(w.y) * 0.125f; q[8 * j + 3] = bf_hi(w.y) * 0.125f;
                  q[8 * j + 4] = bf_lo(w.z) * 0.125f; q[8 * j + 5] = bf_hi(w.z) * 0.125f; q[8 * j + 6] = bf_lo(w.w) * 0.125f; q[8 * j + 7] = bf_hi(w.w) * 0.125f; } }
#pragma unroll
            for (int d = 0; d < 64; ++d) o[d] = 0.f;
            const float sink = p.in[I_SINK][l * 8 + head];
            float mrun = sink, lsum = 0.f;
            const int qb = qi & ~63, kmin = qb + 1, kmax = qb + 63 + 128;
            for (int kj = kmin; kj <= kmax; ++kj) {
                const LAS float* kr = Kf + kj * 64; float s = 0.f;
#pragma unroll
                for (int d4 = 0; d4 < 16; ++d4) { const f32x4 k4 = *(const LAS f32x4*)(kr + d4 * 4); s += (q[4 * d4] * k4[0] + q[4 * d4 + 1] * k4[1]) + (q[4 * d4 + 2] * k4[2] + q[4 * d4 + 3] * k4[3]); }
                const int dist = qi + 128 - kj; const bool valid = (dist >= 0) && (dist < 128) && (kj >= 128 || !first);
                const float logit = s + biasT[head * 128 + (dist & 127)];
                const float mnew = valid ? fmaxf(mrun, logit) : mrun;
                const float corr = __expf(mrun - mnew), pp = valid ? __expf(logit - mnew) : 0.f;
                lsum = lsum * corr + pp; mrun = mnew;
                const LAS float* vr = Vf + kj * 64;
#pragma unroll
                for (int d4 = 0; d4 < 16; ++d4) { const f32x4 v4 = *(const LAS f32x4*)(vr + d4 * 4);
                    o[4 * d4] = o[4 * d4] * corr + pp * v4[0]; o[4 * d4 + 1] = o[4 * d4 + 1] * corr + pp * v4[1]; o[4 * d4 + 2] = o[4 * d4 + 2] * corr + pp * v4[2]; o[4 * d4 + 3] = o[4 * d4 + 3] * corr + pp * v4[3]; }
            }
            const float inv = 1.0f / (lsum + __expf(sink - mrun));
            u32x4* op = (u32x4*)(mix + (size_t)(t0 + qi) * MIXW + head * 64);
#pragma unroll
            for (int j = 0; j < 8; ++j) { u32x4 w; w.x = cvt_pk_bf16(o[8 * j] * inv, o[8 * j + 1] * inv); w.y = cvt_pk_bf16(o[8 * j + 2] * inv, o[8 * j + 3] * inv);
                w.z = cvt_pk_bf16(o[8 * j + 4] * inv, o[8 * j + 5] * inv); w.w = cvt_pk_bf16(o[8 * j + 6] * inv, o[8 * j + 7] * inv); op[j] = w; }
        }
        LAS float* Zs = Kf;
        for (int g = 0; g < 4; ++g) {
            const int w = 2 << g;
            __syncthreads();
            for (int i = tid; i < 143 * 16; i += NTHREADS) { const int row = i >> 4, ch = i & 15; const int tok = t0 - 15 + row;
                u32x4 zv = (u32x4){0u, 0u, 0u, 0u};
                if (row >= 15 || !first) zv = *(const u32x4*)(proj + (size_t)tok * NA + COL_PZ + g * 128 + ch * 8);
                LAS float* zd = Zs + row * 128 + ch * 8;
                zd[0] = bf_lo(zv.x); zd[1] = bf_hi(zv.x); zd[2] = bf_lo(zv.y); zd[3] = bf_hi(zv.y); zd[4] = bf_lo(zv.z); zd[5] = bf_hi(zv.z); zd[6] = bf_lo(zv.w); zd[7] = bf_hi(zv.w); }
            __syncthreads();
            const int c = tid & 127, seg = tid >> 7;
            for (int tt = 0; tt < 32; ++tt) { const int t = seg * 32 + tt, r = t + 15; float sum = 0.f;
                for (int j = 0; j < w; ++j) sum += Zs[(r - j) * 128 + c];
                const int pos = (nb % (SEQ / 128)) * 128 + t; const int cnt = (pos + 1 < w) ? pos + 1 : w;
                const float d = sum / (float)cnt - Zs[r * 128 + c];
                mix[(size_t)(t0 + t) * MIXW + 512 + g * 128 + c] = (bf16_t)(cvt_pk_bf16(d, 0.f) & 0xffffu); }
        }
        __syncthreads();
        for (int tt = 0; tt < 16; ++tt) { const int t = wave * 16 + tt; const u32x4 g4 = *(const u32x4*)(proj + (size_t)(t0 + t) * NA + COL_GV + lane * 8);
            float a[8] = {bf_lo(g4.x), bf_hi(g4.x), bf_lo(g4.y), bf_hi(g4.y), bf_lo(g4.z), bf_hi(g4.z), bf_lo(g4.w), bf_hi(g4.w)}; float ss = 0.f;
#pragma unroll
            for (int j = 0; j < 8; ++j) ss += a[j] * a[j];
            ss = wave_sum(ss); if (lane == 0) rs[t] = 1.0f / sqrtf(ss * (1.0f / 512.0f) + EPS); }
        LAS float* Vn = Kf;
        for (int g = 0; g < 4; ++g) {
            __syncthreads();
            for (int i = tid; i < 128 * 16; i += NTHREADS) { const int s = i >> 4, ch = i & 15; const u32x4 g4 = *(const u32x4*)(proj + (size_t)(t0 + s) * NA + COL_GV + g * 128 + ch * 8);
                const float r = rs[s]; const float* gn = p.in[I_VGAIN] + l * 512 + g * 128 + ch * 8; LAS float* vd = Vn + s * 128 + ch * 8;
                vd[0] = bf_lo(g4.x) * r * gn[0]; vd[1] = bf_hi(g4.x) * r * gn[1]; vd[2] = bf_lo(g4.y) * r * gn[2]; vd[3] = bf_hi(g4.y) * r * gn[3];
                vd[4] = bf_lo(g4.z) * r * gn[4]; vd[5] = bf_hi(g4.z) * r * gn[5]; vd[6] = bf_lo(g4.w) * r * gn[6]; vd[7] = bf_hi(g4.w) * r * gn[7]; }
            __syncthreads();
            const int c = tid & 127, tq = tid >> 7;
            for (int t = tq; t < 128; t += 4) { const float* wrow = p.in[I_WSP] + (((size_t)l * 4 + g) * 128 + t) * 128; float acc = 0.f;
                for (int s = 0; s <= t; ++s) acc += wrow[s] * Vn[s * 128 + c];
                const float mixed = acc + p.in[I_BSP][(l * 4 + g) * 128 + t];
                const float uu = bf1(proj[(size_t)(t0 + t) * NA + COL_GU + g * 128 + c]);
                mix[(size_t)(t0 + t) * MIXW + 1024 + g * 128 + c] = (bf16_t)(cvt_pk_bf16(uu * mixed, 0.f) & 0xffffu); }
        }
    }
}

typedef short s16x4 __attribute__((ext_vector_type(4)));
__device__ __forceinline__ void tr_read8(unsigned addrA, unsigned addrB, s16x4 (&lo)[4], s16x4 (&hi)[4]) {
    asm volatile("ds_read_b64_tr_b16 %0, %8\n\tds_read_b64_tr_b16 %1, %8 offset:32\n\tds_read_b64_tr_b16 %2, %8 offset:64\n\tds_read_b64_tr_b16 %3, %8 offset:96\n\t"
                 "ds_read_b64_tr_b16 %4, %9\n\tds_read_b64_tr_b16 %5, %9 offset:32\n\tds_read_b64_tr_b16 %6, %9 offset:64\n\tds_read_b64_tr_b16 %7, %9 offset:96\n\ts_waitcnt lgkmcnt(0)"
                 : "=&v"(lo[0]), "=&v"(lo[1]), "=&v"(lo[2]), "=&v"(lo[3]), "=&v"(hi[0]), "=&v"(hi[1]), "=&v"(hi[2]), "=&v"(hi[3]) : "v"(addrA), "v"(addrB) : "memory");
}
__device__ __forceinline__ void tr_read4(unsigned addrA, s16x4 (&lo)[4]) {
    asm volatile("ds_read_b64_tr_b16 %0, %4\n\tds_read_b64_tr_b16 %1, %4 offset:32\n\tds_read_b64_tr_b16 %2, %4 offset:64\n\tds_read_b64_tr_b16 %3, %4 offset:96\n\ts_waitcnt lgkmcnt(0)"
                 : "=&v"(lo[0]), "=&v"(lo[1]), "=&v"(lo[2]), "=&v"(lo[3]) : "v"(addrA) : "memory");
}
__device__ __forceinline__ bf16x8 cat44(s16x4 a, s16x4 b) { return (bf16x8){a[0], a[1], a[2], a[3], b[0], b[1], b[2], b[3]}; }
constexpr int KVSTR = 144, VNSTR = 272;
__device__ __forceinline__ void phase_mix(const Params& p, const Frame& F0, int l) {
    const Frame F = local_frame(F0);
    const int tid = F.tid, lane = F.lane, wave = F.wave, fr = lane & 15, fq = lane >> 4;
    LAS unsigned char* Kl = F.lds;
    LAS unsigned char* Vl = F.lds + 256 * KVSTR;
    LAS float* biasT = (LAS float*)(F.lds + 2 * 256 * KVSTR);
    LAS float* rs = biasT + 1024;
    const bf16_t* proj = (const bf16_t*)(p.ws + WS_PROJA);
    bf16_t* mix = (bf16_t*)(p.ws + WS_MIX);
    const float LOG2E = 1.4426950408889634f;
    for (int nb = blockIdx.x; nb < NTOK / 128; nb += F.G) {
        const int t0 = nb * 128; const bool first = (nb % (SEQ / 128)) == 0;
        __syncthreads();
        for (int i = tid; i < 1024; i += NTHREADS) { const int h = i >> 7, dist = i & 127; biasT[i] = p.in[I_RELB][t5_bucket(dist) * 8 + h] * LOG2E; }
        for (int kvh = 0; kvh < 2; ++kvh) {
            __syncthreads();
            for (int c = tid; c < 2048; c += NTHREADS) { const int row = c >> 3, ch = c & 7; const int tok = t0 - 128 + row;
                u32x4 kv = (u32x4){0u, 0u, 0u, 0u}, vv = (u32x4){0u, 0u, 0u, 0u};
                if (row >= 128 || !first) { kv = *(const u32x4*)(proj + (size_t)tok * NA + COL_K + kvh * 64 + ch * 8); vv = *(const u32x4*)(proj + (size_t)tok * NA + COL_V + kvh * 64 + ch * 8); }
                *(LAS u32x4*)(Kl + row * KVSTR + ch * 16) = kv; *(LAS u32x4*)(Vl + row * KVSTR + ch * 16) = vv; }
            __syncthreads();
            const int hq = wave >> 1, qh = wave & 1, head = kvh * 4 + hq;
            float br[9][4];
#pragma unroll
            for (int tt = 0; tt < 9; ++tt)
#pragma unroll
                for (int i = 0; i < 4; ++i) { const int dist = 128 + fr - 4 * fq - 16 * tt - i; br[tt][i] = (dist >= 0 && dist < 128) ? biasT[head * 128 + (dist & 127)] : NEG_INF_F; }
            const float sink2 = p.in[I_SINK][l * 8 + head] * LOG2E;
            const unsigned vbase = (unsigned)(size_t)Vl;
#pragma unroll 1
            for (int r = 0; r < 4; ++r) {
                const int R = qh * 4 + r, q0 = 16 * R;
                bf16x8 qf[2];
#pragma unroll
                for (int s = 0; s < 2; ++s) qf[s] = *(const bf16x8*)(proj + (size_t)(t0 + q0 + fr) * NA + head * 64 + 32 * s + 8 * fq);
                f32x4 sacc[9];
#pragma unroll
                for (int tt = 0; tt < 9; ++tt) { sacc[tt] = (f32x4){0.f, 0.f, 0.f, 0.f};
#pragma unroll
                    for (int s = 0; s < 2; ++s) { const bf16x8 kf = *(const LAS bf16x8*)(Kl + (16 * (R + tt) + fr) * KVSTR + s * 64 + fq * 16);
                        sacc[tt] = __builtin_amdgcn_mfma_f32_16x16x32_bf16(kf, qf[s], sacc[tt], 0, 0, 0); } }
                float mx = sink2;
#pragma unroll
                for (int tt = 0; tt < 9; ++tt) { const bool dead = first && (R + tt < 8);
#pragma unroll
                    for (int i = 0; i < 4; ++i) { const float lg = dead ? NEG_INF_F : (sacc[tt][i] * (0.125f * LOG2E) + br[tt][i]); sacc[tt][i] = lg; mx = fmaxf(mx, lg); } }
                mx = fmaxf(mx, __shfl_xor(mx, 16)); mx = fmaxf(mx, __shfl_xor(mx, 32));
                float ls = 0.f;
#pragma unroll
                for (int tt = 0; tt < 9; ++tt)
#pragma unroll
                    for (int i = 0; i < 4; ++i) { const float pv = __builtin_amdgcn_exp2f(sacc[tt][i] - mx); sacc[tt][i] = pv; ls += pv; }
                ls += __shfl_xor(ls, 16); ls += __shfl_xor(ls, 32);
                const float inv = 1.0f / (ls + __builtin_amdgcn_exp2f(sink2 - mx));
                f32x4 oacc[4];
#pragma unroll
                for (int c = 0; c < 4; ++c) oacc[c] = (f32x4){0.f, 0.f, 0.f, 0.f};
#pragma unroll
                for (int u = 0; u < 5; ++u) {
                    u32x4 pw; pw.x = cvt_pk_bf16(sacc[2 * u][0], sacc[2 * u][1]); pw.y = cvt_pk_bf16(sacc[2 * u][2], sacc[2 * u][3]);
                    if (u < 4) { pw.z = cvt_pk_bf16(sacc[2 * u + 1][0], sacc[2 * u + 1][1]); pw.w = cvt_pk_bf16(sacc[2 * u + 1][2], sacc[2 * u + 1][3]); } else { pw.z = 0u; pw.w = 0u; }
                    const bf16x8 pf = __builtin_bit_cast(bf16x8, pw);
                    const unsigned addrA = vbase + (unsigned)((16 * (R + 2 * u) + 4 * fq + (fr >> 2)) * KVSTR + (4 * (fr & 3)) * 2);
                    s16x4 lo[4], hi[4];
                    if (u < 4) tr_read8(addrA, addrA + 16 * KVSTR, lo, hi);
                    else { tr_read4(addrA, lo);
#pragma unroll
                        for (int c = 0; c < 4; ++c) hi[c] = (s16x4){0, 0, 0, 0}; }
#pragma unroll
                    for (int c = 0; c < 4; ++c) oacc[c] = __builtin_amdgcn_mfma_f32_16x16x32_bf16(cat44(lo[c], hi[c]), pf, oacc[c], 0, 0, 0);
                }
                bf16_t* op = mix + (size_t)(t0 + q0 + fr) * MIXW + head * 64 + 4 * fq;
#pragma unroll
                for (int c = 0; c < 4; ++c) { u32x2 w; w.x = cvt_pk_bf16(oacc[c][0] * inv, oacc[c][1] * inv); w.y = cvt_pk_bf16(oacc[c][2] * inv, oacc[c][3] * inv); *(u32x2*)(op + 16 * c) = w; }
            }
        }
        LAS float* Zs = (LAS float*)F.lds;
        for (int g = 0; g < 4; ++g) {
            const int w = 2 << g;
            __syncthreads();
            for (int i = tid; i < 143 * 16; i += NTHREADS) { const int row = i >> 4, ch = i & 15; const int tok = t0 - 15 + row;
                u32x4 zv = (u32x4){0u, 0u, 0u, 0u};
                if (row >= 15 || !first) zv = *(const u32x4*)(proj + (size_t)tok * NA + COL_PZ + g * 128 + ch * 8);
                LAS float* zd = Zs + row * 128 + ch * 8;
                *(LAS f32x4*)zd = (f32x4){bf_lo(zv.x), bf_hi(zv.x), bf_lo(zv.y), bf_hi(zv.y)}; *(LAS f32x4*)(zd + 4) = (f32x4){bf_lo(zv.z), bf_hi(zv.z), bf_lo(zv.w), bf_hi(zv.w)}; }
            __syncthreads();
            const int c2 = tid & 63, seg = tid >> 6;
            const int tb = seg * 16; float sa = 0.f, sb = 0.f;
            for (int j = 1; j < w; ++j) { const f32x2 z = *(const LAS f32x2*)(Zs + (tb + 15 - j) * 128 + 2 * c2); sa += z[0]; sb += z[1]; }
            const int posb = (nb % (SEQ / 128)) * 128;
            for (int tt = 0; tt < 16; ++tt) { const int t = tb + tt, r = t + 15;
                const f32x2 z = *(const LAS f32x2*)(Zs + r * 128 + 2 * c2); sa += z[0]; sb += z[1];
                const int pos = posb + t; const float icnt = 1.0f / (float)((pos + 1 < w) ? pos + 1 : w);
                *(unsigned*)(mix + (size_t)(t0 + t) * MIXW + 512 + g * 128 + 2 * c2) = cvt_pk_bf16(sa * icnt - z[0], sb * icnt - z[1]);
                const f32x2 zo = *(const LAS f32x2*)(Zs + (r - w + 1) * 128 + 2 * c2); sa -= zo[0]; sb -= zo[1]; }
        }
        __syncthreads();
        for (int tt = 0; tt < 16; ++tt) { const int t = wave * 16 + tt; const u32x4 g4 = *(const u32x4*)(proj + (size_t)(t0 + t) * NA + COL_GV + lane * 8);
            const float a[8] = {bf_lo(g4.x), bf_hi(g4.x), bf_lo(g4.y), bf_hi(g4.y), bf_lo(g4.z), bf_hi(g4.z), bf_lo(g4.w), bf_hi(g4.w)}; float ss = 0.f;
#pragma unroll
            for (int j = 0; j < 8; ++j) ss += a[j] * a[j];
            ss = wave_sum(ss); if (lane == 0) rs[t] = 1.0f / sqrtf(ss * (1.0f / 512.0f) + EPS); }
        LAS unsigned char* Vn = F.lds;
        const bf16_t* Wsp = (const bf16_t*)(p.ws + WS_WSP);
        for (int g = 0; g < 4; ++g) {
            __syncthreads();
            for (int i = tid; i < 128 * 16; i += NTHREADS) { const int s = i >> 4, ch = i & 15; const u32x4 g4 = *(const u32x4*)(proj + (size_t)(t0 + s) * NA + COL_GV + g * 128 + ch * 8);
                const float r = rs[s]; const float* gn = p.in[I_VGAIN] + l * 512 + g * 128 + ch * 8; const f32x4 ga = *(const f32x4*)gn, gb = *(const f32x4*)(gn + 4);
                u32x4 w; w.x = cvt_pk_bf16(bf_lo(g4.x) * r * ga[0], bf_hi(g4.x) * r * ga[1]); w.y = cvt_pk_bf16(bf_lo(g4.y) * r * ga[2], bf_hi(g4.y) * r * ga[3]);
                w.z = cvt_pk_bf16(bf_lo(g4.z) * r * gb[0], bf_hi(g4.z) * r * gb[1]); w.w = cvt_pk_bf16(bf_lo(g4.w) * r * gb[2], bf_hi(g4.w) * r * gb[3]);
                *(LAS u32x4*)(Vn + s * VNSTR + ch * 16) = w; }
            __syncthreads();
            const int T = wave; f32x4 acc[8];
#pragma unroll
            for (int c = 0; c < 8; ++c) acc[c] = (f32x4){0.f, 0.f, 0.f, 0.f};
            const bf16_t* wrow = Wsp + (((size_t)l * 4 + g) * 128 + 16 * T + fr) * 128 + 8 * fq;
            const unsigned vnb = (unsigned)(size_t)Vn;
#pragma unroll 1
            for (int u = 0; u <= (T >> 1); ++u) {
                const bf16x8 wf = *(const bf16x8*)(wrow + 32 * u);
                const unsigned addrA = vnb + (unsigned)((32 * u + 8 * fq + (fr >> 2)) * VNSTR + (4 * (fr & 3)) * 2);
#pragma unroll
                for (int hf = 0; hf < 2; ++hf) { s16x4 lo[4], hi[4]; tr_read8(addrA + hf * 128, addrA + hf * 128 + 4 * VNSTR, lo, hi);
#pragma unroll
                    for (int c = 0; c < 4; ++c) acc[hf * 4 + c] = __builtin_amdgcn_mfma_f32_16x16x32_bf16(cat44(lo[c], hi[c]), wf, acc[hf * 4 + c], 0, 0, 0); }
            }
            const int t = 16 * T + fr; const float bs = p.in[I_BSP][(l * 4 + g) * 128 + t];
            const bf16_t* up = proj + (size_t)(t0 + t) * NA + COL_GU + g * 128 + 4 * fq; bf16_t* op = mix + (size_t)(t0 + t) * MIXW + 1024 + g * 128 + 4 * fq;
#pragma unroll
            for (int c = 0; c < 8; ++c) { const u32x2 uw = *(const u32x2*)(up + 16 * c);
                u32x2 w; w.x = cvt_pk_bf16(bf_lo(uw.x) * (acc[c][0] + bs), bf_hi(uw.x) * (acc[c][1] + bs)); w.y = cvt_pk_bf16(bf_lo(uw.y) * (acc[c][2] + bs), bf_hi(uw.y) * (acc[c][3] + bs));
                *(u32x2*)(op + 16 * c) = w; }
        }
    }
}

__device__ __forceinline__ unsigned ordkey(unsigned bits) { return bits ^ ((unsigned)((int)bits >> 31) | 0x80000000u); }
__device__ __forceinline__ unsigned unord(unsigned k) { return (k & 0x80000000u) ? (k ^ 0x80000000u) : ~k; }
#define TK_SORT16(S) do { { const unsigned h_ = max(S[0], S[1]), l_ = min(S[0], S[1]); S[0] = h_; S[1] = l_; } { const unsigned h_ = max(S[2], S[3]), l_ = min(S[2], S[3]); S[2] = h_; S[3] = l_; } { const unsigned h_ = max(S[0], S[2]), l_ = min(S[0], S[2]); S[0] = h_; S[2] = l_; } { const unsigned h_ = max(S[1], S[3]), l_ = min(S[1], S[3]); S[1] = h_; S[3] = l_; } { const unsigned h_ = max(S[1], S[2]), l_ = min(S[1], S[2]); S[1] = h_; S[2] = l_; } { const unsigned h_ = max(S[4], S[5]), l_ = min(S[4], S[5]); S[4] = h_; S[5] = l_; } { const unsigned h_ = max(S[6], S[7]), l_ = min(S[6], S[7]); S[6] = h_; S[7] = l_; } { const unsigned h_ = max(S[4], S[6]), l_ = min(S[4], S[6]); S[4] = h_; S[6] = l_; } { const unsigned h_ = max(S[5], S[7]), l_ = min(S[5], S[7]); S[5] = h_; S[7] = l_; } { const unsigned h_ = max(S[5], S[6]), l_ = min(S[5], S[6]); S[5] = h_; S[6] = l_; } { const unsigned h_ = max(S[0], S[4]), l_ = min(S[0], S[4]); S[0] = h_; S[4] = l_; } { const unsigned h_ = max(S[2], S[6]), l_ = min(S[2], S[6]); S[2] = h_; S[6] = l_; } { const unsigned h_ = max(S[2], S[4]), l_ = min(S[2], S[4]); S[2] = h_; S[4] = l_; } { const unsigned h_ = max(S[1], S[5]), l_ = min(S[1], S[5]); S[1] = h_; S[5] = l_; } { const unsigned h_ = max(S[3], S[7]), l_ = min(S[3], S[7]); S[3] = h_; S[7] = l_; } { const unsigned h_ = max(S[3], S[5]), l_ = min(S[3], S[5]); S[3] = h_; S[5] = l_; } { const unsigned h_ = max(S[1], S[2]), l_ = min(S[1], S[2]); S[1] = h_; S[2] = l_; } { const unsigned h_ = max(S[3], S[4]), l_ = min(S[3], S[4]); S[3] = h_; S[4] = l_; } { const unsigned h_ = max(S[5], S[6]), l_ = min(S[5], S[6]); S[5] = h_; S[6] = l_; } { const unsigned h_ = max(S[8], S[9]), l_ = min(S[8], S[9]); S[8] = h_; S[9] = l_; } { const unsigned h_ = max(S[10], S[11]), l_ = min(S[10], S[11]); S[10] = h_; S[11] = l_; } { const unsigned h_ = max(S[8], S[10]), l_ = min(S[8], S[10]); S[8] = h_; S[10] = l_; } { const unsigned h_ = max(S[9], S[11]), l_ = min(S[9], S[11]); S[9] = h_; S[11] = l_; } { const unsigned h_ = max(S[9], S[10]), l_ = min(S[9], S[10]); S[9] = h_; S[10] = l_; } { const unsigned h_ = max(S[12], S[13]), l_ = min(S[12], S[13]); S[12] = h_; S[13] = l_; } { const unsigned h_ = max(S[14], S[15]), l_ = min(S[14], S[15]); S[14] = h_; S[15] = l_; } { const unsigned h_ = max(S[12], S[14]), l_ = min(S[12], S[14]); S[12] = h_; S[14] = l_; } { const unsigned h_ = max(S[13], S[15]), l_ = min(S[13], S[15]); S[13] = h_; S[15] = l_; } { const unsigned h_ = max(S[13], S[14]), l_ = min(S[13], S[14]); S[13] = h_; S[14] = l_; } { const unsigned h_ = max(S[8], S[12]), l_ = min(S[8], S[12]); S[8] = h_; S[12] = l_; } { const unsigned h_ = max(S[10], S[14]), l_ = min(S[10], S[14]); S[10] = h_; S[14] = l_; } { const unsigned h_ = max(S[10], S[12]), l_ = min(S[10], S[12]); S[10] = h_; S[12] = l_; } { const unsigned h_ = max(S[9], S[13]), l_ = min(S[9], S[13]); S[9] = h_; S[13] = l_; } { const unsigned h_ = max(S[11], S[15]), l_ = min(S[11], S[15]); S[11] = h_; S[15] = l_; } { const unsigned h_ = max(S[11], S[13]), l_ = min(S[11], S[13]); S[11] = h_; S[13] = l_; } { const unsigned h_ = max(S[9], S[10]), l_ = min(S[9], S[10]); S[9] = h_; S[10] = l_; } { const unsigned h_ = max(S[11], S[12]), l_ = min(S[11], S[12]); S[11] = h_; S[12] = l_; } { const unsigned h_ = max(S[13], S[14]), l_ = min(S[13], S[14]); S[13] = h_; S[14] = l_; } { const unsigned h_ = max(S[0], S[8]), l_ = min(S[0], S[8]); S[0] = h_; S[8] = l_; } { const unsigned h_ = max(S[4], S[12]), l_ = min(S[4], S[12]); S[4] = h_; S[12] = l_; } { const unsigned h_ = max(S[4], S[8]), l_ = min(S[4], S[8]); S[4] = h_; S[8] = l_; } { const unsigned h_ = max(S[2], S[10]), l_ = min(S[2], S[10]); S[2] = h_; S[10] = l_; } { const unsigned h_ = max(S[6], S[14]), l_ = min(S[6], S[14]); S[6] = h_; S[14] = l_; } { const unsigned h_ = max(S[6], S[10]), l_ = min(S[6], S[10]); S[6] = h_; S[10] = l_; } { const unsigned h_ = max(S[2], S[4]), l_ = min(S[2], S[4]); S[2] = h_; S[4] = l_; } { const unsigned h_ = max(S[6], S[8]), l_ = min(S[6], S[8]); S[6] = h_; S[8] = l_; } { const unsigned h_ = max(S[10], S[12]), l_ = min(S[10], S[12]); S[10] = h_; S[12] = l_; } { const unsigned h_ = max(S[1], S[9]), l_ = min(S[1], S[9]); S[1] = h_; S[9] = l_; } { const unsigned h_ = max(S[5], S[13]), l_ = min(S[5], S[13]); S[5] = h_; S[13] = l_; } { const unsigned h_ = max(S[5], S[9]), l_ = min(S[5], S[9]); S[5] = h_; S[9] = l_; } { const unsigned h_ = max(S[3], S[11]), l_ = min(S[3], S[11]); S[3] = h_; S[11] = l_; } { const unsigned h_ = max(S[7], S[15]), l_ = min(S[7], S[15]); S[7] = h_; S[15] = l_; } { const unsigned h_ = max(S[7], S[11]), l_ = min(S[7], S[11]); S[7] = h_; S[11] = l_; } { const unsigned h_ = max(S[3], S[5]), l_ = min(S[3], S[5]); S[3] = h_; S[5] = l_; } { const unsigned h_ = max(S[7], S[9]), l_ = min(S[7], S[9]); S[7] = h_; S[9] = l_; } { const unsigned h_ = max(S[11], S[13]), l_ = min(S[11], S[13]); S[11] = h_; S[13] = l_; } { const unsigned h_ = max(S[1], S[2]), l_ = min(S[1], S[2]); S[1] = h_; S[2] = l_; } { const unsigned h_ = max(S[3], S[4]), l_ = min(S[3], S[4]); S[3] = h_; S[4] = l_; } { const unsigned h_ = max(S[5], S[6]), l_ = min(S[5], S[6]); S[5] = h_; S[6] = l_; } { const unsigned h_ = max(S[7], S[8]), l_ = min(S[7], S[8]); S[7] = h_; S[8] = l_; } { const unsigned h_ = max(S[9], S[10]), l_ = min(S[9], S[10]); S[9] = h_; S[10] = l_; } { const unsigned h_ = max(S[11], S[12]), l_ = min(S[11], S[12]); S[11] = h_; S[12] = l_; } { const unsigned h_ = max(S[13], S[14]), l_ = min(S[13], S[14]); S[13] = h_; S[14] = l_; } } while (0)
#define TK_MERGE16(L, S) do { L[0] = max(L[0], S[15]); L[1] = max(L[1], S[14]); L[2] = max(L[2], S[13]); L[3] = max(L[3], S[12]); L[4] = max(L[4], S[11]); L[5] = max(L[5], S[10]); L[6] = max(L[6], S[9]); L[7] = max(L[7], S[8]); L[8] = max(L[8], S[7]); L[9] = max(L[9], S[6]); L[10] = max(L[10], S[5]); L[11] = max(L[11], S[4]); L[12] = max(L[12], S[3]); L[13] = max(L[13], S[2]); L[14] = max(L[14], S[1]); L[15] = max(L[15], S[0]); { const unsigned h_ = max(L[0], L[8]), l_ = min(L[0], L[8]); L[0] = h_; L[8] = l_; } { const unsigned h_ = max(L[1], L[9]), l_ = min(L[1], L[9]); L[1] = h_; L[9] = l_; } { const unsigned h_ = max(L[2], L[10]), l_ = min(L[2], L[10]); L[2] = h_; L[10] = l_; } { const unsigned h_ = max(L[3], L[11]), l_ = min(L[3], L[11]); L[3] = h_; L[11] = l_; } { const unsigned h_ = max(L[4], L[12]), l_ = min(L[4], L[12]); L[4] = h_; L[12] = l_; } { const unsigned h_ = max(L[5], L[13]), l_ = min(L[5], L[13]); L[5] = h_; L[13] = l_; } { const unsigned h_ = max(L[6], L[14]), l_ = min(L[6], L[14]); L[6] = h_; L[14] = l_; } { const unsigned h_ = max(L[7], L[15]), l_ = min(L[7], L[15]); L[7] = h_; L[15] = l_; } { const unsigned h_ = max(L[0], L[4]), l_ = min(L[0], L[4]); L[0] = h_; L[4] = l_; } { const unsigned h_ = max(L[1], L[5]), l_ = min(L[1], L[5]); L[1] = h_; L[5] = l_; } { const unsigned h_ = max(L[2], L[6]), l_ = min(L[2], L[6]); L[2] = h_; L[6] = l_; } { const unsigned h_ = max(L[3], L[7]), l_ = min(L[3], L[7]); L[3] = h_; L[7] = l_; } { const unsigned h_ = max(L[8], L[12]), l_ = min(L[8], L[12]); L[8] = h_; L[12] = l_; } { const unsigned h_ = max(L[9], L[13]), l_ = min(L[9], L[13]); L[9] = h_; L[13] = l_; } { const unsigned h_ = max(L[10], L[14]), l_ = min(L[10], L[14]); L[10] = h_; L[14] = l_; } { const unsigned h_ = max(L[11], L[15]), l_ = min(L[11], L[15]); L[11] = h_; L[15] = l_; } { const unsigned h_ = max(L[0], L[2]), l_ = min(L[0], L[2]); L[0] = h_; L[2] = l_; } { const unsigned h_ = max(L[1], L[3]), l_ = min(L[1], L[3]); L[1] = h_; L[3] = l_; } { const unsigned h_ = max(L[4], L[6]), l_ = min(L[4], L[6]); L[4] = h_; L[6] = l_; } { const unsigned h_ = max(L[5], L[7]), l_ = min(L[5], L[7]); L[5] = h_; L[7] = l_; } { const unsigned h_ = max(L[8], L[10]), l_ = min(L[8], L[10]); L[8] = h_; L[10] = l_; } { const unsigned h_ = max(L[9], L[11]), l_ = min(L[9], L[11]); L[9] = h_; L[11] = l_; } { const unsigned h_ = max(L[12], L[14]), l_ = min(L[12], L[14]); L[12] = h_; L[14] = l_; } { const unsigned h_ = max(L[13], L[15]), l_ = min(L[13], L[15]); L[13] = h_; L[15] = l_; } { const unsigned h_ = max(L[0], L[1]), l_ = min(L[0], L[1]); L[0] = h_; L[1] = l_; } { const unsigned h_ = max(L[2], L[3]), l_ = min(L[2], L[3]); L[2] = h_; L[3] = l_; } { const unsigned h_ = max(L[4], L[5]), l_ = min(L[4], L[5]); L[4] = h_; L[5] = l_; } { const unsigned h_ = max(L[6], L[7]), l_ = min(L[6], L[7]); L[6] = h_; L[7] = l_; } { const unsigned h_ = max(L[8], L[9]), l_ = min(L[8], L[9]); L[8] = h_; L[9] = l_; } { const unsigned h_ = max(L[10], L[11]), l_ = min(L[10], L[11]); L[10] = h_; L[11] = l_; } { const unsigned h_ = max(L[12], L[13]), l_ = min(L[12], L[13]); L[12] = h_; L[13] = l_; } { const unsigned h_ = max(L[14], L[15]), l_ = min(L[14], L[15]); L[14] = h_; L[15] = l_; } } while (0)
__device__ __forceinline__ void phase_topk(const Params& p, const Frame& F0, int l) {
    const Frame F = local_frame(F0);
    const int lane = F.lane, wave = F.wave;
    LAS float* tile = (LAS float*)(F.lds + wave * 8448);
    LAS unsigned char* itab = (LAS unsigned char*)(F.lds + 8 * 8448 + wave * 64 * 36 + lane * 36);
    const float* scores = (const float*)(p.ws + WS_SCORES);
    const float* rowsq = (const float*)(p.ws + WS_ROWSQP) + (size_t)l * NTOK * 16;
    unsigned* seli = (unsigned*)(p.ws + WS_SELI); float* selg = (float*)(p.ws + WS_SELG);
    const int gw = blockIdx.x * NWAVES + wave, NGW = F.G * NWAVES;
    const int row_l = lane >> 3, cg_l = lane & 7;
    f32x4 cur[8];
    if (gw < NTOK * 8 / 64) {
#pragma unroll
        for (int i = 0; i < 8; ++i) cur[i] = *(const f32x4*)(scores + ((size_t)gw * 64 + 8 * i + row_l) * 256 + cg_l * 4);
    }
    for (int grp = gw; grp < NTOK * 8 / 64; grp += NGW) {
        const size_t item0 = (size_t)grp * 64;
        unsigned L1[16], L2[16];
#pragma unroll
        for (int j = 0; j < 16; ++j) { L1[j] = 0u; L2[j] = 0u; }
#pragma unroll 1
        for (int ch = 0; ch < 8; ++ch) {
#pragma unroll
            for (int i = 0; i < 8; ++i) { LAS float* d = tile + (8 * i + row_l) * 33 + cg_l * 4; d[0] = cur[i][0]; d[1] = cur[i][1]; d[2] = cur[i][2]; d[3] = cur[i][3]; }
            {
                const bool more = (ch < 7) || (grp + NGW < NTOK * 8 / 64);
                const size_t nitem0 = (ch < 7) ? item0 : (size_t)(grp + NGW) * 64; const int nch = (ch < 7) ? ch + 1 : 0;
                if (more) {
#pragma unroll
                    for (int i = 0; i < 8; ++i) cur[i] = *(const f32x4*)(scores + (nitem0 + 8 * i + row_l) * 256 + nch * 32 + cg_l * 4);
                }
            }
            __builtin_amdgcn_wave_barrier(); asm volatile("s_waitcnt lgkmcnt(0)" ::: "memory");
#pragma unroll
            for (int hf = 0; hf < 2; ++hf) { unsigned S[16];
#pragma unroll
                for (int j = 0; j < 16; ++j) S[j] = ordkey((__float_as_uint(tile[lane * 33 + 16 * hf + j]) & 0xffffff80u) | (unsigned)((ch & 3) * 32 + 16 * hf + j));
                TK_SORT16(S);
                if (ch < 4) TK_MERGE16(L1, S); else TK_MERGE16(L2, S); }
            __builtin_amdgcn_wave_barrier(); asm volatile("s_waitcnt lgkmcnt(0)" ::: "memory");
        }
        float f1[16], f2[16];
#pragma unroll
        for (int k = 0; k < 16; ++k) { const unsigned b1 = unord(L1[k]), b2 = unord(L2[k]); f1[k] = __uint_as_float(b1); f2[k] = __uint_as_float(b2); itab[k] = (unsigned char)(b1 & 127u); itab[16 + k] = (unsigned char)(b2 & 127u); }
        unsigned T[16];
        { T[0] = ordkey((__float_as_uint(f1[0] + f2[0]) & 0xffffff00u) | 0u); T[1] = ordkey((__float_as_uint(f1[0] + f2[1]) & 0xffffff00u) | 1u); T[2] = ordkey((__float_as_uint(f1[0] + f2[2]) & 0xffffff00u) | 2u); T[3] = ordkey((__float_as_uint(f1[0] + f2[3]) & 0xffffff00u) | 3u); T[4] = ordkey((__float_as_uint(f1[0] + f2[4]) & 0xffffff00u) | 4u); T[5] = ordkey((__float_as_uint(f1[0] + f2[5]) & 0xffffff00u) | 5u); T[6] = ordkey((__float_as_uint(f1[0] + f2[6]) & 0xffffff00u) | 6u); T[7] = ordkey((__float_as_uint(f1[0] + f2[7]) & 0xffffff00u) | 7u); T[8] = ordkey((__float_as_uint(f1[0] + f2[8]) & 0xffffff00u) | 8u); T[9] = ordkey((__float_as_uint(f1[0] + f2[9]) & 0xffffff00u) | 9u); T[10] = ordkey((__float_as_uint(f1[0] + f2[10]) & 0xffffff00u) | 10u); T[11] = ordkey((__float_as_uint(f1[0] + f2[11]) & 0xffffff00u) | 11u); T[12] = ordkey((__float_as_uint(f1[0] + f2[12]) & 0xffffff00u) | 12u); T[13] = ordkey((__float_as_uint(f1[0] + f2[13]) & 0xffffff00u) | 13u); T[14] = ordkey((__float_as_uint(f1[0] + f2[14]) & 0xffffff00u) | 14u); T[15] = ordkey((__float_as_uint(f1[0] + f2[15]) & 0xffffff00u) | 15u); TK_SORT16(T); }
        { unsigned S[16]; S[0] = ordkey((__float_as_uint(f1[1] + f2[0]) & 0xffffff00u) | 16u); S[1] = ordkey((__float_as_uint(f1[1] + f2[1]) & 0xffffff00u) | 17u); S[2] = ordkey((__float_as_uint(f1[1] + f2[2]) & 0xffffff00u) | 18u); S[3] = ordkey((__float_as_uint(f1[1] + f2[3]) & 0xffffff00u) | 19u); S[4] = ordkey((__float_as_uint(f1[1] + f2[4]) & 0xffffff00u) | 20u); S[5] = ordkey((__float_as_uint(f1[1] + f2[5]) & 0xffffff00u) | 21u); S[6] = ordkey((__float_as_uint(f1[1] + f2[6]) & 0xffffff00u) | 22u); S[7] = ordkey((__float_as_uint(f1[1] + f2[7]) & 0xffffff00u) | 23u); S[8] = ordkey((__float_as_uint(f1[2] + f2[0]) & 0xffffff00u) | 32u); S[9] = ordkey((__float_as_uint(f1[2] + f2[1]) & 0xffffff00u) | 33u); S[10] = ordkey((__float_as_uint(f1[2] + f2[2]) & 0xffffff00u) | 34u); S[11] = ordkey((__float_as_uint(f1[2] + f2[3]) & 0xffffff00u) | 35u); S[12] = ordkey((__float_as_uint(f1[2] + f2[4]) & 0xffffff00u) | 36u); S[13] = ordkey((__float_as_uint(f1[3] + f2[0]) & 0xffffff00u) | 48u); S[14] = ordkey((__float_as_uint(f1[3] + f2[1]) & 0xffffff00u) | 49u); S[15] = ordkey((__float_as_uint(f1[3] + f2[2]) & 0xffffff00u) | 50u); TK_SORT16(S); TK_MERGE16(T, S); }
        { unsigned S[16]; S[0] = ordkey((__float_as_uint(f1[3] + f2[3]) & 0xffffff00u) | 51u); S[1] = ordkey((__float_as_uint(f1[4] + f2[0]) & 0xffffff00u) | 64u); S[2] = ordkey((__float_as_uint(f1[4] + f2[1]) & 0xffffff00u) | 65u); S[3] = ordkey((__float_as_uint(f1[4] + f2[2]) & 0xffffff00u) | 66u); S[4] = ordkey((__float_as_uint(f1[5] + f2[0]) & 0xffffff00u) | 80u); S[5] = ordkey((__float_as_uint(f1[5] + f2[1]) & 0xffffff00u) | 81u); S[6] = ordkey((__float_as_uint(f1[6] + f2[0]) & 0xffffff00u) | 96u); S[7] = ordkey((__float_as_uint(f1[6] + f2[1]) & 0xffffff00u) | 97u); S[8] = ordkey((__float_as_uint(f1[7] + f2[0]) & 0xffffff00u) | 112u); S[9] = ordkey((__float_as_uint(f1[7] + f2[1]) & 0xffffff00u) | 113u); S[10] = ordkey((__float_as_uint(f1[8] + f2[0]) & 0xffffff00u) | 128u); S[11] = ordkey((__float_as_uint(f1[9] + f2[0]) & 0xffffff00u) | 144u); S[12] = ordkey((__float_as_uint(f1[10] + f2[0]) & 0xffffff00u) | 160u); S[13] = ordkey((__float_as_uint(f1[11] + f2[0]) & 0xffffff00u) | 176u); S[14] = ordkey((__float_as_uint(f1[12] + f2[0]) & 0xffffff00u) | 192u); S[15] = ordkey((__float_as_uint(f1[13] + f2[0]) & 0xffffff00u) | 208u); TK_SORT16(S); TK_MERGE16(T, S); }
        { unsigned x = ordkey((__float_as_uint(f1[14] + f2[0]) & 0xffffff00u) | 224u);
#pragma unroll
            for (int k = 0; k < 16; ++k) { const unsigned hi = max(T[k], x); x = min(T[k], x); T[k] = hi; } }
        { unsigned x = ordkey((__float_as_uint(f1[15] + f2[0]) & 0xffffff00u) | 240u);
#pragma unroll
            for (int k = 0; k < 16; ++k) { const unsigned hi = max(T[k], x); x = min(T[k], x); T[k] = hi; } }
        asm volatile("s_waitcnt lgkmcnt(0)" ::: "memory");
        const size_t item = item0 + lane; const int tok = (int)(item >> 3);
        const float rstd = 1.0f / sqrtf(row_sumsq(rowsq, tok) * (1.0f / DM) + EPS);
        float e[16], se = 0.f; unsigned P[16];
        const float t0v = __uint_as_float(unord(T[0]));
#pragma unroll
        for (int k = 0; k < 16; ++k) { const unsigned b = unord(T[k]); e[k] = __expf((__uint_as_float(b) - t0v) * rstd); se += e[k];
            const unsigned code = b & 255u; P[k] = ((unsigned)itab[code >> 4] << 7) | (unsigned)itab[16 + (code & 15u)]; }
        const float inv = 1.0f / se;
        u32x4* di = (u32x4*)(seli + item * 16); f32x4* dg = (f32x4*)(selg + item * 16);
#pragma unroll
        for (int k4 = 0; k4 < 4; ++k4) { di[k4] = (u32x4){P[4 * k4], P[4 * k4 + 1], P[4 * k4 + 2], P[4 * k4 + 3]};
            dg[k4] = (f32x4){e[4 * k4] * inv, e[4 * k4 + 1] * inv, e[4 * k4 + 2] * inv, e[4 * k4 + 3] * inv}; }
        asm volatile("s_waitcnt lgkmcnt(0)" ::: "memory");
    }
}

__device__ __forceinline__ void fp8x16_to_f32(const u32x4 w, float (&f)[16]) {
#pragma unroll
    for (int q = 0; q < 4; ++q) { const f32x2 lo = __builtin_amdgcn_cvt_pk_f32_fp8((int)w[q], false), hi = __builtin_amdgcn_cvt_pk_f32_fp8((int)w[q], true);
        f[4 * q] = lo[0]; f[4 * q + 1] = lo[1]; f[4 * q + 2] = hi[0]; f[4 * q + 3] = hi[1]; }
}
template <int CTRL> __device__ __forceinline__ float dpp_f(float v) { return __uint_as_float(__builtin_amdgcn_update_dpp(0u, __float_as_uint(v), CTRL, 0xF, 0xF, true)); }
#ifndef G_RSH
#define G_RSH 10
#endif
#ifndef GATHER_SWEEP_BARRIER
#define GATHER_SWEEP_BARRIER 1
#endif
constexpr int GT = 4;
__device__ __forceinline__ void phase_gather(const Params& p, const Frame& F0, int l, const XcdBarrier& bar, bool use_bar, bool dry = false, unsigned emask = 0xffffffffu) {
    const Frame F = local_frame(F0);
    const int lane = F.lane;
    const unsigned char* ET = p.ws + WS_EXP + (size_t)l * NEXP * 2 * DM;
    const f32x2* SC = (const f32x2*)(p.ws + WS_ESCALE) + (size_t)l * NEXP;
    const bf16_t* xb = (const bf16_t*)(p.ws + WS_XB);
    bf16_t* xbo = dry ? (bf16_t*)(p.ws + WS_GATES) : (bf16_t*)(p.ws + WS_XB);
    float* outp = dry ? (float*)(p.ws + WS_GATES) : p.out;
    float* rstdo = dry ? (float*)(p.ws + WS_GATES + 160 * MiB) : (float*)(p.ws + WS_RSTD);
    const float* rowsq = (const float*)(p.ws + WS_ROWSQP) + (size_t)l * NTOK * 16;
    const unsigned* seli = (const unsigned*)(p.ws + WS_SELI); const float* selg = (const float*)(p.ws + WS_SELG);
    const float* gain = p.in[I_FFGAIN] + l * DM + lane * 16;
    LAS u32x2* sortl = (LAS u32x2*)(F.lds + F.wave * (GT * 1024));
    const bool dsel0 = (lane & 1) != 0, dsel1 = (lane & 2) != 0, ondiag = (((lane & 15) >> 2) == (lane >> 4));
    const bool b2 = (lane & 4) != 0, b1 = (lane & 2) != 0, b0 = (lane & 1) != 0;
    const int mym = (b2 ? 4 : 0) + (b0 ? 2 : 0) + (b1 ? 1 : 0);
    const int gw = blockIdx.x * NWAVES + F.wave, NGW = F.G * NWAVES;
    const int nsweep = NTOK / (NGW * GT);
    for (int sw = 0; sw < nsweep; ++sw) {
        if (sw > 0 && use_bar && GATHER_SWEEP_BARRIER) xcd_barrier(bar);
        const int tok0 = (sw * NGW + gw) * GT;
        float o[GT][16]; int cur[GT]; long h2lo[GT], h2hi[GT]; float h2s[GT];
#pragma unroll
        for (int tk = 0; tk < GT; ++tk) { const int tok = tok0 + tk;
            const float rstd = 1.0f / sqrtf(row_sumsq(rowsq, tok) * (1.0f / DM) + EPS);
            const u32x4 xw0 = *(const u32x4*)(xb + (size_t)tok * DM + lane * 16), xw1 = *(const u32x4*)(xb + (size_t)tok * DM + lane * 16 + 8);
            const f32x4 g0 = *(const f32x4*)gain, g1 = *(const f32x4*)(gain + 4), g2 = *(const f32x4*)(gain + 8), g3 = *(const f32x4*)(gain + 12);
            float hv[16] = {bf_lo(xw0.x) * rstd * g0[0], bf_hi(xw0.x) * rstd * g0[1], bf_lo(xw0.y) * rstd * g0[2], bf_hi(xw0.y) * rstd * g0[3], bf_lo(xw0.z) * rstd * g1[0], bf_hi(xw0.z) * rstd * g1[1], bf_lo(xw0.w) * rstd * g1[2], bf_hi(xw0.w) * rstd * g1[3],
                            bf_lo(xw1.x) * rstd * g2[0], bf_hi(xw1.x) * rstd * g2[1], bf_lo(xw1.y) * rstd * g2[2], bf_hi(xw1.y) * rstd * g2[3], bf_lo(xw1.z) * rstd * g3[0], bf_hi(xw1.z) * rstd * g3[1], bf_lo(xw1.w) * rstd * g3[2], bf_hi(xw1.w) * rstd * g3[3]};
            float hm = 0.f;
#pragma unroll
            for (int j = 0; j < 16; ++j) hm = fmaxf(hm, fabsf(hv[j]));
#pragma unroll
            for (int of = 1; of < 64; of <<= 1) hm = fmaxf(hm, __shfl_xor(hm, of));
            const float hinv = hm > 0.f ? 448.0f / hm : 0.f; h2s[tk] = hm * (1.0f / 448.0f);
            {   int w0 = 0, w1 = 0, w2 = 0, w3 = 0;
                w0 = __builtin_amdgcn_cvt_pk_fp8_f32(hv[0] * hinv, hv[1] * hinv, w0, false); w0 = __builtin_amdgcn_cvt_pk_fp8_f32(hv[2] * hinv, hv[3] * hinv, w0, true);
                w1 = __builtin_amdgcn_cvt_pk_fp8_f32(hv[4] * hinv, hv[5] * hinv, w1, false); w1 = __builtin_amdgcn_cvt_pk_fp8_f32(hv[6] * hinv, hv[7] * hinv, w1, true);
                w2 = __builtin_amdgcn_cvt_pk_fp8_f32(hv[8] * hinv, hv[9] * hinv, w2, false); w2 = __builtin_amdgcn_cvt_pk_fp8_f32(hv[10] * hinv, hv[11] * hinv, w2, true);
                w3 = __builtin_amdgcn_cvt_pk_fp8_f32(hv[12] * hinv, hv[13] * hinv, w3, false); w3 = __builtin_amdgcn_cvt_pk_fp8_f32(hv[14] * hinv, hv[15] * hinv, w3, true);
                h2lo[tk] = (long)(((unsigned long long)(unsigned)w1 << 32) | (unsigned)w0); h2hi[tk] = (long)(((unsigned long long)(unsigned)w3 << 32) | (unsigned)w2); }
            const unsigned i0 = seli[(size_t)tok * 128 + lane] & emask, i1 = seli[(size_t)tok * 128 + 64 + lane] & emask;
            const float q0 = selg[(size_t)tok * 128 + lane], q1 = selg[(size_t)tok * 128 + 64 + lane];
            const unsigned ep0 = i0 >> G_RSH, ep1 = i1 >> G_RSH; unsigned pos0 = 0, pos1 = 0, base = 0;
#pragma unroll
            for (unsigned ep = 0; ep < (16384u >> G_RSH); ++ep) { const unsigned long long m0 = __ballot(ep0 == ep), m1 = __ballot(ep1 == ep);
                const unsigned c0 = __builtin_amdgcn_mbcnt_hi((unsigned)(m0 >> 32), __builtin_amdgcn_mbcnt_lo((unsigned)m0, 0u)), c1 = __builtin_amdgcn_mbcnt_hi((unsigned)(m1 >> 32), __builtin_amdgcn_mbcnt_lo((unsigned)m1, 0u));
                const unsigned n0 = (unsigned)__popcll(m0), n1 = (unsigned)__popcll(m1);
                pos0 = (ep0 == ep) ? base + c0 : pos0; pos1 = (ep1 == ep) ? base + n0 + c1 : pos1; base += n0 + n1; }
            sortl[tk * 128 + pos0] = (u32x2){i0, __float_as_uint(q0)}; sortl[tk * 128 + pos1] = (u32x2){i1, __float_as_uint(q1)}; cur[tk] = 0;
#pragma unroll
            for (int j = 0; j < 16; ++j) o[tk][j] = 0.f; }
        __builtin_amdgcn_wave_barrier(); asm volatile("s_waitcnt lgkmcnt(0)" ::: "memory");
#pragma unroll 1
        for (int r = 0; r < (16384 >> G_RSH); ++r) {
#pragma unroll
            for (int tk = 0; tk < GT; ++tk) {
                while (cur[tk] < 16) {
                    const int b = cur[tk]; const u32x2 ent = sortl[tk * 128 + 8 * b + mym];
                    unsigned e[8];
                    e[0] = __builtin_amdgcn_readlane(ent.x, 0);
                    if ((int)(e[0] >> G_RSH) > r) break;
                    cur[tk] = b + 1;
#pragma unroll
                    for (int i = 1; i < 8; ++i) e[i] = __builtin_amdgcn_readlane(ent.x, ((i & 4) ? 4 : 0) + ((i & 1) ? 2 : 0) + ((i & 2) ? 1 : 0));
                    u32x4 uu[8], vv[8];
#pragma unroll
                    for (int i = 0; i < 8; ++i) { const unsigned char* rp = ET + (size_t)e[i] * (2 * DM) + lane * 16; uu[i] = *(const u32x4*)rp; vv[i] = *(const u32x4*)(rp + DM); }
                    const unsigned mye = ent.x; const float myg = __uint_as_float(ent.y);
                    const f32x2 sc = SC[mye];
                    float d[8];
#pragma unroll
                    for (int hf = 0; hf < 2; ++hf) { f32x4 acc4[4];
#pragma unroll
                        for (int i = 0; i < 4; ++i) { const u32x4 w = uu[4 * hf + i]; acc4[i] = __builtin_amdgcn_mfma_f32_16x16x32_fp8_fp8((long)(((unsigned long long)w.y << 32) | w.x), h2lo[tk], (f32x4){0.f, 0.f, 0.f, 0.f}, 0, 0, 0); }
#pragma unroll
                        for (int i = 0; i < 4; ++i) { const u32x4 w = uu[4 * hf + i]; acc4[i] = __builtin_amdgcn_mfma_f32_16x16x32_fp8_fp8((long)(((unsigned long long)w.w << 32) | w.z), h2hi[tk], acc4[i], 0, 0, 0); }
#pragma unroll
                        for (int i = 0; i < 4; ++i) { const float lo2 = dsel0 ? acc4[i][1] : acc4[i][0], hi2 = dsel0 ? acc4[i][3] : acc4[i][2]; const float v = dsel1 ? hi2 : lo2; d[4 * hf + i] = ondiag ? v : 0.f; } }
                    float a4[4], c2[2];
#pragma unroll
                    for (int j = 0; j < 4; ++j) { const float keep = b2 ? d[j + 4] : d[j], send = b2 ? d[j] : d[j + 4]; a4[j] = keep + dpp_f<0x141>(send); }
#pragma unroll
                    for (int j = 0; j < 2; ++j) { const float keep = b0 ? a4[j + 2] : a4[j], send = b0 ? a4[j] : a4[j + 2]; c2[j] = keep + dpp_f<0xB1>(send); }
                    float dm; { const float keep = b1 ? c2[1] : c2[0], send = b1 ? c2[0] : c2[1]; dm = keep + dpp_f<0x4E>(send); }
                    dm += dpp_f<0x128>(dm);
                    { const auto s16 = __builtin_amdgcn_permlane16_swap(__float_as_uint(dm), __float_as_uint(dm), false, false); dm = __uint_as_float(s16[0]) + __uint_as_float(s16[1]); }
                    { const auto s32 = __builtin_amdgcn_permlane32_swap(__float_as_uint(dm), __float_as_uint(dm), false, false); dm = __uint_as_float(s32[0]) + __uint_as_float(s32[1]); }
                    const float cf = myg * gelu_tanh(dm * sc[0] * h2s[tk]) * sc[1];
#pragma unroll
                    for (int i = 0; i < 8; ++i) { const float ci = __uint_as_float(__builtin_amdgcn_readlane(__float_as_uint(cf), ((i & 4) ? 4 : 0) + ((i & 1) ? 2 : 0) + ((i & 2) ? 1 : 0)));
                        float f[16]; fp8x16_to_f32(vv[i], f);
#pragma unroll
                        for (int j = 0; j < 16; ++j) o[tk][j] += ci * f[j]; }
                }
            }
        }
#pragma unroll
        for (int tk = 0; tk < GT; ++tk) { const int tok = tok0 + tk;
            const u32x4 xw0 = *(const u32x4*)(xb + (size_t)tok * DM + lane * 16), xw1 = *(const u32x4*)(xb + (size_t)tok * DM + lane * 16 + 8);
            float* ot = o[tk];
            ot[0] += bf_lo(xw0.x); ot[1] += bf_hi(xw0.x); ot[2] += bf_lo(xw0.y); ot[3] += bf_hi(xw0.y); ot[4] += bf_lo(xw0.z); ot[5] += bf_hi(xw0.z); ot[6] += bf_lo(xw0.w); ot[7] += bf_hi(xw0.w);
            ot[8] += bf_lo(xw1.x); ot[9] += bf_hi(xw1.x); ot[10] += bf_lo(xw1.y); ot[11] += bf_hi(xw1.y); ot[12] += bf_lo(xw1.z); ot[13] += bf_hi(xw1.z); ot[14] += bf_lo(xw1.w); ot[15] += bf_hi(xw1.w);
            float ss = 0.f;
#pragma unroll
            for (int i = 0; i < 16; ++i) ss += ot[i] * ot[i];
            ss = wave_sum(ss);
            const float r2 = 1.0f / sqrtf(ss * (1.0f / DM) + EPS);
            if (l + 1 < DEPTH) {
                u32x4 w0, w1; w0.x = cvt_pk_bf16(ot[0], ot[1]); w0.y = cvt_pk_bf16(ot[2], ot[3]); w0.z = cvt_pk_bf16(ot[4], ot[5]); w0.w = cvt_pk_bf16(ot[6], ot[7]);
                w1.x = cvt_pk_bf16(ot[8], ot[9]); w1.y = cvt_pk_bf16(ot[10], ot[11]); w1.z = cvt_pk_bf16(ot[12], ot[13]); w1.w = cvt_pk_bf16(ot[14], ot[15]);
                *(u32x4*)(xbo + (size_t)tok * DM + lane * 16) = w0; *(u32x4*)(xbo + (size_t)tok * DM + lane * 16 + 8) = w1;
                if (lane == 0) rstdo[(size_t)(l + 1) * NTOK + tok] = r2;
            } else {
                const float* fg = p.in[I_FGAIN] + lane * 16; float* dst = outp + (size_t)tok * DM + lane * 16;
#pragma unroll
                for (int q = 0; q < 4; ++q) { const f32x4 gq = *(const f32x4*)(fg + 4 * q);
                    *(f32x4*)(dst + 4 * q) = (f32x4){ot[4 * q] * r2 * gq[0], ot[4 * q + 1] * r2 * gq[1], ot[4 * q + 2] * r2 * gq[2], ot[4 * q + 3] * r2 * gq[3]}; }
            }
        }
    }
}

constexpr int PH_PER_LAYER = 8, N_PHASES = 1 + DEPTH * PH_PER_LAYER;
__global__ void __launch_bounds__(NTHREADS, 2) mk_fwd(Params p) {
    extern __shared__ __attribute__((aligned(16))) unsigned char lds_raw[];
    Frame F; F.lds = (LAS unsigned char*)lds_raw; F.tid = threadIdx.x; F.lane = F.tid & 63; F.wave = __builtin_amdgcn_readfirstlane(F.tid >> 6);
    F.G = gridDim.x; { const int bx = blockIdx.x; F.vcu = (F.G % 8 == 0) ? (bx % 8) * (F.G / 8) + bx / 8 : bx; }
    volatile LAS unsigned* misc = (volatile LAS unsigned*)(F.lds + LDS_MISC);
    if (F.tid < 64) misc[F.tid] = 0u;
    __syncthreads();
    unsigned* ctl = (unsigned*)(p.ws + WS_CTL);
    XcdBarrier bar; bar.bar = ctl + CTL_BAR_WORD; bar.x = 0; bar.st = nullptr;
    const bool one_launch = (p.ph_hi - p.ph_lo) > 1;
    if (one_launch) bar = xcd_barrier_post(ctl + CTL_BAR_WORD, misc);
    const int lo = p.ph_lo, hi = p.ph_hi;
#define IN(k) (lo <= (k) && (k) < hi)
#define SEAM(k) do { if (IN(k) && IN((k) + 1)) xcd_barrier(bar); } while (0)
    bf16_t* xb = (bf16_t*)(p.ws + WS_XB);
    if (IN(0)) { if (PD(8)) phase_prologue(p, F); phase_prologue(p, F); SEAM(0); }
    for (int l = 0; l < DEPTH; ++l) {
        const int b = 1 + l * PH_PER_LAYER;
        const float* rstd_a = (const float*)(p.ws + WS_RSTD) + (size_t)l * NTOK;
        if (IN(b + 0)) {
            pg8::Gemm g{xb, (const bf16_t*)(p.ws + WS_WTIN) + (size_t)l * NIN * DM, DM, DM, DM, 0, 0};
            pg8::TileOrder<1> S; S.init(NTOK, NA, F.G, (int)blockIdx.x);
            EpiProjA E{(bf16_t*)(p.ws + WS_PROJA), rstd_a};
            if (PD(0)) pg8::gemm_phase(F.lds, g, S, E, F.wave);
            pg8::gemm_phase(F.lds, g, S, E, F.wave); SEAM(b + 0);
        }
        if (IN(b + 1)) {
#if defined(MIX_SIMPLE)
            phase_mix_simple(p, F, l);
#else
            if (PD(1)) phase_mix(p, F, l);
            phase_mix(p, F, l);
#endif
            SEAM(b + 1);
        }
        if (IN(b + 2)) {
            pg8::Gemm g{xb, (const bf16_t*)(p.ws + WS_WTIN) + ((size_t)l * NIN + NA) * DM, DM, DM, DM, 0, 0};
            pg8::TileOrder<1> S; S.init(NTOK, NG, F.G, (int)blockIdx.x);
            EpiGates E{(bf16_t*)(p.ws + WS_GATES), rstd_a, p.in[I_BGATE] + l * NG};
            if (PD(2)) pg8::gemm_phase(F.lds, g, S, E, F.wave);
            pg8::gemm_phase(F.lds, g, S, E, F.wave); SEAM(b + 2);
        }
        if (IN(b + 3)) {
            pg8::Gemm g{(const bf16_t*)(p.ws + WS_MIX), (const bf16_t*)(p.ws + WS_WTBR) + (size_t)l * 3 * DM * 512, MIXW, 512, 512, (size_t)512 * 2, (size_t)DM * 512 * 2};
            pg8::TileOrder<3> S; S.init(NTOK, DM, F.G, (int)blockIdx.x);
            EpiMerge E{(const bf16_t*)(p.ws + WS_GATES), (bf16_t*)p.out};
            if (PD(3)) pg8::gemm_phase(F.lds, g, S, E, F.wave);
            pg8::gemm_phase(F.lds, g, S, E, F.wave); SEAM(b + 3);
        }
        if (IN(b + 4)) {
            pg8::Gemm g{(const bf16_t*)p.out, (const bf16_t*)(p.ws + WS_WTOUT) + (size_t)l * DM * DM, DM, DM, DM, 0, 0};
            pg8::TileOrder<1> S; S.init(NTOK, DM, F.G, (int)blockIdx.x);
            EpiResid E{xb, (float*)(p.ws + WS_ROWSQP) + (size_t)l * NTOK * 16, xb};
            if (PD(4)) { EpiResid E2{xb, (float*)(p.ws + WS_ROWSQP) + (size_t)l * NTOK * 16, (bf16_t*)(p.ws + WS_GATES)}; pg8::gemm_phase(F.lds, g, S, E2, F.wave); }
            pg8::gemm_phase(F.lds, g, S, E, F.wave); SEAM(b + 4);
        }
        if (IN(b + 5)) {
            pg8::Gemm g{xb, (const bf16_t*)(p.ws + WS_WEFF) + (size_t)l * PQ * DM, DM, DM, DM, 0, 0};
            pg8::TileOrder<1> S; S.init(NTOK, PQ, F.G, (int)blockIdx.x);
            EpiScores E{(float*)(p.ws + WS_SCORES)};
            if (PD(5)) pg8::gemm_phase(F.lds, g, S, E, F.wave);
            pg8::gemm_phase(F.lds, g, S, E, F.wave); SEAM(b + 5);
        }
        if (IN(b + 6)) { if (PD(6)) phase_topk(p, F, l); phase_topk(p, F, l); SEAM(b + 6); }
        if (IN(b + 7)) { if (PD(7)) phase_gather(p, F, l, bar, one_launch, true); if (PD(9)) phase_gather(p, F, l, bar, one_launch, true, 1023u); phase_gather(p, F, l, bar, one_launch); SEAM(b + 7); }
    }
#undef IN
#undef SEAM
}

extern "C" void kernel_launch(void* const* d_in, const int* in_sizes, int n_in, void* d_out, int out_size, void* d_ws, size_t ws_size, hipStream_t stream) {
    static int grid = 0;
    if (grid == 0) {
        if (n_in != 22 || out_size != NTOK * DM || ws_size < WS_END) { fprintf(stderr, "kernel_launch: unexpected shapes (n_in %d, out %d, ws %zu)\n", n_in, out_size, ws_size); grid = -1; return; }
        int dev = 0, cus = 0, per_cu = 0;
        if (hipGetDevice(&dev) != hipSuccess || hipDeviceGetAttribute(&cus, hipDeviceAttributeMultiprocessorCount, dev) != hipSuccess) { grid = -1; return; }
        if (hipFuncSetAttribute((const void*)mk_fwd, hipFuncAttributeMaxDynamicSharedMemorySize, LDS_BYTES) != hipSuccess) { fprintf(stderr, "kernel_launch: hipFuncSetAttribute failed\n"); grid = -1; return; }
        if (hipOccupancyMaxActiveBlocksPerMultiprocessor(&per_cu, (const void*)mk_fwd, NTHREADS, LDS_BYTES) != hipSuccess || per_cu < 1) { fprintf(stderr, "kernel_launch: occupancy query says %d\n", per_cu); }
        (void)hipGetLastError();
        grid = cus;
    }
    if (grid < 0) return;
    (void)hipMemsetAsync((char*)d_ws + WS_CTL, 0, CTL_ZERO_BYTES, stream);
    Params p; memset(&p, 0, sizeof(p));
    for (int i = 0; i < 22; ++i) p.in[i] = (const float*)d_in[i];
    p.out = (float*)d_out; p.ws = (unsigned char*)d_ws;
#if MK_N_LAUNCHES == 1
    p.ph_lo = 0; p.ph_hi = N_PHASES; p.li = 0;
    hipLaunchKernelGGL(mk_fwd, dim3(grid), dim3(NTHREADS), LDS_BYTES, stream, p);
#else
    for (int ph = 0; ph < N_PHASES; ++ph) { p.ph_lo = ph; p.ph_hi = ph + 1; p.li = ph; hipLaunchKernelGGL(mk_fwd, dim3(grid), dim3(NTHREADS), LDS_BYTES, stream, p); }
#endif
}
```

```cpp
#include <hip/hip_runtime.h>
#include <cstdio>
#include <cstdint>
#include <cstring>

#ifndef MK_N_LAUNCHES
#define MK_N_LAUNCHES 1
#endif

#ifndef PROBE_DOUBLE
#define PROBE_DOUBLE -1
#endif
#define PD(k) (PROBE_DOUBLE == (k) || (PROBE_DOUBLE == 100 && ((k) == 0 || ((k) >= 2 && (k) <= 5))))

#define LAS __attribute__((address_space(3)))
typedef unsigned short bf16_t;
typedef short bf16x8 __attribute__((ext_vector_type(8)));
typedef float f32x4 __attribute__((ext_vector_type(4)));
typedef float f32x2 __attribute__((ext_vector_type(2)));
typedef unsigned u32x4 __attribute__((ext_vector_type(4)));
typedef unsigned u32x2 __attribute__((ext_vector_type(2)));
typedef __bf16 bf16x2_t __attribute__((ext_vector_type(2)));

constexpr int NTOK = 32768, DM = 1024, SEQ = 16384, DEPTH = 2;
constexpr int NA = 2304, NG = 3072, NIN = 5376;
constexpr int COL_K = 512, COL_V = 640, COL_PZ = 768, COL_GU = 1280, COL_GV = 1792;
constexpr int MIXW = 1536;
constexpr int NEXP = 16384, PQ = 2048;
constexpr float EPS = 1e-6f;
constexpr int NWAVES = 8, NTHREADS = 512;

constexpr size_t MiB = 1u << 20;
constexpr size_t WS_CTL = 0, CTL_ZERO_BYTES = 1 * MiB;
constexpr size_t CTL_BAR_WORD = 4096;
constexpr size_t CTL_ROWSQ = 256 * 1024;
constexpr size_t WS_RSTD = 1 * MiB;
constexpr size_t WS_WTIN = 2 * MiB;
constexpr size_t WS_WTBR = 23 * MiB;
constexpr size_t WS_WTOUT = 29 * MiB;
constexpr size_t WS_WEFF = 33 * MiB;
constexpr size_t WS_WSP = 41 * MiB;
constexpr size_t WS_ROWSQP = 42 * MiB;
constexpr size_t WS_ESCALE = 46 * MiB;
constexpr size_t WS_EXP = 48 * MiB;
constexpr size_t WS_XB = 112 * MiB;
constexpr size_t WS_PROJA = 176 * MiB;
constexpr size_t WS_MERGED = 176 * MiB;
constexpr size_t WS_SCORES = 176 * MiB;
constexpr size_t WS_SCRATCH = 176 * MiB;
constexpr size_t WS_GATES = 320 * MiB;
constexpr size_t WS_SELI = 464 * MiB, WS_SELG = 480 * MiB;
constexpr size_t WS_END = 512 * MiB;

constexpr int LDS_BYTES = 163840;
constexpr int LDS_MISC = LDS_BYTES - 256;

#define NEG_INF_F (__uint_as_float(0xff800000u))
__device__ __forceinline__ unsigned cvt_pk_bf16(float lo, float hi) { unsigned r; asm volatile("v_cvt_pk_bf16_f32 %0, %1, %2" : "=v"(r) : "v"(lo), "v"(hi)); return r; }
__device__ __forceinline__ float bf_lo(unsigned u) { return __uint_as_float(u << 16); }
__device__ __forceinline__ float bf_hi(unsigned u) { return __uint_as_float(u & 0xffff0000u); }
__device__ __forceinline__ float bf1(bf16_t u) { return __uint_as_float(((unsigned)u) << 16); }
__device__ __forceinline__ float wave_sum(float v) {
#pragma unroll
    for (int o = 1; o < 64; o <<= 1) v += __shfl_xor(v, o);
    return v;
}
__device__ __forceinline__ float gelu_tanh(float x) {
    const float u = 0.7978845608028654f * (x + 0.044715f * x * x * x);
    const float e = __builtin_amdgcn_exp2f(-2.0f * 1.4426950408889634f * u);
    return x * __builtin_amdgcn_rcpf(1.0f + e);
}
__device__ __forceinline__ float row_sumsq(const float* part, int row) { const f32x4* q = (const f32x4*)(part + (size_t)row * 16); const f32x4 a = q[0], b = q[1], c = q[2], d = q[3];
    return (((a[0] + a[1]) + (a[2] + a[3])) + ((b[0] + b[1]) + (b[2] + b[3]))) + (((c[0] + c[1]) + (c[2] + c[3])) + ((d[0] + d[1]) + (d[2] + d[3]))); }
__device__ __forceinline__ float sigmoidf_(float x) { return __builtin_amdgcn_rcpf(1.0f + __builtin_amdgcn_exp2f(-1.4426950408889634f * x)); }

#define XB_TMO      128
#define XB_XCNT(j)  (256  + 64 * (j))
#define XB_XSUB(j)  (1280 + 64 * (j))
#define XB_XGEN(j)  (2304 + 64 * (j))
#define XB_TOP      3328
#define XB_TOPGEN   3392
#define XCD_BAR_WORDS 3456
#define XB_SPIN_CAP (1u << 18)
__device__ __forceinline__ unsigned xb_ld(unsigned* p)              { return __hip_atomic_load(p, __ATOMIC_RELAXED, __HIP_MEMORY_SCOPE_AGENT); }
__device__ __forceinline__ unsigned xb_add(unsigned* p, unsigned v) { return __hip_atomic_fetch_add(p, v, __ATOMIC_RELAXED, __HIP_MEMORY_SCOPE_AGENT); }
__device__ __forceinline__ unsigned xb_xcc_id() { return (unsigned)__builtin_amdgcn_s_getreg((3 << 11) | 20) & 0xFu; }
#define XB_SPIN(cond, bar) do { unsigned _sp = 0; while (cond) { __builtin_amdgcn_s_sleep(1); \
    if ((++_sp & 255u) == 0u) { if (xb_ld(&(bar)[XB_TMO])) break; if (_sp > XB_SPIN_CAP) { atomicAdd(&(bar)[XB_TMO], 1u); break; } } } } while (0)
struct XcdBarrier { unsigned* bar; unsigned x; volatile LAS unsigned* st; };
__device__ __forceinline__ XcdBarrier xcd_barrier_post(unsigned* bar, volatile LAS unsigned* st) {
    XcdBarrier b; b.bar = bar; b.x = xb_xcc_id(); b.st = st;
    if (threadIdx.x == 0) (void)xb_add(&bar[XB_XCNT(b.x)], 1u);
    return b;
}
__device__ __forceinline__ void xcd_barrier_complete(unsigned* bar, unsigned x, unsigned& nloc, unsigned& nx) {
    const unsigned G = gridDim.x * gridDim.y * gridDim.z;
    unsigned sum, cnt, mine, sp = 0u;
    for (;;) {
        sum = 0u; cnt = 0u; mine = 0u;
#pragma unroll
        for (unsigned j = 0; j < 16; ++j) { const unsigned c = xb_ld(&bar[XB_XCNT(j)]); sum += c; cnt += (c > 0u) ? 1u : 0u; mine = (j == x) ? c : mine; }
        if (sum == G) break;
        __builtin_amdgcn_s_sleep(1);
        if ((++sp & 255u) == 0u) { if (xb_ld(&bar[XB_TMO])) break; if (sp > XB_SPIN_CAP) { atomicAdd(&bar[XB_TMO], 1u); break; } }
    }
    nloc = mine > 0u ? mine : 1u; nx = cnt > 0u ? cnt : 1u;
}
__device__ __forceinline__ void xcd_barrier(const XcdBarrier& b) {
    asm volatile("s_waitcnt vmcnt(0)" ::: "memory");
    __syncthreads();
    if (threadIdx.x == 0) {
        unsigned* bar = b.bar;
        __builtin_amdgcn_s_waitcnt(0);
        unsigned nloc = b.st[0], nx = b.st[1];
        if (nloc == 0u) { xcd_barrier_complete(bar, b.x, nloc, nx); b.st[0] = nloc; b.st[1] = nx; }
        const unsigned old = xb_add(&bar[XB_XSUB(b.x)], 1u);
        const unsigned gen = old / nloc;
        if (old + 1u == (gen + 1u) * nloc) {
            __builtin_amdgcn_fence(__ATOMIC_RELEASE, "agent");
            asm volatile("s_waitcnt vmcnt(0)" ::: "memory");
            const unsigned og = xb_add(&bar[XB_TOP], 1u);
            const unsigned tg = og / nx;
            if (og + 1u == (tg + 1u) * nx) xb_add(&bar[XB_TOPGEN], 1u);
            else XB_SPIN(xb_ld(&bar[XB_TOPGEN]) == tg, bar);
            __builtin_amdgcn_fence(__ATOMIC_ACQUIRE, "agent");
            xb_add(&bar[XB_XGEN(b.x)], 1u);
            asm volatile("s_waitcnt vmcnt(0)" ::: "memory");
        } else {
            XB_SPIN(xb_ld(&bar[XB_XGEN(b.x)]) == gen, bar);
            __builtin_amdgcn_fence(__ATOMIC_ACQUIRE, "agent");
            asm volatile("s_waitcnt vmcnt(0)" ::: "memory");
        }
    }
    __syncthreads();
}

namespace pg8 {
constexpr int BM = 256, BK = 64, HALF = 128, HTB = HALF * BK * 2, STAGE_BYTES = 8 * HTB, NXCD = 8, WGM = 8;
__host__ __device__ __forceinline__ int lds_byte(int r, int c) { const int st = (r >> 4) * 2 + (c >> 5), rr = r & 15, cc = c & 31, ob = rr * 64 + cc * 2; return st * 1024 + (ob ^ (((ob >> 9) & 1) << 5)); }
__host__ __device__ __forceinline__ void stage_rc(int b, int& R, int& C) { const int st = b / 1024, sb = b % 1024, swz = sb ^ (((sb >> 9) & 1) << 5); R = (st >> 1) * 16 + swz / 64; C = (st & 1) * 32 + (swz % 64) / 2; }
__host__ __device__ __forceinline__ int perm32(int rho) { const int n = rho >> 4, i = rho & 15; return 8 * (i >> 2) + 4 * n + (i & 3); }

struct Unit { int pm, pn, z; };
struct Gemm { const bf16_t* A; const bf16_t* Bt; int lda, ldb, K; size_t az, bz; };

template <int ZN> struct TileOrder {
    int nM, nN, nwg, G, c;
    __device__ void init(int M, int N, int G_, int c_) { nM = M / BM; nN = N / BM; nwg = nM * nN; G = G_; c = c_; }
    __device__ bool next(int i, Unit& u) const {
        const long L = (long)(i / ZN) * G + c; if (L >= nwg) return false;
        int wgid = (int)L; { const int q = nwg / NXCD, r = nwg % NXCD, xcd = wgid % NXCD, off = wgid / NXCD; wgid = (xcd < r ? xcd * (q + 1) : r * (q + 1) + (xcd - r) * q) + off; }
        const int nig = WGM * nN, gid = wgid / nig, fm = gid * WGM, gsz = (nM - fm) < WGM ? (nM - fm) : WGM;
        u.pm = fm + ((wgid % nig) % gsz); u.pn = (wgid % nig) / gsz; u.z = i % ZN; return true;
    }
};

template <class Epi, class Sched>
__device__ __forceinline__ void gemm_phase(LAS unsigned char* lds, const Gemm g, const Sched& S, const Epi& E, int wave_id) {
    unsigned ones_; asm volatile("s_mov_b32 %0, -1" : "=s"(ones_));
    int tid_l = (wave_id << 6) | (int)__builtin_amdgcn_mbcnt_hi(ones_, __builtin_amdgcn_mbcnt_lo(ones_, 0u)); asm volatile("" : "+v"(tid_l));
    int wid_l = __builtin_amdgcn_readfirstlane(tid_l >> 6);
    const int tid = tid_l, wid = wid_l, lane = tid & 63, wr = wid >> 2, wc = wid & 3, fr = lane & 15, fq = lane >> 4;
    const int K = g.K, nt = K / BK;
    unsigned voffA[2], voffB[2];
#pragma unroll
    for (int i = 0; i < 2; ++i) { int R, C; stage_rc(tid * 16 + i * 8192, R, C); const int Rb = Epi::PERM ? ((R & ~31) + perm32(R & 31)) : R;
        voffA[i] = (unsigned)(R * g.lda + C) * 2u; voffB[i] = (unsigned)(Rb * g.ldb + C) * 2u; }
    const size_t kstep = (size_t)(BK * 2);
    const size_t hstepA = (size_t)HALF * g.lda * 2, hstepB = (size_t)HALF * g.ldb * 2;
    const size_t tstepA = 2 * hstepA, tstepB = 2 * hstepB;
    const unsigned ldsw = (unsigned)wid * 1024u;
    const int aoff = lds_byte(wr * 64 + fr, fq * 8), boff = lds_byte(wc * 32 + fr, fq * 8);
#define PG8_SA(b, h) (((b) * 2 + (h)) * HTB)
#define PG8_SB(b, h) ((4 + (b) * 2 + (h)) * HTB)
#define PG8_STAGE(bufoff, gbase, voff) do { _Pragma("unroll") for (int _i = 0; _i < 2; ++_i) \
        __builtin_amdgcn_global_load_lds((const unsigned*)((const char*)(gbase) + (voff)[_i]), (LAS unsigned*)(lds + (bufoff) + ldsw + _i * 8192), 16, 0, 0); } while (0)
#define PG8_LDA(dst, b, h) do { _Pragma("unroll") for (int m = 0; m < 4; ++m) _Pragma("unroll") for (int k = 0; k < 2; ++k) dst[m][k] = *(const LAS bf16x8*)(lds + PG8_SA(b, h) + aoff + m * 2048 + k * 1024); } while (0)
#define PG8_LDB(dst, b, h) do { _Pragma("unroll") for (int n = 0; n < 2; ++n) _Pragma("unroll") for (int k = 0; k < 2; ++k) dst[n][k] = *(const LAS bf16x8*)(lds + PG8_SB(b, h) + boff + n * 2048 + k * 1024); } while (0)
#define PG8_MMA(ai, bj, At, Bt) do { __builtin_amdgcn_s_setprio(1); _Pragma("unroll") for (int m = 0; m < 4; ++m) _Pragma("unroll") for (int n = 0; n < 2; ++n) _Pragma("unroll") for (int k = 0; k < 2; ++k) \
        acc[ai][bj][m][n] = __builtin_amdgcn_mfma_f32_16x16x32_bf16(Bt[n][k], At[m][k], acc[ai][bj][m][n], 0, 0, 0); __builtin_amdgcn_s_setprio(0); } while (0)
#define PG8_WAIT_V(n) asm volatile("s_waitcnt vmcnt(" #n ")" ::: "memory")
#define PG8_WAIT_L(n) asm volatile("s_waitcnt lgkmcnt(" #n ")" ::: "memory")
#define PG8_BAR __builtin_amdgcn_s_barrier()
#define PG8_SCHED __builtin_amdgcn_sched_barrier(0)
    Unit cur, nxt; int ui = 0;
    if (!S.next(0, cur)) return;
    f32x4 acc[2][2][4][2];
#pragma unroll
    for (int a = 0; a < 2; ++a)
#pragma unroll
        for (int b = 0; b < 2; ++b)
#pragma unroll
            for (int m = 0; m < 4; ++m)
#pragma unroll
                for (int n = 0; n < 2; ++n) acc[a][b][m][n] = (f32x4){0.f, 0.f, 0.f, 0.f};
    bf16x8 At[4][2], B0[2][2], B1[2][2];
    const char* cA = (const char*)g.A + (size_t)cur.pm * tstepA + (size_t)cur.z * g.az; const char* cB = (const char*)g.Bt + (size_t)cur.pn * tstepB + (size_t)cur.z * g.bz;
    PG8_STAGE(PG8_SB(0, 0), cB, voffB); PG8_STAGE(PG8_SB(0, 1), cB + hstepB, voffB); PG8_STAGE(PG8_SA(0, 0), cA, voffA); PG8_STAGE(PG8_SA(0, 1), cA + hstepA, voffA);
    if (wr == 1) PG8_BAR;
    PG8_WAIT_V(2); PG8_BAR;
    PG8_STAGE(PG8_SB(1, 0), cB + kstep, voffB); PG8_STAGE(PG8_SA(1, 0), cA + kstep, voffA); PG8_STAGE(PG8_SB(1, 1), cB + hstepB + kstep, voffB);
    PG8_WAIT_V(6); PG8_BAR;
    for (;;) {
        const bool has_next = S.next(ui + 1, nxt);
        const char* nA = has_next ? (const char*)g.A + (size_t)nxt.pm * tstepA + (size_t)nxt.z * g.az : cA;
        const char* nB = has_next ? (const char*)g.Bt + (size_t)nxt.pn * tstepB + (size_t)nxt.z * g.bz : cB;
        for (int t = 0; t < nt; t += 2) {
            const bool last = (t == nt - 2);
            const char* a1 = cA + (size_t)(t + 1) * kstep;
            const char* a2 = last ? nA : cA + (size_t)(t + 2) * kstep; const char* b2 = last ? nB : cB + (size_t)(t + 2) * kstep;
            const char* a3 = a2 + kstep; const char* b3 = b2 + kstep;
            PG8_LDB(B0, 0, 0); PG8_LDB(B1, 0, 1); PG8_SCHED; PG8_LDA(At, 0, 0); PG8_STAGE(PG8_SA(1, 1), a1 + hstepA, voffA);
            PG8_WAIT_V(8); PG8_WAIT_L(0); PG8_BAR; PG8_MMA(0, 0, At, B0); PG8_MMA(0, 1, At, B1); PG8_BAR; PG8_SCHED;
            PG8_LDA(At, 0, 1); PG8_STAGE(PG8_SB(0, 0), b2, voffB); PG8_STAGE(PG8_SB(0, 1), b2 + hstepB, voffB); PG8_STAGE(PG8_SA(0, 0), a2, voffA);
            PG8_WAIT_V(8); PG8_WAIT_L(0); PG8_BAR; PG8_MMA(1, 0, At, B0); PG8_MMA(1, 1, At, B1); PG8_BAR; PG8_SCHED;
            PG8_LDB(B0, 1, 0); PG8_LDB(B1, 1, 1); PG8_SCHED; PG8_LDA(At, 1, 0); PG8_STAGE(PG8_SA(0, 1), a2 + hstepA, voffA);
            PG8_WAIT_V(8); PG8_WAIT_L(0); PG8_BAR; PG8_MMA(0, 0, At, B0); PG8_MMA(0, 1, At, B1); PG8_BAR; PG8_SCHED;
            PG8_LDA(At, 1, 1); PG8_STAGE(PG8_SB(1, 0), b3, voffB); PG8_STAGE(PG8_SB(1, 1), b3 + hstepB, voffB); PG8_STAGE(PG8_SA(1, 0), a3, voffA);
            PG8_WAIT_V(8); PG8_WAIT_L(0); PG8_BAR; PG8_MMA(1, 0, At, B0); PG8_MMA(1, 1, At, B1); PG8_BAR; PG8_SCHED;
        }
        if (wr == 0) PG8_BAR;
        E(acc, cur, wr, wc, fr, fq);
        if (!has_next) break;
        if (!E.keep(cur)) {
#pragma unroll
            for (int a = 0; a < 2; ++a)
#pragma unroll
                for (int b = 0; b < 2; ++b)
#pragma unroll
                    for (int m = 0; m < 4; ++m)
#pragma unroll
                        for (int n = 0; n < 2; ++n) acc[a][b][m][n] = (f32x4){0.f, 0.f, 0.f, 0.f};
        }
        cur = nxt; cA = nA; cB = nB; ++ui;
        if (wr == 1) PG8_BAR;
    }
    PG8_WAIT_V(0);
    PG8_BAR;
#undef PG8_SA
#undef PG8_SB
#undef PG8_STAGE
#undef PG8_LDA
#undef PG8_LDB
#undef PG8_MMA
#undef PG8_WAIT_V
#undef PG8_WAIT_L
#undef PG8_BAR
#undef PG8_SCHED
}
}
typedef pg8::Unit Unit;
typedef f32x4 AccT[2][2][4][2];

struct EpiProjA {
    static constexpr bool PERM = true;
    bf16_t* O; const float* rstd;
    __device__ __forceinline__ bool keep(const Unit&) const { return false; }
    template <bool ACT> __device__ __forceinline__ void run(AccT& acc, const Unit& u, int wr, int wc, int fr, int fq) const {
        const int row0 = u.pm * 256 + wr * 64 + fr, col0 = u.pn * 256 + wc * 32 + 8 * fq;
        float rs[2][4];
#pragma unroll
        for (int ai = 0; ai < 2; ++ai)
#pragma unroll
            for (int m = 0; m < 4; ++m) rs[ai][m] = rstd[row0 + ai * 128 + m * 16];
#pragma unroll
        for (int ai = 0; ai < 2; ++ai)
#pragma unroll
            for (int m = 0; m < 4; ++m) { const int row = row0 + ai * 128 + m * 16; bf16_t* rowp = O + (size_t)row * NA + col0;
#pragma unroll
                for (int bj = 0; bj < 2; ++bj) { f32x4 v0 = acc[ai][bj][m][0] * rs[ai][m], v1 = acc[ai][bj][m][1] * rs[ai][m];
                    if (ACT) {
#pragma unroll
                        for (int j = 0; j < 4; ++j) { v0[j] = gelu_tanh(v0[j]); v1[j] = gelu_tanh(v1[j]); } }
                    u32x4 w; w.x = cvt_pk_bf16(v0[0], v0[1]); w.y = cvt_pk_bf16(v0[2], v0[3]); w.z = cvt_pk_bf16(v1[0], v1[1]); w.w = cvt_pk_bf16(v1[2], v1[3]);
                    *(u32x4*)(rowp + bj * 128) = w; } }
    }
    __device__ __forceinline__ void operator()(AccT& acc, const Unit& u, int wr, int wc, int fr, int fq) const {
        if (u.pn >= 5) run<true>(acc, u, wr, wc, fr, fq); else run<false>(acc, u, wr, wc, fr, fq);
    }
};
struct EpiGates {
    static constexpr bool PERM = true;
    unsigned char* O; const float* rstd; const float* bias;
    __device__ __forceinline__ bool keep(const Unit&) const { return false; }
    __device__ __forceinline__ void operator()(AccT& acc, const Unit& u, int wr, int wc, int fr, int fq) const {
        const int row0 = u.pm * 256 + wr * 64 + fr, col0 = u.pn * 256 + wc * 32 + 8 * fq;
        f32x4 bv[2][2];
#pragma unroll
        for (int bj = 0; bj < 2; ++bj)
#pragma unroll
            for (int n = 0; n < 2; ++n) bv[bj][n] = *(const f32x4*)(bias + col0 + bj * 128 + 4 * n);
        unsigned char* tile = O + (size_t)(u.pm * (NG / 256) + u.pn) * 65536 + (wr * 64 + fr) * 256 + wc * 32 + 8 * fq;
        float rsv[2][4];
#pragma unroll
        for (int ai = 0; ai < 2; ++ai)
#pragma unroll
            for (int m = 0; m < 4; ++m) rsv[ai][m] = rstd[row0 + ai * 128 + m * 16];
#pragma unroll
        for (int ai = 0; ai < 2; ++ai)
#pragma unroll
            for (int m = 0; m < 4; ++m) { const float rs = rsv[ai][m]; unsigned wq[4];
#pragma unroll
                for (int bj = 0; bj < 2; ++bj) { f32x4 v0 = acc[ai][bj][m][0] * rs + bv[bj][0], v1 = acc[ai][bj][m][1] * rs + bv[bj][1];
                    unsigned q[8];
#pragma unroll
                    for (int j = 0; j < 4; ++j) { q[j] = (unsigned)(sigmoidf_(v0[j]) * 255.0f + 0.5f); q[4 + j] = (unsigned)(sigmoidf_(v1[j]) * 255.0f + 0.5f); }
                    wq[2 * bj] = q[0] | (q[1] << 8) | (q[2] << 16) | (q[3] << 24); wq[2 * bj + 1] = q[4] | (q[5] << 8) | (q[6] << 16) | (q[7] << 24); }
                *(u32x4*)(O + (size_t)0 * 1048576 + (size_t)(u.pm * (NG / 256) + u.pn) * 65536 + (ai * 4 + m) * 8192 + (((wr * 4 + wc) * 64) + fq * 16 + fr) * 16) = (u32x4){wq[0], wq[1], wq[2], wq[3]}; }
    }
};
struct EpiMerge {
    static constexpr bool PERM = true;
    const unsigned char* gates; bf16_t* O; int cheap;
    __device__ __forceinline__ bool keep(const Unit& u) const { return u.z < 2; }
    static __device__ __forceinline__ void unpack8(const u32x2 a, float (&f)[8]) {
        f[0] = (float)(a.x & 255u); f[1] = (float)((a.x >> 8) & 255u); f[2] = (float)((a.x >> 16) & 255u); f[3] = (float)(a.x >> 24);
        f[4] = (float)(a.y & 255u); f[5] = (float)((a.y >> 8) & 255u); f[6] = (float)((a.y >> 16) & 255u); f[7] = (float)(a.y >> 24); }
    __device__ __forceinline__ void operator()(AccT& acc, const Unit& u, int wr, int wc, int fr, int fq) const {
        const int z = u.z;
        if (cheap && z < 2) return;
        constexpr int GTS = 4 * 65536;
        const __amdgpu_buffer_rsrc_t gr = __builtin_amdgcn_make_buffer_rsrc(const_cast<unsigned char*>(gates) + (size_t)0 * 1048576, 0, NTOK * NG, 0x00020000);
        const __amdgpu_buffer_rsrc_t orr = __builtin_amdgcn_make_buffer_rsrc(O, 0, NTOK * DM * 2, 0x00020000);
        const int gsoff = (u.pm * (NG / 256) + u.pn) * 65536 + z * GTS, gsoffb = gsoff + (z < 2 ? GTS : 0);
        const int lofs = (((wr * 4 + wc) * 64) + fq * 16 + fr) * 16;
        const int osoff = (u.pm * 256 * DM + u.pn * 256) * 2, oofs = ((wr * 64 + fr) * DM + wc * 32 + 8 * fq) * 2;
        const float lo = (z == 0) ? 0.0f : 0.5f; const bool last = (z == 2);
#pragma unroll
        for (int aq = 0; aq < 4; ++aq) { const int ai = aq >> 1, m0 = (aq & 1) * 2; u32x2 A[2][2], B[2][2];
#pragma unroll
            for (int mm = 0; mm < 2; ++mm)
#pragma unroll
                for (int bj = 0; bj < 2; ++bj) { A[mm][bj] = __builtin_amdgcn_raw_buffer_load_b64(gr, lofs + bj * 8, gsoff + (ai * 4 + (m0 + mm)) * 8192, 0);
                    B[mm][bj] = __builtin_amdgcn_raw_buffer_load_b64(gr, lofs + bj * 8, gsoffb + (ai * 4 + (m0 + mm)) * 8192, 0); }
#pragma unroll
            for (int mm = 0; mm < 2; ++mm)
#pragma unroll
                for (int bj = 0; bj < 2; ++bj) { const int m = m0 + mm; float fa[8], fb[8]; unpack8(A[mm][bj], fa); unpack8(B[mm][bj], fb);
                    float f[8];
#pragma unroll
                    for (int j = 0; j < 8; ++j) { const float den = last ? 255.0f : fmaxf(fb[j], 0.5f); f[j] = fmaxf(fa[j], lo) * __builtin_amdgcn_rcpf(den); }
                    f32x4 v0 = acc[ai][bj][m][0], v1 = acc[ai][bj][m][1];
                    v0[0] *= f[0]; v0[1] *= f[1]; v0[2] *= f[2]; v0[3] *= f[3]; v1[0] *= f[4]; v1[1] *= f[5]; v1[2] *= f[6]; v1[3] *= f[7];
                    acc[ai][bj][m][0] = v0; acc[ai][bj][m][1] = v1;
                    if (last) { u32x4 w; w.x = cvt_pk_bf16(v0[0], v0[1]); w.y = cvt_pk_bf16(v0[2], v0[3]); w.z = cvt_pk_bf16(v1[0], v1[1]); w.w = cvt_pk_bf16(v1[2], v1[3]);
                        __builtin_amdgcn_raw_buffer_store_b128(w, orr, oofs + bj * 256, osoff + (ai * 128 + m * 16) * DM * 2, 0); } }
        }
    }
};
struct EpiResid {
    static constexpr bool PERM = true;
    bf16_t* X; float* rowsq; bf16_t* XO;
    __device__ __forceinline__ bool keep(const Unit&) const { return false; }
    __device__ __forceinline__ void operator()(AccT& acc, const Unit& u, int wr, int wc, int fr, int fq) const {
        const int row0 = u.pm * 256 + wr * 64 + fr, col0 = u.pn * 256 + wc * 32 + 8 * fq;
#pragma unroll
        for (int ai = 0; ai < 2; ++ai)
#pragma unroll
            for (int m = 0; m < 4; ++m) { const int row = row0 + ai * 128 + m * 16; bf16_t* rowp = X + (size_t)row * DM + col0; float ss = 0.f;
#pragma unroll
                for (int bj = 0; bj < 2; ++bj) { const u32x4 x = *(const u32x4*)(rowp + bj * 128);
                    f32x4 v0 = acc[ai][bj][m][0], v1 = acc[ai][bj][m][1];
                    v0[0] += bf_lo(x.x); v0[1] += bf_hi(x.x); v0[2] += bf_lo(x.y); v0[3] += bf_hi(x.y); v1[0] += bf_lo(x.z); v1[1] += bf_hi(x.z); v1[2] += bf_lo(x.w); v1[3] += bf_hi(x.w);
                    ss += (v0[0] * v0[0] + v0[1] * v0[1]) + (v0[2] * v0[2] + v0[3] * v0[3]) + (v1[0] * v1[0] + v1[1] * v1[1]) + (v1[2] * v1[2] + v1[3] * v1[3]);
                    u32x4 w; w.x = cvt_pk_bf16(v0[0], v0[1]); w.y = cvt_pk_bf16(v0[2], v0[3]); w.z = cvt_pk_bf16(v1[0], v1[1]); w.w = cvt_pk_bf16(v1[2], v1[3]);
                    *(u32x4*)(XO + (size_t)row * DM + col0 + bj * 128) = w; }
                ss += __shfl_xor(ss, 16); ss += __shfl_xor(ss, 32);
                if (fq == 0) rowsq[(size_t)row * 16 + u.pn * 4 + wc] = ss; }
    }
};
struct EpiScores {
    static constexpr bool PERM = true;
    bf16_t* C;
    __device__ __forceinline__ bool keep(const Unit&) const { return false; }
    __device__ __forceinline__ void operator()(AccT& acc, const Unit& u, int wr, int wc, int fr, int fq) const {
        const int row0 = u.pm * 256 + wr * 64 + fr, col0 = u.pn * 256 + wc * 32 + 8 * fq;
#pragma unroll
        for (int ai = 0; ai < 2; ++ai)
#pragma unroll
            for (int m = 0; m < 4; ++m) { bf16_t* rowp = C + (size_t)(row0 + ai * 128 + m * 16) * PQ + col0;
#pragma unroll
                for (int bj = 0; bj < 2; ++bj) { const f32x4 v0 = acc[ai][bj][m][0], v1 = acc[ai][bj][m][1];
                    u32x4 w; w.x = cvt_pk_bf16(v0[0], v0[1]); w.y = cvt_pk_bf16(v0[2], v0[3]); w.z = cvt_pk_bf16(v1[0], v1[1]); w.w = cvt_pk_bf16(v1[2], v1[3]);
                    *(u32x4*)(rowp + bj * 128) = w; } }
    }
};

struct Params {
    const float* in[22];
    float* out; unsigned char* ws;
    int ph_lo, ph_hi, li, pad;
    int rep[12];
};
enum { I_X = 0, I_RELB, I_FGAIN, I_AGAIN, I_WIN, I_BGATE, I_SINK, I_WPOOL, I_PSCALE, I_VGAIN, I_WSP, I_BSP, I_WA, I_WB, I_WC, I_WOUT, I_FFGAIN, I_WQ, I_K1, I_K2, I_EU, I_EV };

struct Frame { LAS unsigned char* lds; int tid, lane, wave, G, vcu; };
__device__ __forceinline__ int tid_from_wave(int wave) { unsigned ones; asm volatile("s_mov_b32 %0, -1" : "=s"(ones));
    int t = (wave << 6) | (int)__builtin_amdgcn_mbcnt_hi(ones, __builtin_amdgcn_mbcnt_lo(ones, 0u)); asm volatile("" : "+v"(t)); return t; }
__device__ __forceinline__ Frame local_frame(const Frame& F0) { Frame F = F0; const int t = tid_from_wave(F0.wave); F.tid = t; F.lane = t & 63; return F; }

__device__ __forceinline__ void p0_transpose_item(const float* W, int N, bf16_t* WT, int ldo, const float* kscale, LAS float* scr, int item, int lane) {
    const int nblk = N / 32, kb = item / nblk, nb = item % nblk, k0 = 64 * kb, n0 = 32 * nb;
#pragma unroll 8
    for (int i = 0; i < 32; ++i) { const int kk = 2 * i + (lane >> 5); float v = W[(size_t)(k0 + kk) * N + n0 + (lane & 31)]; if (kscale) v *= kscale[k0 + kk]; scr[kk * 33 + (lane & 31)] = v; }
    asm volatile("s_waitcnt lgkmcnt(0)" ::: "memory");
    const int c = lane & 7;
#pragma unroll
    for (int j = 0; j < 4; ++j) { const int n = (lane >> 3) + 8 * j; const LAS float* s = scr + (8 * c) * 33 + n;
        u32x4 o; o.x = cvt_pk_bf16(s[0 * 33], s[1 * 33]); o.y = cvt_pk_bf16(s[2 * 33], s[3 * 33]); o.z = cvt_pk_bf16(s[4 * 33], s[5 * 33]); o.w = cvt_pk_bf16(s[6 * 33], s[7 * 33]);
        *(u32x4*)(WT + (size_t)(n0 + n) * ldo + k0 + 8 * c) = o; }
    asm volatile("s_waitcnt lgkmcnt(0)" ::: "memory");
}
__device__ __forceinline__ void convert_experts(const Params& p, const Frame& F) {
    const int gw = blockIdx.x * NWAVES + F.wave, NGW = F.G * NWAVES, lane = F.lane;
    constexpr int RB = 4;
    for (int r0 = gw * RB; r0 < DEPTH * 2 * NEXP; r0 += NGW * RB) {
        f32x4 v[RB][4];
#pragma unroll
        for (int q = 0; q < RB; ++q) { const int r = r0 + q; const int l = r / (2 * NEXP), tb = (r / NEXP) & 1, row = r % NEXP;
            const float* src = (tb ? p.in[I_EV] : p.in[I_EU]) + ((size_t)l * NEXP + row) * DM + lane * 16;
            v[q][0] = *(const f32x4*)src; v[q][1] = *(const f32x4*)(src + 4); v[q][2] = *(const f32x4*)(src + 8); v[q][3] = *(const f32x4*)(src + 12); }
#pragma unroll
        for (int q = 0; q < RB; ++q) { const int r = r0 + q; const int l = r / (2 * NEXP), tb = (r / NEXP) & 1, row = r % NEXP;
            float mx = 0.f;
#pragma unroll
            for (int j = 0; j < 4; ++j) mx = fmaxf(mx, fmaxf(fmaxf(fabsf(v[q][j][0]), fabsf(v[q][j][1])), fmaxf(fabsf(v[q][j][2]), fabsf(v[q][j][3]))));
#pragma unroll
            for (int o = 1; o < 64; o <<= 1) mx = fmaxf(mx, __shfl_xor(mx, o));
            const float inv = mx > 0.f ? 448.0f / mx : 0.f;
            int w[4];
#pragma unroll
            for (int j = 0; j < 4; ++j) { w[j] = 0; w[j] = __builtin_amdgcn_cvt_pk_fp8_f32(v[q][j][0] * inv, v[q][j][1] * inv, w[j], false); w[j] = __builtin_amdgcn_cvt_pk_fp8_f32(v[q][j][2] * inv, v[q][j][3] * inv, w[j], true); }
            *(u32x4*)(p.ws + WS_EXP + (((size_t)l * 2 + tb) * NEXP + row) * DM + lane * 16) = (u32x4){(unsigned)w[0], (unsigned)w[1], (unsigned)w[2], (unsigned)w[3]};
            if (lane == 0) ((float*)(p.ws + WS_ESCALE))[((size_t)l * NEXP + row) * 2 + tb] = mx * (1.0f / 448.0f); }
    }
}
__device__ __forceinline__ void phase_prologue(const Params& p, const Frame& F0) {
    const Frame F = local_frame(F0);
    const int gw = F.vcu * NWAVES + F.wave, NGW = F.G * NWAVES, lane = F.lane;
    LAS float* scr = (LAS float*)(F.lds + F.wave * 16384);
    constexpr int I_IN = (DM / 64) * (NIN / 32), I_BR = (512 / 64) * (DM / 32), I_OUT = (DM / 64) * (DM / 32);
    constexpr int PER_L = I_IN + 2 * I_BR + I_OUT;
    for (int it = gw; it < DEPTH * PER_L; it += NGW) {
        const int l = it / PER_L; int r = it % PER_L;
        if (r < I_IN) { p0_transpose_item(p.in[I_WIN] + (size_t)l * DM * NIN, NIN, (bf16_t*)(p.ws + WS_WTIN) + (size_t)l * NIN * DM, DM, p.in[I_AGAIN] + l * DM, scr, r, lane); continue; } r -= I_IN;
        if (r < I_BR) { p0_transpose_item(p.in[I_WA] + (size_t)l * 512 * DM, DM, (bf16_t*)(p.ws + WS_WTBR) + (size_t)(l * 3 + 0) * DM * 512, 512, nullptr, scr, r, lane); continue; } r -= I_BR;
        if (r < I_BR) { p0_transpose_item(p.in[I_WC] + (size_t)l * 512 * DM, DM, (bf16_t*)(p.ws + WS_WTBR) + (size_t)(l * 3 + 2) * DM * 512, 512, nullptr, scr, r, lane); continue; } r -= I_BR;
        p0_transpose_item(p.in[I_WOUT] + (size_t)l * DM * DM, DM, (bf16_t*)(p.ws + WS_WTOUT) + (size_t)l * DM * DM, DM, nullptr, scr, r, lane);
    }
    {
        float* rstd = (float*)(p.ws + WS_RSTD);
        for (int m0 = gw * 4; m0 < NTOK; m0 += NGW * 4) {
            f32x4 v[4][4];
#pragma unroll
            for (int q = 0; q < 4; ++q) { const f32x4* xr = (const f32x4*)(p.in[I_X] + (size_t)(m0 + q) * DM) + lane;
#pragma unroll
                for (int j = 0; j < 4; ++j) v[q][j] = xr[64 * j]; }
#pragma unroll
            for (int q = 0; q < 4; ++q) { float s = 0.f;
#pragma unroll
                for (int j = 0; j < 4; ++j) s += (v[q][j][0] * v[q][j][0] + v[q][j][1] * v[q][j][1]) + (v[q][j][2] * v[q][j][2] + v[q][j][3] * v[q][j][3]);
                s = wave_sum(s);
                u32x2* o = (u32x2*)((bf16_t*)(p.ws + WS_XB) + (size_t)(m0 + q) * DM) + lane;
#pragma unroll
                for (int j = 0; j < 4; ++j) { u32x2 w; w.x = cvt_pk_bf16(v[q][j][0], v[q][j][1]); w.y = cvt_pk_bf16(v[q][j][2], v[q][j][3]); o[64 * j] = w; }
                if (lane == 0) rstd[m0 + q] = 1.0f / sqrtf(s * (1.0f / DM) + EPS); }
        }
    }
    for (int i = blockIdx.x * NTHREADS + F.tid; i < DEPTH * 4 * 128 * 128; i += F.G * NTHREADS) { const int t = (i >> 7) & 127, s = i & 127;
        ((bf16_t*)(p.ws + WS_WSP))[i] = (bf16_t)(cvt_pk_bf16(s <= t ? p.in[I_WSP][i] : 0.f, 0.f) & 0xffffu); }
    convert_experts(p, F);
    __syncthreads();
    {
        LAS float* coef = (LAS float*)F.lds;
        for (int u = blockIdx.x; u < DEPTH * 4 * 32; u += F.G) {
            const int l = u / 128, g = (u / 32) % 4, c0 = (u % 32) * 4;
            __syncthreads();
            for (int i = F.tid; i < 512; i += NTHREADS) { const int cc = i >> 7, j = i & 127;
                coef[i] = p.in[I_WPOOL][(((size_t)l * 4 + g) * 128 + c0 + cc) * 128 + j] * p.in[I_PSCALE][l * 512 + g * 128 + j]; }
            __syncthreads();
            const float* wb = p.in[I_WB] + ((size_t)l * 512 + g * 128) * DM;
            float a0[4], a1[4];
#pragma unroll
            for (int cc = 0; cc < 4; ++cc) { a0[cc] = 0.f; a1[cc] = 0.f; }
#pragma unroll 4
            for (int j = 0; j < 128; ++j) { const float w0 = wb[(size_t)j * DM + F.tid], w1 = wb[(size_t)j * DM + F.tid + 512];
#pragma unroll
                for (int cc = 0; cc < 4; ++cc) { const float cf = coef[cc * 128 + j]; a0[cc] += cf * w0; a1[cc] += cf * w1; } }
            bf16_t* dst = (bf16_t*)(p.ws + WS_WTBR) + (size_t)(l * 3 + 1) * DM * 512 + g * 128 + c0;
            u32x2 w; w.x = cvt_pk_bf16(a0[0], a0[1]); w.y = cvt_pk_bf16(a0[2], a0[3]); *(u32x2*)(dst + (size_t)F.tid * 512) = w;
            u32x2 y; y.x = cvt_pk_bf16(a1[0], a1[1]); y.y = cvt_pk_bf16(a1[2], a1[3]); *(u32x2*)(dst + (size_t)(F.tid + 512) * 512) = y;
        }
    }
    {
        const int fr = F.lane & 15, fq = F.lane >> 4;
        for (int u = blockIdx.x; u < DEPTH * 16 * 16; u += F.G) {
            const int l = u / 256, s = (u / 16) % 16, c0 = (u % 16) * 64;
            const float* keys = ((s & 1) ? p.in[I_K2] : p.in[I_K1]) + (size_t)l * 128 * 128 + (size_t)(16 * F.wave + fr) * 128 + 8 * fq;
            const float* wq = p.in[I_WQ] + (size_t)l * DM * PQ + (size_t)(c0 + fr) * PQ + s * 128 + 8 * fq;
            f32x4 acc[4];
#pragma unroll
            for (int ct = 0; ct < 4; ++ct) acc[ct] = (f32x4){0.f, 0.f, 0.f, 0.f};
#pragma unroll
            for (int ks = 0; ks < 4; ++ks) {
                const f32x4 k0 = *(const f32x4*)(keys + 32 * ks), k1 = *(const f32x4*)(keys + 32 * ks + 4);
                u32x4 kb; kb.x = cvt_pk_bf16(k0[0], k0[1]); kb.y = cvt_pk_bf16(k0[2], k0[3]); kb.z = cvt_pk_bf16(k1[0], k1[1]); kb.w = cvt_pk_bf16(k1[2], k1[3]);
#pragma unroll
                for (int ct = 0; ct < 4; ++ct) { const float* wp = wq + (size_t)(16 * ct) * PQ + 32 * ks; const f32x4 w0 = *(const f32x4*)wp, w1 = *(const f32x4*)(wp + 4);
                    u32x4 wb; wb.x = cvt_pk_bf16(w0[0], w0[1]); wb.y = cvt_pk_bf16(w0[2], w0[3]); wb.z = cvt_pk_bf16(w1[0], w1[1]); wb.w = cvt_pk_bf16(w1[2], w1[3]);
                    acc[ct] = __builtin_amdgcn_mfma_f32_16x16x32_bf16(__builtin_bit_cast(bf16x8, wb), __builtin_bit_cast(bf16x8, kb), acc[ct], 0, 0, 0); }
            }
            bf16_t* dst = (bf16_t*)(p.ws + WS_WEFF) + ((size_t)l * PQ + s * 128 + 16 * F.wave + fr) * DM + c0 + 4 * fq;
#pragma unroll
            for (int ct = 0; ct < 4; ++ct) { const f32x4 gn = *(const f32x4*)(p.in[I_FFGAIN] + l * DM + c0 + 16 * ct + 4 * fq);
                u32x2 w; w.x = cvt_pk_bf16(acc[ct][0] * gn[0], acc[ct][1] * gn[1]); w.y = cvt_pk_bf16(acc[ct][2] * gn[2], acc[ct][3] * gn[3]); *(u32x2*)(dst + 16 * ct) = w; }
        }
    }
}

__device__ __forceinline__ int t5_bucket(int n) {
    if (n < 16) return n;
    const float v = logf((float)n / 16.0f) / 2.0794415416798357f * 16.0f;
    const int b = 16 + (int)v; return b < 31 ? b : 31;
}
__device__ __forceinline__ void phase_mix_simple(const Params& p, const Frame& F0, int l) {
    const Frame F = local_frame(F0);
    const int tid = F.tid, lane = F.lane, wave = F.wave;
    LAS float* Kf = (LAS float*)F.lds;
    LAS float* Vf = Kf + 256 * 64;
    LAS float* biasT = Vf + 256 * 64;
    LAS float* rs = biasT + 1024;
    const bf16_t* proj = (const bf16_t*)(p.ws + WS_PROJA);
    bf16_t* mix = (bf16_t*)p.out;
    for (int nb = blockIdx.x; nb < NTOK / 128; nb += F.G) {
        const int t0 = nb * 128; const bool first = (nb % (SEQ / 128)) == 0;
        __syncthreads();
        for (int i = tid; i < 1024; i += NTHREADS) { const int h = i >> 7, dist = i & 127; biasT[i] = p.in[I_RELB][t5_bucket(dist) * 8 + h]; }
        for (int kvh = 0; kvh < 2; ++kvh) {
            __syncthreads();
            for (int c = tid; c < 2048; c += NTHREADS) { const int row = c >> 3, ch = c & 7; const int tok = t0 - 128 + row;
                u32x4 kv = (u32x4){0u, 0u, 0u, 0u}, vv = (u32x4){0u, 0u, 0u, 0u};
                if (row >= 128 || !first) { kv = *(const u32x4*)(proj + (size_t)tok * NA + COL_K + kvh * 64 + ch * 8); vv = *(const u32x4*)(proj + (size_t)tok * NA + COL_V + kvh * 64 + ch * 8); }
                LAS float* kd = Kf + row * 64 + ch * 8; LAS float* vd = Vf + row * 64 + ch * 8;
                kd[0] = bf_lo(kv.x); kd[1] = bf_hi(kv.x); kd[2] = bf_lo(kv.y); kd[3] = bf_hi(kv.y); kd[4] = bf_lo(kv.z); kd[5] = bf_hi(kv.z); kd[6] = bf_lo(kv.w); kd[7] = bf_hi(kv.w);
                vd[0] = bf_lo(vv.x); vd[1] = bf_hi(vv.x); vd[2] = bf_lo(vv.y); vd[3] = bf_hi(vv.y); vd[4] = bf_lo(vv.z); vd[5] = bf_hi(vv.z); vd[6] = bf_lo(vv.w); vd[7] = bf_hi(vv.w); }
            __syncthreads();
            const int hq = tid >> 7, qi = tid & 127, head = kvh * 4 + hq;
            float q[64], o[64];
            { const u32x4* qp = (const u32x4*)(proj + (size_t)(t0 + qi) * NA + head * 64);
#pragma unroll
              for (int j = 0; j < 8; ++j) { const u32x4 w = qp[j]; q[8 * j + 0] = bf_lo(w.x) * 0.125f; q[8 * j + 1] = bf_hi(w.x) * 0.125f; q[8 * j + 2] = bf_lo(w.y) * 0.125f; q[8 * j + 3] = bf_hi(w.y) * 0.125f;
                  q[8 * j + 4] = bf_lo(w.z) * 0.125f; q[8 * j + 5] = bf_hi(w.z) * 0.125f; q[8 * j + 6] = bf_lo(w.w) * 0.125f; q[8 * j + 7] = bf_hi(w.w) * 0.125f; } }
#pragma unroll
            for (int d = 0; d < 64; ++d) o[d] = 0.f;
            const float sink = p.in[I_SINK][l * 8 + head];
            float mrun = sink, lsum = 0.f;
            const int qb = qi & ~63, kmin = qb + 1, kmax = qb + 63 + 128;
            for (int kj = kmin; kj <= kmax; ++kj) {
                const LAS float* kr = Kf + kj * 64; float s = 0.f;
#pragma unroll
                for (int d4 = 0; d4 < 16; ++d4) { const f32x4 k4 = *(const LAS f32x4*)(kr + d4 * 4); s += (q[4 * d4] * k4[0] + q[4 * d4 + 1] * k4[1]) + (q[4 * d4 + 2] * k4[2] + q[4 * d4 + 3] * k4[3]); }
                const int dist = qi + 128 - kj; const bool valid = (dist >= 0) && (dist < 128) && (kj >= 128 || !first);
                const float logit = s + biasT[head * 128 + (dist & 127)];
                const float mnew = valid ? fmaxf(mrun, logit) : mrun;
                const float corr = __expf(mrun - mnew), pp = valid ? __expf(logit - mnew) : 0.f;
                lsum = lsum * corr + pp; mrun = mnew;
                const LAS float* vr = Vf + kj * 64;
#pragma unroll
                for (int d4 = 0; d4 < 16; ++d4) { const f32x4 v4 = *(const LAS f32x4*)(vr + d4 * 4);
                    o[4 * d4] = o[4 * d4] * corr + pp * v4[0]; o[4 * d4 + 1] = o[4 * d4 + 1] * corr + pp * v4[1]; o[4 * d4 + 2] = o[4 * d4 + 2] * corr + pp * v4[2]; o[4 * d4 + 3] = o[4 * d4 + 3] * corr + pp * v4[3]; }
            }
            const float inv = 1.0f / (lsum + __expf(sink - mrun));
            u32x4* op = (u32x4*)(mix + (size_t)(t0 + qi) * MIXW + head * 64);
#pragma unroll
            for (int j = 0; j < 8; ++j) { u32x4 w; w.x = cvt_pk_bf16(o[8 * j] * inv, o[8 * j + 1] * inv); w.y = cvt_pk_bf16(o[8 * j + 2] * inv, o[8 * j + 3] * inv);
                w.z = cvt_pk_bf16(o[8 * j + 4] * inv, o[8 * j + 5] * inv); w.w = cvt_pk_bf16(o[8 * j + 6] * inv, o[8 * j + 7] * inv); op[j] = w; }
        }
        LAS float* Zs = Kf;
        for (int g = 0; g < 4; ++g) {
            const int w = 2 << g;
            __syncthreads();
            for (int i = tid; i < 143 * 16; i += NTHREADS) { const int row = i >> 4, ch = i & 15; const int tok = t0 - 15 + row;
                u32x4 zv = (u32x4){0u, 0u, 0u, 0u};
                if (row >= 15 || !first) zv = *(const u32x4*)(proj + (size_t)tok * NA + COL_PZ + g * 128 + ch * 8);
                LAS float* zd = Zs + row * 128 + ch * 8;
                zd[0] = bf_lo(zv.x); zd[1] = bf_hi(zv.x); zd[2] = bf_lo(zv.y); zd[3] = bf_hi(zv.y); zd[4] = bf_lo(zv.z); zd[5] = bf_hi(zv.z); zd[6] = bf_lo(zv.w); zd[7] = bf_hi(zv.w); }
            __syncthreads();
            const int c = tid & 127, seg = tid >> 7;
            for (int tt = 0; tt < 32; ++tt) { const int t = seg * 32 + tt, r = t + 15; float sum = 0.f;
                for (int j = 0; j < w; ++j) sum += Zs[(r - j) * 128 + c];
                const int pos = (nb % (SEQ / 128)) * 128 + t; const int cnt = (pos + 1 < w) ? pos + 1 : w;
                const float d = sum / (float)cnt - Zs[r * 128 + c];
                mix[(size_t)(t0 + t) * MIXW + 512 + g * 128 + c] = (bf16_t)(cvt_pk_bf16(d, 0.f) & 0xffffu); }
        }
        __syncthreads();
        for (int tt = 0; tt < 16; ++tt) { const int t = wave * 16 + tt; const u32x4 g4 = *(const u32x4*)(proj + (size_t)(t0 + t) * NA + COL_GV + lane * 8);
            float a[8] = {bf_lo(g4.x), bf_hi(g4.x), bf_lo(g4.y), bf_hi(g4.y), bf_lo(g4.z), bf_hi(g4.z), bf_lo(g4.w), bf_hi(g4.w)}; float ss = 0.f;
#pragma unroll
            for (int j = 0; j < 8; ++j) ss += a[j] * a[j];
            ss = wave_sum(ss); if (lane == 0) rs[t] = 1.0f / sqrtf(ss * (1.0f / 512.0f) + EPS); }
        LAS float* Vn = Kf;
        for (int g = 0; g < 4; ++g) {
            __syncthreads();
            for (int i = tid; i < 128 * 16; i += NTHREADS) { const int s = i >> 4, ch = i & 15; const u32x4 g4 = *(const u32x4*)(proj + (size_t)(t0 + s) * NA + COL_GV + g * 128 + ch * 8);
                const float r = rs[s]; const float* gn = p.in[I_VGAIN] + l * 512 + g * 128 + ch * 8; LAS float* vd = Vn + s * 128 + ch * 8;
                vd[0] = bf_lo(g4.x) * r * gn[0]; vd[1] = bf_hi(g4.x) * r * gn[1]; vd[2] = bf_lo(g4.y) * r * gn[2]; vd[3] = bf_hi(g4.y) * r * gn[3];
                vd[4] = bf_lo(g4.z) * r * gn[4]; vd[5] = bf_hi(g4.z) * r * gn[5]; vd[6] = bf_lo(g4.w) * r * gn[6]; vd[7] = bf_hi(g4.w) * r * gn[7]; }
            __syncthreads();
            const int c = tid & 127, tq = tid >> 7;
            for (int t = tq; t < 128; t += 4) { const float* wrow = p.in[I_WSP] + (((size_t)l * 4 + g) * 128 + t) * 128; float acc = 0.f;
                for (int s = 0; s <= t; ++s) acc += wrow[s] * Vn[s * 128 + c];
                const float mixed = acc + p.in[I_BSP][(l * 4 + g) * 128 + t];
                const float uu = bf1(proj[(size_t)(t0 + t) * NA + COL_GU + g * 128 + c]);
                mix[(size_t)(t0 + t) * MIXW + 1024 + g * 128 + c] = (bf16_t)(cvt_pk_bf16(uu * mixed, 0.f) & 0xffffu); }
        }
    }
}

typedef short s16x4 __attribute__((ext_vector_type(4)));
__device__ __forceinline__ void tr_read8(unsigned addrA, unsigned addrB, s16x4 (&lo)[4], s16x4 (&hi)[4]) {
    asm volatile("ds_read_b64_tr_b16 %0, %8\n\tds_read_b64_tr_b16 %1, %8 offset:32\n\tds_read_b64_tr_b16 %2, %8 offset:64\n\tds_read_b64_tr_b16 %3, %8 offset:96\n\t"
                 "ds_read_b64_tr_b16 %4, %9\n\tds_read_b64_tr_b16 %5, %9 offset:32\n\tds_read_b64_tr_b16 %6, %9 offset:64\n\tds_read_b64_tr_b16 %7, %9 offset:96\n\ts_waitcnt lgkmcnt(0)"
                 : "=&v"(lo[0]), "=&v"(lo[1]), "=&v"(lo[2]), "=&v"(lo[3]), "=&v"(hi[0]), "=&v"(hi[1]), "=&v"(hi[2]), "=&v"(hi[3]) : "v"(addrA), "v"(addrB) : "memory");
}
__device__ __forceinline__ void tr_read4(unsigned addrA, s16x4 (&lo)[4]) {
    asm volatile("ds_read_b64_tr_b16 %0, %4\n\tds_read_b64_tr_b16 %1, %4 offset:32\n\tds_read_b64_tr_b16 %2, %4 offset:64\n\tds_read_b64_tr_b16 %3, %4 offset:96\n\ts_waitcnt lgkmcnt(0)"
                 : "=&v"(lo[0]), "=&v"(lo[1]), "=&v"(lo[2]), "=&v"(lo[3]) : "v"(addrA) : "memory");
}
__device__ __forceinline__ bf16x8 cat44(s16x4 a, s16x4 b) { return (bf16x8){a[0], a[1], a[2], a[3], b[0], b[1], b[2], b[3]}; }
constexpr int KVSTR = 144, VNSTR = 272;
__device__ __forceinline__ void phase_mix(const Params& p, const Frame& F0, int l) {
    const Frame F = local_frame(F0);
    const int tid = F.tid, lane = F.lane, wave = F.wave, fr = lane & 15, fq = lane >> 4;
    LAS float* biasT = (LAS float*)(F.lds + 4 * 256 * KVSTR);
    LAS float* rs = biasT + 1024;
    const bf16_t* proj = (const bf16_t*)(p.ws + WS_PROJA);
    bf16_t* mix = (bf16_t*)p.out;
    const float LOG2E = 1.4426950408889634f;
    for (int nb = blockIdx.x; nb < NTOK / 128; nb += F.G) {
        const int t0 = nb * 128; const bool first = (nb % (SEQ / 128)) == 0;
        __syncthreads();
        for (int i = tid; i < 1024; i += NTHREADS) { const int h = i >> 7, dist = i & 127; biasT[i] = p.in[I_RELB][t5_bucket(dist) * 8 + h] * LOG2E; }
        __syncthreads();
        for (int c = tid; c < 4096; c += NTHREADS) { const int kvh = c >> 11, row = (c >> 3) & 255, ch = c & 7; const int tok = t0 - 128 + row;
            u32x4 kv = (u32x4){0u, 0u, 0u, 0u}, vv = (u32x4){0u, 0u, 0u, 0u};
            if (row >= 128 || !first) { kv = *(const u32x4*)(proj + (size_t)tok * NA + COL_K + kvh * 64 + ch * 8); vv = *(const u32x4*)(proj + (size_t)tok * NA + COL_V + kvh * 64 + ch * 8); }
            *(LAS u32x4*)(F.lds + kvh * (512 * KVSTR) + row * KVSTR + ch * 16) = kv; *(LAS u32x4*)(F.lds + kvh * (512 * KVSTR) + 256 * KVSTR + row * KVSTR + ch * 16) = vv; }
        __syncthreads();
        for (int kvh = 0; kvh < 2; ++kvh) {
            LAS unsigned char* Kl = F.lds + kvh * (512 * KVSTR);
            LAS unsigned char* Vl = Kl + 256 * KVSTR;
            const int hq = wave >> 1, qh = wave & 1, head = kvh * 4 + hq;
            float br[9][4];
#pragma unroll
            for (int tt = 0; tt < 9; ++tt)
#pragma unroll
                for (int i = 0; i < 4; ++i) { const int dist = 128 + fr - 4 * fq - 16 * tt - i; br[tt][i] = (dist >= 0 && dist < 128) ? biasT[head * 128 + (dist & 127)] : NEG_INF_F; }
            const float sink2 = p.in[I_SINK][l * 8 + head] * LOG2E;
            const unsigned vbase = (unsigned)(size_t)Vl;
#pragma unroll 1
            for (int r = 0; r < 4; ++r) {
                const int R = qh * 4 + r, q0 = 16 * R;
                bf16x8 qf[2];
#pragma unroll
                for (int s = 0; s < 2; ++s) qf[s] = *(const bf16x8*)(proj + (size_t)(t0 + q0 + fr) * NA + head * 64 + 32 * s + 8 * fq);
                f32x4 sacc[9];
#pragma unroll
                for (int tt = 0; tt < 9; ++tt) { sacc[tt] = (f32x4){0.f, 0.f, 0.f, 0.f};
#pragma unroll
                    for (int s = 0; s < 2; ++s) { const bf16x8 kf = *(const LAS bf16x8*)(Kl + (16 * (R + tt) + fr) * KVSTR + s * 64 + fq * 16);
                        sacc[tt] = __builtin_amdgcn_mfma_f32_16x16x32_bf16(kf, qf[s], sacc[tt], 0, 0, 0); } }
                float mx = sink2;
#pragma unroll
                for (int tt = 0; tt < 9; ++tt) { const bool dead = first && (R + tt < 8);
#pragma unroll
                    for (int i = 0; i < 4; ++i) { const float lg = dead ? NEG_INF_F : (sacc[tt][i] * (0.125f * LOG2E) + br[tt][i]); sacc[tt][i] = lg; mx = fmaxf(mx, lg); } }
                mx = fmaxf(mx, __shfl_xor(mx, 16)); mx = fmaxf(mx, __shfl_xor(mx, 32));
                float ls = 0.f;
#pragma unroll
                for (int tt = 0; tt < 9; ++tt)
#pragma unroll
                    for (int i = 0; i < 4; ++i) { const float pv = __builtin_amdgcn_exp2f(sacc[tt][i] - mx); sacc[tt][i] = pv; ls += pv; }
                ls += __shfl_xor(ls, 16); ls += __shfl_xor(ls, 32);
                const float inv = 1.0f / (ls + __builtin_amdgcn_exp2f(sink2 - mx));
                f32x4 oacc[4];
#pragma unroll
                for (int c = 0; c < 4; ++c) oacc[c] = (f32x4){0.f, 0.f, 0.f, 0.f};
#pragma unroll
                for (int u = 0; u < 5; ++u) {
                    u32x4 pw; pw.x = cvt_pk_bf16(sacc[2 * u][0], sacc[2 * u][1]); pw.y = cvt_pk_bf16(sacc[2 * u][2], sacc[2 * u][3]);
                    if (u < 4) { pw.z = cvt_pk_bf16(sacc[2 * u + 1][0], sacc[2 * u + 1][1]); pw.w = cvt_pk_bf16(sacc[2 * u + 1][2], sacc[2 * u + 1][3]); } else { pw.z = 0u; pw.w = 0u; }
                    const bf16x8 pf = __builtin_bit_cast(bf16x8, pw);
                    const unsigned addrA = vbase + (unsigned)((16 * (R + 2 * u) + 4 * fq + (fr >> 2)) * KVSTR + (4 * (fr & 3)) * 2);
                    s16x4 lo[4], hi[4];
                    if (u < 4) tr_read8(addrA, addrA + 16 * KVSTR, lo, hi);
                    else { tr_read4(addrA, lo);
#pragma unroll
                        for (int c = 0; c < 4; ++c) hi[c] = (s16x4){0, 0, 0, 0}; }
#pragma unroll
                    for (int c = 0; c < 4; ++c) oacc[c] = __builtin_amdgcn_mfma_f32_16x16x32_bf16(cat44(lo[c], hi[c]), pf, oacc[c], 0, 0, 0);
                }
                bf16_t* op = mix + (size_t)(t0 + q0 + fr) * MIXW + head * 64 + 4 * fq;
#pragma unroll
                for (int c = 0; c < 4; ++c) { u32x2 w; w.x = cvt_pk_bf16(oacc[c][0] * inv, oacc[c][1] * inv); w.y = cvt_pk_bf16(oacc[c][2] * inv, oacc[c][3] * inv); *(u32x2*)(op + 16 * c) = w; }
            }
        }
        for (int gp = 0; gp < 2; ++gp) {
            __syncthreads();
            for (int i = tid; i < 2 * 143 * 16; i += NTHREADS) { const int gi = i / (143 * 16), ii = i % (143 * 16), row = ii >> 4, ch = ii & 15; const int tok = t0 - 15 + row, g = 2 * gp + gi;
                u32x4 zv = (u32x4){0u, 0u, 0u, 0u};
                if (row >= 15 || !first) zv = *(const u32x4*)(proj + (size_t)tok * NA + COL_PZ + g * 128 + ch * 8);
                LAS float* zd = (LAS float*)F.lds + gi * (143 * 128) + row * 128 + ch * 8;
                *(LAS f32x4*)zd = (f32x4){bf_lo(zv.x), bf_hi(zv.x), bf_lo(zv.y), bf_hi(zv.y)}; *(LAS f32x4*)(zd + 4) = (f32x4){bf_lo(zv.z), bf_hi(zv.z), bf_lo(zv.w), bf_hi(zv.w)}; }
            __syncthreads();
#pragma unroll 1
            for (int gi = 0; gi < 2; ++gi) { const int g = 2 * gp + gi, w = 2 << g; const LAS float* Zs = (const LAS float*)F.lds + gi * (143 * 128);
                const int c2 = tid & 63, seg = tid >> 6;
                const int tb = seg * 16; float sa = 0.f, sb = 0.f;
                for (int j = 1; j < w; ++j) { const f32x2 z = *(const LAS f32x2*)(Zs + (tb + 15 - j) * 128 + 2 * c2); sa += z[0]; sb += z[1]; }
                const int posb = (nb % (SEQ / 128)) * 128;
                for (int tt = 0; tt < 16; ++tt) { const int t = tb + tt, r = t + 15;
                    const f32x2 z = *(const LAS f32x2*)(Zs + r * 128 + 2 * c2); sa += z[0]; sb += z[1];
                    const int pos = posb + t; const float icnt = 1.0f / (float)((pos + 1 < w) ? pos + 1 : w);
                    *(unsigned*)(mix + (size_t)(t0 + t) * MIXW + 512 + g * 128 + 2 * c2) = cvt_pk_bf16(sa * icnt - z[0], sb * icnt - z[1]);
                    const f32x2 zo = *(const LAS f32x2*)(Zs + (r - w + 1) * 128 + 2 * c2); sa -= zo[0]; sb -= zo[1]; } }
        }
        __syncthreads();
        for (int tt = 0; tt < 16; ++tt) { const int t = wave * 16 + tt; const u32x4 g4 = *(const u32x4*)(proj + (size_t)(t0 + t) * NA + COL_GV + lane * 8);
            const float a[8] = {bf_lo(g4.x), bf_hi(g4.x), bf_lo(g4.y), bf_hi(g4.y), bf_lo(g4.z), bf_hi(g4.z), bf_lo(g4.w), bf_hi(g4.w)}; float ss = 0.f;
#pragma unroll
            for (int j = 0; j < 8; ++j) ss += a[j] * a[j];
            ss = wave_sum(ss); if (lane == 0) rs[t] = 1.0f / sqrtf(ss * (1.0f / 512.0f) + EPS); }
        const bf16_t* Wsp = (const bf16_t*)(p.ws + WS_WSP);
        __syncthreads();
        for (int i = tid; i < 4 * 128 * 16; i += NTHREADS) { const int g = i >> 11, s = (i >> 4) & 127, ch = i & 15; const u32x4 g4 = *(const u32x4*)(proj + (size_t)(t0 + s) * NA + COL_GV + g * 128 + ch * 8);
            const float r = rs[s]; const float* gn = p.in[I_VGAIN] + l * 512 + g * 128 + ch * 8; const f32x4 ga = *(const f32x4*)gn, gb = *(const f32x4*)(gn + 4);
            u32x4 w; w.x = cvt_pk_bf16(bf_lo(g4.x) * r * ga[0], bf_hi(g4.x) * r * ga[1]); w.y = cvt_pk_bf16(bf_lo(g4.y) * r * ga[2], bf_hi(g4.y) * r * ga[3]);
            w.z = cvt_pk_bf16(bf_lo(g4.z) * r * gb[0], bf_hi(g4.z) * r * gb[1]); w.w = cvt_pk_bf16(bf_lo(g4.w) * r * gb[2], bf_hi(g4.w) * r * gb[3]);
            *(LAS u32x4*)(F.lds + g * (128 * VNSTR) + s * VNSTR + ch * 16) = w; }
        __syncthreads();
        for (int g = 0; g < 4; ++g) {
            LAS unsigned char* Vn = F.lds + g * (128 * VNSTR);
            const int T = wave; f32x4 acc[8];
#pragma unroll
            for (int c = 0; c < 8; ++c) acc[c] = (f32x4){0.f, 0.f, 0.f, 0.f};
            const bf16_t* wrow = Wsp + (((size_t)l * 4 + g) * 128 + 16 * T + fr) * 128 + 8 * fq;
            const unsigned vnb = (unsigned)(size_t)Vn;
#pragma unroll 1
            for (int u = 0; u <= (T >> 1); ++u) {
                const bf16x8 wf = *(const bf16x8*)(wrow + 32 * u);
                const unsigned addrA = vnb + (unsigned)((32 * u + 8 * fq + (fr >> 2)) * VNSTR + (4 * (fr & 3)) * 2);
#pragma unroll
                for (int hf = 0; hf < 2; ++hf) { s16x4 lo[4], hi[4]; tr_read8(addrA + hf * 128, addrA + hf * 128 + 4 * VNSTR, lo, hi);
#pragma unroll
                    for (int c = 0; c < 4; ++c) acc[hf * 4 + c] = __builtin_amdgcn_mfma_f32_16x16x32_bf16(cat44(lo[c], hi[c]), wf, acc[hf * 4 + c], 0, 0, 0); }
            }
            const int t = 16 * T + fr; const float bs = p.in[I_BSP][(l * 4 + g) * 128 + t];
            const bf16_t* up = proj + (size_t)(t0 + t) * NA + COL_GU + g * 128 + 4 * fq; bf16_t* op = mix + (size_t)(t0 + t) * MIXW + 1024 + g * 128 + 4 * fq;
#pragma unroll
            for (int c = 0; c < 8; ++c) { const u32x2 uw = *(const u32x2*)(up + 16 * c);
                u32x2 w; w.x = cvt_pk_bf16(bf_lo(uw.x) * (acc[c][0] + bs), bf_hi(uw.x) * (acc[c][1] + bs)); w.y = cvt_pk_bf16(bf_lo(uw.y) * (acc[c][2] + bs), bf_hi(uw.y) * (acc[c][3] + bs));
                *(u32x2*)(op + 16 * c) = w; }
        }
    }
}

__device__ __forceinline__ unsigned ordkey(unsigned bits) { return bits ^ ((unsigned)((int)bits >> 31) | 0x80000000u); }
__device__ __forceinline__ unsigned unord(unsigned k) { return (k & 0x80000000u) ? (k ^ 0x80000000u) : ~k; }
#define TK_SORT16(S) do { { const unsigned h_ = max(S[0], S[1]), l_ = min(S[0], S[1]); S[0] = h_; S[1] = l_; } { const unsigned h_ = max(S[2], S[3]), l_ = min(S[2], S[3]); S[2] = h_; S[3] = l_; } { const unsigned h_ = max(S[0], S[2]), l_ = min(S[0], S[2]); S[0] = h_; S[2] = l_; } { const unsigned h_ = max(S[1], S[3]), l_ = min(S[1], S[3]); S[1] = h_; S[3] = l_; } { const unsigned h_ = max(S[1], S[2]), l_ = min(S[1], S[2]); S[1] = h_; S[2] = l_; } { const unsigned h_ = max(S[4], S[5]), l_ = min(S[4], S[5]); S[4] = h_; S[5] = l_; } { const unsigned h_ = max(S[6], S[7]), l_ = min(S[6], S[7]); S[6] = h_; S[7] = l_; } { const unsigned h_ = max(S[4], S[6]), l_ = min(S[4], S[6]); S[4] = h_; S[6] = l_; } { const unsigned h_ = max(S[5], S[7]), l_ = min(S[5], S[7]); S[5] = h_; S[7] = l_; } { const unsigned h_ = max(S[5], S[6]), l_ = min(S[5], S[6]); S[5] = h_; S[6] = l_; } { const unsigned h_ = max(S[0], S[4]), l_ = min(S[0], S[4]); S[0] = h_; S[4] = l_; } { const unsigned h_ = max(S[2], S[6]), l_ = min(S[2], S[6]); S[2] = h_; S[6] = l_; } { const unsigned h_ = max(S[2], S[4]), l_ = min(S[2], S[4]); S[2] = h_; S[4] = l_; } { const unsigned h_ = max(S[1], S[5]), l_ = min(S[1], S[5]); S[1] = h_; S[5] = l_; } { const unsigned h_ = max(S[3], S[7]), l_ = min(S[3], S[7]); S[3] = h_; S[7] = l_; } { const unsigned h_ = max(S[3], S[5]), l_ = min(S[3], S[5]); S[3] = h_; S[5] = l_; } { const unsigned h_ = max(S[1], S[2]), l_ = min(S[1], S[2]); S[1] = h_; S[2] = l_; } { const unsigned h_ = max(S[3], S[4]), l_ = min(S[3], S[4]); S[3] = h_; S[4] = l_; } { const unsigned h_ = max(S[5], S[6]), l_ = min(S[5], S[6]); S[5] = h_; S[6] = l_; } { const unsigned h_ = max(S[8], S[9]), l_ = min(S[8], S[9]); S[8] = h_; S[9] = l_; } { const unsigned h_ = max(S[10], S[11]), l_ = min(S[10], S[11]); S[10] = h_; S[11] = l_; } { const unsigned h_ = max(S[8], S[10]), l_ = min(S[8], S[10]); S[8] = h_; S[10] = l_; } { const unsigned h_ = max(S[9], S[11]), l_ = min(S[9], S[11]); S[9] = h_; S[11] = l_; } { const unsigned h_ = max(S[9], S[10]), l_ = min(S[9], S[10]); S[9] = h_; S[10] = l_; } { const unsigned h_ = max(S[12], S[13]), l_ = min(S[12], S[13]); S[12] = h_; S[13] = l_; } { const unsigned h_ = max(S[14], S[15]), l_ = min(S[14], S[15]); S[14] = h_; S[15] = l_; } { const unsigned h_ = max(S[12], S[14]), l_ = min(S[12], S[14]); S[12] = h_; S[14] = l_; } { const unsigned h_ = max(S[13], S[15]), l_ = min(S[13], S[15]); S[13] = h_; S[15] = l_; } { const unsigned h_ = max(S[13], S[14]), l_ = min(S[13], S[14]); S[13] = h_; S[14] = l_; } { const unsigned h_ = max(S[8], S[12]), l_ = min(S[8], S[12]); S[8] = h_; S[12] = l_; } { const unsigned h_ = max(S[10], S[14]), l_ = min(S[10], S[14]); S[10] = h_; S[14] = l_; } { const unsigned h_ = max(S[10], S[12]), l_ = min(S[10], S[12]); S[10] = h_; S[12] = l_; } { const unsigned h_ = max(S[9], S[13]), l_ = min(S[9], S[13]); S[9] = h_; S[13] = l_; } { const unsigned h_ = max(S[11], S[15]), l_ = min(S[11], S[15]); S[11] = h_; S[15] = l_; } { const unsigned h_ = max(S[11], S[13]), l_ = min(S[11], S[13]); S[11] = h_; S[13] = l_; } { const unsigned h_ = max(S[9], S[10]), l_ = min(S[9], S[10]); S[9] = h_; S[10] = l_; } { const unsigned h_ = max(S[11], S[12]), l_ = min(S[11], S[12]); S[11] = h_; S[12] = l_; } { const unsigned h_ = max(S[13], S[14]), l_ = min(S[13], S[14]); S[13] = h_; S[14] = l_; } { const unsigned h_ = max(S[0], S[8]), l_ = min(S[0], S[8]); S[0] = h_; S[8] = l_; } { const unsigned h_ = max(S[4], S[12]), l_ = min(S[4], S[12]); S[4] = h_; S[12] = l_; } { const unsigned h_ = max(S[4], S[8]), l_ = min(S[4], S[8]); S[4] = h_; S[8] = l_; } { const unsigned h_ = max(S[2], S[10]), l_ = min(S[2], S[10]); S[2] = h_; S[10] = l_; } { const unsigned h_ = max(S[6], S[14]), l_ = min(S[6], S[14]); S[6] = h_; S[14] = l_; } { const unsigned h_ = max(S[6], S[10]), l_ = min(S[6], S[10]); S[6] = h_; S[10] = l_; } { const unsigned h_ = max(S[2], S[4]), l_ = min(S[2], S[4]); S[2] = h_; S[4] = l_; } { const unsigned h_ = max(S[6], S[8]), l_ = min(S[6], S[8]); S[6] = h_; S[8] = l_; } { const unsigned h_ = max(S[10], S[12]), l_ = min(S[10], S[12]); S[10] = h_; S[12] = l_; } { const unsigned h_ = max(S[1], S[9]), l_ = min(S[1], S[9]); S[1] = h_; S[9] = l_; } { const unsigned h_ = max(S[5], S[13]), l_ = min(S[5], S[13]); S[5] = h_; S[13] = l_; } { const unsigned h_ = max(S[5], S[9]), l_ = min(S[5], S[9]); S[5] = h_; S[9] = l_; } { const unsigned h_ = max(S[3], S[11]), l_ = min(S[3], S[11]); S[3] = h_; S[11] = l_; } { const unsigned h_ = max(S[7], S[15]), l_ = min(S[7], S[15]); S[7] = h_; S[15] = l_; } { const unsigned h_ = max(S[7], S[11]), l_ = min(S[7], S[11]); S[7] = h_; S[11] = l_; } { const unsigned h_ = max(S[3], S[5]), l_ = min(S[3], S[5]); S[3] = h_; S[5] = l_; } { const unsigned h_ = max(S[7], S[9]), l_ = min(S[7], S[9]); S[7] = h_; S[9] = l_; } { const unsigned h_ = max(S[11], S[13]), l_ = min(S[11], S[13]); S[11] = h_; S[13] = l_; } { const unsigned h_ = max(S[1], S[2]), l_ = min(S[1], S[2]); S[1] = h_; S[2] = l_; } { const unsigned h_ = max(S[3], S[4]), l_ = min(S[3], S[4]); S[3] = h_; S[4] = l_; } { const unsigned h_ = max(S[5], S[6]), l_ = min(S[5], S[6]); S[5] = h_; S[6] = l_; } { const unsigned h_ = max(S[7], S[8]), l_ = min(S[7], S[8]); S[7] = h_; S[8] = l_; } { const unsigned h_ = max(S[9], S[10]), l_ = min(S[9], S[10]); S[9] = h_; S[10] = l_; } { const unsigned h_ = max(S[11], S[12]), l_ = min(S[11], S[12]); S[11] = h_; S[12] = l_; } { const unsigned h_ = max(S[13], S[14]), l_ = min(S[13], S[14]); S[13] = h_; S[14] = l_; } } while (0)
#define TK_MERGE16(L, S) do { L[0] = max(L[0], S[15]); L[1] = max(L[1], S[14]); L[2] = max(L[2], S[13]); L[3] = max(L[3], S[12]); L[4] = max(L[4], S[11]); L[5] = max(L[5], S[10]); L[6] = max(L[6], S[9]); L[7] = max(L[7], S[8]); L[8] = max(L[8], S[7]); L[9] = max(L[9], S[6]); L[10] = max(L[10], S[5]); L[11] = max(L[11], S[4]); L[12] = max(L[12], S[3]); L[13] = max(L[13], S[2]); L[14] = max(L[14], S[1]); L[15] = max(L[15], S[0]); { const unsigned h_ = max(L[0], L[8]), l_ = min(L[0], L[8]); L[0] = h_; L[8] = l_; } { const unsigned h_ = max(L[1], L[9]), l_ = min(L[1], L[9]); L[1] = h_; L[9] = l_; } { const unsigned h_ = max(L[2], L[10]), l_ = min(L[2], L[10]); L[2] = h_; L[10] = l_; } { const unsigned h_ = max(L[3], L[11]), l_ = min(L[3], L[11]); L[3] = h_; L[11] = l_; } { const unsigned h_ = max(L[4], L[12]), l_ = min(L[4], L[12]); L[4] = h_; L[12] = l_; } { const unsigned h_ = max(L[5], L[13]), l_ = min(L[5], L[13]); L[5] = h_; L[13] = l_; } { const unsigned h_ = max(L[6], L[14]), l_ = min(L[6], L[14]); L[6] = h_; L[14] = l_; } { const unsigned h_ = max(L[7], L[15]), l_ = min(L[7], L[15]); L[7] = h_; L[15] = l_; } { const unsigned h_ = max(L[0], L[4]), l_ = min(L[0], L[4]); L[0] = h_; L[4] = l_; } { const unsigned h_ = max(L[1], L[5]), l_ = min(L[1], L[5]); L[1] = h_; L[5] = l_; } { const unsigned h_ = max(L[2], L[6]), l_ = min(L[2], L[6]); L[2] = h_; L[6] = l_; } { const unsigned h_ = max(L[3], L[7]), l_ = min(L[3], L[7]); L[3] = h_; L[7] = l_; } { const unsigned h_ = max(L[8], L[12]), l_ = min(L[8], L[12]); L[8] = h_; L[12] = l_; } { const unsigned h_ = max(L[9], L[13]), l_ = min(L[9], L[13]); L[9] = h_; L[13] = l_; } { const unsigned h_ = max(L[10], L[14]), l_ = min(L[10], L[14]); L[10] = h_; L[14] = l_; } { const unsigned h_ = max(L[11], L[15]), l_ = min(L[11], L[15]); L[11] = h_; L[15] = l_; } { const unsigned h_ = max(L[0], L[2]), l_ = min(L[0], L[2]); L[0] = h_; L[2] = l_; } { const unsigned h_ = max(L[1], L[3]), l_ = min(L[1], L[3]); L[1] = h_; L[3] = l_; } { const unsigned h_ = max(L[4], L[6]), l_ = min(L[4], L[6]); L[4] = h_; L[6] = l_; } { const unsigned h_ = max(L[5], L[7]), l_ = min(L[5], L[7]); L[5] = h_; L[7] = l_; } { const unsigned h_ = max(L[8], L[10]), l_ = min(L[8], L[10]); L[8] = h_; L[10] = l_; } { const unsigned h_ = max(L[9], L[11]), l_ = min(L[9], L[11]); L[9] = h_; L[11] = l_; } { const unsigned h_ = max(L[12], L[14]), l_ = min(L[12], L[14]); L[12] = h_; L[14] = l_; } { const unsigned h_ = max(L[13], L[15]), l_ = min(L[13], L[15]); L[13] = h_; L[15] = l_; } { const unsigned h_ = max(L[0], L[1]), l_ = min(L[0], L[1]); L[0] = h_; L[1] = l_; } { const unsigned h_ = max(L[2], L[3]), l_ = min(L[2], L[3]); L[2] = h_; L[3] = l_; } { const unsigned h_ = max(L[4], L[5]), l_ = min(L[4], L[5]); L[4] = h_; L[5] = l_; } { const unsigned h_ = max(L[6], L[7]), l_ = min(L[6], L[7]); L[6] = h_; L[7] = l_; } { const unsigned h_ = max(L[8], L[9]), l_ = min(L[8], L[9]); L[8] = h_; L[9] = l_; } { const unsigned h_ = max(L[10], L[11]), l_ = min(L[10], L[11]); L[10] = h_; L[11] = l_; } { const unsigned h_ = max(L[12], L[13]), l_ = min(L[12], L[13]); L[12] = h_; L[13] = l_; } { const unsigned h_ = max(L[14], L[15]), l_ = min(L[14], L[15]); L[14] = h_; L[15] = l_; } } while (0)
__device__ __forceinline__ void phase_topk(const Params& p, const Frame& F0, int l) {
    const Frame F = local_frame(F0);
    const int lane = F.lane, wave = F.wave;
    LAS float* tile = (LAS float*)(F.lds + wave * 8448);
    LAS unsigned char* itab = (LAS unsigned char*)(F.lds + 8 * 8448 + wave * 64 * 36 + lane * 36);
    const float* scores = (const float*)(p.ws + WS_SCORES);
    const float* rowsq = (const float*)(p.ws + WS_ROWSQP) + (size_t)l * NTOK * 16;
    unsigned* seli = (unsigned*)(p.ws + WS_SELI); float* selg = (float*)(p.ws + WS_SELG);
    const int gw = blockIdx.x * NWAVES + wave, NGW = F.G * NWAVES;
    const int row_l = lane >> 3, cg_l = lane & 7;
    const bf16_t* scores_b = (const bf16_t*)(p.ws + WS_SCORES);
    u32x4 cur[8];
    if (gw < NTOK * 8 / 64) {
#pragma unroll
        for (int i = 0; i < 8; ++i) cur[i] = *(const u32x4*)(scores_b + ((size_t)gw * 64 + 8 * i + row_l) * 256 + cg_l * 8);
    }
    LAS unsigned* tileu = (LAS unsigned*)tile;
    for (int grp = gw; grp < NTOK * 8 / 64; grp += NGW) {
        const size_t item0 = (size_t)grp * 64;
        unsigned L1[16], L2[16];
#pragma unroll
        for (int j = 0; j < 16; ++j) { L1[j] = 0u; L2[j] = 0u; }
#pragma unroll 1
        for (int ch = 0; ch < 4; ++ch) {
#pragma unroll
            for (int i = 0; i < 8; ++i) { LAS unsigned* d = tileu + (8 * i + row_l) * 33 + cg_l * 4; d[0] = cur[i].x; d[1] = cur[i].y; d[2] = cur[i].z; d[3] = cur[i].w; }
            {
                const bool more = (ch < 3) || (grp + NGW < NTOK * 8 / 64);
                const size_t nitem0 = (ch < 3) ? item0 : (size_t)(grp + NGW) * 64; const int nch = (ch < 3) ? ch + 1 : 0;
                if (more) {
#pragma unroll
                    for (int i = 0; i < 8; ++i) cur[i] = *(const u32x4*)(scores_b + (nitem0 + 8 * i + row_l) * 256 + nch * 64 + cg_l * 8);
                }
            }
            __builtin_amdgcn_wave_barrier(); asm volatile("s_waitcnt lgkmcnt(0)" ::: "memory");
#pragma unroll
            for (int qd = 0; qd < 4; ++qd) { unsigned S[16];
#pragma unroll
                for (int j = 0; j < 8; ++j) { const unsigned w = tileu[lane * 33 + 8 * qd + j]; const unsigned idx = (unsigned)((ch & 1) * 64 + 16 * qd + 2 * j);
                    S[2 * j] = ordkey((w << 16) | idx); S[2 * j + 1] = ordkey((w & 0xffff0000u) | (idx + 1u)); }
                TK_SORT16(S);
                if (ch < 2) TK_MERGE16(L1, S); else TK_MERGE16(L2, S); }
            __builtin_amdgcn_wave_barrier(); asm volatile("s_waitcnt lgkmcnt(0)" ::: "memory");
        }
        float f1[16], f2[16];
#pragma unroll
        for (int k = 0; k < 16; ++k) { const unsigned b1 = unord(L1[k]), b2 = unord(L2[k]); f1[k] = __uint_as_float(b1); f2[k] = __uint_as_float(b2); itab[k] = (unsigned char)(b1 & 127u); itab[16 + k] = (unsigned char)(b2 & 127u); }
        unsigned T[16];
        { T[0] = ordkey((__float_as_uint(f1[0] + f2[0]) & 0xffffff00u) | 0u); T[1] = ordkey((__float_as_uint(f1[0] + f2[1]) & 0xffffff00u) | 1u); T[2] = ordkey((__float_as_uint(f1[0] + f2[2]) & 0xffffff00u) | 2u); T[3] = ordkey((__float_as_uint(f1[0] + f2[3]) & 0xffffff00u) | 3u); T[4] = ordkey((__float_as_uint(f1[0] + f2[4]) & 0xffffff00u) | 4u); T[5] = ordkey((__float_as_uint(f1[0] + f2[5]) & 0xffffff00u) | 5u); T[6] = ordkey((__float_as_uint(f1[0] + f2[6]) & 0xffffff00u) | 6u); T[7] = ordkey((__float_as_uint(f1[0] + f2[7]) & 0xffffff00u) | 7u); T[8] = ordkey((__float_as_uint(f1[0] + f2[8]) & 0xffffff00u) | 8u); T[9] = ordkey((__float_as_uint(f1[0] + f2[9]) & 0xffffff00u) | 9u); T[10] = ordkey((__float_as_uint(f1[0] + f2[10]) & 0xffffff00u) | 10u); T[11] = ordkey((__float_as_uint(f1[0] + f2[11]) & 0xffffff00u) | 11u); T[12] = ordkey((__float_as_uint(f1[0] + f2[12]) & 0xffffff00u) | 12u); T[13] = ordkey((__float_as_uint(f1[0] + f2[13]) & 0xffffff00u) | 13u); T[14] = ordkey((__float_as_uint(f1[0] + f2[14]) & 0xffffff00u) | 14u); T[15] = ordkey((__float_as_uint(f1[0] + f2[15]) & 0xffffff00u) | 15u); TK_SORT16(T); }
        { unsigned S[16]; S[0] = ordkey((__float_as_uint(f1[1] + f2[0]) & 0xffffff00u) | 16u); S[1] = ordkey((__float_as_uint(f1[1] + f2[1]) & 0xffffff00u) | 17u); S[2] = ordkey((__float_as_uint(f1[1] + f2[2]) & 0xffffff00u) | 18u); S[3] = ordkey((__float_as_uint(f1[1] + f2[3]) & 0xffffff00u) | 19u); S[4] = ordkey((__float_as_uint(f1[1] + f2[4]) & 0xffffff00u) | 20u); S[5] = ordkey((__float_as_uint(f1[1] + f2[5]) & 0xffffff00u) | 21u); S[6] = ordkey((__float_as_uint(f1[1] + f2[6]) & 0xffffff00u) | 22u); S[7] = ordkey((__float_as_uint(f1[1] + f2[7]) & 0xffffff00u) | 23u); S[8] = ordkey((__float_as_uint(f1[2] + f2[0]) & 0xffffff00u) | 32u); S[9] = ordkey((__float_as_uint(f1[2] + f2[1]) & 0xffffff00u) | 33u); S[10] = ordkey((__float_as_uint(f1[2] + f2[2]) & 0xffffff00u) | 34u); S[11] = ordkey((__float_as_uint(f1[2] + f2[3]) & 0xffffff00u) | 35u); S[12] = ordkey((__float_as_uint(f1[2] + f2[4]) & 0xffffff00u) | 36u); S[13] = ordkey((__float_as_uint(f1[3] + f2[0]) & 0xffffff00u) | 48u); S[14] = ordkey((__float_as_uint(f1[3] + f2[1]) & 0xffffff00u) | 49u); S[15] = ordkey((__float_as_uint(f1[3] + f2[2]) & 0xffffff00u) | 50u); TK_SORT16(S); TK_MERGE16(T, S); }
        { unsigned S[16]; S[0] = ordkey((__float_as_uint(f1[3] + f2[3]) & 0xffffff00u) | 51u); S[1] = ordkey((__float_as_uint(f1[4] + f2[0]) & 0xffffff00u) | 64u); S[2] = ordkey((__float_as_uint(f1[4] + f2[1]) & 0xffffff00u) | 65u); S[3] = ordkey((__float_as_uint(f1[4] + f2[2]) & 0xffffff00u) | 66u); S[4] = ordkey((__float_as_uint(f1[5] + f2[0]) & 0xffffff00u) | 80u); S[5] = ordkey((__float_as_uint(f1[5] + f2[1]) & 0xffffff00u) | 81u); S[6] = ordkey((__float_as_uint(f1[6] + f2[0]) & 0xffffff00u) | 96u); S[7] = ordkey((__float_as_uint(f1[6] + f2[1]) & 0xffffff00u) | 97u); S[8] = ordkey((__float_as_uint(f1[7] + f2[0]) & 0xffffff00u) | 112u); S[9] = ordkey((__float_as_uint(f1[7] + f2[1]) & 0xffffff00u) | 113u); S[10] = ordkey((__float_as_uint(f1[8] + f2[0]) & 0xffffff00u) | 128u); S[11] = ordkey((__float_as_uint(f1[9] + f2[0]) & 0xffffff00u) | 144u); S[12] = ordkey((__float_as_uint(f1[10] + f2[0]) & 0xffffff00u) | 160u); S[13] = ordkey((__float_as_uint(f1[11] + f2[0]) & 0xffffff00u) | 176u); S[14] = ordkey((__float_as_uint(f1[12] + f2[0]) & 0xffffff00u) | 192u); S[15] = ordkey((__float_as_uint(f1[13] + f2[0]) & 0xffffff00u) | 208u); TK_SORT16(S); TK_MERGE16(T, S); }
        { unsigned x = ordkey((__float_as_uint(f1[14] + f2[0]) & 0xffffff00u) | 224u);
#pragma unroll
            for (int k = 0; k < 16; ++k) { const unsigned hi = max(T[k], x); x = min(T[k], x); T[k] = hi; } }
        { unsigned x = ordkey((__float_as_uint(f1[15] + f2[0]) & 0xffffff00u) | 240u);
#pragma unroll
            for (int k = 0; k < 16; ++k) { const unsigned hi = max(T[k], x); x = min(T[k], x); T[k] = hi; } }
        asm volatile("s_waitcnt lgkmcnt(0)" ::: "memory");
        const size_t item = item0 + lane; const int tok = (int)(item >> 3);
        const float rstd = 1.0f / sqrtf(row_sumsq(rowsq, tok) * (1.0f / DM) + EPS);
        float e[16], se = 0.f; unsigned P[16];
        const float t0v = __uint_as_float(unord(T[0]));
#pragma unroll
        for (int k = 0; k < 16; ++k) { const unsigned b = unord(T[k]); e[k] = __expf((__uint_as_float(b) - t0v) * rstd); se += e[k];
            const unsigned code = b & 255u; P[k] = ((unsigned)itab[code >> 4] << 7) | (unsigned)itab[16 + (code & 15u)]; }
        const float inv = 1.0f / se;
        u32x4* di = (u32x4*)(seli + item * 16); f32x4* dg = (f32x4*)(selg + item * 16);
#pragma unroll
        for (int k4 = 0; k4 < 4; ++k4) { di[k4] = (u32x4){P[4 * k4], P[4 * k4 + 1], P[4 * k4 + 2], P[4 * k4 + 3]};
            dg[k4] = (f32x4){e[4 * k4] * inv, e[4 * k4 + 1] * inv, e[4 * k4 + 2] * inv, e[4 * k4 + 3] * inv}; }
        asm volatile("s_waitcnt lgkmcnt(0)" ::: "memory");
    }
}

__device__ __forceinline__ void fp8x16_to_f32(const u32x4 w, float (&f)[16]) {
#pragma unroll
    for (int q = 0; q < 4; ++q) { const f32x2 lo = __builtin_amdgcn_cvt_pk_f32_fp8((int)w[q], false), hi = __builtin_amdgcn_cvt_pk_f32_fp8((int)w[q], true);
        f[4 * q] = lo[0]; f[4 * q + 1] = lo[1]; f[4 * q + 2] = hi[0]; f[4 * q + 3] = hi[1]; }
}
template <int CTRL> __device__ __forceinline__ float dpp_f(float v) { return __uint_as_float(__builtin_amdgcn_update_dpp(0u, __float_as_uint(v), CTRL, 0xF, 0xF, true)); }
#ifndef MERGE_STAGGER
#define MERGE_STAGGER 0
#endif
#ifndef VB
#define VB 16
#endif
#ifndef G_RSH
#define G_RSH 10
#endif
#ifndef GATHER_SWEEP_BARRIER
#define GATHER_SWEEP_BARRIER 1
#endif
constexpr int GT = 4;
__device__ __forceinline__ void phase_gather(const Params& p, const Frame& F0, int l, const XcdBarrier& bar, bool use_bar, bool dry = false, unsigned emask = 0xffffffffu) {
    const Frame F = local_frame(F0);
    const int lane = F.lane;
    const unsigned char* ET = p.ws + WS_EXP + (size_t)l * NEXP * 2 * DM;
    const f32x2* SC = (const f32x2*)(p.ws + WS_ESCALE) + (size_t)l * NEXP;
    const bf16_t* xb = (const bf16_t*)(p.ws + WS_XB);
    const float* rowsq = (const float*)(p.ws + WS_ROWSQP) + (size_t)l * NTOK * 16;
    const unsigned* seli = (const unsigned*)(p.ws + WS_SELI); const float* selg = (const float*)(p.ws + WS_SELG);
    const float* gain = p.in[I_FFGAIN] + l * DM + lane * 16;
    LAS u32x2* sortl = (LAS u32x2*)(F.lds + F.wave * (GT * 1024));
    LAS float* cfl = (LAS float*)(F.lds + NWAVES * (GT * 1024) + F.wave * (GT * 512));
    LAS u32x4* h2l = (LAS u32x4*)(F.lds + NWAVES * (GT * 1536) + F.wave * (GT * 1024));
    LAS float* h2sl = (LAS float*)(F.lds + NWAVES * (GT * 2560) + F.wave * 64);
    const bool dsel0 = (lane & 1) != 0, dsel1 = (lane & 2) != 0, ondiag = (((lane & 15) >> 2) == (lane >> 4));
    const bool b2 = (lane & 4) != 0, b1 = (lane & 2) != 0, b0 = (lane & 1) != 0;
    const int mym = (b2 ? 4 : 0) + (b0 ? 2 : 0) + (b1 ? 1 : 0);
    const int gw = blockIdx.x * NWAVES + F.wave, NGW = F.G * NWAVES;
    const int nsweep = NTOK / (NGW * GT);
    for (int sw = 0; sw < nsweep; ++sw) {
        if (sw > 0 && use_bar && GATHER_SWEEP_BARRIER) xcd_barrier(bar);
        const int tok0 = (sw * NGW + gw) * GT;
        int cur[GT];
#pragma unroll
        for (int tk = 0; tk < GT; ++tk) { const int tok = tok0 + tk;
            const float rstd = 1.0f / sqrtf(row_sumsq(rowsq, tok) * (1.0f / DM) + EPS);
            const u32x4 xw0 = *(const u32x4*)(xb + (size_t)tok * DM + lane * 16), xw1 = *(const u32x4*)(xb + (size_t)tok * DM + lane * 16 + 8);
            const f32x4 g0 = *(const f32x4*)gain, g1 = *(const f32x4*)(gain + 4), g2 = *(const f32x4*)(gain + 8), g3 = *(const f32x4*)(gain + 12);
            float hv[16] = {bf_lo(xw0.x) * rstd * g0[0], bf_hi(xw0.x) * rstd * g0[1], bf_lo(xw0.y) * rstd * g0[2], bf_hi(xw0.y) * rstd * g0[3], bf_lo(xw0.z) * rstd * g1[0], bf_hi(xw0.z) * rstd * g1[1], bf_lo(xw0.w) * rstd * g1[2], bf_hi(xw0.w) * rstd * g1[3],
                            bf_lo(xw1.x) * rstd * g2[0], bf_hi(xw1.x) * rstd * g2[1], bf_lo(xw1.y) * rstd * g2[2], bf_hi(xw1.y) * rstd * g2[3], bf_lo(xw1.z) * rstd * g3[0], bf_hi(xw1.z) * rstd * g3[1], bf_lo(xw1.w) * rstd * g3[2], bf_hi(xw1.w) * rstd * g3[3]};
            float hm = 0.f;
#pragma unroll
            for (int j = 0; j < 16; ++j) hm = fmaxf(hm, fabsf(hv[j]));
#pragma unroll
            for (int of = 1; of < 64; of <<= 1) hm = fmaxf(hm, __shfl_xor(hm, of));
            const float hinv = hm > 0.f ? 448.0f / hm : 0.f; if (lane == 0) h2sl[tk] = hm * (1.0f / 448.0f);
            {   int w0 = 0, w1 = 0, w2 = 0, w3 = 0;
                w0 = __builtin_amdgcn_cvt_pk_fp8_f32(hv[0] * hinv, hv[1] * hinv, w0, false); w0 = __builtin_amdgcn_cvt_pk_fp8_f32(hv[2] * hinv, hv[3] * hinv, w0, true);
                w1 = __builtin_amdgcn_cvt_pk_fp8_f32(hv[4] * hinv, hv[5] * hinv, w1, false); w1 = __builtin_amdgcn_cvt_pk_fp8_f32(hv[6] * hinv, hv[7] * hinv, w1, true);
                w2 = __builtin_amdgcn_cvt_pk_fp8_f32(hv[8] * hinv, hv[9] * hinv, w2, false); w2 = __builtin_amdgcn_cvt_pk_fp8_f32(hv[10] * hinv, hv[11] * hinv, w2, true);
                w3 = __builtin_amdgcn_cvt_pk_fp8_f32(hv[12] * hinv, hv[13] * hinv, w3, false); w3 = __builtin_amdgcn_cvt_pk_fp8_f32(hv[14] * hinv, hv[15] * hinv, w3, true);
                h2l[tk * 64 + lane] = (u32x4){(unsigned)w0, (unsigned)w1, (unsigned)w2, (unsigned)w3}; }
            const unsigned i0 = seli[(size_t)tok * 128 + lane] & emask, i1 = seli[(size_t)tok * 128 + 64 + lane] & emask;
            const float q0 = selg[(size_t)tok * 128 + lane], q1 = selg[(size_t)tok * 128 + 64 + lane];
            const unsigned ep0 = i0 >> G_RSH, ep1 = i1 >> G_RSH; unsigned pos0 = 0, pos1 = 0, base = 0;
#pragma unroll
            for (unsigned ep = 0; ep < (16384u >> G_RSH); ++ep) { const unsigned long long m0 = __ballot(ep0 == ep), m1 = __ballot(ep1 == ep);
                const unsigned c0 = __builtin_amdgcn_mbcnt_hi((unsigned)(m0 >> 32), __builtin_amdgcn_mbcnt_lo((unsigned)m0, 0u)), c1 = __builtin_amdgcn_mbcnt_hi((unsigned)(m1 >> 32), __builtin_amdgcn_mbcnt_lo((unsigned)m1, 0u));
                const unsigned n0 = (unsigned)__popcll(m0), n1 = (unsigned)__popcll(m1);
                pos0 = (ep0 == ep) ? base + c0 : pos0; pos1 = (ep1 == ep) ? base + n0 + c1 : pos1; base += n0 + n1; }
            sortl[tk * 128 + pos0] = (u32x2){i0, __float_as_uint(q0)}; sortl[tk * 128 + pos1] = (u32x2){i1, __float_as_uint(q1)}; cur[tk] = 0; }
        __builtin_amdgcn_wave_barrier(); asm volatile("s_waitcnt lgkmcnt(0)" ::: "memory");
        unsigned ord;
        {   const unsigned first = sortl[(lane >> 4) * 128 + 8 * (lane & 15)].x;
            const unsigned key = (((first >> G_RSH) * GT + (unsigned)(lane >> 4)) << 4) | (unsigned)(lane & 15);
            unsigned rank = 0;
#pragma unroll 8
            for (int m = 0; m < 64; ++m) { const unsigned km = __builtin_amdgcn_readlane(key, m); rank += (km < key) ? 1u : 0u; }
            ord = (unsigned)__builtin_amdgcn_ds_permute((int)(rank << 2), (int)lane); }
        asm volatile("s_waitcnt lgkmcnt(0)" ::: "memory");
        {
            u32x4 ub[2][8]; f32x2 bsc[2]; float bmg[2]; int bid[2];
#define G_ISSUE_U(n, s) do { const int id_ = __builtin_amdgcn_readlane(ord, (n)); bid[s] = id_; const u32x2 ent_ = sortl[(id_ >> 4) * 128 + 8 * (id_ & 15) + mym]; bmg[s] = __uint_as_float(ent_.y); \
            _Pragma("unroll") for (int i_ = 0; i_ < 8; ++i_) { const unsigned e_ = __builtin_amdgcn_readlane(ent_.x, ((i_ & 4) ? 4 : 0) + ((i_ & 1) ? 2 : 0) + ((i_ & 2) ? 1 : 0)); ub[s][i_] = *(const u32x4*)(ET + (size_t)e_ * DM + lane * 16); } \
            bsc[s] = SC[ent_.x]; } while (0)
#define G_COMPUTE_U(s) do { const int tk_ = bid[s] >> 4, b_ = bid[s] & 15; const u32x4 hq_ = h2l[tk_ * 64 + lane]; const float hs_ = h2sl[tk_]; \
            const long hlo_ = (long)(((unsigned long long)hq_.y << 32) | hq_.x), hhi_ = (long)(((unsigned long long)hq_.w << 32) | hq_.z); \
            float d_[8]; \
            _Pragma("unroll") for (int hf_ = 0; hf_ < 2; ++hf_) { f32x4 acc4_[4]; \
                _Pragma("unroll") for (int i_ = 0; i_ < 4; ++i_) { const u32x4 w_ = ub[s][4 * hf_ + i_]; acc4_[i_] = __builtin_amdgcn_mfma_f32_16x16x32_fp8_fp8((long)(((unsigned long long)w_.y << 32) | w_.x), hlo_, (f32x4){0.f, 0.f, 0.f, 0.f}, 0, 0, 0); } \
                _Pragma("unroll") for (int i_ = 0; i_ < 4; ++i_) { const u32x4 w_ = ub[s][4 * hf_ + i_]; acc4_[i_] = __builtin_amdgcn_mfma_f32_16x16x32_fp8_fp8((long)(((unsigned long long)w_.w << 32) | w_.z), hhi_, acc4_[i_], 0, 0, 0); } \
                _Pragma("unroll") for (int i_ = 0; i_ < 4; ++i_) { const float lo2_ = dsel0 ? acc4_[i_][1] : acc4_[i_][0], hi2_ = dsel0 ? acc4_[i_][3] : acc4_[i_][2]; const float v_ = dsel1 ? hi2_ : lo2_; d_[4 * hf_ + i_] = ondiag ? v_ : 0.f; } } \
            float a4_[4], c2_[2]; \
            _Pragma("unroll") for (int j_ = 0; j_ < 4; ++j_) { const float keep_ = b2 ? d_[j_ + 4] : d_[j_], send_ = b2 ? d_[j_] : d_[j_ + 4]; a4_[j_] = keep_ + dpp_f<0x141>(send_); } \
            _Pragma("unroll") for (int j_ = 0; j_ < 2; ++j_) { const float keep_ = b0 ? a4_[j_ + 2] : a4_[j_], send_ = b0 ? a4_[j_] : a4_[j_ + 2]; c2_[j_] = keep_ + dpp_f<0xB1>(send_); } \
            float dm_; { const float keep_ = b1 ? c2_[1] : c2_[0], send_ = b1 ? c2_[0] : c2_[1]; dm_ = keep_ + dpp_f<0x4E>(send_); } \
            dm_ += dpp_f<0x128>(dm_); \
            { const auto s16_ = __builtin_amdgcn_permlane16_swap(__float_as_uint(dm_), __float_as_uint(dm_), false, false); dm_ = __uint_as_float(s16_[0]) + __uint_as_float(s16_[1]); } \
            { const auto s32_ = __builtin_amdgcn_permlane32_swap(__float_as_uint(dm_), __float_as_uint(dm_), false, false); dm_ = __uint_as_float(s32_[0]) + __uint_as_float(s32_[1]); } \
            const float cf_ = bmg[s] * gelu_tanh(dm_ * bsc[s][0] * hs_) * bsc[s][1]; \
            if (lane < 8) cfl[tk_ * 128 + 8 * b_ + mym] = cf_; } while (0)
            G_ISSUE_U(0, 0);
#pragma unroll 1
            for (int n = 0; n < GT * 16; n += 2) {
                G_ISSUE_U(n + 1, 1); G_COMPUTE_U(0);
                if (n + 2 < GT * 16) G_ISSUE_U(n + 2, 0);
                G_COMPUTE_U(1);
            }
#undef G_ISSUE_U
#undef G_COMPUTE_U
        }
        __builtin_amdgcn_wave_barrier(); asm volatile("s_waitcnt lgkmcnt(0)" ::: "memory");
        f32x2 o2[GT][8];
#pragma unroll
        for (int tk = 0; tk < GT; ++tk) { cur[tk] = 0;
#pragma unroll
            for (int j = 0; j < 8; ++j) o2[tk][j] = (f32x2){0.f, 0.f}; }
#pragma unroll 1
        for (int r = 0; r < (16384 >> G_RSH); ++r) {
#pragma unroll
            for (int tk = 0; tk < GT; ++tk) {
                while (cur[tk] < 128 / VB) {
                    const int b = cur[tk]; const unsigned ex = sortl[tk * 128 + VB * b + (lane & (VB - 1))].x;
                    unsigned e[VB];
                    e[0] = __builtin_amdgcn_readlane(ex, 0);
                    if ((int)(e[0] >> G_RSH) > r) break;
                    cur[tk] = b + 1;
#pragma unroll
                    for (int i = 1; i < VB; ++i) e[i] = __builtin_amdgcn_readlane(ex, i);
                    u32x4 vv[VB];
#pragma unroll
                    for (int i = 0; i < VB; ++i) { vv[i] = *(const u32x4*)(ET + (size_t)(NEXP + e[i]) * DM + lane * 16); if (VB > 8) asm volatile("" ::: "memory"); }
                    f32x4 cq[VB / 4];
#pragma unroll
                    for (int q = 0; q < VB / 4; ++q) cq[q] = *(const LAS f32x4*)(cfl + tk * 128 + VB * b + 4 * q);
#pragma unroll
                    for (int i = 0; i < VB; ++i) { const float ci = cq[i >> 2][i & 3];
                        if (VB > 8 && (i & 1) == 0) {
                            asm volatile("" : "+v"(vv[i]), "+v"(vv[i + 1]), "+v"(o2[tk][0]), "+v"(o2[tk][1]), "+v"(o2[tk][2]), "+v"(o2[tk][3]), "+v"(o2[tk][4]), "+v"(o2[tk][5]), "+v"(o2[tk][6]), "+v"(o2[tk][7])); }
                        float f[16]; fp8x16_to_f32(vv[i], f);
#pragma unroll
                        for (int j = 0; j < 8; ++j) o2[tk][j] += (f32x2){ci, ci} * (f32x2){f[2 * j], f[2 * j + 1]}; }
                }
            }
        }
        float o[GT][16];
#pragma unroll
        for (int tk = 0; tk < GT; ++tk)
#pragma unroll
            for (int j = 0; j < 8; ++j) { o[tk][2 * j] = o2[tk][j][0]; o[tk][2 * j + 1] = o2[tk][j][1]; }
        int dry_v = dry ? 1 : 0; asm volatile("" : "+v"(dry_v)); const int dry_l = __builtin_amdgcn_readfirstlane(dry_v);
        bf16_t* xbo = dry_l ? (bf16_t*)(p.ws + WS_SCRATCH) : (bf16_t*)(p.ws + WS_XB);
        float* outp = dry_l ? (float*)(p.ws + WS_SCRATCH) : p.out;
        float* rstdo = dry_l ? (float*)(p.ws + WS_SCRATCH + 130 * MiB) : (float*)(p.ws + WS_RSTD);
#pragma unroll
        for (int tk = 0; tk < GT; ++tk) { const int tok = tok0 + tk;
            const u32x4 xw0 = *(const u32x4*)(xb + (size_t)tok * DM + lane * 16), xw1 = *(const u32x4*)(xb + (size_t)tok * DM + lane * 16 + 8);
            float* ot = o[tk];
            ot[0] += bf_lo(xw0.x); ot[1] += bf_hi(xw0.x); ot[2] += bf_lo(xw0.y); ot[3] += bf_hi(xw0.y); ot[4] += bf_lo(xw0.z); ot[5] += bf_hi(xw0.z); ot[6] += bf_lo(xw0.w); ot[7] += bf_hi(xw0.w);
            ot[8] += bf_lo(xw1.x); ot[9] += bf_hi(xw1.x); ot[10] += bf_lo(xw1.y); ot[11] += bf_hi(xw1.y); ot[12] += bf_lo(xw1.z); ot[13] += bf_hi(xw1.z); ot[14] += bf_lo(xw1.w); ot[15] += bf_hi(xw1.w);
            float ss = 0.f;
#pragma unroll
            for (int i = 0; i < 16; ++i) ss += ot[i] * ot[i];
            ss = wave_sum(ss);
            const float r2 = 1.0f / sqrtf(ss * (1.0f / DM) + EPS);
            if (l + 1 < DEPTH) {
                u32x4 w0, w1; w0.x = cvt_pk_bf16(ot[0], ot[1]); w0.y = cvt_pk_bf16(ot[2], ot[3]); w0.z = cvt_pk_bf16(ot[4], ot[5]); w0.w = cvt_pk_bf16(ot[6], ot[7]);
                w1.x = cvt_pk_bf16(ot[8], ot[9]); w1.y = cvt_pk_bf16(ot[10], ot[11]); w1.z = cvt_pk_bf16(ot[12], ot[13]); w1.w = cvt_pk_bf16(ot[14], ot[15]);
                *(u32x4*)(xbo + (size_t)tok * DM + lane * 16) = w0; *(u32x4*)(xbo + (size_t)tok * DM + lane * 16 + 8) = w1;
                if (lane == 0) rstdo[(size_t)(l + 1) * NTOK + tok] = r2;
            } else {
                const float* fg = p.in[I_FGAIN] + lane * 16; float* dst = outp + (size_t)tok * DM + lane * 16;
#pragma unroll
                for (int q = 0; q < 4; ++q) { const f32x4 gq = *(const f32x4*)(fg + 4 * q);
                    *(f32x4*)(dst + 4 * q) = (f32x4){ot[4 * q] * r2 * gq[0], ot[4 * q + 1] * r2 * gq[1], ot[4 * q + 2] * r2 * gq[2], ot[4 * q + 3] * r2 * gq[3]}; }
            }
        }
    }
}

constexpr int PH_PER_LAYER = 8, N_PHASES = 1 + DEPTH * PH_PER_LAYER;
__global__ void __launch_bounds__(NTHREADS, 2) mk_fwd(Params p) {
    extern __shared__ __attribute__((aligned(16))) unsigned char lds_raw[];
    Frame F; F.lds = (LAS unsigned char*)lds_raw; F.tid = threadIdx.x; F.lane = F.tid & 63; F.wave = __builtin_amdgcn_readfirstlane(F.tid >> 6);
    F.G = gridDim.x; { const int bx = blockIdx.x; F.vcu = (F.G % 8 == 0) ? (bx % 8) * (F.G / 8) + bx / 8 : bx; }
    volatile LAS unsigned* misc = (volatile LAS unsigned*)(F.lds + LDS_MISC);
    if (F.tid < 64) misc[F.tid] = 0u;
    __syncthreads();
    unsigned* ctl = (unsigned*)(p.ws + WS_CTL);
    XcdBarrier bar; bar.bar = ctl + CTL_BAR_WORD; bar.x = 0; bar.st = nullptr;
    const bool one_launch = (p.ph_hi - p.ph_lo) > 1;
    if (one_launch) bar = xcd_barrier_post(ctl + CTL_BAR_WORD, misc);
    const int lo = p.ph_lo, hi = p.ph_hi;
#define IN(k) (lo <= (k) && (k) < hi)
#define SEAM(k) do { if (IN(k) && IN((k) + 1)) xcd_barrier(bar); } while (0)
    bf16_t* xb = (bf16_t*)(p.ws + WS_XB);
    if (IN(0)) { for (int rp = 0; rp < p.rep[8]; ++rp) phase_prologue(p, F); SEAM(0); }
    for (int l = 0; l < DEPTH; ++l) {
        const int b = 1 + l * PH_PER_LAYER;
        const float* rstd_a = (const float*)(p.ws + WS_RSTD) + (size_t)l * NTOK;
        if (IN(b + 0)) {
            pg8::Gemm g{xb, (const bf16_t*)(p.ws + WS_WTIN) + (size_t)l * NIN * DM, DM, DM, DM, 0, 0};
            pg8::TileOrder<1> S; S.init(NTOK, NA, F.G, (int)blockIdx.x);
            EpiProjA E{(bf16_t*)(p.ws + WS_PROJA), rstd_a};
            for (int rp = 0; rp < p.rep[0]; ++rp) pg8::gemm_phase(F.lds, g, S, E, F.wave);
            SEAM(b + 0);
        }
        if (IN(b + 1)) {
#if defined(MIX_SIMPLE)
            phase_mix_simple(p, F, l);
#else
            for (int rp = 0; rp < p.rep[1]; ++rp) phase_mix(p, F, l);
#endif
            __syncthreads();
        }
        if (IN(b + 2)) {
            pg8::Gemm g{xb, (const bf16_t*)(p.ws + WS_WTIN) + ((size_t)l * NIN + NA) * DM, DM, DM, DM, 0, 0};
            pg8::TileOrder<1> S; S.init(NTOK, NG, F.G, (int)blockIdx.x);
            EpiGates E{(unsigned char*)(p.ws + WS_GATES), rstd_a, p.in[I_BGATE] + l * NG};
            for (int rp = 0; rp < p.rep[2]; ++rp) pg8::gemm_phase(F.lds, g, S, E, F.wave);
            SEAM(b + 2);
        }
        if (IN(b + 3)) {
            pg8::Gemm g{(const bf16_t*)p.out, (const bf16_t*)(p.ws + WS_WTBR) + (size_t)l * 3 * DM * 512, MIXW, 512, 512, (size_t)512 * 2, (size_t)DM * 512 * 2};
            pg8::TileOrder<3> S; S.init(NTOK, DM, F.G, (int)blockIdx.x);
            EpiMerge E{(const unsigned char*)(p.ws + WS_GATES), (bf16_t*)(p.ws + WS_MERGED), 0};
            if (MERGE_STAGGER) { const unsigned long long t0_ = __builtin_amdgcn_s_memrealtime(), d_ = (unsigned long long)((blockIdx.x >> 3) & 3u) * MERGE_STAGGER;
                while (__builtin_amdgcn_s_memrealtime() - t0_ < d_) __builtin_amdgcn_s_sleep(8); }
            for (int rp = 0; rp < p.rep[3]; ++rp) { E.cheap = (rp + 1 < p.rep[3]) ? p.rep[10] : 0; pg8::gemm_phase(F.lds, g, S, E, F.wave); }
            SEAM(b + 3);
        }
        if (IN(b + 4)) {
            pg8::Gemm g{(const bf16_t*)(p.ws + WS_MERGED), (const bf16_t*)(p.ws + WS_WTOUT) + (size_t)l * DM * DM, DM, DM, DM, 0, 0};
            pg8::TileOrder<1> S; S.init(NTOK, DM, F.G, (int)blockIdx.x);
            for (int rp = 0; rp < p.rep[4]; ++rp) { EpiResid E{xb, (float*)(p.ws + WS_ROWSQP) + (size_t)l * NTOK * 16, (rp + 1 < p.rep[4]) ? (bf16_t*)(p.ws + WS_GATES) : xb}; pg8::gemm_phase(F.lds, g, S, E, F.wave); }
            SEAM(b + 4);
        }
        if (IN(b + 5)) {
            pg8::Gemm g{xb, (const bf16_t*)(p.ws + WS_WEFF) + (size_t)l * PQ * DM, DM, DM, DM, 0, 0};
            pg8::TileOrder<1> S; S.init(NTOK, PQ, F.G, (int)blockIdx.x);
            EpiScores E{(bf16_t*)(p.ws + WS_SCORES)};
            for (int rp = 0; rp < p.rep[5]; ++rp) pg8::gemm_phase(F.lds, g, S, E, F.wave);
            SEAM(b + 5);
        }
        if (IN(b + 6)) { for (int rp = 0; rp < p.rep[6]; ++rp) phase_topk(p, F, l); SEAM(b + 6); }
        if (IN(b + 7)) { for (int rp = 0; rp < p.rep[7]; ++rp) { const bool dry = rp + 1 < p.rep[7]; phase_gather(p, F, l, bar, one_launch, dry, (dry && p.rep[9]) ? 1023u : 0xffffffffu); } SEAM(b + 7); }
    }
#undef IN
#undef SEAM
}

extern "C" void kernel_launch(void* const* d_in, const int* in_sizes, int n_in, void* d_out, int out_size, void* d_ws, size_t ws_size, hipStream_t stream) {
    static int grid = 0;
    if (grid == 0) {
        if (n_in != 22 || out_size != NTOK * DM || ws_size < WS_END) { fprintf(stderr, "kernel_launch: unexpected shapes (n_in %d, out %d, ws %zu)\n", n_in, out_size, ws_size); grid = -1; return; }
        int dev = 0, cus = 0, per_cu = 0;
        if (hipGetDevice(&dev) != hipSuccess || hipDeviceGetAttribute(&cus, hipDeviceAttributeMultiprocessorCount, dev) != hipSuccess) { grid = -1; return; }
        if (hipFuncSetAttribute((const void*)mk_fwd, hipFuncAttributeMaxDynamicSharedMemorySize, LDS_BYTES) != hipSuccess) { fprintf(stderr, "kernel_launch: hipFuncSetAttribute failed\n"); grid = -1; return; }
        if (hipOccupancyMaxActiveBlocksPerMultiprocessor(&per_cu, (const void*)mk_fwd, NTHREADS, LDS_BYTES) != hipSuccess || per_cu < 1) { fprintf(stderr, "kernel_launch: occupancy query says %d\n", per_cu); }
        (void)hipGetLastError();
        grid = cus;
    }
    if (grid < 0) return;
    (void)hipMemsetAsync((char*)d_ws + WS_CTL, 0, CTL_ZERO_BYTES, stream);
    Params p; memset(&p, 0, sizeof(p));
    for (int i = 0; i < 22; ++i) p.in[i] = (const float*)d_in[i];
    p.out = (float*)d_out; p.ws = (unsigned char*)d_ws;
    for (int i = 0; i < 12; ++i) p.rep[i] = 1;
    for (int i = 0; i < 9; ++i) if (PD(i)) p.rep[i] = 2;
    p.rep[9] = 0; if (PD(9)) { p.rep[7] = 2; p.rep[9] = 1; }
    p.rep[10] = 0; if (PD(10)) { p.rep[3] = 2; p.rep[10] = 1; }
#if MK_N_LAUNCHES == 1
    p.ph_lo = 0; p.ph_hi = N_PHASES; p.li = 0;
    hipLaunchKernelGGL(mk_fwd, dim3(grid), dim3(NTHREADS), LDS_BYTES, stream, p);
#else
    for (int ph = 0; ph < N_PHASES; ++ph) { p.ph_lo = ph; p.ph_hi = ph + 1; p.li = ph; hipLaunchKernelGGL(mk_fwd, dim3(grid), dim3(NTHREADS), LDS_BYTES, stream, p); }
#endif
}
```

```cpp
#include <hip/hip_runtime.h>
#include <cstdio>
#include <cstdint>
#include <cstring>

#ifndef MK_N_LAUNCHES
#define MK_N_LAUNCHES 1
#endif

#ifndef PROBE_DOUBLE
#define PROBE_DOUBLE -1
#endif
#define PD(k) (PROBE_DOUBLE == (k) || (PROBE_DOUBLE == 100 && ((k) == 0 || ((k) >= 2 && (k) <= 5))))

#define LAS __attribute__((address_space(3)))
typedef unsigned short bf16_t;
typedef short bf16x8 __attribute__((ext_vector_type(8)));
typedef float f32x4 __attribute__((ext_vector_type(4)));
typedef float f32x2 __attribute__((ext_vector_type(2)));
typedef unsigned u32x4 __attribute__((ext_vector_type(4)));
typedef unsigned u32x2 __attribute__((ext_vector_type(2)));
typedef __bf16 bf16x2_t __attribute__((ext_vector_type(2)));

constexpr int NTOK = 32768, DM = 1024, SEQ = 16384, DEPTH = 2;
constexpr int NA = 2304, NG = 3072, NIN = 5376;
constexpr int COL_K = 512, COL_V = 640, COL_PZ = 768, COL_GU = 1280, COL_GV = 1792;
constexpr int MIXW = 1536;
constexpr int NEXP = 16384, PQ = 2048;
constexpr float EPS = 1e-6f;
constexpr int NWAVES = 8, NTHREADS = 512;

constexpr size_t MiB = 1u << 20;
constexpr size_t WS_CTL = 0, CTL_ZERO_BYTES = 1 * MiB;
constexpr size_t CTL_BAR_WORD = 4096;
constexpr size_t CTL_ROWSQ = 256 * 1024;
constexpr size_t WS_RSTD = 1 * MiB;
constexpr size_t WS_WTIN = 2 * MiB;
constexpr size_t WS_WTBR = 23 * MiB;
constexpr size_t WS_WTOUT = 29 * MiB;
constexpr size_t WS_WEFF = 33 * MiB;
constexpr size_t WS_WSP = 41 * MiB;
constexpr size_t WS_ROWSQP = 42 * MiB;
constexpr size_t WS_ESCALE = 46 * MiB;
constexpr size_t WS_EXP = 48 * MiB;
constexpr size_t WS_XB = 112 * MiB;
constexpr size_t WS_PROJA = 176 * MiB;
constexpr size_t WS_MERGED = 176 * MiB;
constexpr size_t WS_SCORES = 176 * MiB;
constexpr size_t WS_SCRATCH = 176 * MiB;
constexpr size_t WS_GATES = 320 * MiB;
constexpr size_t WS_SELI = 464 * MiB, WS_SELG = 480 * MiB;
constexpr size_t WS_END = 512 * MiB;

constexpr int LDS_BYTES = 163840;
constexpr int LDS_MISC = LDS_BYTES - 256;

#define NEG_INF_F (__uint_as_float(0xff800000u))
__device__ __forceinline__ unsigned cvt_pk_bf16(float lo, float hi) { unsigned r; asm volatile("v_cvt_pk_bf16_f32 %0, %1, %2" : "=v"(r) : "v"(lo), "v"(hi)); return r; }
__device__ __forceinline__ float bf_lo(unsigned u) { return __uint_as_float(u << 16); }
__device__ __forceinline__ float bf_hi(unsigned u) { return __uint_as_float(u & 0xffff0000u); }
__device__ __forceinline__ float bf1(bf16_t u) { return __uint_as_float(((unsigned)u) << 16); }
__device__ __forceinline__ float wave_sum(float v) {
#pragma unroll
    for (int o = 1; o < 64; o <<= 1) v += __shfl_xor(v, o);
    return v;
}
__device__ __forceinline__ float gelu_tanh(float x) {
    const float u = 0.7978845608028654f * (x + 0.044715f * x * x * x);
    const float e = __builtin_amdgcn_exp2f(-2.0f * 1.4426950408889634f * u);
    return x * __builtin_amdgcn_rcpf(1.0f + e);
}
__device__ __forceinline__ float row_sumsq(const float* part, int row) { const f32x4* q = (const f32x4*)(part + (size_t)row * 16); const f32x4 a = q[0], b = q[1], c = q[2], d = q[3];
    return (((a[0] + a[1]) + (a[2] + a[3])) + ((b[0] + b[1]) + (b[2] + b[3]))) + (((c[0] + c[1]) + (c[2] + c[3])) + ((d[0] + d[1]) + (d[2] + d[3]))); }
__device__ __forceinline__ float sigmoidf_(float x) { return __builtin_amdgcn_rcpf(1.0f + __builtin_amdgcn_exp2f(-1.4426950408889634f * x)); }

#define XB_TMO      128
#define XB_XCNT(j)  (256  + 64 * (j))
#define XB_XSUB(j)  (1280 + 64 * (j))
#define XB_XGEN(j)  (2304 + 64 * (j))
#define XB_TOP      3328
#define XB_TOPGEN   3392
#define XCD_BAR_WORDS 3456
#define XB_SPIN_CAP (1u << 18)
__device__ __forceinline__ unsigned xb_ld(unsigned* p)              { return __hip_atomic_load(p, __ATOMIC_RELAXED, __HIP_MEMORY_SCOPE_AGENT); }
__device__ __forceinline__ unsigned xb_add(unsigned* p, unsigned v) { return __hip_atomic_fetch_add(p, v, __ATOMIC_RELAXED, __HIP_MEMORY_SCOPE_AGENT); }
__device__ __forceinline__ unsigned xb_xcc_id() { return (unsigned)__builtin_amdgcn_s_getreg((3 << 11) | 20) & 0xFu; }
#define XB_SPIN(cond, bar) do { unsigned _sp = 0; while (cond) { __builtin_amdgcn_s_sleep(1); \
    if ((++_sp & 255u) == 0u) { if (xb_ld(&(bar)[XB_TMO])) break; if (_sp > XB_SPIN_CAP) { atomicAdd(&(bar)[XB_TMO], 1u); break; } } } } while (0)
struct XcdBarrier { unsigned* bar; unsigned x; volatile LAS unsigned* st; };
__device__ __forceinline__ XcdBarrier xcd_barrier_post(unsigned* bar, volatile LAS unsigned* st) {
    XcdBarrier b; b.bar = bar; b.x = xb_xcc_id(); b.st = st;
    if (threadIdx.x == 0) (void)xb_add(&bar[XB_XCNT(b.x)], 1u);
    return b;
}
__device__ __forceinline__ void xcd_barrier_complete(unsigned* bar, unsigned x, unsigned& nloc, unsigned& nx) {
    const unsigned G = gridDim.x * gridDim.y * gridDim.z;
    unsigned sum, cnt, mine, sp = 0u;
    for (;;) {
        sum = 0u; cnt = 0u; mine = 0u;
#pragma unroll
        for (unsigned j = 0; j < 16; ++j) { const unsigned c = xb_ld(&bar[XB_XCNT(j)]); sum += c; cnt += (c > 0u) ? 1u : 0u; mine = (j == x) ? c : mine; }
        if (sum == G) break;
        __builtin_amdgcn_s_sleep(1);
        if ((++sp & 255u) == 0u) { if (xb_ld(&bar[XB_TMO])) break; if (sp > XB_SPIN_CAP) { atomicAdd(&bar[XB_TMO], 1u); break; } }
    }
    nloc = mine > 0u ? mine : 1u; nx = cnt > 0u ? cnt : 1u;
}
__device__ __forceinline__ void xcd_barrier(const XcdBarrier& b) {
    asm volatile("s_waitcnt vmcnt(0)" ::: "memory");
    __syncthreads();
    if (threadIdx.x == 0) {
        unsigned* bar = b.bar;
        __builtin_amdgcn_s_waitcnt(0);
        unsigned nloc = b.st[0], nx = b.st[1];
        if (nloc == 0u) { xcd_barrier_complete(bar, b.x, nloc, nx); b.st[0] = nloc; b.st[1] = nx; }
        const unsigned old = xb_add(&bar[XB_XSUB(b.x)], 1u);
        const unsigned gen = old / nloc;
        if (old + 1u == (gen + 1u) * nloc) {
            __builtin_amdgcn_fence(__ATOMIC_RELEASE, "agent");
            asm volatile("s_waitcnt vmcnt(0)" ::: "memory");
            const unsigned og = xb_add(&bar[XB_TOP], 1u);
            const unsigned tg = og / nx;
            if (og + 1u == (tg + 1u) * nx) xb_add(&bar[XB_TOPGEN], 1u);
            else XB_SPIN(xb_ld(&bar[XB_TOPGEN]) == tg, bar);
            __builtin_amdgcn_fence(__ATOMIC_ACQUIRE, "agent");
            xb_add(&bar[XB_XGEN(b.x)], 1u);
            asm volatile("s_waitcnt vmcnt(0)" ::: "memory");
        } else {
            XB_SPIN(xb_ld(&bar[XB_XGEN(b.x)]) == gen, bar);
            __builtin_amdgcn_fence(__ATOMIC_ACQUIRE, "agent");
            asm volatile("s_waitcnt vmcnt(0)" ::: "memory");
        }
    }
    __syncthreads();
}

constexpr int CTL_ALIGN_WORD = 16384;
__device__ __forceinline__ void xcd_align(const XcdBarrier& b) {
    __syncthreads();
    if (threadIdx.x == 0) {
        const unsigned nloc = b.st[0];
        if (nloc != 0u) {
            unsigned* w = b.bar + (CTL_ALIGN_WORD - (int)CTL_BAR_WORD) + b.x * 32u;
            const unsigned old = xb_add(w, 1u), target = (old / nloc + 1u) * nloc;
            XB_SPIN(xb_ld(w) < target, b.bar);
        }
    }
    __syncthreads();
}

namespace pg8 {
constexpr int BM = 256, BK = 64, HALF = 128, HTB = HALF * BK * 2, STAGE_BYTES = 8 * HTB, NXCD = 8, WGM = 8;
__host__ __device__ __forceinline__ int lds_byte(int r, int c) { const int st = (r >> 4) * 2 + (c >> 5), rr = r & 15, cc = c & 31, ob = rr * 64 + cc * 2; return st * 1024 + (ob ^ (((ob >> 9) & 1) << 5)); }
__host__ __device__ __forceinline__ void stage_rc(int b, int& R, int& C) { const int st = b / 1024, sb = b % 1024, swz = sb ^ (((sb >> 9) & 1) << 5); R = (st >> 1) * 16 + swz / 64; C = (st & 1) * 32 + (swz % 64) / 2; }
__host__ __device__ __forceinline__ int perm32(int rho) { const int n = rho >> 4, i = rho & 15; return 8 * (i >> 2) + 4 * n + (i & 3); }

struct Unit { int pm, pn, z; };
struct Gemm { const bf16_t* A; const bf16_t* Bt; int lda, ldb, K; size_t az, bz; };

template <int ZN> struct TileOrder {
    int nM, nN, nwg, G, c;
    __device__ void init(int M, int N, int G_, int c_) { nM = M / BM; nN = N / BM; nwg = nM * nN; G = G_; c = c_; }
    __device__ bool next(int i, Unit& u) const {
        const long L = (long)(i / ZN) * G + c; if (L >= nwg) return false;
        int wgid = (int)L; { const int q = nwg / NXCD, r = nwg % NXCD, xcd = wgid % NXCD, off = wgid / NXCD; wgid = (xcd < r ? xcd * (q + 1) : r * (q + 1) + (xcd - r) * q) + off; }
        const int nig = WGM * nN, gid = wgid / nig, fm = gid * WGM, gsz = (nM - fm) < WGM ? (nM - fm) : WGM;
        u.pm = fm + ((wgid % nig) % gsz); u.pn = (wgid % nig) / gsz; u.z = i % ZN; return true;
    }
};

template <class Epi, class Sched>
__device__ __forceinline__ void gemm_phase(LAS unsigned char* lds, const Gemm g, const Sched& S, const Epi& E, int wave_id) {
    unsigned ones_; asm volatile("s_mov_b32 %0, -1" : "=s"(ones_));
    int tid_l = (wave_id << 6) | (int)__builtin_amdgcn_mbcnt_hi(ones_, __builtin_amdgcn_mbcnt_lo(ones_, 0u)); asm volatile("" : "+v"(tid_l));
    int wid_l = __builtin_amdgcn_readfirstlane(tid_l >> 6);
    const int tid = tid_l, wid = wid_l, lane = tid & 63, wr = wid >> 2, wc = wid & 3, fr = lane & 15, fq = lane >> 4;
    const int K = g.K, nt = K / BK;
    unsigned voffA[2], voffB[2];
#pragma unroll
    for (int i = 0; i < 2; ++i) { int R, C; stage_rc(tid * 16 + i * 8192, R, C); const int Rb = Epi::PERM ? ((R & ~31) + perm32(R & 31)) : R;
        voffA[i] = (unsigned)(R * g.lda + C) * 2u; voffB[i] = (unsigned)(Rb * g.ldb + C) * 2u; }
    const size_t kstep = (size_t)(BK * 2);
    const size_t hstepA = (size_t)HALF * g.lda * 2, hstepB = (size_t)HALF * g.ldb * 2;
    const size_t tstepA = 2 * hstepA, tstepB = 2 * hstepB;
    const unsigned ldsw = (unsigned)wid * 1024u;
    const int aoff = lds_byte(wr * 64 + fr, fq * 8), boff = lds_byte(wc * 32 + fr, fq * 8);
#define PG8_SA(b, h) (((b) * 2 + (h)) * HTB)
#define PG8_SB(b, h) ((4 + (b) * 2 + (h)) * HTB)
#define PG8_STAGE(bufoff, gbase, voff) do { _Pragma("unroll") for (int _i = 0; _i < 2; ++_i) \
        __builtin_amdgcn_global_load_lds((const unsigned*)((const char*)(gbase) + (voff)[_i]), (LAS unsigned*)(lds + (bufoff) + ldsw + _i * 8192), 16, 0, 0); } while (0)
#define PG8_LDA(dst, b, h) do { _Pragma("unroll") for (int m = 0; m < 4; ++m) _Pragma("unroll") for (int k = 0; k < 2; ++k) dst[m][k] = *(const LAS bf16x8*)(lds + PG8_SA(b, h) + aoff + m * 2048 + k * 1024); } while (0)
#define PG8_LDB(dst, b, h) do { _Pragma("unroll") for (int n = 0; n < 2; ++n) _Pragma("unroll") for (int k = 0; k < 2; ++k) dst[n][k] = *(const LAS bf16x8*)(lds + PG8_SB(b, h) + boff + n * 2048 + k * 1024); } while (0)
#define PG8_MMA(ai, bj, At, Bt) do { __builtin_amdgcn_s_setprio(1); _Pragma("unroll") for (int m = 0; m < 4; ++m) _Pragma("unroll") for (int n = 0; n < 2; ++n) _Pragma("unroll") for (int k = 0; k < 2; ++k) \
        acc[ai][bj][m][n] = __builtin_amdgcn_mfma_f32_16x16x32_bf16(Bt[n][k], At[m][k], acc[ai][bj][m][n], 0, 0, 0); __builtin_amdgcn_s_setprio(0); } while (0)
#define PG8_WAIT_V(n) asm volatile("s_waitcnt vmcnt(" #n ")" ::: "memory")
#define PG8_WAIT_L(n) asm volatile("s_waitcnt lgkmcnt(" #n ")" ::: "memory")
#define PG8_BAR __builtin_amdgcn_s_barrier()
#define PG8_SCHED __builtin_amdgcn_sched_barrier(0)
    Unit cur, nxt; int ui = 0;
    if (!S.next(0, cur)) return;
    f32x4 acc[2][2][4][2];
#pragma unroll
    for (int a = 0; a < 2; ++a)
#pragma unroll
        for (int b = 0; b < 2; ++b)
#pragma unroll
            for (int m = 0; m < 4; ++m)
#pragma unroll
                for (int n = 0; n < 2; ++n) acc[a][b][m][n] = (f32x4){0.f, 0.f, 0.f, 0.f};
    bf16x8 At[4][2], B0[2][2], B1[2][2];
    const char* cA = (const char*)g.A + (size_t)cur.pm * tstepA + (size_t)cur.z * g.az; const char* cB = (const char*)g.Bt + (size_t)cur.pn * tstepB + (size_t)cur.z * g.bz;
    PG8_STAGE(PG8_SB(0, 0), cB, voffB); PG8_STAGE(PG8_SB(0, 1), cB + hstepB, voffB); PG8_STAGE(PG8_SA(0, 0), cA, voffA); PG8_STAGE(PG8_SA(0, 1), cA + hstepA, voffA);
    if (wr == 1) PG8_BAR;
    PG8_WAIT_V(2); PG8_BAR;
    PG8_STAGE(PG8_SB(1, 0), cB + kstep, voffB); PG8_STAGE(PG8_SA(1, 0), cA + kstep, voffA); PG8_STAGE(PG8_SB(1, 1), cB + hstepB + kstep, voffB);
    PG8_WAIT_V(6); PG8_BAR;
    for (;;) {
        const bool has_next = S.next(ui + 1, nxt);
        const char* nA = has_next ? (const char*)g.A + (size_t)nxt.pm * tstepA + (size_t)nxt.z * g.az : cA;
        const char* nB = has_next ? (const char*)g.Bt + (size_t)nxt.pn * tstepB + (size_t)nxt.z * g.bz : cB;
        for (int t = 0; t < nt; t += 2) {
            const bool last = (t == nt - 2);
            const char* a1 = cA + (size_t)(t + 1) * kstep;
            const char* a2 = last ? nA : cA + (size_t)(t + 2) * kstep; const char* b2 = last ? nB : cB + (size_t)(t + 2) * kstep;
            const char* a3 = a2 + kstep; const char* b3 = b2 + kstep;
            PG8_LDB(B0, 0, 0); PG8_LDB(B1, 0, 1); PG8_SCHED; PG8_LDA(At, 0, 0); PG8_STAGE(PG8_SA(1, 1), a1 + hstepA, voffA);
            PG8_WAIT_V(8); PG8_WAIT_L(0); PG8_BAR; PG8_MMA(0, 0, At, B0); PG8_MMA(0, 1, At, B1); PG8_BAR; PG8_SCHED;
            PG8_LDA(At, 0, 1); PG8_STAGE(PG8_SB(0, 0), b2, voffB); PG8_STAGE(PG8_SB(0, 1), b2 + hstepB, voffB); PG8_STAGE(PG8_SA(0, 0), a2, voffA);
            PG8_WAIT_V(8); PG8_WAIT_L(0); PG8_BAR; PG8_MMA(1, 0, At, B0); PG8_MMA(1, 1, At, B1); PG8_BAR; PG8_SCHED;
            PG8_LDB(B0, 1, 0); PG8_LDB(B1, 1, 1); PG8_SCHED; PG8_LDA(At, 1, 0); PG8_STAGE(PG8_SA(0, 1), a2 + hstepA, voffA);
            PG8_WAIT_V(8); PG8_WAIT_L(0); PG8_BAR; PG8_MMA(0, 0, At, B0); PG8_MMA(0, 1, At, B1); PG8_BAR; PG8_SCHED;
            PG8_LDA(At, 1, 1); PG8_STAGE(PG8_SB(1, 0), b3, voffB); PG8_STAGE(PG8_SB(1, 1), b3 + hstepB, voffB); PG8_STAGE(PG8_SA(1, 0), a3, voffA);
            PG8_WAIT_V(8); PG8_WAIT_L(0); PG8_BAR; PG8_MMA(1, 0, At, B0); PG8_MMA(1, 1, At, B1); PG8_BAR; PG8_SCHED;
        }
        if (wr == 0) PG8_BAR;
        E(acc, cur, wr, wc, fr, fq);
        if (!has_next) break;
        if (!E.keep(cur)) {
#pragma unroll
            for (int a = 0; a < 2; ++a)
#pragma unroll
                for (int b = 0; b < 2; ++b)
#pragma unroll
                    for (int m = 0; m < 4; ++m)
#pragma unroll
                        for (int n = 0; n < 2; ++n) acc[a][b][m][n] = (f32x4){0.f, 0.f, 0.f, 0.f};
        }
        cur = nxt; cA = nA; cB = nB; ++ui;
        if (wr == 1) PG8_BAR;
    }
    PG8_WAIT_V(0);
    PG8_BAR;
#undef PG8_SA
#undef PG8_SB
#undef PG8_STAGE
#undef PG8_LDA
#undef PG8_LDB
#undef PG8_MMA
#undef PG8_WAIT_V
#undef PG8_WAIT_L
#undef PG8_BAR
#undef PG8_SCHED
}
}
typedef pg8::Unit Unit;
typedef f32x4 AccT[2][2][4][2];

struct EpiProjA {
    static constexpr bool PERM = true;
    bf16_t* O; const float* rstd;
    __device__ __forceinline__ bool keep(const Unit&) const { return false; }
    template <bool ACT> __device__ __forceinline__ void run(AccT& acc, const Unit& u, int wr, int wc, int fr, int fq) const {
        const int row0 = u.pm * 256 + wr * 64 + fr, col0 = u.pn * 256 + wc * 32 + 8 * fq;
        float rs[2][4];
#pragma unroll
        for (int ai = 0; ai < 2; ++ai)
#pragma unroll
            for (int m = 0; m < 4; ++m) rs[ai][m] = rstd[row0 + ai * 128 + m * 16];
#pragma unroll
        for (int ai = 0; ai < 2; ++ai)
#pragma unroll
            for (int m = 0; m < 4; ++m) { const int row = row0 + ai * 128 + m * 16; bf16_t* rowp = O + (size_t)row * NA + col0;
#pragma unroll
                for (int bj = 0; bj < 2; ++bj) { f32x4 v0 = acc[ai][bj][m][0] * rs[ai][m], v1 = acc[ai][bj][m][1] * rs[ai][m];
                    if (ACT) {
#pragma unroll
                        for (int j = 0; j < 4; ++j) { v0[j] = gelu_tanh(v0[j]); v1[j] = gelu_tanh(v1[j]); } }
                    u32x4 w; w.x = cvt_pk_bf16(v0[0], v0[1]); w.y = cvt_pk_bf16(v0[2], v0[3]); w.z = cvt_pk_bf16(v1[0], v1[1]); w.w = cvt_pk_bf16(v1[2], v1[3]);
                    *(u32x4*)(rowp + bj * 128) = w; } }
    }
    __device__ __forceinline__ void operator()(AccT& acc, const Unit& u, int wr, int wc, int fr, int fq) const {
        if (u.pn >= 5) run<true>(acc, u, wr, wc, fr, fq); else run<false>(acc, u, wr, wc, fr, fq);
    }
};
struct EpiGates {
    static constexpr bool PERM = true;
    unsigned char* O; const float* rstd; const float* bias;
    __device__ __forceinline__ bool keep(const Unit&) const { return false; }
    __device__ __forceinline__ void operator()(AccT& acc, const Unit& u, int wr, int wc, int fr, int fq) const {
        const int row0 = u.pm * 256 + wr * 64 + fr, col0 = u.pn * 256 + wc * 32 + 8 * fq;
        f32x4 bv[2][2];
#pragma unroll
        for (int bj = 0; bj < 2; ++bj)
#pragma unroll
            for (int n = 0; n < 2; ++n) bv[bj][n] = *(const f32x4*)(bias + col0 + bj * 128 + 4 * n);
        unsigned char* tile = O + (size_t)(u.pm * (NG / 256) + u.pn) * 65536 + (wr * 64 + fr) * 256 + wc * 32 + 8 * fq;
        float rsv[2][4];
#pragma unroll
        for (int ai = 0; ai < 2; ++ai)
#pragma unroll
            for (int m = 0; m < 4; ++m) rsv[ai][m] = rstd[row0 + ai * 128 + m * 16];
#pragma unroll
        for (int ai = 0; ai < 2; ++ai)
#pragma unroll
            for (int m = 0; m < 4; ++m) { const float rs = rsv[ai][m]; unsigned wq[4];
#pragma unroll
                for (int bj = 0; bj < 2; ++bj) { f32x4 v0 = acc[ai][bj][m][0] * rs + bv[bj][0], v1 = acc[ai][bj][m][1] * rs + bv[bj][1];
                    unsigned q[8];
#pragma unroll
                    for (int j = 0; j < 4; ++j) { q[j] = (unsigned)(sigmoidf_(v0[j]) * 255.0f + 0.5f); q[4 + j] = (unsigned)(sigmoidf_(v1[j]) * 255.0f + 0.5f); }
                    wq[2 * bj] = q[0] | (q[1] << 8) | (q[2] << 16) | (q[3] << 24); wq[2 * bj + 1] = q[4] | (q[5] << 8) | (q[6] << 16) | (q[7] << 24); }
                *(u32x4*)(O + (size_t)0 * 1048576 + (size_t)(u.pm * (NG / 256) + u.pn) * 65536 + (ai * 4 + m) * 8192 + (((wr * 4 + wc) * 64) + fq * 16 + fr) * 16) = (u32x4){wq[0], wq[1], wq[2], wq[3]}; }
    }
};
struct EpiMerge {
    static constexpr bool PERM = true;
    const unsigned char* gates; bf16_t* O; int cheap;
    __device__ __forceinline__ bool keep(const Unit& u) const { return u.z < 2; }
    static __device__ __forceinline__ void unpack8(const u32x2 a, float (&f)[8]) {
        f[0] = (float)(a.x & 255u); f[1] = (float)((a.x >> 8) & 255u); f[2] = (float)((a.x >> 16) & 255u); f[3] = (float)(a.x >> 24);
        f[4] = (float)(a.y & 255u); f[5] = (float)((a.y >> 8) & 255u); f[6] = (float)((a.y >> 16) & 255u); f[7] = (float)(a.y >> 24); }
    __device__ __forceinline__ void operator()(AccT& acc, const Unit& u, int wr, int wc, int fr, int fq) const {
        const int z = u.z;
        if (cheap && z < 2) return;
        constexpr int GTS = 4 * 65536;
        const __amdgpu_buffer_rsrc_t gr = __builtin_amdgcn_make_buffer_rsrc(const_cast<unsigned char*>(gates) + (size_t)0 * 1048576, 0, NTOK * NG, 0x00020000);
        const __amdgpu_buffer_rsrc_t orr = __builtin_amdgcn_make_buffer_rsrc(O, 0, NTOK * DM * 2, 0x00020000);
        const int gsoff = (u.pm * (NG / 256) + u.pn) * 65536 + z * GTS, gsoffb = gsoff + (z < 2 ? GTS : 0);
        const int lofs = (((wr * 4 + wc) * 64) + fq * 16 + fr) * 16;
        const int osoff = (u.pm * 256 * DM + u.pn * 256) * 2, oofs = ((wr * 64 + fr) * DM + wc * 32 + 8 * fq) * 2;
        const float lo = (z == 0) ? 0.0f : 0.5f; const bool last = (z == 2);
#pragma unroll
        for (int aq = 0; aq < 4; ++aq) { const int ai = aq >> 1, m0 = (aq & 1) * 2; u32x2 A[2][2], B[2][2];
#pragma unroll
            for (int mm = 0; mm < 2; ++mm)
#pragma unroll
                for (int bj = 0; bj < 2; ++bj) { A[mm][bj] = __builtin_amdgcn_raw_buffer_load_b64(gr, lofs + bj * 8, gsoff + (ai * 4 + (m0 + mm)) * 8192, 0);
                    B[mm][bj] = __builtin_amdgcn_raw_buffer_load_b64(gr, lofs + bj * 8, gsoffb + (ai * 4 + (m0 + mm)) * 8192, 0); }
#pragma unroll
            for (int mm = 0; mm < 2; ++mm)
#pragma unroll
                for (int bj = 0; bj < 2; ++bj) { const int m = m0 + mm; float fa[8], fb[8]; unpack8(A[mm][bj], fa); unpack8(B[mm][bj], fb);
                    float f[8];
#pragma unroll
                    for (int j = 0; j < 8; ++j) { const float den = last ? 255.0f : fmaxf(fb[j], 0.5f); f[j] = fmaxf(fa[j], lo) * __builtin_amdgcn_rcpf(den); }
                    f32x4 v0 = acc[ai][bj][m][0], v1 = acc[ai][bj][m][1];
                    v0[0] *= f[0]; v0[1] *= f[1]; v0[2] *= f[2]; v0[3] *= f[3]; v1[0] *= f[4]; v1[1] *= f[5]; v1[2] *= f[6]; v1[3] *= f[7];
                    acc[ai][bj][m][0] = v0; acc[ai][bj][m][1] = v1;
                    if (last) { u32x4 w; w.x = cvt_pk_bf16(v0[0], v0[1]); w.y = cvt_pk_bf16(v0[2], v0[3]); w.z = cvt_pk_bf16(v1[0], v1[1]); w.w = cvt_pk_bf16(v1[2], v1[3]);
                        __builtin_amdgcn_raw_buffer_store_b128(w, orr, oofs + bj * 256, osoff + (ai * 128 + m * 16) * DM * 2, 0); } }
        }
    }
};
struct EpiResid {
    static constexpr bool PERM = true;
    bf16_t* X; float* rowsq; bf16_t* XO;
    __device__ __forceinline__ bool keep(const Unit&) const { return false; }
    __device__ __forceinline__ void operator()(AccT& acc, const Unit& u, int wr, int wc, int fr, int fq) const {
        const int row0 = u.pm * 256 + wr * 64 + fr, col0 = u.pn * 256 + wc * 32 + 8 * fq;
#pragma unroll
        for (int ai = 0; ai < 2; ++ai)
#pragma unroll
            for (int m = 0; m < 4; ++m) { const int row = row0 + ai * 128 + m * 16; bf16_t* rowp = X + (size_t)row * DM + col0; float ss = 0.f;
#pragma unroll
                for (int bj = 0; bj < 2; ++bj) { const u32x4 x = *(const u32x4*)(rowp + bj * 128);
                    f32x4 v0 = acc[ai][bj][m][0], v1 = acc[ai][bj][m][1];
                    v0[0] += bf_lo(x.x); v0[1] += bf_hi(x.x); v0[2] += bf_lo(x.y); v0[3] += bf_hi(x.y); v1[0] += bf_lo(x.z); v1[1] += bf_hi(x.z); v1[2] += bf_lo(x.w); v1[3] += bf_hi(x.w);
                    ss += (v0[0] * v0[0] + v0[1] * v0[1]) + (v0[2] * v0[2] + v0[3] * v0[3]) + (v1[0] * v1[0] + v1[1] * v1[1]) + (v1[2] * v1[2] + v1[3] * v1[3]);
                    u32x4 w; w.x = cvt_pk_bf16(v0[0], v0[1]); w.y = cvt_pk_bf16(v0[2], v0[3]); w.z = cvt_pk_bf16(v1[0], v1[1]); w.w = cvt_pk_bf16(v1[2], v1[3]);
                    *(u32x4*)(XO + (size_t)row * DM + col0 + bj * 128) = w; }
                ss += __shfl_xor(ss, 16); ss += __shfl_xor(ss, 32);
                if (fq == 0) rowsq[(size_t)row * 16 + u.pn * 4 + wc] = ss; }
    }
};
struct EpiScores {
    static constexpr bool PERM = true;
    bf16_t* C;
    __device__ __forceinline__ bool keep(const Unit&) const { return false; }
    __device__ __forceinline__ void operator()(AccT& acc, const Unit& u, int wr, int wc, int fr, int fq) const {
        const int row0 = u.pm * 256 + wr * 64 + fr, col0 = u.pn * 256 + wc * 32 + 8 * fq;
#pragma unroll
        for (int ai = 0; ai < 2; ++ai)
#pragma unroll
            for (int m = 0; m < 4; ++m) { bf16_t* rowp = C + (size_t)(row0 + ai * 128 + m * 16) * PQ + col0;
#pragma unroll
                for (int bj = 0; bj < 2; ++bj) { const f32x4 v0 = acc[ai][bj][m][0], v1 = acc[ai][bj][m][1];
                    u32x4 w; w.x = cvt_pk_bf16(v0[0], v0[1]); w.y = cvt_pk_bf16(v0[2], v0[3]); w.z = cvt_pk_bf16(v1[0], v1[1]); w.w = cvt_pk_bf16(v1[2], v1[3]);
                    *(u32x4*)(rowp + bj * 128) = w; } }
    }
};

struct Params {
    const float* in[22];
    float* out; unsigned char* ws;
    int ph_lo, ph_hi, li, pad;
    int rep[12];
};
enum { I_X = 0, I_RELB, I_FGAIN, I_AGAIN, I_WIN, I_BGATE, I_SINK, I_WPOOL, I_PSCALE, I_VGAIN, I_WSP, I_BSP, I_WA, I_WB, I_WC, I_WOUT, I_FFGAIN, I_WQ, I_K1, I_K2, I_EU, I_EV };

struct Frame { LAS unsigned char* lds; int tid, lane, wave, G, vcu; };
__device__ __forceinline__ int tid_from_wave(int wave) { unsigned ones; asm volatile("s_mov_b32 %0, -1" : "=s"(ones));
    int t = (wave << 6) | (int)__builtin_amdgcn_mbcnt_hi(ones, __builtin_amdgcn_mbcnt_lo(ones, 0u)); asm volatile("" : "+v"(t)); return t; }
__device__ __forceinline__ Frame local_frame(const Frame& F0) { Frame F = F0; const int t = tid_from_wave(F0.wave); F.tid = t; F.lane = t & 63; return F; }

__device__ __forceinline__ void p0_transpose_item(const float* W, int N, bf16_t* WT, int ldo, const float* kscale, LAS float* scr, int item, int lane) {
    const int nblk = N / 32, kb = item / nblk, nb = item % nblk, k0 = 64 * kb, n0 = 32 * nb;
#pragma unroll 8
    for (int i = 0; i < 32; ++i) { const int kk = 2 * i + (lane >> 5); float v = W[(size_t)(k0 + kk) * N + n0 + (lane & 31)]; if (kscale) v *= kscale[k0 + kk]; scr[kk * 33 + (lane & 31)] = v; }
    asm volatile("s_waitcnt lgkmcnt(0)" ::: "memory");
    const int c = lane & 7;
#pragma unroll
    for (int j = 0; j < 4; ++j) { const int n = (lane >> 3) + 8 * j; const LAS float* s = scr + (8 * c) * 33 + n;
        u32x4 o; o.x = cvt_pk_bf16(s[0 * 33], s[1 * 33]); o.y = cvt_pk_bf16(s[2 * 33], s[3 * 33]); o.z = cvt_pk_bf16(s[4 * 33], s[5 * 33]); o.w = cvt_pk_bf16(s[6 * 33], s[7 * 33]);
        *(u32x4*)(WT + (size_t)(n0 + n) * ldo + k0 + 8 * c) = o; }
    asm volatile("s_waitcnt lgkmcnt(0)" ::: "memory");
}
__device__ __forceinline__ void convert_experts(const Params& p, const Frame& F) {
    const int gw = blockIdx.x * NWAVES + F.wave, NGW = F.G * NWAVES, lane = F.lane;
    constexpr int RB = 4;
    for (int r0 = gw * RB; r0 < DEPTH * 2 * NEXP; r0 += NGW * RB) {
        f32x4 v[RB][4];
#pragma unroll
        for (int q = 0; q < RB; ++q) { const int r = r0 + q; const int l = r / (2 * NEXP), tb = (r / NEXP) & 1, row = r % NEXP;
            const float* src = (tb ? p.in[I_EV] : p.in[I_EU]) + ((size_t)l * NEXP + row) * DM + lane * 16;
            v[q][0] = *(const f32x4*)src; v[q][1] = *(const f32x4*)(src + 4); v[q][2] = *(const f32x4*)(src + 8); v[q][3] = *(const f32x4*)(src + 12); }
#pragma unroll
        for (int q = 0; q < RB; ++q) { const int r = r0 + q; const int l = r / (2 * NEXP), tb = (r / NEXP) & 1, row = r % NEXP;
            float mx = 0.f;
#pragma unroll
            for (int j = 0; j < 4; ++j) mx = fmaxf(mx, fmaxf(fmaxf(fabsf(v[q][j][0]), fabsf(v[q][j][1])), fmaxf(fabsf(v[q][j][2]), fabsf(v[q][j][3]))));
#pragma unroll
            for (int o = 1; o < 64; o <<= 1) mx = fmaxf(mx, __shfl_xor(mx, o));
            const float inv = mx > 0.f ? 448.0f / mx : 0.f;
            int w[4];
#pragma unroll
            for (int j = 0; j < 4; ++j) { w[j] = 0; w[j] = __builtin_amdgcn_cvt_pk_fp8_f32(v[q][j][0] * inv, v[q][j][1] * inv, w[j], false); w[j] = __builtin_amdgcn_cvt_pk_fp8_f32(v[q][j][2] * inv, v[q][j][3] * inv, w[j], true); }
            *(u32x4*)(p.ws + WS_EXP + (((size_t)l * 2 + tb) * NEXP + row) * DM + lane * 16) = (u32x4){(unsigned)w[0], (unsigned)w[1], (unsigned)w[2], (unsigned)w[3]};
            if (lane == 0) ((float*)(p.ws + WS_ESCALE))[((size_t)l * NEXP + row) * 2 + tb] = mx * (1.0f / 448.0f); }
    }
}
__device__ __forceinline__ void phase_prologue(const Params& p, const Frame& F0) {
    const Frame F = local_frame(F0);
    const int gw = F.vcu * NWAVES + F.wave, NGW = F.G * NWAVES, lane = F.lane;
    LAS float* scr = (LAS float*)(F.lds + F.wave * 16384);
    constexpr int I_IN = (DM / 64) * (NIN / 32), I_BR = (512 / 64) * (DM / 32), I_OUT = (DM / 64) * (DM / 32);
    constexpr int PER_L = I_IN + 2 * I_BR + I_OUT;
    for (int it = gw; it < DEPTH * PER_L; it += NGW) {
        const int l = it / PER_L; int r = it % PER_L;
        if (r < I_IN) { p0_transpose_item(p.in[I_WIN] + (size_t)l * DM * NIN, NIN, (bf16_t*)(p.ws + WS_WTIN) + (size_t)l * NIN * DM, DM, p.in[I_AGAIN] + l * DM, scr, r, lane); continue; } r -= I_IN;
        if (r < I_BR) { p0_transpose_item(p.in[I_WA] + (size_t)l * 512 * DM, DM, (bf16_t*)(p.ws + WS_WTBR) + (size_t)(l * 3 + 0) * DM * 512, 512, nullptr, scr, r, lane); continue; } r -= I_BR;
        if (r < I_BR) { p0_transpose_item(p.in[I_WC] + (size_t)l * 512 * DM, DM, (bf16_t*)(p.ws + WS_WTBR) + (size_t)(l * 3 + 2) * DM * 512, 512, nullptr, scr, r, lane); continue; } r -= I_BR;
        p0_transpose_item(p.in[I_WOUT] + (size_t)l * DM * DM, DM, (bf16_t*)(p.ws + WS_WTOUT) + (size_t)l * DM * DM, DM, nullptr, scr, r, lane);
    }
    {
        float* rstd = (float*)(p.ws + WS_RSTD);
        for (int m0 = gw * 4; m0 < NTOK; m0 += NGW * 4) {
            f32x4 v[4][4];
#pragma unroll
            for (int q = 0; q < 4; ++q) { const f32x4* xr = (const f32x4*)(p.in[I_X] + (size_t)(m0 + q) * DM) + lane;
#pragma unroll
                for (int j = 0; j < 4; ++j) v[q][j] = xr[64 * j]; }
#pragma unroll
            for (int q = 0; q < 4; ++q) { float s = 0.f;
#pragma unroll
                for (int j = 0; j < 4; ++j) s += (v[q][j][0] * v[q][j][0] + v[q][j][1] * v[q][j][1]) + (v[q][j][2] * v[q][j][2] + v[q][j][3] * v[q][j][3]);
                s = wave_sum(s);
                u32x2* o = (u32x2*)((bf16_t*)(p.ws + WS_XB) + (size_t)(m0 + q) * DM) + lane;
#pragma unroll
                for (int j = 0; j < 4; ++j) { u32x2 w; w.x = cvt_pk_bf16(v[q][j][0], v[q][j][1]); w.y = cvt_pk_bf16(v[q][j][2], v[q][j][3]); o[64 * j] = w; }
                if (lane == 0) rstd[m0 + q] = 1.0f / sqrtf(s * (1.0f / DM) + EPS); }
        }
    }
    for (int i = blockIdx.x * NTHREADS + F.tid; i < DEPTH * 4 * 128 * 128; i += F.G * NTHREADS) { const int t = (i >> 7) & 127, s = i & 127;
        ((bf16_t*)(p.ws + WS_WSP))[i] = (bf16_t)(cvt_pk_bf16(s <= t ? p.in[I_WSP][i] : 0.f, 0.f) & 0xffffu); }
    convert_experts(p, F);
    __syncthreads();
    {
        LAS float* coef = (LAS float*)F.lds;
        for (int u = blockIdx.x; u < DEPTH * 4 * 32; u += F.G) {
            const int l = u / 128, g = (u / 32) % 4, c0 = (u % 32) * 4;
            __syncthreads();
            for (int i = F.tid; i < 512; i += NTHREADS) { const int cc = i >> 7, j = i & 127;
                coef[i] = p.in[I_WPOOL][(((size_t)l * 4 + g) * 128 + c0 + cc) * 128 + j] * p.in[I_PSCALE][l * 512 + g * 128 + j]; }
            __syncthreads();
            const float* wb = p.in[I_WB] + ((size_t)l * 512 + g * 128) * DM;
            float a0[4], a1[4];
#pragma unroll
            for (int cc = 0; cc < 4; ++cc) { a0[cc] = 0.f; a1[cc] = 0.f; }
#pragma unroll 4
            for (int j = 0; j < 128; ++j) { const float w0 = wb[(size_t)j * DM + F.tid], w1 = wb[(size_t)j * DM + F.tid + 512];
#pragma unroll
                for (int cc = 0; cc < 4; ++cc) { const float cf = coef[cc * 128 + j]; a0[cc] += cf * w0; a1[cc] += cf * w1; } }
            bf16_t* dst = (bf16_t*)(p.ws + WS_WTBR) + (size_t)(l * 3 + 1) * DM * 512 + g * 128 + c0;
            u32x2 w; w.x = cvt_pk_bf16(a0[0], a0[1]); w.y = cvt_pk_bf16(a0[2], a0[3]); *(u32x2*)(dst + (size_t)F.tid * 512) = w;
            u32x2 y; y.x = cvt_pk_bf16(a1[0], a1[1]); y.y = cvt_pk_bf16(a1[2], a1[3]); *(u32x2*)(dst + (size_t)(F.tid + 512) * 512) = y;
        }
    }
    {
        const int fr = F.lane & 15, fq = F.lane >> 4;
        for (int u = blockIdx.x; u < DEPTH * 16 * 16; u += F.G) {
            const int l = u / 256, s = (u / 16) % 16, c0 = (u % 16) * 64;
            const float* keys = ((s & 1) ? p.in[I_K2] : p.in[I_K1]) + (size_t)l * 128 * 128 + (size_t)(16 * F.wave + fr) * 128 + 8 * fq;
            const float* wq = p.in[I_WQ] + (size_t)l * DM * PQ + (size_t)(c0 + fr) * PQ + s * 128 + 8 * fq;
            f32x4 acc[4];
#pragma unroll
            for (int ct = 0; ct < 4; ++ct) acc[ct] = (f32x4){0.f, 0.f, 0.f, 0.f};
#pragma unroll
            for (int ks = 0; ks < 4; ++ks) {
                const f32x4 k0 = *(const f32x4*)(keys + 32 * ks), k1 = *(const f32x4*)(keys + 32 * ks + 4);
                u32x4 kb; kb.x = cvt_pk_bf16(k0[0], k0[1]); kb.y = cvt_pk_bf16(k0[2], k0[3]); kb.z = cvt_pk_bf16(k1[0], k1[1]); kb.w = cvt_pk_bf16(k1[2], k1[3]);
#pragma unroll
                for (int ct = 0; ct < 4; ++ct) { const float* wp = wq + (size_t)(16 * ct) * PQ + 32 * ks; const f32x4 w0 = *(const f32x4*)wp, w1 = *(const f32x4*)(wp + 4);
                    u32x4 wb; wb.x = cvt_pk_bf16(w0[0], w0[1]); wb.y = cvt_pk_bf16(w0[2], w0[3]); wb.z = cvt_pk_bf16(w1[0], w1[1]); wb.w = cvt_pk_bf16(w1[2], w1[3]);
                    acc[ct] = __builtin_amdgcn_mfma_f32_16x16x32_bf16(__builtin_bit_cast(bf16x8, wb), __builtin_bit_cast(bf16x8, kb), acc[ct], 0, 0, 0); }
            }
            bf16_t* dst = (bf16_t*)(p.ws + WS_WEFF) + ((size_t)l * PQ + s * 128 + 16 * F.wave + fr) * DM + c0 + 4 * fq;
#pragma unroll
            for (int ct = 0; ct < 4; ++ct) { const f32x4 gn = *(const f32x4*)(p.in[I_FFGAIN] + l * DM + c0 + 16 * ct + 4 * fq);
                u32x2 w; w.x = cvt_pk_bf16(acc[ct][0] * gn[0], acc[ct][1] * gn[1]); w.y = cvt_pk_bf16(acc[ct][2] * gn[2], acc[ct][3] * gn[3]); *(u32x2*)(dst + 16 * ct) = w; }
        }
    }
}

__device__ __forceinline__ int t5_bucket(int n) {
    if (n < 16) return n;
    const float v = logf((float)n / 16.0f) / 2.0794415416798357f * 16.0f;
    const int b = 16 + (int)v; return b < 31 ? b : 31;
}
__device__ __forceinline__ void phase_mix_simple(const Params& p, const Frame& F0, int l) {
    const Frame F = local_frame(F0);
    const int tid = F.tid, lane = F.lane, wave = F.wave;
    LAS float* Kf = (LAS float*)F.lds;
    LAS float* Vf = Kf + 256 * 64;
    LAS float* biasT = Vf + 256 * 64;
    LAS float* rs = biasT + 1024;
    const bf16_t* proj = (const bf16_t*)(p.ws + WS_PROJA);
    bf16_t* mix = (bf16_t*)p.out;
    for (int nb = blockIdx.x; nb < NTOK / 128; nb += F.G) {
        const int t0 = nb * 128; const bool first = (nb % (SEQ / 128)) == 0;
        __syncthreads();
        for (int i = tid; i < 1024; i += NTHREADS) { const int h = i >> 7, dist = i & 127; biasT[i] = p.in[I_RELB][t5_bucket(dist) * 8 + h]; }
        for (int kvh = 0; kvh < 2; ++kvh) {
            __syncthreads();
            for (int c = tid; c < 2048; c += NTHREADS) { const int row = c >> 3, ch = c & 7; const int tok = t0 - 128 + row;
                u32x4 kv = (u32x4){0u, 0u, 0u, 0u}, vv = (u32x4){0u, 0u, 0u, 0u};
                if (row >= 128 || !first) { kv = *(const u32x4*)(proj + (size_t)tok * NA + COL_K + kvh * 64 + ch * 8); vv = *(const u32x4*)(proj + (size_t)tok * NA + COL_V + kvh * 64 + ch * 8); }
                LAS float* kd = Kf + row * 64 + ch * 8; LAS float* vd = Vf + row * 64 + ch * 8;
                kd[0] = bf_lo(kv.x); kd[1] = bf_hi(kv.x); kd[2] = bf_lo(kv.y); kd[3] = bf_hi(kv.y); kd[4] = bf_lo(kv.z); kd[5] = bf_hi(kv.z); kd[6] = bf_lo(kv.w); kd[7] = bf_hi(kv.w);
                vd[0] = bf_lo(vv.x); vd[1] = bf_hi(vv.x); vd[2] = bf_lo(vv.y); vd[3] = bf_hi(vv.y); vd[4] = bf_lo(vv.z); vd[5] = bf_hi(vv.z); vd[6] = bf_lo(vv.w); vd[7] = bf_hi(vv.w); }
            __syncthreads();
            const int hq = tid >> 7, qi = tid & 127, head = kvh * 4 + hq;
            float q[64], o[64];
            { const u32x4* qp = (const u32x4*)(proj + (size_t)(t0 + qi) * NA + head * 64);
#pragma unroll
              for (int j = 0; j < 8; ++j) { const u32x4 w = qp[j]; q[8 * j + 0] = bf_lo(w.x) * 0.125f; q[8 * j + 1] = bf_hi(w.x) * 0.125f; q[8 * j + 2] = bf_lo(w.y) * 0.125f; q[8 * j + 3] = bf_hi(w.y) * 0.125f;
                  q[8 * j + 4] = bf_lo(w.z) * 0.125f; q[8 * j + 5] = bf_hi(w.z) * 0.125f; q[8 * j + 6] = bf_lo(w.w) * 0.125f; q[8 * j + 7] = bf_hi(w.w) * 0.125f; } }
#pragma unroll
            for (int d = 0; d < 64; ++d) o[d] = 0.f;
            const float sink = p.in[I_SINK][l * 8 + head];
            float mrun = sink, lsum = 0.f;
            const int qb = qi & ~63, kmin = qb + 1, kmax = qb + 63 + 128;
            for (int kj = kmin; kj <= kmax; ++kj) {
                const LAS float* kr = Kf + kj * 64; float s = 0.f;
#pragma unroll
                for (int d4 = 0; d4 < 16; ++d4) { const f32x4 k4 = *(const LAS f32x4*)(kr + d4 * 4); s += (q[4 * d4] * k4[0] + q[4 * d4 + 1] * k4[1]) + (q[4 * d4 + 2] * k4[2] + q[4 * d4 + 3] * k4[3]); }
                const int dist = qi + 128 - kj; const bool valid = (dist >= 0) && (dist < 128) && (kj >= 128 || !first);
                const float logit = s + biasT[head * 128 + (dist & 127)];
                const float mnew = valid ? fmaxf(mrun, logit) : mrun;
                const float corr = __expf(mrun - mnew), pp = valid ? __expf(logit - mnew) : 0.f;
                lsum = lsum * corr + pp; mrun = mnew;
                const LAS float* vr = Vf + kj * 64;
#pragma unroll
                for (int d4 = 0; d4 < 16; ++d4) { const f32x4 v4 = *(const LAS f32x4*)(vr + d4 * 4);
                    o[4 * d4] = o[4 * d4] * corr + pp * v4[0]; o[4 * d4 + 1] = o[4 * d4 + 1] * corr + pp * v4[1]; o[4 * d4 + 2] = o[4 * d4 + 2] * corr + pp * v4[2]; o[4 * d4 + 3] = o[4 * d4 + 3] * corr + pp * v4[3]; }
            }
            const float inv = 1.0f / (lsum + __expf(sink - mrun));
            u32x4* op = (u32x4*)(mix + (size_t)(t0 + qi) * MIXW + head * 64);
#pragma unroll
            for (int j = 0; j < 8; ++j) { u32x4 w; w.x = cvt_pk_bf16(o[8 * j] * inv, o[8 * j + 1] * inv); w.y = cvt_pk_bf16(o[8 * j + 2] * inv, o[8 * j + 3] * inv);
                w.z = cvt_pk_bf16(o[8 * j + 4] * inv, o[8 * j + 5] * inv); w.w = cvt_pk_bf16(o[8 * j + 6] * inv, o[8 * j + 7] * inv); op[j] = w; }
        }
        LAS float* Zs = Kf;
        for (int g = 0; g < 4; ++g) {
            const int w = 2 << g;
            __syncthreads();
            for (int i = tid; i < 143 * 16; i += NTHREADS) { const int row = i >> 4, ch = i & 15; const int tok = t0 - 15 + row;
                u32x4 zv = (u32x4){0u, 0u, 0u, 0u};
                if (row >= 15 || !first) zv = *(const u32x4*)(proj + (size_t)tok * NA + COL_PZ + g * 128 + ch * 8);
                LAS float* zd = Zs + row * 128 + ch * 8;
                zd[0] = bf_lo(zv.x); zd[1] = bf_hi(zv.x); zd[2] = bf_lo(zv.y); zd[3] = bf_hi(zv.y); zd[4] = bf_lo(zv.z); zd[5] = bf_hi(zv.z); zd[6] = bf_lo(zv.w); zd[7] = bf_hi(zv.w); }
            __syncthreads();
            const int c = tid & 127, seg = tid >> 7;
            for (int tt = 0; tt < 32; ++tt) { const int t = seg * 32 + tt, r = t + 15; float sum = 0.f;
                for (int j = 0; j < w; ++j) sum += Zs[(r - j) * 128 + c];
                const int pos = (nb % (SEQ / 128)) * 128 + t; const int cnt = (pos + 1 < w) ? pos + 1 : w;
                const float d = sum / (float)cnt - Zs[r * 128 + c];
                mix[(size_t)(t0 + t) * MIXW + 512 + g * 128 + c] = (bf16_t)(cvt_pk_bf16(d, 0.f) & 0xffffu); }
        }
        __syncthreads();
        for (int tt = 0; tt < 16; ++tt) { const int t = wave * 16 + tt; const u32x4 g4 = *(const u32x4*)(proj + (size_t)(t0 + t) * NA + COL_GV + lane * 8);
            float a[8] = {bf_lo(g4.x), bf_hi(g4.x), bf_lo(g4.y), bf_hi(g4.y), bf_lo(g4.z), bf_hi(g4.z), bf_lo(g4.w), bf_hi(g4.w)}; float ss = 0.f;
#pragma unroll
            for (int j = 0; j < 8; ++j) ss += a[j] * a[j];
            ss = wave_sum(ss); if (lane == 0) rs[t] = 1.0f / sqrtf(ss * (1.0f / 512.0f) + EPS); }
        LAS float* Vn = Kf;
        for (int g = 0; g < 4; ++g) {
            __syncthreads();
            for (int i = tid; i < 128 * 16; i += NTHREADS) { const int s = i >> 4, ch = i & 15; const u32x4 g4 = *(const u32x4*)(proj + (size_t)(t0 + s) * NA + COL_GV + g * 128 + ch * 8);
                const float r = rs[s]; const float* gn = p.in[I_VGAIN] + l * 512 + g * 128 + ch * 8; LAS float* vd = Vn + s * 128 + ch * 8;
                vd[0] = bf_lo(g4.x) * r * gn[0]; vd[1] = bf_hi(g4.x) * r * gn[1]; vd[2] = bf_lo(g4.y) * r * gn[2]; vd[3] = bf_hi(g4.y) * r * gn[3];
                vd[4] = bf_lo(g4.z) * r * gn[4]; vd[5] = bf_hi(g4.z) * r * gn[5]; vd[6] = bf_lo(g4.w) * r * gn[6]; vd[7] = bf_hi(g4.w) * r * gn[7]; }
            __syncthreads();
            const int c = tid & 127, tq = tid >> 7;
            for (int t = tq; t < 128; t += 4) { const float* wrow = p.in[I_WSP] + (((size_t)l * 4 + g) * 128 + t) * 128; float acc = 0.f;
                for (int s = 0; s <= t; ++s) acc += wrow[s] * Vn[s * 128 + c];
                const float mixed = acc + p.in[I_BSP][(l * 4 + g) * 128 + t];
                const float uu = bf1(proj[(size_t)(t0 + t) * NA + COL_GU + g * 128 + c]);
                mix[(size_t)(t0 + t) * MIXW + 1024 + g * 128 + c] = (bf16_t)(cvt_pk_bf16(uu * mixed, 0.f) & 0xffffu); }
        }
    }
}

typedef short s16x4 __attribute__((ext_vector_type(4)));
__device__ __forceinline__ void tr_read8(unsigned addrA, unsigned addrB, s16x4 (&lo)[4], s16x4 (&hi)[4]) {
    asm volatile("ds_read_b64_tr_b16 %0, %8\n\tds_read_b64_tr_b16 %1, %8 offset:32\n\tds_read_b64_tr_b16 %2, %8 offset:64\n\tds_read_b64_tr_b16 %3, %8 offset:96\n\t"
                 "ds_read_b64_tr_b16 %4, %9\n\tds_read_b64_tr_b16 %5, %9 offset:32\n\tds_read_b64_tr_b16 %6, %9 offset:64\n\tds_read_b64_tr_b16 %7, %9 offset:96\n\ts_waitcnt lgkmcnt(0)"
                 : "=&v"(lo[0]), "=&v"(lo[1]), "=&v"(lo[2]), "=&v"(lo[3]), "=&v"(hi[0]), "=&v"(hi[1]), "=&v"(hi[2]), "=&v"(hi[3]) : "v"(addrA), "v"(addrB) : "memory");
}
__device__ __forceinline__ void tr_read4(unsigned addrA, s16x4 (&lo)[4]) {
    asm volatile("ds_read_b64_tr_b16 %0, %4\n\tds_read_b64_tr_b16 %1, %4 offset:32\n\tds_read_b64_tr_b16 %2, %4 offset:64\n\tds_read_b64_tr_b16 %3, %4 offset:96\n\ts_waitcnt lgkmcnt(0)"
                 : "=&v"(lo[0]), "=&v"(lo[1]), "=&v"(lo[2]), "=&v"(lo[3]) : "v"(addrA) : "memory");
}
__device__ __forceinline__ bf16x8 cat44(s16x4 a, s16x4 b) { return (bf16x8){a[0], a[1], a[2], a[3], b[0], b[1], b[2], b[3]}; }
constexpr int KVSTR = 144, VNSTR = 272;
__device__ __forceinline__ void phase_mix(const Params& p, const Frame& F0, int l) {
    const Frame F = local_frame(F0);
    const int tid = F.tid, lane = F.lane, wave = F.wave, fr = lane & 15, fq = lane >> 4;
    LAS float* biasT = (LAS float*)(F.lds + 4 * 256 * KVSTR);
    LAS float* rs = biasT + 1024;
    const bf16_t* proj = (const bf16_t*)(p.ws + WS_PROJA);
    bf16_t* mix = (bf16_t*)p.out;
    const float LOG2E = 1.4426950408889634f;
    for (int nb = blockIdx.x; nb < NTOK / 128; nb += F.G) {
        const int t0 = nb * 128; const bool first = (nb % (SEQ / 128)) == 0;
        __syncthreads();
        for (int i = tid; i < 1024; i += NTHREADS) { const int h = i >> 7, dist = i & 127; biasT[i] = p.in[I_RELB][t5_bucket(dist) * 8 + h] * LOG2E; }
        __syncthreads();
        for (int c = tid; c < 4096; c += NTHREADS) { const int kvh = c >> 11, row = (c >> 3) & 255, ch = c & 7; const int tok = t0 - 128 + row;
            u32x4 kv = (u32x4){0u, 0u, 0u, 0u}, vv = (u32x4){0u, 0u, 0u, 0u};
            if (row >= 128 || !first) { kv = *(const u32x4*)(proj + (size_t)tok * NA + COL_K + kvh * 64 + ch * 8); vv = *(const u32x4*)(proj + (size_t)tok * NA + COL_V + kvh * 64 + ch * 8); }
            *(LAS u32x4*)(F.lds + kvh * (512 * KVSTR) + row * KVSTR + ch * 16) = kv; *(LAS u32x4*)(F.lds + kvh * (512 * KVSTR) + 256 * KVSTR + row * KVSTR + ch * 16) = vv; }
        __syncthreads();
        for (int kvh = 0; kvh < 2; ++kvh) {
            LAS unsigned char* Kl = F.lds + kvh * (512 * KVSTR);
            LAS unsigned char* Vl = Kl + 256 * KVSTR;
            const int hq = wave >> 1, qh = wave & 1, head = kvh * 4 + hq;
            float br[9][4];
#pragma unroll
            for (int tt = 0; tt < 9; ++tt)
#pragma unroll
                for (int i = 0; i < 4; ++i) { const int dist = 128 + fr - 4 * fq - 16 * tt - i; br[tt][i] = (dist >= 0 && dist < 128) ? biasT[head * 128 + (dist & 127)] : NEG_INF_F; }
            const float sink2 = p.in[I_SINK][l * 8 + head] * LOG2E;
            const unsigned vbase = (unsigned)(size_t)Vl;
#pragma unroll 1
            for (int r = 0; r < 4; ++r) {
                const int R = qh * 4 + r, q0 = 16 * R;
                bf16x8 qf[2];
#pragma unroll
                for (int s = 0; s < 2; ++s) qf[s] = *(const bf16x8*)(proj + (size_t)(t0 + q0 + fr) * NA + head * 64 + 32 * s + 8 * fq);
                f32x4 sacc[9];
#pragma unroll
                for (int tt = 0; tt < 9; ++tt) { sacc[tt] = (f32x4){0.f, 0.f, 0.f, 0.f};
#pragma unroll
                    for (int s = 0; s < 2; ++s) { const bf16x8 kf = *(const LAS bf16x8*)(Kl + (16 * (R + tt) + fr) * KVSTR + s * 64 + fq * 16);
                        sacc[tt] = __builtin_amdgcn_mfma_f32_16x16x32_bf16(kf, qf[s], sacc[tt], 0, 0, 0); } }
                float mx = sink2;
#pragma unroll
                for (int tt = 0; tt < 9; ++tt) { const bool dead = first && (R + tt < 8);
#pragma unroll
                    for (int i = 0; i < 4; ++i) { const float lg = dead ? NEG_INF_F : (sacc[tt][i] * (0.125f * LOG2E) + br[tt][i]); sacc[tt][i] = lg; mx = fmaxf(mx, lg); } }
                mx = fmaxf(mx, __shfl_xor(mx, 16)); mx = fmaxf(mx, __shfl_xor(mx, 32));
                float ls = 0.f;
#pragma unroll
                for (int tt = 0; tt < 9; ++tt)
#pragma unroll
                    for (int i = 0; i < 4; ++i) { const float pv = __builtin_amdgcn_exp2f(sacc[tt][i] - mx); sacc[tt][i] = pv; ls += pv; }
                ls += __shfl_xor(ls, 16); ls += __shfl_xor(ls, 32);
                const float inv = 1.0f / (ls + __builtin_amdgcn_exp2f(sink2 - mx));
                f32x4 oacc[4];
#pragma unroll
                for (int c = 0; c < 4; ++c) oacc[c] = (f32x4){0.f, 0.f, 0.f, 0.f};
#pragma unroll
                for (int u = 0; u < 5; ++u) {
                    u32x4 pw; pw.x = cvt_pk_bf16(sacc[2 * u][0], sacc[2 * u][1]); pw.y = cvt_pk_bf16(sacc[2 * u][2], sacc[2 * u][3]);
                    if (u < 4) { pw.z = cvt_pk_bf16(sacc[2 * u + 1][0], sacc[2 * u + 1][1]); pw.w = cvt_pk_bf16(sacc[2 * u + 1][2], sacc[2 * u + 1][3]); } else { pw.z = 0u; pw.w = 0u; }
                    const bf16x8 pf = __builtin_bit_cast(bf16x8, pw);
                    const unsigned addrA = vbase + (unsigned)((16 * (R + 2 * u) + 4 * fq + (fr >> 2)) * KVSTR + (4 * (fr & 3)) * 2);
                    s16x4 lo[4], hi[4];
                    if (u < 4) tr_read8(addrA, addrA + 16 * KVSTR, lo, hi);
                    else { tr_read4(addrA, lo);
#pragma unroll
                        for (int c = 0; c < 4; ++c) hi[c] = (s16x4){0, 0, 0, 0}; }
#pragma unroll
                    for (int c = 0; c < 4; ++c) oacc[c] = __builtin_amdgcn_mfma_f32_16x16x32_bf16(cat44(lo[c], hi[c]), pf, oacc[c], 0, 0, 0);
                }
                bf16_t* op = mix + (size_t)(t0 + q0 + fr) * MIXW + head * 64 + 4 * fq;
#pragma unroll
                for (int c = 0; c < 4; ++c) { u32x2 w; w.x = cvt_pk_bf16(oacc[c][0] * inv, oacc[c][1] * inv); w.y = cvt_pk_bf16(oacc[c][2] * inv, oacc[c][3] * inv); *(u32x2*)(op + 16 * c) = w; }
            }
        }
        for (int gp = 0; gp < 2; ++gp) {
            __syncthreads();
            for (int i = tid; i < 2 * 143 * 16; i += NTHREADS) { const int gi = i / (143 * 16), ii = i % (143 * 16), row = ii >> 4, ch = ii & 15; const int tok = t0 - 15 + row, g = 2 * gp + gi;
                u32x4 zv = (u32x4){0u, 0u, 0u, 0u};
                if (row >= 15 || !first) zv = *(const u32x4*)(proj + (size_t)tok * NA + COL_PZ + g * 128 + ch * 8);
                LAS float* zd = (LAS float*)F.lds + gi * (143 * 128) + row * 128 + ch * 8;
                *(LAS f32x4*)zd = (f32x4){bf_lo(zv.x), bf_hi(zv.x), bf_lo(zv.y), bf_hi(zv.y)}; *(LAS f32x4*)(zd + 4) = (f32x4){bf_lo(zv.z), bf_hi(zv.z), bf_lo(zv.w), bf_hi(zv.w)}; }
            __syncthreads();
#pragma unroll 1
            for (int gi = 0; gi < 2; ++gi) { const int g = 2 * gp + gi, w = 2 << g; const LAS float* Zs = (const LAS float*)F.lds + gi * (143 * 128);
                const int c2 = tid & 63, seg = tid >> 6;
                const int tb = seg * 16; float sa = 0.f, sb = 0.f;
                for (int j = 1; j < w; ++j) { const f32x2 z = *(const LAS f32x2*)(Zs + (tb + 15 - j) * 128 + 2 * c2); sa += z[0]; sb += z[1]; }
                const int posb = (nb % (SEQ / 128)) * 128;
                for (int tt = 0; tt < 16; ++tt) { const int t = tb + tt, r = t + 15;
                    const f32x2 z = *(const LAS f32x2*)(Zs + r * 128 + 2 * c2); sa += z[0]; sb += z[1];
                    const int pos = posb + t; const float icnt = 1.0f / (float)((pos + 1 < w) ? pos + 1 : w);
                    *(unsigned*)(mix + (size_t)(t0 + t) * MIXW + 512 + g * 128 + 2 * c2) = cvt_pk_bf16(sa * icnt - z[0], sb * icnt - z[1]);
                    const f32x2 zo = *(const LAS f32x2*)(Zs + (r - w + 1) * 128 + 2 * c2); sa -= zo[0]; sb -= zo[1]; } }
        }
        __syncthreads();
        for (int tt = 0; tt < 16; ++tt) { const int t = wave * 16 + tt; const u32x4 g4 = *(const u32x4*)(proj + (size_t)(t0 + t) * NA + COL_GV + lane * 8);
            const float a[8] = {bf_lo(g4.x), bf_hi(g4.x), bf_lo(g4.y), bf_hi(g4.y), bf_lo(g4.z), bf_hi(g4.z), bf_lo(g4.w), bf_hi(g4.w)}; float ss = 0.f;
#pragma unroll
            for (int j = 0; j < 8; ++j) ss += a[j] * a[j];
            ss = wave_sum(ss); if (lane == 0) rs[t] = 1.0f / sqrtf(ss * (1.0f / 512.0f) + EPS); }
        const bf16_t* Wsp = (const bf16_t*)(p.ws + WS_WSP);
        __syncthreads();
        for (int i = tid; i < 4 * 128 * 16; i += NTHREADS) { const int g = i >> 11, s = (i >> 4) & 127, ch = i & 15; const u32x4 g4 = *(const u32x4*)(proj + (size_t)(t0 + s) * NA + COL_GV + g * 128 + ch * 8);
            const float r = rs[s]; const float* gn = p.in[I_VGAIN] + l * 512 + g * 128 + ch * 8; const f32x4 ga = *(const f32x4*)gn, gb = *(const f32x4*)(gn + 4);
            u32x4 w; w.x = cvt_pk_bf16(bf_lo(g4.x) * r * ga[0], bf_hi(g4.x) * r * ga[1]); w.y = cvt_pk_bf16(bf_lo(g4.y) * r * ga[2], bf_hi(g4.y) * r * ga[3]);
            w.z = cvt_pk_bf16(bf_lo(g4.z) * r * gb[0], bf_hi(g4.z) * r * gb[1]); w.w = cvt_pk_bf16(bf_lo(g4.w) * r * gb[2], bf_hi(g4.w) * r * gb[3]);
            *(LAS u32x4*)(F.lds + g * (128 * VNSTR) + s * VNSTR + ch * 16) = w; }
        __syncthreads();
        for (int g = 0; g < 4; ++g) {
            LAS unsigned char* Vn = F.lds + g * (128 * VNSTR);
            const int T = wave; f32x4 acc[8];
#pragma unroll
            for (int c = 0; c < 8; ++c) acc[c] = (f32x4){0.f, 0.f, 0.f, 0.f};
            const bf16_t* wrow = Wsp + (((size_t)l * 4 + g) * 128 + 16 * T + fr) * 128 + 8 * fq;
            const unsigned vnb = (unsigned)(size_t)Vn;
#pragma unroll 1
            for (int u = 0; u <= (T >> 1); ++u) {
                const bf16x8 wf = *(const bf16x8*)(wrow + 32 * u);
                const unsigned addrA = vnb + (unsigned)((32 * u + 8 * fq + (fr >> 2)) * VNSTR + (4 * (fr & 3)) * 2);
#pragma unroll
                for (int hf = 0; hf < 2; ++hf) { s16x4 lo[4], hi[4]; tr_read8(addrA + hf * 128, addrA + hf * 128 + 4 * VNSTR, lo, hi);
#pragma unroll
                    for (int c = 0; c < 4; ++c) acc[hf * 4 + c] = __builtin_amdgcn_mfma_f32_16x16x32_bf16(cat44(lo[c], hi[c]), wf, acc[hf * 4 + c], 0, 0, 0); }
            }
            const int t = 16 * T + fr; const float bs = p.in[I_BSP][(l * 4 + g) * 128 + t];
            const bf16_t* up = proj + (size_t)(t0 + t) * NA + COL_GU + g * 128 + 4 * fq; bf16_t* op = mix + (size_t)(t0 + t) * MIXW + 1024 + g * 128 + 4 * fq;
#pragma unroll
            for (int c = 0; c < 8; ++c) { const u32x2 uw = *(const u32x2*)(up + 16 * c);
                u32x2 w; w.x = cvt_pk_bf16(bf_lo(uw.x) * (acc[c][0] + bs), bf_hi(uw.x) * (acc[c][1] + bs)); w.y = cvt_pk_bf16(bf_lo(uw.y) * (acc[c][2] + bs), bf_hi(uw.y) * (acc[c][3] + bs));
                *(u32x2*)(op + 16 * c) = w; }
        }
    }
}

__device__ __forceinline__ unsigned ordkey(unsigned bits) { return bits ^ ((unsigned)((int)bits >> 31) | 0x80000000u); }
__device__ __forceinline__ unsigned unord(unsigned k) { return (k & 0x80000000u) ? (k ^ 0x80000000u) : ~k; }
#define TK_SORT16(S) do { { const unsigned h_ = max(S[0], S[1]), l_ = min(S[0], S[1]); S[0] = h_; S[1] = l_; } { const unsigned h_ = max(S[2], S[3]), l_ = min(S[2], S[3]); S[2] = h_; S[3] = l_; } { const unsigned h_ = max(S[0], S[2]), l_ = min(S[0], S[2]); S[0] = h_; S[2] = l_; } { const unsigned h_ = max(S[1], S[3]), l_ = min(S[1], S[3]); S[1] = h_; S[3] = l_; } { const unsigned h_ = max(S[1], S[2]), l_ = min(S[1], S[2]); S[1] = h_; S[2] = l_; } { const unsigned h_ = max(S[4], S[5]), l_ = min(S[4], S[5]); S[4] = h_; S[5] = l_; } { const unsigned h_ = max(S[6], S[7]), l_ = min(S[6], S[7]); S[6] = h_; S[7] = l_; } { const unsigned h_ = max(S[4], S[6]), l_ = min(S[4], S[6]); S[4] = h_; S[6] = l_; } { const unsigned h_ = max(S[5], S[7]), l_ = min(S[5], S[7]); S[5] = h_; S[7] = l_; } { const unsigned h_ = max(S[5], S[6]), l_ = min(S[5], S[6]); S[5] = h_; S[6] = l_; } { const unsigned h_ = max(S[0], S[4]), l_ = min(S[0], S[4]); S[0] = h_; S[4] = l_; } { const unsigned h_ = max(S[2], S[6]), l_ = min(S[2], S[6]); S[2] = h_; S[6] = l_; } { const unsigned h_ = max(S[2], S[4]), l_ = min(S[2], S[4]); S[2] = h_; S[4] = l_; } { const unsigned h_ = max(S[1], S[5]), l_ = min(S[1], S[5]); S[1] = h_; S[5] = l_; } { const unsigned h_ = max(S[3], S[7]), l_ = min(S[3], S[7]); S[3] = h_; S[7] = l_; } { const unsigned h_ = max(S[3], S[5]), l_ = min(S[3], S[5]); S[3] = h_; S[5] = l_; } { const unsigned h_ = max(S[1], S[2]), l_ = min(S[1], S[2]); S[1] = h_; S[2] = l_; } { const unsigned h_ = max(S[3], S[4]), l_ = min(S[3], S[4]); S[3] = h_; S[4] = l_; } { const unsigned h_ = max(S[5], S[6]), l_ = min(S[5], S[6]); S[5] = h_; S[6] = l_; } { const unsigned h_ = max(S[8], S[9]), l_ = min(S[8], S[9]); S[8] = h_; S[9] = l_; } { const unsigned h_ = max(S[10], S[11]), l_ = min(S[10], S[11]); S[10] = h_; S[11] = l_; } { const unsigned h_ = max(S[8], S[10]), l_ = min(S[8], S[10]); S[8] = h_; S[10] = l_; } { const unsigned h_ = max(S[9], S[11]), l_ = min(S[9], S[11]); S[9] = h_; S[11] = l_; } { const unsigned h_ = max(S[9], S[10]), l_ = min(S[9], S[10]); S[9] = h_; S[10] = l_; } { const unsigned h_ = max(S[12], S[13]), l_ = min(S[12], S[13]); S[12] = h_; S[13] = l_; } { const unsigned h_ = max(S[14], S[15]), l_ = min(S[14], S[15]); S[14] = h_; S[15] = l_; } { const unsigned h_ = max(S[12], S[14]), l_ = min(S[12], S[14]); S[12] = h_; S[14] = l_; } { const unsigned h_ = max(S[13], S[15]), l_ = min(S[13], S[15]); S[13] = h_; S[15] = l_; } { const unsigned h_ = max(S[13], S[14]), l_ = min(S[13], S[14]); S[13] = h_; S[14] = l_; } { const unsigned h_ = max(S[8], S[12]), l_ = min(S[8], S[12]); S[8] = h_; S[12] = l_; } { const unsigned h_ = max(S[10], S[14]), l_ = min(S[10], S[14]); S[10] = h_; S[14] = l_; } { const unsigned h_ = max(S[10], S[12]), l_ = min(S[10], S[12]); S[10] = h_; S[12] = l_; } { const unsigned h_ = max(S[9], S[13]), l_ = min(S[9], S[13]); S[9] = h_; S[13] = l_; } { const unsigned h_ = max(S[11], S[15]), l_ = min(S[11], S[15]); S[11] = h_; S[15] = l_; } { const unsigned h_ = max(S[11], S[13]), l_ = min(S[11], S[13]); S[11] = h_; S[13] = l_; } { const unsigned h_ = max(S[9], S[10]), l_ = min(S[9], S[10]); S[9] = h_; S[10] = l_; } { const unsigned h_ = max(S[11], S[12]), l_ = min(S[11], S[12]); S[11] = h_; S[12] = l_; } { const unsigned h_ = max(S[13], S[14]), l_ = min(S[13], S[14]); S[13] = h_; S[14] = l_; } { const unsigned h_ = max(S[0], S[8]), l_ = min(S[0], S[8]); S[0] = h_; S[8] = l_; } { const unsigned h_ = max(S[4], S[12]), l_ = min(S[4], S[12]); S[4] = h_; S[12] = l_; } { const unsigned h_ = max(S[4], S[8]), l_ = min(S[4], S[8]); S[4] = h_; S[8] = l_; } { const unsigned h_ = max(S[2], S[10]), l_ = min(S[2], S[10]); S[2] = h_; S[10] = l_; } { const unsigned h_ = max(S[6], S[14]), l_ = min(S[6], S[14]); S[6] = h_; S[14] = l_; } { const unsigned h_ = max(S[6], S[10]), l_ = min(S[6], S[10]); S[6] = h_; S[10] = l_; } { const unsigned h_ = max(S[2], S[4]), l_ = min(S[2], S[4]); S[2] = h_; S[4] = l_; } { const unsigned h_ = max(S[6], S[8]), l_ = min(S[6], S[8]); S[6] = h_; S[8] = l_; } { const unsigned h_ = max(S[10], S[12]), l_ = min(S[10], S[12]); S[10] = h_; S[12] = l_; } { const unsigned h_ = max(S[1], S[9]), l_ = min(S[1], S[9]); S[1] = h_; S[9] = l_; } { const unsigned h_ = max(S[5], S[13]), l_ = min(S[5], S[13]); S[5] = h_; S[13] = l_; } { const unsigned h_ = max(S[5], S[9]), l_ = min(S[5], S[9]); S[5] = h_; S[9] = l_; } { const unsigned h_ = max(S[3], S[11]), l_ = min(S[3], S[11]); S[3] = h_; S[11] = l_; } { const unsigned h_ = max(S[7], S[15]), l_ = min(S[7], S[15]); S[7] = h_; S[15] = l_; } { const unsigned h_ = max(S[7], S[11]), l_ = min(S[7], S[11]); S[7] = h_; S[11] = l_; } { const unsigned h_ = max(S[3], S[5]), l_ = min(S[3], S[5]); S[3] = h_; S[5] = l_; } { const unsigned h_ = max(S[7], S[9]), l_ = min(S[7], S[9]); S[7] = h_; S[9] = l_; } { const unsigned h_ = max(S[11], S[13]), l_ = min(S[11], S[13]); S[11] = h_; S[13] = l_; } { const unsigned h_ = max(S[1], S[2]), l_ = min(S[1], S[2]); S[1] = h_; S[2] = l_; } { const unsigned h_ = max(S[3], S[4]), l_ = min(S[3], S[4]); S[3] = h_; S[4] = l_; } { const unsigned h_ = max(S[5], S[6]), l_ = min(S[5], S[6]); S[5] = h_; S[6] = l_; } { const unsigned h_ = max(S[7], S[8]), l_ = min(S[7], S[8]); S[7] = h_; S[8] = l_; } { const unsigned h_ = max(S[9], S[10]), l_ = min(S[9], S[10]); S[9] = h_; S[10] = l_; } { const unsigned h_ = max(S[11], S[12]), l_ = min(S[11], S[12]); S[11] = h_; S[12] = l_; } { const unsigned h_ = max(S[13], S[14]), l_ = min(S[13], S[14]); S[13] = h_; S[14] = l_; } } while (0)
#define TK_MERGE16(L, S) do { L[0] = max(L[0], S[15]); L[1] = max(L[1], S[14]); L[2] = max(L[2], S[13]); L[3] = max(L[3], S[12]); L[4] = max(L[4], S[11]); L[5] = max(L[5], S[10]); L[6] = max(L[6], S[9]); L[7] = max(L[7], S[8]); L[8] = max(L[8], S[7]); L[9] = max(L[9], S[6]); L[10] = max(L[10], S[5]); L[11] = max(L[11], S[4]); L[12] = max(L[12], S[3]); L[13] = max(L[13], S[2]); L[14] = max(L[14], S[1]); L[15] = max(L[15], S[0]); { const unsigned h_ = max(L[0], L[8]), l_ = min(L[0], L[8]); L[0] = h_; L[8] = l_; } { const unsigned h_ = max(L[1], L[9]), l_ = min(L[1], L[9]); L[1] = h_; L[9] = l_; } { const unsigned h_ = max(L[2], L[10]), l_ = min(L[2], L[10]); L[2] = h_; L[10] = l_; } { const unsigned h_ = max(L[3], L[11]), l_ = min(L[3], L[11]); L[3] = h_; L[11] = l_; } { const unsigned h_ = max(L[4], L[12]), l_ = min(L[4], L[12]); L[4] = h_; L[12] = l_; } { const unsigned h_ = max(L[5], L[13]), l_ = min(L[5], L[13]); L[5] = h_; L[13] = l_; } { const unsigned h_ = max(L[6], L[14]), l_ = min(L[6], L[14]); L[6] = h_; L[14] = l_; } { const unsigned h_ = max(L[7], L[15]), l_ = min(L[7], L[15]); L[7] = h_; L[15] = l_; } { const unsigned h_ = max(L[0], L[4]), l_ = min(L[0], L[4]); L[0] = h_; L[4] = l_; } { const unsigned h_ = max(L[1], L[5]), l_ = min(L[1], L[5]); L[1] = h_; L[5] = l_; } { const unsigned h_ = max(L[2], L[6]), l_ = min(L[2], L[6]); L[2] = h_; L[6] = l_; } { const unsigned h_ = max(L[3], L[7]), l_ = min(L[3], L[7]); L[3] = h_; L[7] = l_; } { const unsigned h_ = max(L[8], L[12]), l_ = min(L[8], L[12]); L[8] = h_; L[12] = l_; } { const unsigned h_ = max(L[9], L[13]), l_ = min(L[9], L[13]); L[9] = h_; L[13] = l_; } { const unsigned h_ = max(L[10], L[14]), l_ = min(L[10], L[14]); L[10] = h_; L[14] = l_; } { const unsigned h_ = max(L[11], L[15]), l_ = min(L[11], L[15]); L[11] = h_; L[15] = l_; } { const unsigned h_ = max(L[0], L[2]), l_ = min(L[0], L[2]); L[0] = h_; L[2] = l_; } { const unsigned h_ = max(L[1], L[3]), l_ = min(L[1], L[3]); L[1] = h_; L[3] = l_; } { const unsigned h_ = max(L[4], L[6]), l_ = min(L[4], L[6]); L[4] = h_; L[6] = l_; } { const unsigned h_ = max(L[5], L[7]), l_ = min(L[5], L[7]); L[5] = h_; L[7] = l_; } { const unsigned h_ = max(L[8], L[10]), l_ = min(L[8], L[10]); L[8] = h_; L[10] = l_; } { const unsigned h_ = max(L[9], L[11]), l_ = min(L[9], L[11]); L[9] = h_; L[11] = l_; } { const unsigned h_ = max(L[12], L[14]), l_ = min(L[12], L[14]); L[12] = h_; L[14] = l_; } { const unsigned h_ = max(L[13], L[15]), l_ = min(L[13], L[15]); L[13] = h_; L[15] = l_; } { const unsigned h_ = max(L[0], L[1]), l_ = min(L[0], L[1]); L[0] = h_; L[1] = l_; } { const unsigned h_ = max(L[2], L[3]), l_ = min(L[2], L[3]); L[2] = h_; L[3] = l_; } { const unsigned h_ = max(L[4], L[5]), l_ = min(L[4], L[5]); L[4] = h_; L[5] = l_; } { const unsigned h_ = max(L[6], L[7]), l_ = min(L[6], L[7]); L[6] = h_; L[7] = l_; } { const unsigned h_ = max(L[8], L[9]), l_ = min(L[8], L[9]); L[8] = h_; L[9] = l_; } { const unsigned h_ = max(L[10], L[11]), l_ = min(L[10], L[11]); L[10] = h_; L[11] = l_; } { const unsigned h_ = max(L[12], L[13]), l_ = min(L[12], L[13]); L[12] = h_; L[13] = l_; } { const unsigned h_ = max(L[14], L[15]), l_ = min(L[14], L[15]); L[14] = h_; L[15] = l_; } } while (0)
__device__ __forceinline__ void phase_topk(const Params& p, const Frame& F0, int l) {
    const Frame F = local_frame(F0);
    const int lane = F.lane, wave = F.wave;
    LAS float* tile = (LAS float*)(F.lds + wave * 8448);
    LAS unsigned char* itab = (LAS unsigned char*)(F.lds + 8 * 8448 + wave * 64 * 36 + lane * 36);
    const float* scores = (const float*)(p.ws + WS_SCORES);
    const float* rowsq = (const float*)(p.ws + WS_ROWSQP) + (size_t)l * NTOK * 16;
    unsigned* seli = (unsigned*)(p.ws + WS_SELI); float* selg = (float*)(p.ws + WS_SELG);
    const int gw = blockIdx.x * NWAVES + wave, NGW = F.G * NWAVES;
    const int row_l = lane >> 3, cg_l = lane & 7;
    const bf16_t* scores_b = (const bf16_t*)(p.ws + WS_SCORES);
    u32x4 cur[8];
    if (gw < NTOK * 8 / 64) {
#pragma unroll
        for (int i = 0; i < 8; ++i) cur[i] = *(const u32x4*)(scores_b + ((size_t)gw * 64 + 8 * i + row_l) * 256 + cg_l * 8);
    }
    LAS unsigned* tileu = (LAS unsigned*)tile;
    for (int grp = gw; grp < NTOK * 8 / 64; grp += NGW) {
        const size_t item0 = (size_t)grp * 64;
        unsigned L1[16], L2[16];
#pragma unroll
        for (int j = 0; j < 16; ++j) { L1[j] = 0u; L2[j] = 0u; }
#pragma unroll 1
        for (int ch = 0; ch < 4; ++ch) {
#pragma unroll
            for (int i = 0; i < 8; ++i) { LAS unsigned* d = tileu + (8 * i + row_l) * 33 + cg_l * 4; d[0] = cur[i].x; d[1] = cur[i].y; d[2] = cur[i].z; d[3] = cur[i].w; }
            {
                const bool more = (ch < 3) || (grp + NGW < NTOK * 8 / 64);
                const size_t nitem0 = (ch < 3) ? item0 : (size_t)(grp + NGW) * 64; const int nch = (ch < 3) ? ch + 1 : 0;
                if (more) {
#pragma unroll
                    for (int i = 0; i < 8; ++i) cur[i] = *(const u32x4*)(scores_b + (nitem0 + 8 * i + row_l) * 256 + nch * 64 + cg_l * 8);
                }
            }
            __builtin_amdgcn_wave_barrier(); asm volatile("s_waitcnt lgkmcnt(0)" ::: "memory");
#pragma unroll
            for (int qd = 0; qd < 4; ++qd) { unsigned S[16];
#pragma unroll
                for (int j = 0; j < 8; ++j) { const unsigned w = tileu[lane * 33 + 8 * qd + j]; const unsigned idx = (unsigned)((ch & 1) * 64 + 16 * qd + 2 * j);
                    S[2 * j] = ordkey((w << 16) | idx); S[2 * j + 1] = ordkey((w & 0xffff0000u) | (idx + 1u)); }
                TK_SORT16(S);
                if (ch < 2) TK_MERGE16(L1, S); else TK_MERGE16(L2, S); }
            __builtin_amdgcn_wave_barrier(); asm volatile("s_waitcnt lgkmcnt(0)" ::: "memory");
        }
        float f1[16], f2[16];
#pragma unroll
        for (int k = 0; k < 16; ++k) { const unsigned b1 = unord(L1[k]), b2 = unord(L2[k]); f1[k] = __uint_as_float(b1); f2[k] = __uint_as_float(b2); itab[k] = (unsigned char)(b1 & 127u); itab[16 + k] = (unsigned char)(b2 & 127u); }
        unsigned T[16];
        { T[0] = ordkey((__float_as_uint(f1[0] + f2[0]) & 0xffffff00u) | 0u); T[1] = ordkey((__float_as_uint(f1[0] + f2[1]) & 0xffffff00u) | 1u); T[2] = ordkey((__float_as_uint(f1[0] + f2[2]) & 0xffffff00u) | 2u); T[3] = ordkey((__float_as_uint(f1[0] + f2[3]) & 0xffffff00u) | 3u); T[4] = ordkey((__float_as_uint(f1[0] + f2[4]) & 0xffffff00u) | 4u); T[5] = ordkey((__float_as_uint(f1[0] + f2[5]) & 0xffffff00u) | 5u); T[6] = ordkey((__float_as_uint(f1[0] + f2[6]) & 0xffffff00u) | 6u); T[7] = ordkey((__float_as_uint(f1[0] + f2[7]) & 0xffffff00u) | 7u); T[8] = ordkey((__float_as_uint(f1[0] + f2[8]) & 0xffffff00u) | 8u); T[9] = ordkey((__float_as_uint(f1[0] + f2[9]) & 0xffffff00u) | 9u); T[10] = ordkey((__float_as_uint(f1[0] + f2[10]) & 0xffffff00u) | 10u); T[11] = ordkey((__float_as_uint(f1[0] + f2[11]) & 0xffffff00u) | 11u); T[12] = ordkey((__float_as_uint(f1[0] + f2[12]) & 0xffffff00u) | 12u); T[13] = ordkey((__float_as_uint(f1[0] + f2[13]) & 0xffffff00u) | 13u); T[14] = ordkey((__float_as_uint(f1[0] + f2[14]) & 0xffffff00u) | 14u); T[15] = ordkey((__float_as_uint(f1[0] + f2[15]) & 0xffffff00u) | 15u); TK_SORT16(T); }
        { unsigned S[16]; S[0] = ordkey((__float_as_uint(f1[1] + f2[0]) & 0xffffff00u) | 16u); S[1] = ordkey((__float_as_uint(f1[1] + f2[1]) & 0xffffff00u) | 17u); S[2] = ordkey((__float_as_uint(f1[1] + f2[2]) & 0xffffff00u) | 18u); S[3] = ordkey((__float_as_uint(f1[1] + f2[3]) & 0xffffff00u) | 19u); S[4] = ordkey((__float_as_uint(f1[1] + f2[4]) & 0xffffff00u) | 20u); S[5] = ordkey((__float_as_uint(f1[1] + f2[5]) & 0xffffff00u) | 21u); S[6] = ordkey((__float_as_uint(f1[1] + f2[6]) & 0xffffff00u) | 22u); S[7] = ordkey((__float_as_uint(f1[1] + f2[7]) & 0xffffff00u) | 23u); S[8] = ordkey((__float_as_uint(f1[2] + f2[0]) & 0xffffff00u) | 32u); S[9] = ordkey((__float_as_uint(f1[2] + f2[1]) & 0xffffff00u) | 33u); S[10] = ordkey((__float_as_uint(f1[2] + f2[2]) & 0xffffff00u) | 34u); S[11] = ordkey((__float_as_uint(f1[2] + f2[3]) & 0xffffff00u) | 35u); S[12] = ordkey((__float_as_uint(f1[2] + f2[4]) & 0xffffff00u) | 36u); S[13] = ordkey((__float_as_uint(f1[3] + f2[0]) & 0xffffff00u) | 48u); S[14] = ordkey((__float_as_uint(f1[3] + f2[1]) & 0xffffff00u) | 49u); S[15] = ordkey((__float_as_uint(f1[3] + f2[2]) & 0xffffff00u) | 50u); TK_SORT16(S); TK_MERGE16(T, S); }
        { unsigned S[16]; S[0] = ordkey((__float_as_uint(f1[3] + f2[3]) & 0xffffff00u) | 51u); S[1] = ordkey((__float_as_uint(f1[4] + f2[0]) & 0xffffff00u) | 64u); S[2] = ordkey((__float_as_uint(f1[4] + f2[1]) & 0xffffff00u) | 65u); S[3] = ordkey((__float_as_uint(f1[4] + f2[2]) & 0xffffff00u) | 66u); S[4] = ordkey((__float_as_uint(f1[5] + f2[0]) & 0xffffff00u) | 80u); S[5] = ordkey((__float_as_uint(f1[5] + f2[1]) & 0xffffff00u) | 81u); S[6] = ordkey((__float_as_uint(f1[6] + f2[0]) & 0xffffff00u) | 96u); S[7] = ordkey((__float_as_uint(f1[6] + f2[1]) & 0xffffff00u) | 97u); S[8] = ordkey((__float_as_uint(f1[7] + f2[0]) & 0xffffff00u) | 112u); S[9] = ordkey((__float_as_uint(f1[7] + f2[1]) & 0xffffff00u) | 113u); S[10] = ordkey((__float_as_uint(f1[8] + f2[0]) & 0xffffff00u) | 128u); S[11] = ordkey((__float_as_uint(f1[9] + f2[0]) & 0xffffff00u) | 144u); S[12] = ordkey((__float_as_uint(f1[10] + f2[0]) & 0xffffff00u) | 160u); S[13] = ordkey((__float_as_uint(f1[11] + f2[0]) & 0xffffff00u) | 176u); S[14] = ordkey((__float_as_uint(f1[12] + f2[0]) & 0xffffff00u) | 192u); S[15] = ordkey((__float_as_uint(f1[13] + f2[0]) & 0xffffff00u) | 208u); TK_SORT16(S); TK_MERGE16(T, S); }
        { unsigned x = ordkey((__float_as_uint(f1[14] + f2[0]) & 0xffffff00u) | 224u);
#pragma unroll
            for (int k = 0; k < 16; ++k) { const unsigned hi = max(T[k], x); x = min(T[k], x); T[k] = hi; } }
        { unsigned x = ordkey((__float_as_uint(f1[15] + f2[0]) & 0xffffff00u) | 240u);
#pragma unroll
            for (int k = 0; k < 16; ++k) { const unsigned hi = max(T[k], x); x = min(T[k], x); T[k] = hi; } }
        asm volatile("s_waitcnt lgkmcnt(0)" ::: "memory");
        const size_t item = item0 + lane; const int tok = (int)(item >> 3);
        const float rstd = 1.0f / sqrtf(row_sumsq(rowsq, tok) * (1.0f / DM) + EPS);
        float e[16], se = 0.f; unsigned P[16];
        const float t0v = __uint_as_float(unord(T[0]));
#pragma unroll
        for (int k = 0; k < 16; ++k) { const unsigned b = unord(T[k]); e[k] = __expf((__uint_as_float(b) - t0v) * rstd); se += e[k];
            const unsigned code = b & 255u; P[k] = ((unsigned)itab[code >> 4] << 7) | (unsigned)itab[16 + (code & 15u)]; }
        const float inv = 1.0f / se;
        u32x4* di = (u32x4*)(seli + item * 16); f32x4* dg = (f32x4*)(selg + item * 16);
#pragma unroll
        for (int k4 = 0; k4 < 4; ++k4) { di[k4] = (u32x4){P[4 * k4], P[4 * k4 + 1], P[4 * k4 + 2], P[4 * k4 + 3]};
            dg[k4] = (f32x4){e[4 * k4] * inv, e[4 * k4 + 1] * inv, e[4 * k4 + 2] * inv, e[4 * k4 + 3] * inv}; }
        asm volatile("s_waitcnt lgkmcnt(0)" ::: "memory");
    }
}

__device__ __forceinline__ void fp8x16_to_f32(const u32x4 w, float (&f)[16]) {
#pragma unroll
    for (int q = 0; q < 4; ++q) { const f32x2 lo = __builtin_amdgcn_cvt_pk_f32_fp8((int)w[q], false), hi = __builtin_amdgcn_cvt_pk_f32_fp8((int)w[q], true);
        f[4 * q] = lo[0]; f[4 * q + 1] = lo[1]; f[4 * q + 2] = hi[0]; f[4 * q + 3] = hi[1]; }
}
template <int CTRL> __device__ __forceinline__ float dpp_f(float v) { return __uint_as_float(__builtin_amdgcn_update_dpp(0u, __float_as_uint(v), CTRL, 0xF, 0xF, true)); }
#ifndef MERGE_STAGGER
#define MERGE_STAGGER 0
#endif
#ifndef VB
#define VB 16
#endif
#ifndef G_RSH
#define G_RSH 10
#endif
#ifndef GATHER_SWEEP_BARRIER
#define GATHER_SWEEP_BARRIER 2
#endif
constexpr int GT = 4;
__device__ __forceinline__ void phase_gather(const Params& p, const Frame& F0, int l, const XcdBarrier& bar, bool use_bar, bool dry = false, unsigned emask = 0xffffffffu) {
    const Frame F = local_frame(F0);
    const int lane = F.lane;
    const unsigned char* ET = p.ws + WS_EXP + (size_t)l * NEXP * 2 * DM;
    const f32x2* SC = (const f32x2*)(p.ws + WS_ESCALE) + (size_t)l * NEXP;
    const bf16_t* xb = (const bf16_t*)(p.ws + WS_XB);
    const float* rowsq = (const float*)(p.ws + WS_ROWSQP) + (size_t)l * NTOK * 16;
    const unsigned* seli = (const unsigned*)(p.ws + WS_SELI); const float* selg = (const float*)(p.ws + WS_SELG);
    const float* gain = p.in[I_FFGAIN] + l * DM + lane * 16;
    LAS u32x2* sortl = (LAS u32x2*)(F.lds + F.wave * (GT * 1024));
    LAS float* cfl = (LAS float*)(F.lds + NWAVES * (GT * 1024) + F.wave * (GT * 512));
    LAS u32x4* h2l = (LAS u32x4*)(F.lds + NWAVES * (GT * 1536) + F.wave * (GT * 1024));
    LAS float* h2sl = (LAS float*)(F.lds + NWAVES * (GT * 2560) + F.wave * 64);
    const bool dsel0 = (lane & 1) != 0, dsel1 = (lane & 2) != 0, ondiag = (((lane & 15) >> 2) == (lane >> 4));
    const bool b2 = (lane & 4) != 0, b1 = (lane & 2) != 0, b0 = (lane & 1) != 0;
    const int mym = (b2 ? 4 : 0) + (b0 ? 2 : 0) + (b1 ? 1 : 0);
    const int gw = blockIdx.x * NWAVES + F.wave, NGW = F.G * NWAVES;
    const int nsweep = NTOK / (NGW * GT);
    for (int sw = 0; sw < nsweep; ++sw) {
        if (sw > 0 && use_bar && GATHER_SWEEP_BARRIER) { if (GATHER_SWEEP_BARRIER == 2) xcd_align(bar); else xcd_barrier(bar); }
        const int tok0 = (sw * NGW + gw) * GT;
        int cur[GT];
#pragma unroll
        for (int tk = 0; tk < GT; ++tk) { const int tok = tok0 + tk;
            const float rstd = 1.0f / sqrtf(row_sumsq(rowsq, tok) * (1.0f / DM) + EPS);
            const u32x4 xw0 = *(const u32x4*)(xb + (size_t)tok * DM + lane * 16), xw1 = *(const u32x4*)(xb + (size_t)tok * DM + lane * 16 + 8);
            const f32x4 g0 = *(const f32x4*)gain, g1 = *(const f32x4*)(gain + 4), g2 = *(const f32x4*)(gain + 8), g3 = *(const f32x4*)(gain + 12);
            float hv[16] = {bf_lo(xw0.x) * rstd * g0[0], bf_hi(xw0.x) * rstd * g0[1], bf_lo(xw0.y) * rstd * g0[2], bf_hi(xw0.y) * rstd * g0[3], bf_lo(xw0.z) * rstd * g1[0], bf_hi(xw0.z) * rstd * g1[1], bf_lo(xw0.w) * rstd * g1[2], bf_hi(xw0.w) * rstd * g1[3],
                            bf_lo(xw1.x) * rstd * g2[0], bf_hi(xw1.x) * rstd * g2[1], bf_lo(xw1.y) * rstd * g2[2], bf_hi(xw1.y) * rstd * g2[3], bf_lo(xw1.z) * rstd * g3[0], bf_hi(xw1.z) * rstd * g3[1], bf_lo(xw1.w) * rstd * g3[2], bf_hi(xw1.w) * rstd * g3[3]};
            float hm = 0.f;
#pragma unroll
            for (int j = 0; j < 16; ++j) hm = fmaxf(hm, fabsf(hv[j]));
#pragma unroll
            for (int of = 1; of < 64; of <<= 1) hm = fmaxf(hm, __shfl_xor(hm, of));
            const float hinv = hm > 0.f ? 448.0f / hm : 0.f; if (lane == 0) h2sl[tk] = hm * (1.0f / 448.0f);
            {   int w0 = 0, w1 = 0, w2 = 0, w3 = 0;
                w0 = __builtin_amdgcn_cvt_pk_fp8_f32(hv[0] * hinv, hv[1] * hinv, w0, false); w0 = __builtin_amdgcn_cvt_pk_fp8_f32(hv[2] * hinv, hv[3] * hinv, w0, true);
                w1 = __builtin_amdgcn_cvt_pk_fp8_f32(hv[4] * hinv, hv[5] * hinv, w1, false); w1 = __builtin_amdgcn_cvt_pk_fp8_f32(hv[6] * hinv, hv[7] * hinv, w1, true);
                w2 = __builtin_amdgcn_cvt_pk_fp8_f32(hv[8] * hinv, hv[9] * hinv, w2, false); w2 = __builtin_amdgcn_cvt_pk_fp8_f32(hv[10] * hinv, hv[11] * hinv, w2, true);
                w3 = __builtin_amdgcn_cvt_pk_fp8_f32(hv[12] * hinv, hv[13] * hinv, w3, false); w3 = __builtin_amdgcn_cvt_pk_fp8_f32(hv[14] * hinv, hv[15] * hinv, w3, true);
                h2l[tk * 64 + lane] = (u32x4){(unsigned)w0, (unsigned)w1, (unsigned)w2, (unsigned)w3}; }
            const unsigned i0 = seli[(size_t)tok * 128 + lane] & emask, i1 = seli[(size_t)tok * 128 + 64 + lane] & emask;
            const float q0 = selg[(size_t)tok * 128 + lane], q1 = selg[(size_t)tok * 128 + 64 + lane];
            const unsigned ep0 = i0 >> G_RSH, ep1 = i1 >> G_RSH; unsigned pos0 = 0, pos1 = 0, base = 0;
#pragma unroll
            for (unsigned ep = 0; ep < (16384u >> G_RSH); ++ep) { const unsigned long long m0 = __ballot(ep0 == ep), m1 = __ballot(ep1 == ep);
                const unsigned c0 = __builtin_amdgcn_mbcnt_hi((unsigned)(m0 >> 32), __builtin_amdgcn_mbcnt_lo((unsigned)m0, 0u)), c1 = __builtin_amdgcn_mbcnt_hi((unsigned)(m1 >> 32), __builtin_amdgcn_mbcnt_lo((unsigned)m1, 0u));
                const unsigned n0 = (unsigned)__popcll(m0), n1 = (unsigned)__popcll(m1);
                pos0 = (ep0 == ep) ? base + c0 : pos0; pos1 = (ep1 == ep) ? base + n0 + c1 : pos1; base += n0 + n1; }
            sortl[tk * 128 + pos0] = (u32x2){i0, __float_as_uint(q0)}; sortl[tk * 128 + pos1] = (u32x2){i1, __float_as_uint(q1)}; cur[tk] = 0; }
        __builtin_amdgcn_wave_barrier(); asm volatile("s_waitcnt lgkmcnt(0)" ::: "memory");
        unsigned ord;
        {   const unsigned first = sortl[(lane >> 4) * 128 + 8 * (lane & 15)].x;
            const unsigned key = (((first >> G_RSH) * GT + (unsigned)(lane >> 4)) << 4) | (unsigned)(lane & 15);
            unsigned rank = 0;
#pragma unroll 8
            for (int m = 0; m < 64; ++m) { const unsigned km = __builtin_amdgcn_readlane(key, m); rank += (km < key) ? 1u : 0u; }
            ord = (unsigned)__builtin_amdgcn_ds_permute((int)(rank << 2), (int)lane); }
        asm volatile("s_waitcnt lgkmcnt(0)" ::: "memory");
        {
            u32x4 ub[2][8]; f32x2 bsc[2]; float bmg[2]; int bid[2];
#define G_ISSUE_U(n, s) do { const int id_ = __builtin_amdgcn_readlane(ord, (n)); bid[s] = id_; const u32x2 ent_ = sortl[(id_ >> 4) * 128 + 8 * (id_ & 15) + mym]; bmg[s] = __uint_as_float(ent_.y); \
            _Pragma("unroll") for (int i_ = 0; i_ < 8; ++i_) { const unsigned e_ = __builtin_amdgcn_readlane(ent_.x, ((i_ & 4) ? 4 : 0) + ((i_ & 1) ? 2 : 0) + ((i_ & 2) ? 1 : 0)); ub[s][i_] = *(const u32x4*)(ET + (size_t)e_ * DM + lane * 16); } \
            bsc[s] = SC[ent_.x]; } while (0)
#define G_COMPUTE_U(s) do { const int tk_ = bid[s] >> 4, b_ = bid[s] & 15; const u32x4 hq_ = h2l[tk_ * 64 + lane]; const float hs_ = h2sl[tk_]; \
            const long hlo_ = (long)(((unsigned long long)hq_.y << 32) | hq_.x), hhi_ = (long)(((unsigned long long)hq_.w << 32) | hq_.z); \
            float d_[8]; \
            _Pragma("unroll") for (int hf_ = 0; hf_ < 2; ++hf_) { f32x4 acc4_[4]; \
                _Pragma("unroll") for (int i_ = 0; i_ < 4; ++i_) { const u32x4 w_ = ub[s][4 * hf_ + i_]; acc4_[i_] = __builtin_amdgcn_mfma_f32_16x16x32_fp8_fp8((long)(((unsigned long long)w_.y << 32) | w_.x), hlo_, (f32x4){0.f, 0.f, 0.f, 0.f}, 0, 0, 0); } \
                _Pragma("unroll") for (int i_ = 0; i_ < 4; ++i_) { const u32x4 w_ = ub[s][4 * hf_ + i_]; acc4_[i_] = __builtin_amdgcn_mfma_f32_16x16x32_fp8_fp8((long)(((unsigned long long)w_.w << 32) | w_.z), hhi_, acc4_[i_], 0, 0, 0); } \
                _Pragma("unroll") for (int i_ = 0; i_ < 4; ++i_) { const float lo2_ = dsel0 ? acc4_[i_][1] : acc4_[i_][0], hi2_ = dsel0 ? acc4_[i_][3] : acc4_[i_][2]; const float v_ = dsel1 ? hi2_ : lo2_; d_[4 * hf_ + i_] = ondiag ? v_ : 0.f; } } \
            float a4_[4], c2_[2]; \
            _Pragma("unroll") for (int j_ = 0; j_ < 4; ++j_) { const float keep_ = b2 ? d_[j_ + 4] : d_[j_], send_ = b2 ? d_[j_] : d_[j_ + 4]; a4_[j_] = keep_ + dpp_f<0x141>(send_); } \
            _Pragma("unroll") for (int j_ = 0; j_ < 2; ++j_) { const float keep_ = b0 ? a4_[j_ + 2] : a4_[j_], send_ = b0 ? a4_[j_] : a4_[j_ + 2]; c2_[j_] = keep_ + dpp_f<0xB1>(send_); } \
            float dm_; { const float keep_ = b1 ? c2_[1] : c2_[0], send_ = b1 ? c2_[0] : c2_[1]; dm_ = keep_ + dpp_f<0x4E>(send_); } \
            dm_ += dpp_f<0x128>(dm_); \
            { const auto s16_ = __builtin_amdgcn_permlane16_swap(__float_as_uint(dm_), __float_as_uint(dm_), false, false); dm_ = __uint_as_float(s16_[0]) + __uint_as_float(s16_[1]); } \
            { const auto s32_ = __builtin_amdgcn_permlane32_swap(__float_as_uint(dm_), __float_as_uint(dm_), false, false); dm_ = __uint_as_float(s32_[0]) + __uint_as_float(s32_[1]); } \
            const float cf_ = bmg[s] * gelu_tanh(dm_ * bsc[s][0] * hs_) * bsc[s][1]; \
            if (lane < 8) cfl[tk_ * 128 + 8 * b_ + mym] = cf_; } while (0)
            G_ISSUE_U(0, 0);
#pragma unroll 1
            for (int n = 0; n < GT * 16; n += 2) {
                G_ISSUE_U(n + 1, 1); G_COMPUTE_U(0);
                if (n + 2 < GT * 16) G_ISSUE_U(n + 2, 0);
                G_COMPUTE_U(1);
            }
#undef G_ISSUE_U
#undef G_COMPUTE_U
        }
        __builtin_amdgcn_wave_barrier(); asm volatile("s_waitcnt lgkmcnt(0)" ::: "memory");
        f32x2 o2[GT][8];
#pragma unroll
        for (int tk = 0; tk < GT; ++tk) { cur[tk] = 0;
#pragma unroll
            for (int j = 0; j < 8; ++j) o2[tk][j] = (f32x2){0.f, 0.f}; }
#pragma unroll 1
        for (int r = 0; r < (16384 >> G_RSH); ++r) {
#pragma unroll
            for (int tk = 0; tk < GT; ++tk) {
                while (cur[tk] < 128 / VB) {
                    const int b = cur[tk]; const unsigned ex = sortl[tk * 128 + VB * b + (lane & (VB - 1))].x;
                    unsigned e[VB];
                    e[0] = __builtin_amdgcn_readlane(ex, 0);
                    if ((int)(e[0] >> G_RSH) > r) break;
                    cur[tk] = b + 1;
#pragma unroll
                    for (int i = 1; i < VB; ++i) e[i] = __builtin_amdgcn_readlane(ex, i);
                    u32x4 vv[VB];
#pragma unroll
                    for (int i = 0; i < VB; ++i) { vv[i] = *(const u32x4*)(ET + (size_t)(NEXP + e[i]) * DM + lane * 16); if (VB > 8) asm volatile("" ::: "memory"); }
                    f32x4 cq[VB / 4];
#pragma unroll
                    for (int q = 0; q < VB / 4; ++q) cq[q] = *(const LAS f32x4*)(cfl + tk * 128 + VB * b + 4 * q);
#pragma unroll
                    for (int i = 0; i < VB; ++i) { const float ci = cq[i >> 2][i & 3];
                        if (VB > 8 && (i & 1) == 0) {
                            asm volatile("" : "+v"(vv[i]), "+v"(vv[i + 1]), "+v"(o2[tk][0]), "+v"(o2[tk][1]), "+v"(o2[tk][2]), "+v"(o2[tk][3]), "+v"(o2[tk][4]), "+v"(o2[tk][5]), "+v"(o2[tk][6]), "+v"(o2[tk][7])); }
                        float f[16]; fp8x16_to_f32(vv[i], f);
#pragma unroll
                        for (int j = 0; j < 8; ++j) o2[tk][j] += (f32x2){ci, ci} * (f32x2){f[2 * j], f[2 * j + 1]}; }
                }
            }
        }
        float o[GT][16];
#pragma unroll
        for (int tk = 0; tk < GT; ++tk)
#pragma unroll
            for (int j = 0; j < 8; ++j) { o[tk][2 * j] = o2[tk][j][0]; o[tk][2 * j + 1] = o2[tk][j][1]; }
        int dry_v = dry ? 1 : 0; asm volatile("" : "+v"(dry_v)); const int dry_l = __builtin_amdgcn_readfirstlane(dry_v);
        bf16_t* xbo = dry_l ? (bf16_t*)(p.ws + WS_SCRATCH) : (bf16_t*)(p.ws + WS_XB);
        float* outp = dry_l ? (float*)(p.ws + WS_SCRATCH) : p.out;
        float* rstdo = dry_l ? (float*)(p.ws + WS_SCRATCH + 130 * MiB) : (float*)(p.ws + WS_RSTD);
#pragma unroll
        for (int tk = 0; tk < GT; ++tk) { const int tok = tok0 + tk;
            const u32x4 xw0 = *(const u32x4*)(xb + (size_t)tok * DM + lane * 16), xw1 = *(const u32x4*)(xb + (size_t)tok * DM + lane * 16 + 8);
            float* ot = o[tk];
            ot[0] += bf_lo(xw0.x); ot[1] += bf_hi(xw0.x); ot[2] += bf_lo(xw0.y); ot[3] += bf_hi(xw0.y); ot[4] += bf_lo(xw0.z); ot[5] += bf_hi(xw0.z); ot[6] += bf_lo(xw0.w); ot[7] += bf_hi(xw0.w);
            ot[8] += bf_lo(xw1.x); ot[9] += bf_hi(xw1.x); ot[10] += bf_lo(xw1.y); ot[11] += bf_hi(xw1.y); ot[12] += bf_lo(xw1.z); ot[13] += bf_hi(xw1.z); ot[14] += bf_lo(xw1.w); ot[15] += bf_hi(xw1.w);
            float ss = 0.f;
#pragma unroll
            for (int i = 0; i < 16; ++i) ss += ot[i] * ot[i];
            ss = wave_sum(ss);
            const float r2 = 1.0f / sqrtf(ss * (1.0f / DM) + EPS);
            if (l + 1 < DEPTH) {
                u32x4 w0, w1; w0.x = cvt_pk_bf16(ot[0], ot[1]); w0.y = cvt_pk_bf16(ot[2], ot[3]); w0.z = cvt_pk_bf16(ot[4], ot[5]); w0.w = cvt_pk_bf16(ot[6], ot[7]);
                w1.x = cvt_pk_bf16(ot[8], ot[9]); w1.y = cvt_pk_bf16(ot[10], ot[11]); w1.z = cvt_pk_bf16(ot[12], ot[13]); w1.w = cvt_pk_bf16(ot[14], ot[15]);
                *(u32x4*)(xbo + (size_t)tok * DM + lane * 16) = w0; *(u32x4*)(xbo + (size_t)tok * DM + lane * 16 + 8) = w1;
                if (lane == 0) rstdo[(size_t)(l + 1) * NTOK + tok] = r2;
            } else {
                const float* fg = p.in[I_FGAIN] + lane * 16; float* dst = outp + (size_t)tok * DM + lane * 16;
#pragma unroll
                for (int q = 0; q < 4; ++q) { const f32x4 gq = *(const f32x4*)(fg + 4 * q);
                    *(f32x4*)(dst + 4 * q) = (f32x4){ot[4 * q] * r2 * gq[0], ot[4 * q + 1] * r2 * gq[1], ot[4 * q + 2] * r2 * gq[2], ot[4 * q + 3] * r2 * gq[3]}; }
            }
        }
    }
}

constexpr int PH_PER_LAYER = 8, N_PHASES = 1 + DEPTH * PH_PER_LAYER;
__global__ void __launch_bounds__(NTHREADS, 2) mk_fwd(Params p) {
    extern __shared__ __attribute__((aligned(16))) unsigned char lds_raw[];
    Frame F; F.lds = (LAS unsigned char*)lds_raw; F.tid = threadIdx.x; F.lane = F.tid & 63; F.wave = __builtin_amdgcn_readfirstlane(F.tid >> 6);
    F.G = gridDim.x; { const int bx = blockIdx.x; F.vcu = (F.G % 8 == 0) ? (bx % 8) * (F.G / 8) + bx / 8 : bx; }
    volatile LAS unsigned* misc = (volatile LAS unsigned*)(F.lds + LDS_MISC);
    if (F.tid < 64) misc[F.tid] = 0u;
    __syncthreads();
    unsigned* ctl = (unsigned*)(p.ws + WS_CTL);
    XcdBarrier bar; bar.bar = ctl + CTL_BAR_WORD; bar.x = 0; bar.st = nullptr;
    const bool one_launch = (p.ph_hi - p.ph_lo) > 1;
    if (one_launch) bar = xcd_barrier_post(ctl + CTL_BAR_WORD, misc);
    const int lo = p.ph_lo, hi = p.ph_hi;
#define IN(k) (lo <= (k) && (k) < hi)
#define SEAM(k) do { if (IN(k) && IN((k) + 1)) xcd_barrier(bar); } while (0)
    bf16_t* xb = (bf16_t*)(p.ws + WS_XB);
    if (IN(0)) { for (int rp = 0; rp < p.rep[8]; ++rp) phase_prologue(p, F); SEAM(0); }
    for (int l = 0; l < DEPTH; ++l) {
        const int b = 1 + l * PH_PER_LAYER;
        const float* rstd_a = (const float*)(p.ws + WS_RSTD) + (size_t)l * NTOK;
        if (IN(b + 0)) {
            pg8::Gemm g{xb, (const bf16_t*)(p.ws + WS_WTIN) + (size_t)l * NIN * DM, DM, DM, DM, 0, 0};
            pg8::TileOrder<1> S; S.init(NTOK, NA, F.G, (int)blockIdx.x);
            EpiProjA E{(bf16_t*)(p.ws + WS_PROJA), rstd_a};
            for (int rp = 0; rp < p.rep[0]; ++rp) pg8::gemm_phase(F.lds, g, S, E, F.wave);
            SEAM(b + 0);
        }
        if (IN(b + 1)) {
#if defined(MIX_SIMPLE)
            phase_mix_simple(p, F, l);
#else
            for (int rp = 0; rp < p.rep[1]; ++rp) phase_mix(p, F, l);
#endif
            __syncthreads();
        }
        if (IN(b + 2)) {
            pg8::Gemm g{xb, (const bf16_t*)(p.ws + WS_WTIN) + ((size_t)l * NIN + NA) * DM, DM, DM, DM, 0, 0};
            pg8::TileOrder<1> S; S.init(NTOK, NG, F.G, (int)blockIdx.x);
            EpiGates E{(unsigned char*)(p.ws + WS_GATES), rstd_a, p.in[I_BGATE] + l * NG};
            for (int rp = 0; rp < p.rep[2]; ++rp) pg8::gemm_phase(F.lds, g, S, E, F.wave);
            SEAM(b + 2);
        }
        if (IN(b + 3)) {
            pg8::Gemm g{(const bf16_t*)p.out, (const bf16_t*)(p.ws + WS_WTBR) + (size_t)l * 3 * DM * 512, MIXW, 512, 512, (size_t)512 * 2, (size_t)DM * 512 * 2};
            pg8::TileOrder<3> S; S.init(NTOK, DM, F.G, (int)blockIdx.x);
            EpiMerge E{(const unsigned char*)(p.ws + WS_GATES), (bf16_t*)(p.ws + WS_MERGED), 0};
            if (MERGE_STAGGER) { const unsigned long long t0_ = __builtin_amdgcn_s_memrealtime(), d_ = (unsigned long long)((blockIdx.x >> 3) & 3u) * MERGE_STAGGER;
                while (__builtin_amdgcn_s_memrealtime() - t0_ < d_) __builtin_amdgcn_s_sleep(8); }
            for (int rp = 0; rp < p.rep[3]; ++rp) { E.cheap = (rp + 1 < p.rep[3]) ? p.rep[10] : 0; pg8::gemm_phase(F.lds, g, S, E, F.wave); }
            SEAM(b + 3);
        }
        if (IN(b + 4)) {
            pg8::Gemm g{(const bf16_t*)(p.ws + WS_MERGED), (const bf16_t*)(p.ws + WS_WTOUT) + (size_t)l * DM * DM, DM, DM, DM, 0, 0};
            pg8::TileOrder<1> S; S.init(NTOK, DM, F.G, (int)blockIdx.x);
            for (int rp = 0; rp < p.rep[4]; ++rp) { EpiResid E{xb, (float*)(p.ws + WS_ROWSQP) + (size_t)l * NTOK * 16, (rp + 1 < p.rep[4]) ? (bf16_t*)(p.ws + WS_GATES) : xb}; pg8::gemm_phase(F.lds, g, S, E, F.wave); }
            SEAM(b + 4);
        }
        if (IN(b + 5)) {
            pg8::Gemm g{xb, (const bf16_t*)(p.ws + WS_WEFF) + (size_t)l * PQ * DM, DM, DM, DM, 0, 0};
            pg8::TileOrder<1> S; S.init(NTOK, PQ, F.G, (int)blockIdx.x);
            EpiScores E{(bf16_t*)(p.ws + WS_SCORES)};
            for (int rp = 0; rp < p.rep[5]; ++rp) pg8::gemm_phase(F.lds, g, S, E, F.wave);
            SEAM(b + 5);
        }
        if (IN(b + 6)) { for (int rp = 0; rp < p.rep[6]; ++rp) phase_topk(p, F, l); SEAM(b + 6); }
        if (IN(b + 7)) { for (int rp = 0; rp < p.rep[7]; ++rp) { const bool dry = rp + 1 < p.rep[7]; phase_gather(p, F, l, bar, one_launch, dry, (dry && p.rep[9]) ? 1023u : 0xffffffffu); } SEAM(b + 7); }
    }
#undef IN
#undef SEAM
}

extern "C" void kernel_launch(void* const* d_in, const int* in_sizes, int n_in, void* d_out, int out_size, void* d_ws, size_t ws_size, hipStream_t stream) {
    static int grid = 0;
    if (grid == 0) {
        if (n_in != 22 || out_size != NTOK * DM || ws_size < WS_END) { fprintf(stderr, "kernel_launch: unexpected shapes (n_in %d, out %d, ws %zu)\n", n_in, out_size, ws_size); grid = -1; return; }
        int dev = 0, cus = 0, per_cu = 0;
        if (hipGetDevice(&dev) != hipSuccess || hipDeviceGetAttribute(&cus, hipDeviceAttributeMultiprocessorCount, dev) != hipSuccess) { grid = -1; return; }
        if (hipFuncSetAttribute((const void*)mk_fwd, hipFuncAttributeMaxDynamicSharedMemorySize, LDS_BYTES) != hipSuccess) { fprintf(stderr, "kernel_launch: hipFuncSetAttribute failed\n"); grid = -1; return; }
        if (hipOccupancyMaxActiveBlocksPerMultiprocessor(&per_cu, (const void*)mk_fwd, NTHREADS, LDS_BYTES) != hipSuccess || per_cu < 1) { fprintf(stderr, "kernel_launch: occupancy query says %d\n", per_cu); }
        (void)hipGetLastError();
        grid = cus;
    }
    if (grid < 0) return;
    (void)hipMemsetAsync((char*)d_ws + WS_CTL, 0, CTL_ZERO_BYTES, stream);
    Params p; memset(&p, 0, sizeof(p));
    for (int i = 0; i < 22; ++i) p.in[i] = (const float*)d_in[i];
    p.out = (float*)d_out; p.ws = (unsigned char*)d_ws;
    for (int i = 0; i < 12; ++i) p.rep[i] = 1;
    for (int i = 0; i < 9; ++i) if (PD(i)) p.rep[i] = 2;
    p.rep[9] = 0; if (PD(9)) { p.rep[7] = 2; p.rep[9] = 1; }
    p.rep[10] = 0; if (PD(10)) { p.rep[3] = 2; p.rep[10] = 1; }
#if MK_N_LAUNCHES == 1
    p.ph_lo = 0; p.ph_hi = N_PHASES; p.li = 0;
    hipLaunchKernelGGL(mk_fwd, dim3(grid), dim3(NTHREADS), LDS_BYTES, stream, p);
#else
    for (int ph = 0; ph < N_PHASES; ++ph) { p.ph_lo = ph; p.ph_hi = ph + 1; p.li = ph; hipLaunchKernelGGL(mk_fwd, dim3(grid), dim3(NTHREADS), LDS_BYTES, stream, p); }
#endif
}
```

```cpp
#include <hip/hip_runtime.h>
#include <cstdio>
#include <cstdint>
#include <cstring>

#ifndef MK_N_LAUNCHES
#define MK_N_LAUNCHES 1
#endif

#ifndef PROBE_DOUBLE
#define PROBE_DOUBLE -1
#endif
#define PD(k) (PROBE_DOUBLE == (k) || (PROBE_DOUBLE == 100 && ((k) == 0 || ((k) >= 2 && (k) <= 5))))

#define LAS __attribute__((address_space(3)))
typedef unsigned short bf16_t;
typedef short bf16x8 __attribute__((ext_vector_type(8)));
typedef float f32x4 __attribute__((ext_vector_type(4)));
typedef float f32x2 __attribute__((ext_vector_type(2)));
typedef unsigned u32x4 __attribute__((ext_vector_type(4)));
typedef unsigned u32x2 __attribute__((ext_vector_type(2)));
typedef __bf16 bf16x2_t __attribute__((ext_vector_type(2)));

constexpr int NTOK = 32768, DM = 1024, SEQ = 16384, DEPTH = 2;
constexpr int NA = 2304, NG = 3072, NIN = 5376;
constexpr int COL_K = 512, COL_V = 640, COL_PZ = 768, COL_GU = 1280, COL_GV = 1792;
constexpr int MIXW = 1536;
constexpr int NEXP = 16384, PQ = 2048;
constexpr float EPS = 1e-6f;
constexpr int NWAVES = 8, NTHREADS = 512;

constexpr size_t MiB = 1u << 20;
constexpr size_t WS_CTL = 0, CTL_ZERO_BYTES = 1 * MiB;
constexpr size_t CTL_BAR_WORD = 4096;
constexpr size_t CTL_ROWSQ = 256 * 1024;
constexpr size_t WS_RSTD = 1 * MiB;
constexpr size_t WS_WTIN = 2 * MiB;
constexpr size_t WS_WTBR = 23 * MiB;
constexpr size_t WS_WTOUT = 29 * MiB;
constexpr size_t WS_WEFF = 33 * MiB;
constexpr size_t WS_WSP = 41 * MiB;
constexpr size_t WS_ROWSQP = 42 * MiB;
constexpr size_t WS_ESCALE = 46 * MiB;
constexpr size_t WS_EXP = 48 * MiB;
constexpr size_t WS_XB = 112 * MiB;
constexpr size_t WS_PROJA = 176 * MiB;
constexpr size_t WS_MERGED = 176 * MiB;
constexpr size_t WS_SCORES = 176 * MiB;
constexpr size_t WS_SCRATCH = 176 * MiB;
constexpr size_t WS_GATES = 320 * MiB;
constexpr size_t WS_SELI = 464 * MiB, WS_SELG = 480 * MiB;
constexpr size_t WS_END = 512 * MiB;

constexpr int LDS_BYTES = 163840;
constexpr int LDS_MISC = LDS_BYTES - 256;

#define NEG_INF_F (__uint_as_float(0xff800000u))
__device__ __forceinline__ unsigned cvt_pk_bf16(float lo, float hi) { unsigned r; asm volatile("v_cvt_pk_bf16_f32 %0, %1, %2" : "=v"(r) : "v"(lo), "v"(hi)); return r; }
__device__ __forceinline__ float bf_lo(unsigned u) { return __uint_as_float(u << 16); }
__device__ __forceinline__ float bf_hi(unsigned u) { return __uint_as_float(u & 0xffff0000u); }
__device__ __forceinline__ float bf1(bf16_t u) { return __uint_as_float(((unsigned)u) << 16); }
__device__ __forceinline__ float wave_sum(float v) {
#pragma unroll
    for (int o = 1; o < 64; o <<= 1) v += __shfl_xor(v, o);
    return v;
}
__device__ __forceinline__ float gelu_tanh(float x) {
    const float u = 0.7978845608028654f * (x + 0.044715f * x * x * x);
    const float e = __builtin_amdgcn_exp2f(-2.0f * 1.4426950408889634f * u);
    return x * __builtin_amdgcn_rcpf(1.0f + e);
}
__device__ __forceinline__ float row_sumsq(const float* part, int row) { const f32x4* q = (const f32x4*)(part + (size_t)row * 16); const f32x4 a = q[0], b = q[1], c = q[2], d = q[3];
    return (((a[0] + a[1]) + (a[2] + a[3])) + ((b[0] + b[1]) + (b[2] + b[3]))) + (((c[0] + c[1]) + (c[2] + c[3])) + ((d[0] + d[1]) + (d[2] + d[3]))); }
__device__ __forceinline__ float sigmoidf_(float x) { return __builtin_amdgcn_rcpf(1.0f + __builtin_amdgcn_exp2f(-1.4426950408889634f * x)); }

#define XB_TMO      128
#define XB_XCNT(j)  (256  + 64 * (j))
#define XB_XSUB(j)  (1280 + 64 * (j))
#define XB_XGEN(j)  (2304 + 64 * (j))
#define XB_TOP      3328
#define XB_TOPGEN   3392
#define XCD_BAR_WORDS 3456
#define XB_SPIN_CAP (1u << 18)
__device__ __forceinline__ unsigned xb_ld(unsigned* p)              { return __hip_atomic_load(p, __ATOMIC_RELAXED, __HIP_MEMORY_SCOPE_AGENT); }
__device__ __forceinline__ unsigned xb_add(unsigned* p, unsigned v) { return __hip_atomic_fetch_add(p, v, __ATOMIC_RELAXED, __HIP_MEMORY_SCOPE_AGENT); }
__device__ __forceinline__ unsigned xb_xcc_id() { return (unsigned)__builtin_amdgcn_s_getreg((3 << 11) | 20) & 0xFu; }
#define XB_SPIN(cond, bar) do { unsigned _sp = 0; while (cond) { __builtin_amdgcn_s_sleep(1); \
    if ((++_sp & 255u) == 0u) { if (xb_ld(&(bar)[XB_TMO])) break; if (_sp > XB_SPIN_CAP) { atomicAdd(&(bar)[XB_TMO], 1u); break; } } } } while (0)
struct XcdBarrier { unsigned* bar; unsigned x; volatile LAS unsigned* st; };
__device__ __forceinline__ XcdBarrier xcd_barrier_post(unsigned* bar, volatile LAS unsigned* st) {
    XcdBarrier b; b.bar = bar; b.x = xb_xcc_id(); b.st = st;
    if (threadIdx.x == 0) (void)xb_add(&bar[XB_XCNT(b.x)], 1u);
    return b;
}
__device__ __forceinline__ void xcd_barrier_complete(unsigned* bar, unsigned x, unsigned& nloc, unsigned& nx) {
    const unsigned G = gridDim.x * gridDim.y * gridDim.z;
    unsigned sum, cnt, mine, sp = 0u;
    for (;;) {
        sum = 0u; cnt = 0u; mine = 0u;
#pragma unroll
        for (unsigned j = 0; j < 16; ++j) { const unsigned c = xb_ld(&bar[XB_XCNT(j)]); sum += c; cnt += (c > 0u) ? 1u : 0u; mine = (j == x) ? c : mine; }
        if (sum == G) break;
        __builtin_amdgcn_s_sleep(1);
        if ((++sp & 255u) == 0u) { if (xb_ld(&bar[XB_TMO])) break; if (sp > XB_SPIN_CAP) { atomicAdd(&bar[XB_TMO], 1u); break; } }
    }
    nloc = mine > 0u ? mine : 1u; nx = cnt > 0u ? cnt : 1u;
}
__device__ __forceinline__ void xcd_barrier(const XcdBarrier& b) {
    asm volatile("s_waitcnt vmcnt(0)" ::: "memory");
    __syncthreads();
    if (threadIdx.x == 0) {
        unsigned* bar = b.bar;
        __builtin_amdgcn_s_waitcnt(0);
        unsigned nloc = b.st[0], nx = b.st[1];
        if (nloc == 0u) { xcd_barrier_complete(bar, b.x, nloc, nx); b.st[0] = nloc; b.st[1] = nx; }
        const unsigned old = xb_add(&bar[XB_XSUB(b.x)], 1u);
        const unsigned gen = old / nloc;
        if (old + 1u == (gen + 1u) * nloc) {
            __builtin_amdgcn_fence(__ATOMIC_RELEASE, "agent");
            asm volatile("s_waitcnt vmcnt(0)" ::: "memory");
            const unsigned og = xb_add(&bar[XB_TOP], 1u);
            const unsigned tg = og / nx;
            if (og + 1u == (tg + 1u) * nx) xb_add(&bar[XB_TOPGEN], 1u);
            else XB_SPIN(xb_ld(&bar[XB_TOPGEN]) == tg, bar);
            __builtin_amdgcn_fence(__ATOMIC_ACQUIRE, "agent");
            xb_add(&bar[XB_XGEN(b.x)], 1u);
            asm volatile("s_waitcnt vmcnt(0)" ::: "memory");
        } else {
            XB_SPIN(xb_ld(&bar[XB_XGEN(b.x)]) == gen, bar);
            __builtin_amdgcn_fence(__ATOMIC_ACQUIRE, "agent");
            asm volatile("s_waitcnt vmcnt(0)" ::: "memory");
        }
    }
    __syncthreads();
}

constexpr int CTL_ALIGN_WORD = 16384;
__device__ __forceinline__ void xcd_align(const XcdBarrier& b) {
    __syncthreads();
    if (threadIdx.x == 0) {
        const unsigned nloc = b.st[0];
        if (nloc != 0u) {
            unsigned* w = b.bar + (CTL_ALIGN_WORD - (int)CTL_BAR_WORD) + b.x * 32u;
            const unsigned old = xb_add(w, 1u), target = (old / nloc + 1u) * nloc;
            XB_SPIN(xb_ld(w) < target, b.bar);
        }
    }
    __syncthreads();
}

namespace pg8 {
constexpr int BM = 256, BK = 64, HALF = 128, HTB = HALF * BK * 2, STAGE_BYTES = 8 * HTB, NXCD = 8, WGM = 8;
__host__ __device__ __forceinline__ int lds_byte(int r, int c) { const int st = (r >> 4) * 2 + (c >> 5), rr = r & 15, cc = c & 31, ob = rr * 64 + cc * 2; return st * 1024 + (ob ^ (((ob >> 9) & 1) << 5)); }
__host__ __device__ __forceinline__ void stage_rc(int b, int& R, int& C) { const int st = b / 1024, sb = b % 1024, swz = sb ^ (((sb >> 9) & 1) << 5); R = (st >> 1) * 16 + swz / 64; C = (st & 1) * 32 + (swz % 64) / 2; }
__host__ __device__ __forceinline__ int perm32(int rho) { const int n = rho >> 4, i = rho & 15; return 8 * (i >> 2) + 4 * n + (i & 3); }

struct Unit { int pm, pn, z; };
struct Gemm { const bf16_t* A; const bf16_t* Bt; int lda, ldb, K; size_t az, bz; };

template <int ZN> struct TileOrder {
    int nM, nN, nwg, G, c;
    __device__ void init(int M, int N, int G_, int c_) { nM = M / BM; nN = N / BM; nwg = nM * nN; G = G_; c = c_; }
    __device__ bool next(int i, Unit& u) const {
        const long L = (long)(i / ZN) * G + c; if (L >= nwg) return false;
        int wgid = (int)L; { const int q = nwg / NXCD, r = nwg % NXCD, xcd = wgid % NXCD, off = wgid / NXCD; wgid = (xcd < r ? xcd * (q + 1) : r * (q + 1) + (xcd - r) * q) + off; }
        const int nig = WGM * nN, gid = wgid / nig, fm = gid * WGM, gsz = (nM - fm) < WGM ? (nM - fm) : WGM;
        u.pm = fm + ((wgid % nig) % gsz); u.pn = (wgid % nig) / gsz; u.z = i % ZN; return true;
    }
};

template <class Epi, class Sched>
__device__ __forceinline__ void gemm_phase(LAS unsigned char* lds, const Gemm g, const Sched& S, const Epi& E, int wave_id) {
    unsigned ones_; asm volatile("s_mov_b32 %0, -1" : "=s"(ones_));
    int tid_l = (wave_id << 6) | (int)__builtin_amdgcn_mbcnt_hi(ones_, __builtin_amdgcn_mbcnt_lo(ones_, 0u)); asm volatile("" : "+v"(tid_l));
    int wid_l = __builtin_amdgcn_readfirstlane(tid_l >> 6);
    const int tid = tid_l, wid = wid_l, lane = tid & 63, wr = wid >> 2, wc = wid & 3, fr = lane & 15, fq = lane >> 4;
    const int K = g.K, nt = K / BK;
    unsigned voffA[2], voffB[2];
#pragma unroll
    for (int i = 0; i < 2; ++i) { int R, C; stage_rc(tid * 16 + i * 8192, R, C); const int Rb = Epi::PERM ? ((R & ~31) + perm32(R & 31)) : R;
        voffA[i] = (unsigned)(R * g.lda + C) * 2u; voffB[i] = (unsigned)(Rb * g.ldb + C) * 2u; }
    const size_t kstep = (size_t)(BK * 2);
    const size_t hstepA = (size_t)HALF * g.lda * 2, hstepB = (size_t)HALF * g.ldb * 2;
    const size_t tstepA = 2 * hstepA, tstepB = 2 * hstepB;
    const unsigned ldsw = (unsigned)wid * 1024u;
    const int aoff = lds_byte(wr * 64 + fr, fq * 8), boff = lds_byte(wc * 32 + fr, fq * 8);
#define PG8_SA(b, h) (((b) * 2 + (h)) * HTB)
#define PG8_SB(b, h) ((4 + (b) * 2 + (h)) * HTB)
#define PG8_STAGE(bufoff, gbase, voff) do { _Pragma("unroll") for (int _i = 0; _i < 2; ++_i) \
        __builtin_amdgcn_global_load_lds((const unsigned*)((const char*)(gbase) + (voff)[_i]), (LAS unsigned*)(lds + (bufoff) + ldsw + _i * 8192), 16, 0, 0); } while (0)
#define PG8_LDA(dst, b, h) do { _Pragma("unroll") for (int m = 0; m < 4; ++m) _Pragma("unroll") for (int k = 0; k < 2; ++k) dst[m][k] = *(const LAS bf16x8*)(lds + PG8_SA(b, h) + aoff + m * 2048 + k * 1024); } while (0)
#define PG8_LDB(dst, b, h) do { _Pragma("unroll") for (int n = 0; n < 2; ++n) _Pragma("unroll") for (int k = 0; k < 2; ++k) dst[n][k] = *(const LAS bf16x8*)(lds + PG8_SB(b, h) + boff + n * 2048 + k * 1024); } while (0)
#define PG8_MMA(ai, bj, At, Bt) do { __builtin_amdgcn_s_setprio(1); _Pragma("unroll") for (int m = 0; m < 4; ++m) _Pragma("unroll") for (int n = 0; n < 2; ++n) _Pragma("unroll") for (int k = 0; k < 2; ++k) \
        acc[ai][bj][m][n] = __builtin_amdgcn_mfma_f32_16x16x32_bf16(Bt[n][k], At[m][k], acc[ai][bj][m][n], 0, 0, 0); __builtin_amdgcn_s_setprio(0); } while (0)
#define PG8_WAIT_V(n) asm volatile("s_waitcnt vmcnt(" #n ")" ::: "memory")
#define PG8_WAIT_L(n) asm volatile("s_waitcnt lgkmcnt(" #n ")" ::: "memory")
#define PG8_BAR __builtin_amdgcn_s_barrier()
#define PG8_SCHED __builtin_amdgcn_sched_barrier(0)
    Unit cur, nxt; int ui = 0;
    if (!S.next(0, cur)) return;
    f32x4 acc[2][2][4][2];
#pragma unroll
    for (int a = 0; a < 2; ++a)
#pragma unroll
        for (int b = 0; b < 2; ++b)
#pragma unroll
            for (int m = 0; m < 4; ++m)
#pragma unroll
                for (int n = 0; n < 2; ++n) acc[a][b][m][n] = (f32x4){0.f, 0.f, 0.f, 0.f};
    bf16x8 At[4][2], B0[2][2], B1[2][2];
    const char* cA = (const char*)g.A + (size_t)cur.pm * tstepA + (size_t)cur.z * g.az; const char* cB = (const char*)g.Bt + (size_t)cur.pn * tstepB + (size_t)cur.z * g.bz;
    PG8_STAGE(PG8_SB(0, 0), cB, voffB); PG8_STAGE(PG8_SB(0, 1), cB + hstepB, voffB); PG8_STAGE(PG8_SA(0, 0), cA, voffA); PG8_STAGE(PG8_SA(0, 1), cA + hstepA, voffA);
    if (wr == 1) PG8_BAR;
    PG8_WAIT_V(2); PG8_BAR;
    PG8_STAGE(PG8_SB(1, 0), cB + kstep, voffB); PG8_STAGE(PG8_SA(1, 0), cA + kstep, voffA); PG8_STAGE(PG8_SB(1, 1), cB + hstepB + kstep, voffB);
    PG8_WAIT_V(6); PG8_BAR;
    for (;;) {
        const bool has_next = S.next(ui + 1, nxt);
        const char* nA = has_next ? (const char*)g.A + (size_t)nxt.pm * tstepA + (size_t)nxt.z * g.az : cA;
        const char* nB = has_next ? (const char*)g.Bt + (size_t)nxt.pn * tstepB + (size_t)nxt.z * g.bz : cB;
        for (int t = 0; t < nt; t += 2) {
            const bool last = (t == nt - 2);
            const char* a1 = cA + (size_t)(t + 1) * kstep;
            const char* a2 = last ? nA : cA + (size_t)(t + 2) * kstep; const char* b2 = last ? nB : cB + (size_t)(t + 2) * kstep;
            const char* a3 = a2 + kstep; const char* b3 = b2 + kstep;
            PG8_LDB(B0, 0, 0); PG8_LDB(B1, 0, 1); PG8_SCHED; PG8_LDA(At, 0, 0); PG8_STAGE(PG8_SA(1, 1), a1 + hstepA, voffA);
            PG8_WAIT_V(8); PG8_WAIT_L(0); PG8_BAR; PG8_MMA(0, 0, At, B0); PG8_MMA(0, 1, At, B1); PG8_BAR; PG8_SCHED;
            PG8_LDA(At, 0, 1); PG8_STAGE(PG8_SB(0, 0), b2, voffB); PG8_STAGE(PG8_SB(0, 1), b2 + hstepB, voffB); PG8_STAGE(PG8_SA(0, 0), a2, voffA);
            PG8_WAIT_V(8); PG8_WAIT_L(0); PG8_BAR; PG8_MMA(1, 0, At, B0); PG8_MMA(1, 1, At, B1); PG8_BAR; PG8_SCHED;
            PG8_LDB(B0, 1, 0); PG8_LDB(B1, 1, 1); PG8_SCHED; PG8_LDA(At, 1, 0); PG8_STAGE(PG8_SA(0, 1), a2 + hstepA, voffA);
            PG8_WAIT_V(8); PG8_WAIT_L(0); PG8_BAR; PG8_MMA(0, 0, At, B0); PG8_MMA(0, 1, At, B1); PG8_BAR; PG8_SCHED;
            PG8_LDA(At, 1, 1); PG8_STAGE(PG8_SB(1, 0), b3, voffB); PG8_STAGE(PG8_SB(1, 1), b3 + hstepB, voffB); PG8_STAGE(PG8_SA(1, 0), a3, voffA);
            PG8_WAIT_V(8); PG8_WAIT_L(0); PG8_BAR; PG8_MMA(1, 0, At, B0); PG8_MMA(1, 1, At, B1); PG8_BAR; PG8_SCHED;
        }
        if (wr == 0) PG8_BAR;
        E(acc, cur, wr, wc, fr, fq);
        if (!has_next) break;
        if (!E.keep(cur)) {
#pragma unroll
            for (int a = 0; a < 2; ++a)
#pragma unroll
                for (int b = 0; b < 2; ++b)
#pragma unroll
                    for (int m = 0; m < 4; ++m)
#pragma unroll
                        for (int n = 0; n < 2; ++n) acc[a][b][m][n] = (f32x4){0.f, 0.f, 0.f, 0.f};
        }
        cur = nxt; cA = nA; cB = nB; ++ui;
        if (wr == 1) PG8_BAR;
    }
    PG8_WAIT_V(0);
    PG8_BAR;
#undef PG8_SA
#undef PG8_SB
#undef PG8_STAGE
#undef PG8_LDA
#undef PG8_LDB
#undef PG8_MMA
#undef PG8_WAIT_V
#undef PG8_WAIT_L
#undef PG8_BAR
#undef PG8_SCHED
}
}
typedef pg8::Unit Unit;
typedef f32x4 AccT[2][2][4][2];

struct EpiProjA {
    static constexpr bool PERM = true;
    bf16_t* O; const float* rstd;
    __device__ __forceinline__ bool keep(const Unit&) const { return false; }
    template <bool ACT> __device__ __forceinline__ void run(AccT& acc, const Unit& u, int wr, int wc, int fr, int fq) const {
        const int row0 = u.pm * 256 + wr * 64 + fr, col0 = u.pn * 256 + wc * 32 + 8 * fq;
        float rs[2][4];
#pragma unroll
        for (int ai = 0; ai < 2; ++ai)
#pragma unroll
            for (int m = 0; m < 4; ++m) rs[ai][m] = rstd[row0 + ai * 128 + m * 16];
#pragma unroll
        for (int ai = 0; ai < 2; ++ai)
#pragma unroll
            for (int m = 0; m < 4; ++m) { const int row = row0 + ai * 128 + m * 16; bf16_t* rowp = O + (size_t)row * NA + col0;
#pragma unroll
                for (int bj = 0; bj < 2; ++bj) { f32x4 v0 = acc[ai][bj][m][0] * rs[ai][m], v1 = acc[ai][bj][m][1] * rs[ai][m];
                    if (ACT) {
#pragma unroll
                        for (int j = 0; j < 4; ++j) { v0[j] = gelu_tanh(v0[j]); v1[j] = gelu_tanh(v1[j]); } }
                    u32x4 w; w.x = cvt_pk_bf16(v0[0], v0[1]); w.y = cvt_pk_bf16(v0[2], v0[3]); w.z = cvt_pk_bf16(v1[0], v1[1]); w.w = cvt_pk_bf16(v1[2], v1[3]);
                    *(u32x4*)(rowp + bj * 128) = w; } }
    }
    __device__ __forceinline__ void operator()(AccT& acc, const Unit& u, int wr, int wc, int fr, int fq) const {
        if (u.pn >= 5) run<true>(acc, u, wr, wc, fr, fq); else run<false>(acc, u, wr, wc, fr, fq);
    }
};
struct EpiGates {
    static constexpr bool PERM = true;
    unsigned char* O; const float* rstd; const float* bias;
    __device__ __forceinline__ bool keep(const Unit&) const { return false; }
    __device__ __forceinline__ void operator()(AccT& acc, const Unit& u, int wr, int wc, int fr, int fq) const {
        const int row0 = u.pm * 256 + wr * 64 + fr, col0 = u.pn * 256 + wc * 32 + 8 * fq;
        f32x4 bv[2][2];
#pragma unroll
        for (int bj = 0; bj < 2; ++bj)
#pragma unroll
            for (int n = 0; n < 2; ++n) bv[bj][n] = *(const f32x4*)(bias + col0 + bj * 128 + 4 * n);
        unsigned char* tile = O + (size_t)(u.pm * (NG / 256) + u.pn) * 65536 + (wr * 64 + fr) * 256 + wc * 32 + 8 * fq;
        float rsv[2][4];
#pragma unroll
        for (int ai = 0; ai < 2; ++ai)
#pragma unroll
            for (int m = 0; m < 4; ++m) rsv[ai][m] = rstd[row0 + ai * 128 + m * 16];
#pragma unroll
        for (int ai = 0; ai < 2; ++ai)
#pragma unroll
            for (int m = 0; m < 4; ++m) { const float rs = rsv[ai][m]; unsigned wq[4];
#pragma unroll
                for (int bj = 0; bj < 2; ++bj) { f32x4 v0 = acc[ai][bj][m][0] * rs + bv[bj][0], v1 = acc[ai][bj][m][1] * rs + bv[bj][1];
                    unsigned q[8];
#pragma unroll
                    for (int j = 0; j < 4; ++j) { q[j] = (unsigned)(sigmoidf_(v0[j]) * 255.0f + 0.5f); q[4 + j] = (unsigned)(sigmoidf_(v1[j]) * 255.0f + 0.5f); }
                    wq[2 * bj] = q[0] | (q[1] << 8) | (q[2] << 16) | (q[3] << 24); wq[2 * bj + 1] = q[4] | (q[5] << 8) | (q[6] << 16) | (q[7] << 24); }
                *(u32x4*)(O + (size_t)0 * 1048576 + (size_t)(u.pm * (NG / 256) + u.pn) * 65536 + (ai * 4 + m) * 8192 + (((wr * 4 + wc) * 64) + fq * 16 + fr) * 16) = (u32x4){wq[0], wq[1], wq[2], wq[3]}; }
    }
};
struct EpiMerge {
    static constexpr bool PERM = true;
    const unsigned char* gates; bf16_t* O; int cheap;
    __device__ __forceinline__ bool keep(const Unit& u) const { return u.z < 2; }
    static __device__ __forceinline__ void unpack8(const u32x2 a, float (&f)[8]) {
        f[0] = (float)(a.x & 255u); f[1] = (float)((a.x >> 8) & 255u); f[2] = (float)((a.x >> 16) & 255u); f[3] = (float)(a.x >> 24);
        f[4] = (float)(a.y & 255u); f[5] = (float)((a.y >> 8) & 255u); f[6] = (float)((a.y >> 16) & 255u); f[7] = (float)(a.y >> 24); }
    __device__ __forceinline__ void operator()(AccT& acc, const Unit& u, int wr, int wc, int fr, int fq) const {
        const int z = u.z;
        if (cheap && z < 2) return;
        constexpr int GTS = 4 * 65536;
        const __amdgpu_buffer_rsrc_t gr = __builtin_amdgcn_make_buffer_rsrc(const_cast<unsigned char*>(gates) + (size_t)0 * 1048576, 0, NTOK * NG, 0x00020000);
        const __amdgpu_buffer_rsrc_t orr = __builtin_amdgcn_make_buffer_rsrc(O, 0, NTOK * DM * 2, 0x00020000);
        const int gsoff = (u.pm * (NG / 256) + u.pn) * 65536 + z * GTS, gsoffb = gsoff + (z < 2 ? GTS : 0);
        const int lofs = (((wr * 4 + wc) * 64) + fq * 16 + fr) * 16;
        const int osoff = (u.pm * 256 * DM + u.pn * 256) * 2, oofs = ((wr * 64 + fr) * DM + wc * 32 + 8 * fq) * 2;
        const float lo = (z == 0) ? 0.0f : 0.5f; const bool last = (z == 2);
#pragma unroll
        for (int aq = 0; aq < 4; ++aq) { const int ai = aq >> 1, m0 = (aq & 1) * 2; u32x2 A[2][2], B[2][2];
#pragma unroll
            for (int mm = 0; mm < 2; ++mm)
#pragma unroll
                for (int bj = 0; bj < 2; ++bj) { A[mm][bj] = __builtin_amdgcn_raw_buffer_load_b64(gr, lofs + bj * 8, gsoff + (ai * 4 + (m0 + mm)) * 8192, 0);
                    B[mm][bj] = __builtin_amdgcn_raw_buffer_load_b64(gr, lofs + bj * 8, gsoffb + (ai * 4 + (m0 + mm)) * 8192, 0); }
#pragma unroll
            for (int mm = 0; mm < 2; ++mm)
#pragma unroll
                for (int bj = 0; bj < 2; ++bj) { const int m = m0 + mm; float fa[8], fb[8]; unpack8(A[mm][bj], fa); unpack8(B[mm][bj], fb);
                    float f[8];
#pragma unroll
                    for (int j = 0; j < 8; ++j) { const float den = last ? 255.0f : fmaxf(fb[j], 0.5f); f[j] = fmaxf(fa[j], lo) * __builtin_amdgcn_rcpf(den); }
                    f32x4 v0 = acc[ai][bj][m][0], v1 = acc[ai][bj][m][1];
                    v0[0] *= f[0]; v0[1] *= f[1]; v0[2] *= f[2]; v0[3] *= f[3]; v1[0] *= f[4]; v1[1] *= f[5]; v1[2] *= f[6]; v1[3] *= f[7];
                    acc[ai][bj][m][0] = v0; acc[ai][bj][m][1] = v1;
                    if (last) { u32x4 w; w.x = cvt_pk_bf16(v0[0], v0[1]); w.y = cvt_pk_bf16(v0[2], v0[3]); w.z = cvt_pk_bf16(v1[0], v1[1]); w.w = cvt_pk_bf16(v1[2], v1[3]);
                        __builtin_amdgcn_raw_buffer_store_b128(w, orr, oofs + bj * 256, osoff + (ai * 128 + m * 16) * DM * 2, 0); } }
        }
    }
};
struct EpiResid {
    static constexpr bool PERM = true;
    bf16_t* X; float* rowsq; bf16_t* XO;
    __device__ __forceinline__ bool keep(const Unit&) const { return false; }
    __device__ __forceinline__ void operator()(AccT& acc, const Unit& u, int wr, int wc, int fr, int fq) const {
        const int row0 = u.pm * 256 + wr * 64 + fr, col0 = u.pn * 256 + wc * 32 + 8 * fq;
#pragma unroll
        for (int ai = 0; ai < 2; ++ai)
#pragma unroll
            for (int m = 0; m < 4; ++m) { const int row = row0 + ai * 128 + m * 16; bf16_t* rowp = X + (size_t)row * DM + col0; float ss = 0.f;
#pragma unroll
                for (int bj = 0; bj < 2; ++bj) { const u32x4 x = *(const u32x4*)(rowp + bj * 128);
                    f32x4 v0 = acc[ai][bj][m][0], v1 = acc[ai][bj][m][1];
                    v0[0] += bf_lo(x.x); v0[1] += bf_hi(x.x); v0[2] += bf_lo(x.y); v0[3] += bf_hi(x.y); v1[0] += bf_lo(x.z); v1[1] += bf_hi(x.z); v1[2] += bf_lo(x.w); v1[3] += bf_hi(x.w);
                    ss += (v0[0] * v0[0] + v0[1] * v0[1]) + (v0[2] * v0[2] + v0[3] * v0[3]) + (v1[0] * v1[0] + v1[1] * v1[1]) + (v1[2] * v1[2] + v1[3] * v1[3]);
                    u32x4 w; w.x = cvt_pk_bf16(v0[0], v0[1]); w.y = cvt_pk_bf16(v0[2], v0[3]); w.z = cvt_pk_bf16(v1[0], v1[1]); w.w = cvt_pk_bf16(v1[2], v1[3]);
                    *(u32x4*)(XO + (size_t)row * DM + col0 + bj * 128) = w; }
                ss += __shfl_xor(ss, 16); ss += __shfl_xor(ss, 32);
                if (fq == 0) rowsq[(size_t)row * 16 + u.pn * 4 + wc] = ss; }
    }
};
struct EpiScores {
    static constexpr bool PERM = true;
    bf16_t* C;
    __device__ __forceinline__ bool keep(const Unit&) const { return false; }
    __device__ __forceinline__ void operator()(AccT& acc, const Unit& u, int wr, int wc, int fr, int fq) const {
        const int row0 = u.pm * 256 + wr * 64 + fr, col0 = u.pn * 256 + wc * 32 + 8 * fq;
#pragma unroll
        for (int ai = 0; ai < 2; ++ai)
#pragma unroll
            for (int m = 0; m < 4; ++m) { bf16_t* rowp = C + (size_t)(row0 + ai * 128 + m * 16) * PQ + col0;
#pragma unroll
                for (int bj = 0; bj < 2; ++bj) { const f32x4 v0 = acc[ai][bj][m][0], v1 = acc[ai][bj][m][1];
                    u32x4 w; w.x = cvt_pk_bf16(v0[0], v0[1]); w.y = cvt_pk_bf16(v0[2], v0[3]); w.z = cvt_pk_bf16(v1[0], v1[1]); w.w = cvt_pk_bf16(v1[2], v1[3]);
                    *(u32x4*)(rowp + bj * 128) = w; } }
    }
};

struct Params {
    const float* in[22];
    float* out; unsigned char* ws;
    int ph_lo, ph_hi, li, pad;
    int rep[12];
};
enum { I_X = 0, I_RELB, I_FGAIN, I_AGAIN, I_WIN, I_BGATE, I_SINK, I_WPOOL, I_PSCALE, I_VGAIN, I_WSP, I_BSP, I_WA, I_WB, I_WC, I_WOUT, I_FFGAIN, I_WQ, I_K1, I_K2, I_EU, I_EV };

struct Frame { LAS unsigned char* lds; int tid, lane, wave, G, vcu; };
__device__ __forceinline__ int tid_from_wave(int wave) { unsigned ones; asm volatile("s_mov_b32 %0, -1" : "=s"(ones));
    int t = (wave << 6) | (int)__builtin_amdgcn_mbcnt_hi(ones, __builtin_amdgcn_mbcnt_lo(ones, 0u)); asm volatile("" : "+v"(t)); return t; }
__device__ __forceinline__ Frame local_frame(const Frame& F0) { Frame F = F0; const int t = tid_from_wave(F0.wave); F.tid = t; F.lane = t & 63; return F; }

__device__ __forceinline__ void p0_transpose_item(const float* W, int N, bf16_t* WT, int ldo, const float* kscale, LAS float* scr, int item, int lane) {
    const int nblk = N / 32, kb = item / nblk, nb = item % nblk, k0 = 64 * kb, n0 = 32 * nb;
#pragma unroll 8
    for (int i = 0; i < 32; ++i) { const int kk = 2 * i + (lane >> 5); float v = W[(size_t)(k0 + kk) * N + n0 + (lane & 31)]; if (kscale) v *= kscale[k0 + kk]; scr[kk * 33 + (lane & 31)] = v; }
    asm volatile("s_waitcnt lgkmcnt(0)" ::: "memory");
    const int c = lane & 7;
#pragma unroll
    for (int j = 0; j < 4; ++j) { const int n = (lane >> 3) + 8 * j; const LAS float* s = scr + (8 * c) * 33 + n;
        u32x4 o; o.x = cvt_pk_bf16(s[0 * 33], s[1 * 33]); o.y = cvt_pk_bf16(s[2 * 33], s[3 * 33]); o.z = cvt_pk_bf16(s[4 * 33], s[5 * 33]); o.w = cvt_pk_bf16(s[6 * 33], s[7 * 33]);
        *(u32x4*)(WT + (size_t)(n0 + n) * ldo + k0 + 8 * c) = o; }
    asm volatile("s_waitcnt lgkmcnt(0)" ::: "memory");
}
typedef unsigned u32x3 __attribute__((ext_vector_type(3)));
typedef unsigned u32x6 __attribute__((ext_vector_type(6)));
typedef int i32x8 __attribute__((ext_vector_type(8)));
typedef float f32x16 __attribute__((ext_vector_type(16)));
constexpr int UROW = 768;
__device__ __forceinline__ void convert_experts(const Params& p, const Frame& F) {
    const int gw = blockIdx.x * NWAVES + F.wave, NGW = F.G * NWAVES, lane = F.lane;
    constexpr int RB = 4;
    for (int r0 = gw * RB; r0 < DEPTH * 2 * NEXP; r0 += NGW * RB) {
        f32x4 v[RB][4];
#pragma unroll
        for (int q = 0; q < RB; ++q) { const int r = r0 + q; const int l = r / (2 * NEXP), tb = (r / NEXP) & 1, row = r % NEXP;
            const float* src = (tb ? p.in[I_EV] : p.in[I_EU]) + ((size_t)l * NEXP + row) * DM + lane * 16;
            v[q][0] = *(const f32x4*)src; v[q][1] = *(const f32x4*)(src + 4); v[q][2] = *(const f32x4*)(src + 8); v[q][3] = *(const f32x4*)(src + 12); }
#pragma unroll
        for (int q = 0; q < RB; ++q) { const int r = r0 + q; const int l = r / (2 * NEXP), tb = (r / NEXP) & 1, row = r % NEXP;
            float mx = 0.f;
#pragma unroll
            for (int j = 0; j < 4; ++j) mx = fmaxf(mx, fmaxf(fmaxf(fabsf(v[q][j][0]), fabsf(v[q][j][1])), fmaxf(fabsf(v[q][j][2]), fabsf(v[q][j][3]))));
#pragma unroll
            for (int o = 1; o < 64; o <<= 1) mx = fmaxf(mx, __shfl_xor(mx, o));
            if (tb == 1) {
                const float inv = mx > 0.f ? 448.0f / mx : 0.f;
                int w[4];
#pragma unroll
                for (int j = 0; j < 4; ++j) { w[j] = 0; w[j] = __builtin_amdgcn_cvt_pk_fp8_f32(v[q][j][0] * inv, v[q][j][1] * inv, w[j], false); w[j] = __builtin_amdgcn_cvt_pk_fp8_f32(v[q][j][2] * inv, v[q][j][3] * inv, w[j], true); }
                *(u32x4*)(p.ws + WS_EXP + (((size_t)l * 2 + 1) * NEXP + row) * DM + lane * 16) = (u32x4){(unsigned)w[0], (unsigned)w[1], (unsigned)w[2], (unsigned)w[3]};
                if (lane == 0) ((float*)(p.ws + WS_ESCALE))[((size_t)l * NEXP + row) * 2 + 1] = mx * (1.0f / 448.0f);
            } else {
                const float inv = mx > 0.f ? 7.5f / mx : 0.f;
                f32x16 xe, xo;
#pragma unroll
                for (int j = 0; j < 4; ++j) { xe[2 * j] = v[q][j][0] * inv; xo[2 * j] = v[q][j][1] * inv; xe[2 * j + 1] = v[q][j][2] * inv; xo[2 * j + 1] = v[q][j][3] * inv; }
#pragma unroll
                for (int i = 8; i < 16; ++i) { xe[i] = 0.f; xo[i] = 0.f; }
                const u32x6 w6 = __builtin_amdgcn_cvt_scalef32_2xpk16_fp6_f32(xe, xo, 1.0f);
                *(u32x3*)(p.ws + WS_EXP + ((size_t)l * 2 * NEXP) * DM + (size_t)row * UROW + lane * 12) = (u32x3){w6[0], w6[1], w6[2]};
                if (lane == 0) ((float*)(p.ws + WS_ESCALE))[((size_t)l * NEXP + row) * 2 + 0] = mx * (1.0f / 7.5f);
            } }
    }
}
__device__ __forceinline__ void phase_prologue(const Params& p, const Frame& F0) {
    const Frame F = local_frame(F0);
    const int gw = F.vcu * NWAVES + F.wave, NGW = F.G * NWAVES, lane = F.lane;
    LAS float* scr = (LAS float*)(F.lds + F.wave * 16384);
    constexpr int I_IN = (DM / 64) * (NIN / 32), I_BR = (512 / 64) * (DM / 32), I_OUT = (DM / 64) * (DM / 32);
    constexpr int PER_L = I_IN + 2 * I_BR + I_OUT;
    for (int it = gw; it < DEPTH * PER_L; it += NGW) {
        const int l = it / PER_L; int r = it % PER_L;
        if (r < I_IN) { p0_transpose_item(p.in[I_WIN] + (size_t)l * DM * NIN, NIN, (bf16_t*)(p.ws + WS_WTIN) + (size_t)l * NIN * DM, DM, p.in[I_AGAIN] + l * DM, scr, r, lane); continue; } r -= I_IN;
        if (r < I_BR) { p0_transpose_item(p.in[I_WA] + (size_t)l * 512 * DM, DM, (bf16_t*)(p.ws + WS_WTBR) + (size_t)(l * 3 + 0) * DM * 512, 512, nullptr, scr, r, lane); continue; } r -= I_BR;
        if (r < I_BR) { p0_transpose_item(p.in[I_WC] + (size_t)l * 512 * DM, DM, (bf16_t*)(p.ws + WS_WTBR) + (size_t)(l * 3 + 2) * DM * 512, 512, nullptr, scr, r, lane); continue; } r -= I_BR;
        p0_transpose_item(p.in[I_WOUT] + (size_t)l * DM * DM, DM, (bf16_t*)(p.ws + WS_WTOUT) + (size_t)l * DM * DM, DM, nullptr, scr, r, lane);
    }
    {
        float* rstd = (float*)(p.ws + WS_RSTD);
        for (int m0 = gw * 4; m0 < NTOK; m0 += NGW * 4) {
            f32x4 v[4][4];
#pragma unroll
            for (int q = 0; q < 4; ++q) { const f32x4* xr = (const f32x4*)(p.in[I_X] + (size_t)(m0 + q) * DM) + lane;
#pragma unroll
                for (int j = 0; j < 4; ++j) v[q][j] = xr[64 * j]; }
#pragma unroll
            for (int q = 0; q < 4; ++q) { float s = 0.f;
#pragma unroll
                for (int j = 0; j < 4; ++j) s += (v[q][j][0] * v[q][j][0] + v[q][j][1] * v[q][j][1]) + (v[q][j][2] * v[q][j][2] + v[q][j][3] * v[q][j][3]);
                s = wave_sum(s);
                u32x2* o = (u32x2*)((bf16_t*)(p.ws + WS_XB) + (size_t)(m0 + q) * DM) + lane;
#pragma unroll
                for (int j = 0; j < 4; ++j) { u32x2 w; w.x = cvt_pk_bf16(v[q][j][0], v[q][j][1]); w.y = cvt_pk_bf16(v[q][j][2], v[q][j][3]); o[64 * j] = w; }
                if (lane == 0) rstd[m0 + q] = 1.0f / sqrtf(s * (1.0f / DM) + EPS); }
        }
    }
    for (int i = blockIdx.x * NTHREADS + F.tid; i < DEPTH * 4 * 128 * 128; i += F.G * NTHREADS) { const int t = (i >> 7) & 127, s = i & 127;
        ((bf16_t*)(p.ws + WS_WSP))[i] = (bf16_t)(cvt_pk_bf16(s <= t ? p.in[I_WSP][i] : 0.f, 0.f) & 0xffffu); }
    convert_experts(p, F);
    __syncthreads();
    {
        LAS float* coef = (LAS float*)F.lds;
        for (int u = blockIdx.x; u < DEPTH * 4 * 32; u += F.G) {
            const int l = u / 128, g = (u / 32) % 4, c0 = (u % 32) * 4;
            __syncthreads();
            for (int i = F.tid; i < 512; i += NTHREADS) { const int cc = i >> 7, j = i & 127;
                coef[i] = p.in[I_WPOOL][(((size_t)l * 4 + g) * 128 + c0 + cc) * 128 + j] * p.in[I_PSCALE][l * 512 + g * 128 + j]; }
            __syncthreads();
            const float* wb = p.in[I_WB] + ((size_t)l * 512 + g * 128) * DM;
            float a0[4], a1[4];
#pragma unroll
            for (int cc = 0; cc < 4; ++cc) { a0[cc] = 0.f; a1[cc] = 0.f; }
#pragma unroll 4
            for (int j = 0; j < 128; ++j) { const float w0 = wb[(size_t)j * DM + F.tid], w1 = wb[(size_t)j * DM + F.tid + 512];
#pragma unroll
                for (int cc = 0; cc < 4; ++cc) { const float cf = coef[cc * 128 + j]; a0[cc] += cf * w0; a1[cc] += cf * w1; } }
            bf16_t* dst = (bf16_t*)(p.ws + WS_WTBR) + (size_t)(l * 3 + 1) * DM * 512 + g * 128 + c0;
            u32x2 w; w.x = cvt_pk_bf16(a0[0], a0[1]); w.y = cvt_pk_bf16(a0[2], a0[3]); *(u32x2*)(dst + (size_t)F.tid * 512) = w;
            u32x2 y; y.x = cvt_pk_bf16(a1[0], a1[1]); y.y = cvt_pk_bf16(a1[2], a1[3]); *(u32x2*)(dst + (size_t)(F.tid + 512) * 512) = y;
        }
    }
    {
        const int fr = F.lane & 15, fq = F.lane >> 4;
        for (int u = blockIdx.x; u < DEPTH * 16 * 16; u += F.G) {
            const int l = u / 256, s = (u / 16) % 16, c0 = (u % 16) * 64;
            const float* keys = ((s & 1) ? p.in[I_K2] : p.in[I_K1]) + (size_t)l * 128 * 128 + (size_t)(16 * F.wave + fr) * 128 + 8 * fq;
            const float* wq = p.in[I_WQ] + (size_t)l * DM * PQ + (size_t)(c0 + fr) * PQ + s * 128 + 8 * fq;
            f32x4 acc[4];
#pragma unroll
            for (int ct = 0; ct < 4; ++ct) acc[ct] = (f32x4){0.f, 0.f, 0.f, 0.f};
#pragma unroll
            for (int ks = 0; ks < 4; ++ks) {
                const f32x4 k0 = *(const f32x4*)(keys + 32 * ks), k1 = *(const f32x4*)(keys + 32 * ks + 4);
                u32x4 kb; kb.x = cvt_pk_bf16(k0[0], k0[1]); kb.y = cvt_pk_bf16(k0[2], k0[3]); kb.z = cvt_pk_bf16(k1[0], k1[1]); kb.w = cvt_pk_bf16(k1[2], k1[3]);
#pragma unroll
                for (int ct = 0; ct < 4; ++ct) { const float* wp = wq + (size_t)(16 * ct) * PQ + 32 * ks; const f32x4 w0 = *(const f32x4*)wp, w1 = *(const f32x4*)(wp + 4);
                    u32x4 wb; wb.x = cvt_pk_bf16(w0[0], w0[1]); wb.y = cvt_pk_bf16(w0[2], w0[3]); wb.z = cvt_pk_bf16(w1[0], w1[1]); wb.w = cvt_pk_bf16(w1[2], w1[3]);
                    acc[ct] = __builtin_amdgcn_mfma_f32_16x16x32_bf16(__builtin_bit_cast(bf16x8, wb), __builtin_bit_cast(bf16x8, kb), acc[ct], 0, 0, 0); }
            }
            bf16_t* dst = (bf16_t*)(p.ws + WS_WEFF) + ((size_t)l * PQ + s * 128 + 16 * F.wave + fr) * DM + c0 + 4 * fq;
#pragma unroll
            for (int ct = 0; ct < 4; ++ct) { const f32x4 gn = *(const f32x4*)(p.in[I_FFGAIN] + l * DM + c0 + 16 * ct + 4 * fq);
                u32x2 w; w.x = cvt_pk_bf16(acc[ct][0] * gn[0], acc[ct][1] * gn[1]); w.y = cvt_pk_bf16(acc[ct][2] * gn[2], acc[ct][3] * gn[3]); *(u32x2*)(dst + 16 * ct) = w; }
        }
    }
}

__device__ __forceinline__ int t5_bucket(int n) {
    if (n < 16) return n;
    const float v = logf((float)n / 16.0f) / 2.0794415416798357f * 16.0f;
    const int b = 16 + (int)v; return b < 31 ? b : 31;
}
__device__ __forceinline__ void phase_mix_simple(const Params& p, const Frame& F0, int l) {
    const Frame F = local_frame(F0);
    const int tid = F.tid, lane = F.lane, wave = F.wave;
    LAS float* Kf = (LAS float*)F.lds;
    LAS float* Vf = Kf + 256 * 64;
    LAS float* biasT = Vf + 256 * 64;
    LAS float* rs = biasT + 1024;
    const bf16_t* proj = (const bf16_t*)(p.ws + WS_PROJA);
    bf16_t* mix = (bf16_t*)p.out;
    for (int nb = blockIdx.x; nb < NTOK / 128; nb += F.G) {
        const int t0 = nb * 128; const bool first = (nb % (SEQ / 128)) == 0;
        __syncthreads();
        for (int i = tid; i < 1024; i += NTHREADS) { const int h = i >> 7, dist = i & 127; biasT[i] = p.in[I_RELB][t5_bucket(dist) * 8 + h]; }
        for (int kvh = 0; kvh < 2; ++kvh) {
            __syncthreads();
            for (int c = tid; c < 2048; c += NTHREADS) { const int row = c >> 3, ch = c & 7; const int tok = t0 - 128 + row;
                u32x4 kv = (u32x4){0u, 0u, 0u, 0u}, vv = (u32x4){0u, 0u, 0u, 0u};
                if (row >= 128 || !first) { kv = *(const u32x4*)(proj + (size_t)tok * NA + COL_K + kvh * 64 + ch * 8); vv = *(const u32x4*)(proj + (size_t)tok * NA + COL_V + kvh * 64 + ch * 8); }
                LAS float* kd = Kf + row * 64 + ch * 8; LAS float* vd = Vf + row * 64 + ch * 8;
                kd[0] = bf_lo(kv.x); kd[1] = bf_hi(kv.x); kd[2] = bf_lo(kv.y); kd[3] = bf_hi(kv.y); kd[4] = bf_lo(kv.z); kd[5] = bf_hi(kv.z); kd[6] = bf_lo(kv.w); kd[7] = bf_hi(kv.w);
                vd[0] = bf_lo(vv.x); vd[1] = bf_hi(vv.x); vd[2] = bf_lo(vv.y); vd[3] = bf_hi(vv.y); vd[4] = bf_lo(vv.z); vd[5] = bf_hi(vv.z); vd[6] = bf_lo(vv.w); vd[7] = bf_hi(vv.w); }
            __syncthreads();
            const int hq = tid >> 7, qi = tid & 127, head = kvh * 4 + hq;
            float q[64], o[64];
            { const u32x4* qp = (const u32x4*)(proj + (size_t)(t0 + qi) * NA + head * 64);
#pragma unroll
              for (int j = 0; j < 8; ++j) { const u32x4 w = qp[j]; q[8 * j + 0] = bf_lo(w.x) * 0.125f; q[8 * j + 1] = bf_hi(w.x) * 0.125f; q[8 * j + 2] = bf_lo(w.y) * 0.125f; q[8 * j + 3] = bf_hi(w.y) * 0.125f;
                  q[8 * j + 4] = bf_lo(w.z) * 0.125f; q[8 * j + 5] = bf_hi(w.z) * 0.125f; q[8 * j + 6] = bf_lo(w.w) * 0.125f; q[8 * j + 7] = bf_hi(w.w) * 0.125f; } }
#pragma unroll
            for (int d = 0; d < 64; ++d) o[d] = 0.f;
            const float sink = p.in[I_SINK][l * 8 + head];
            float mrun = sink, lsum = 0.f;
            const int qb = qi & ~63, kmin = qb + 1, kmax = qb + 63 + 128;
            for (int kj = kmin; kj <= kmax; ++kj) {
                const LAS float* kr = Kf + kj * 64; float s = 0.f;
#pragma unroll
                for (int d4 = 0; d4 < 16; ++d4) { const f32x4 k4 = *(const LAS f32x4*)(kr + d4 * 4); s += (q[4 * d4] * k4[0] + q[4 * d4 + 1] * k4[1]) + (q[4 * d4 + 2] * k4[2] + q[4 * d4 + 3] * k4[3]); }
                const int dist = qi + 128 - kj; const bool valid = (dist >= 0) && (dist < 128) && (kj >= 128 || !first);
                const float logit = s + biasT[head * 128 + (dist & 127)];
                const float mnew = valid ? fmaxf(mrun, logit) : mrun;
                const float corr = __expf(mrun - mnew), pp = valid ? __expf(logit - mnew) : 0.f;
                lsum = lsum * corr + pp; mrun = mnew;
                const LAS float* vr = Vf + kj * 64;
#pragma unroll
                for (int d4 = 0; d4 < 16; ++d4) { const f32x4 v4 = *(const LAS f32x4*)(vr + d4 * 4);
                    o[4 * d4] = o[4 * d4] * corr + pp * v4[0]; o[4 * d4 + 1] = o[4 * d4 + 1] * corr + pp * v4[1]; o[4 * d4 + 2] = o[4 * d4 + 2] * corr + pp * v4[2]; o[4 * d4 + 3] = o[4 * d4 + 3] * corr + pp * v4[3]; }
            }
            const float inv = 1.0f / (lsum + __expf(sink - mrun));
            u32x4* op = (u32x4*)(mix + (size_t)(t0 + qi) * MIXW + head * 64);
#pragma unroll
            for (int j = 0; j < 8; ++j) { u32x4 w; w.x = cvt_pk_bf16(o[8 * j] * inv, o[8 * j + 1] * inv); w.y = cvt_pk_bf16(o[8 * j + 2] * inv, o[8 * j + 3] * inv);
                w.z = cvt_pk_bf16(o[8 * j + 4] * inv, o[8 * j + 5] * inv); w.w = cvt_pk_bf16(o[8 * j + 6] * inv, o[8 * j + 7] * inv); op[j] = w; }
        }
        LAS float* Zs = Kf;
        for (int g = 0; g < 4; ++g) {
            const int w = 2 << g;
            __syncthreads();
            for (int i = tid; i < 143 * 16; i += NTHREADS) { const int row = i >> 4, ch = i & 15; const int tok = t0 - 15 + row;
                u32x4 zv = (u32x4){0u, 0u, 0u, 0u};
                if (row >= 15 || !first) zv = *(const u32x4*)(proj + (size_t)tok * NA + COL_PZ + g * 128 + ch * 8);
                LAS float* zd = Zs + row * 128 + ch * 8;
                zd[0] = bf_lo(zv.x); zd[1] = bf_hi(zv.x); zd[2] = bf_lo(zv.y); zd[3] = bf_hi(zv.y); zd[4] = bf_lo(zv.z); zd[5] = bf_hi(zv.z); zd[6] = bf_lo(zv.w); zd[7] = bf_hi(zv.w); }
            __syncthreads();
            const int c = tid & 127, seg = tid >> 7;
            for (int tt = 0; tt < 32; ++tt) { const int t = seg * 32 + tt, r = t + 15; float sum = 0.f;
                for (int j = 0; j < w; ++j) sum += Zs[(r - j) * 128 + c];
                const int pos = (nb % (SEQ / 128)) * 128 + t; const int cnt = (pos + 1 < w) ? pos + 1 : w;
                const float d = sum / (float)cnt - Zs[r * 128 + c];
                mix[(size_t)(t0 + t) * MIXW + 512 + g * 128 + c] = (bf16_t)(cvt_pk_bf16(d, 0.f) & 0xffffu); }
        }
        __syncthreads();
        for (int tt = 0; tt < 16; ++tt) { const int t = wave * 16 + tt; const u32x4 g4 = *(const u32x4*)(proj + (size_t)(t0 + t) * NA + COL_GV + lane * 8);
            float a[8] = {bf_lo(g4.x), bf_hi(g4.x), bf_lo(g4.y), bf_hi(g4.y), bf_lo(g4.z), bf_hi(g4.z), bf_lo(g4.w), bf_hi(g4.w)}; float ss = 0.f;
#pragma unroll
            for (int j = 0; j < 8; ++j) ss += a[j] * a[j];
            ss = wave_sum(ss); if (lane == 0) rs[t] = 1.0f / sqrtf(ss * (1.0f / 512.0f) + EPS); }
        LAS float* Vn = Kf;
        for (int g = 0; g < 4; ++g) {
            __syncthreads();
            for (int i = tid; i < 128 * 16; i += NTHREADS) { const int s = i >> 4, ch = i & 15; const u32x4 g4 = *(const u32x4*)(proj + (size_t)(t0 + s) * NA + COL_GV + g * 128 + ch * 8);
                const float r = rs[s]; const float* gn = p.in[I_VGAIN] + l * 512 + g * 128 + ch * 8; LAS float* vd = Vn + s * 128 + ch * 8;
                vd[0] = bf_lo(g4.x) * r * gn[0]; vd[1] = bf_hi(g4.x) * r * gn[1]; vd[2] = bf_lo(g4.y) * r * gn[2]; vd[3] = bf_hi(g4.y) * r * gn[3];
                vd[4] = bf_lo(g4.z) * r * gn[4]; vd[5] = bf_hi(g4.z) * r * gn[5]; vd[6] = bf_lo(g4.w) * r * gn[6]; vd[7] = bf_hi(g4.w) * r * gn[7]; }
            __syncthreads();
            const int c = tid & 127, tq = tid >> 7;
            for (int t = tq; t < 128; t += 4) { const float* wrow = p.in[I_WSP] + (((size_t)l * 4 + g) * 128 + t) * 128; float acc = 0.f;
                for (int s = 0; s <= t; ++s) acc += wrow[s] * Vn[s * 128 + c];
                const float mixed = acc + p.in[I_BSP][(l * 4 + g) * 128 + t];
                const float uu = bf1(proj[(size_t)(t0 + t) * NA + COL_GU + g * 128 + c]);
                mix[(size_t)(t0 + t) * MIXW + 1024 + g * 128 + c] = (bf16_t)(cvt_pk_bf16(uu * mixed, 0.f) & 0xffffu); }
        }
    }
}

typedef short s16x4 __attribute__((ext_vector_type(4)));
__device__ __forceinline__ void tr_read8(unsigned addrA, unsigned addrB, s16x4 (&lo)[4], s16x4 (&hi)[4]) {
    asm volatile("ds_read_b64_tr_b16 %0, %8\n\tds_read_b64_tr_b16 %1, %8 offset:32\n\tds_read_b64_tr_b16 %2, %8 offset:64\n\tds_read_b64_tr_b16 %3, %8 offset:96\n\t"
                 "ds_read_b64_tr_b16 %4, %9\n\tds_read_b64_tr_b16 %5, %9 offset:32\n\tds_read_b64_tr_b16 %6, %9 offset:64\n\tds_read_b64_tr_b16 %7, %9 offset:96\n\ts_waitcnt lgkmcnt(0)"
                 : "=&v"(lo[0]), "=&v"(lo[1]), "=&v"(lo[2]), "=&v"(lo[3]), "=&v"(hi[0]), "=&v"(hi[1]), "=&v"(hi[2]), "=&v"(hi[3]) : "v"(addrA), "v"(addrB) : "memory");
}
__device__ __forceinline__ void tr_read4(unsigned addrA, s16x4 (&lo)[4]) {
    asm volatile("ds_read_b64_tr_b16 %0, %4\n\tds_read_b64_tr_b16 %1, %4 offset:32\n\tds_read_b64_tr_b16 %2, %4 offset:64\n\tds_read_b64_tr_b16 %3, %4 offset:96\n\ts_waitcnt lgkmcnt(0)"
                 : "=&v"(lo[0]), "=&v"(lo[1]), "=&v"(lo[2]), "=&v"(lo[3]) : "v"(addrA) : "memory");
}
__device__ __forceinline__ bf16x8 cat44(s16x4 a, s16x4 b) { return (bf16x8){a[0], a[1], a[2], a[3], b[0], b[1], b[2], b[3]}; }
constexpr int KVSTR = 144, VNSTR = 272;
__device__ __forceinline__ void phase_mix(const Params& p, const Frame& F0, int l) {
    const Frame F = local_frame(F0);
    const int tid = F.tid, lane = F.lane, wave = F.wave, fr = lane & 15, fq = lane >> 4;
    LAS float* biasT = (LAS float*)(F.lds + 4 * 256 * KVSTR);
    LAS float* rs = biasT + 1024;
    const bf16_t* proj = (const bf16_t*)(p.ws + WS_PROJA);
    bf16_t* mix = (bf16_t*)p.out;
    const float LOG2E = 1.4426950408889634f;
    for (int nb = blockIdx.x; nb < NTOK / 128; nb += F.G) {
        const int t0 = nb * 128; const bool first = (nb % (SEQ / 128)) == 0;
        __syncthreads();
        for (int i = tid; i < 1024; i += NTHREADS) { const int h = i >> 7, dist = i & 127; biasT[i] = p.in[I_RELB][t5_bucket(dist) * 8 + h] * LOG2E; }
        __syncthreads();
        for (int c = tid; c < 4096; c += NTHREADS) { const int kvh = c >> 11, row = (c >> 3) & 255, ch = c & 7; const int tok = t0 - 128 + row;
            u32x4 kv = (u32x4){0u, 0u, 0u, 0u}, vv = (u32x4){0u, 0u, 0u, 0u};
            if (row >= 128 || !first) { kv = *(const u32x4*)(proj + (size_t)tok * NA + COL_K + kvh * 64 + ch * 8); vv = *(const u32x4*)(proj + (size_t)tok * NA + COL_V + kvh * 64 + ch * 8); }
            *(LAS u32x4*)(F.lds + kvh * (512 * KVSTR) + row * KVSTR + ch * 16) = kv; *(LAS u32x4*)(F.lds + kvh * (512 * KVSTR) + 256 * KVSTR + row * KVSTR + ch * 16) = vv; }
        __syncthreads();
        for (int kvh = 0; kvh < 2; ++kvh) {
            LAS unsigned char* Kl = F.lds + kvh * (512 * KVSTR);
            LAS unsigned char* Vl = Kl + 256 * KVSTR;
            const int hq = wave >> 1, qh = wave & 1, head = kvh * 4 + hq;
            float br[9][4];
#pragma unroll
            for (int tt = 0; tt < 9; ++tt)
#pragma unroll
                for (int i = 0; i < 4; ++i) { const int dist = 128 + fr - 4 * fq - 16 * tt - i; br[tt][i] = (dist >= 0 && dist < 128) ? biasT[head * 128 + (dist & 127)] : NEG_INF_F; }
            const float sink2 = p.in[I_SINK][l * 8 + head] * LOG2E;
            const unsigned vbase = (unsigned)(size_t)Vl;
#pragma unroll 1
            for (int r = 0; r < 4; ++r) {
                const int R = qh * 4 + r, q0 = 16 * R;
                bf16x8 qf[2];
#pragma unroll
                for (int s = 0; s < 2; ++s) qf[s] = *(const bf16x8*)(proj + (size_t)(t0 + q0 + fr) * NA + head * 64 + 32 * s + 8 * fq);
                f32x4 sacc[9];
#pragma unroll
                for (int tt = 0; tt < 9; ++tt) { sacc[tt] = (f32x4){0.f, 0.f, 0.f, 0.f};
#pragma unroll
                    for (int s = 0; s < 2; ++s) { const bf16x8 kf = *(const LAS bf16x8*)(Kl + (16 * (R + tt) + fr) * KVSTR + s * 64 + fq * 16);
                        sacc[tt] = __builtin_amdgcn_mfma_f32_16x16x32_bf16(kf, qf[s], sacc[tt], 0, 0, 0); } }
                float mx = sink2;
#pragma unroll
                for (int tt = 0; tt < 9; ++tt) { const bool dead = first && (R + tt < 8);
#pragma unroll
                    for (int i = 0; i < 4; ++i) { const float lg = dead ? NEG_INF_F : (sacc[tt][i] * (0.125f * LOG2E) + br[tt][i]); sacc[tt][i] = lg; mx = fmaxf(mx, lg); } }
                mx = fmaxf(mx, __shfl_xor(mx, 16)); mx = fmaxf(mx, __shfl_xor(mx, 32));
                float ls = 0.f;
#pragma unroll
                for (int tt = 0; tt < 9; ++tt)
#pragma unroll
                    for (int i = 0; i < 4; ++i) { const float pv = __builtin_amdgcn_exp2f(sacc[tt][i] - mx); sacc[tt][i] = pv; ls += pv; }
                ls += __shfl_xor(ls, 16); ls += __shfl_xor(ls, 32);
                const float inv = 1.0f / (ls + __builtin_amdgcn_exp2f(sink2 - mx));
                f32x4 oacc[4];
#pragma unroll
                for (int c = 0; c < 4; ++c) oacc[c] = (f32x4){0.f, 0.f, 0.f, 0.f};
#pragma unroll
                for (int u = 0; u < 5; ++u) {
                    u32x4 pw; pw.x = cvt_pk_bf16(sacc[2 * u][0], sacc[2 * u][1]); pw.y = cvt_pk_bf16(sacc[2 * u][2], sacc[2 * u][3]);
                    if (u < 4) { pw.z = cvt_pk_bf16(sacc[2 * u + 1][0], sacc[2 * u + 1][1]); pw.w = cvt_pk_bf16(sacc[2 * u + 1][2], sacc[2 * u + 1][3]); } else { pw.z = 0u; pw.w = 0u; }
                    const bf16x8 pf = __builtin_bit_cast(bf16x8, pw);
                    const unsigned addrA = vbase + (unsigned)((16 * (R + 2 * u) + 4 * fq + (fr >> 2)) * KVSTR + (4 * (fr & 3)) * 2);
                    s16x4 lo[4], hi[4];
                    if (u < 4) tr_read8(addrA, addrA + 16 * KVSTR, lo, hi);
                    else { tr_read4(addrA, lo);
#pragma unroll
                        for (int c = 0; c < 4; ++c) hi[c] = (s16x4){0, 0, 0, 0}; }
#pragma unroll
                    for (int c = 0; c < 4; ++c) oacc[c] = __builtin_amdgcn_mfma_f32_16x16x32_bf16(cat44(lo[c], hi[c]), pf, oacc[c], 0, 0, 0);
                }
                bf16_t* op = mix + (size_t)(t0 + q0 + fr) * MIXW + head * 64 + 4 * fq;
#pragma unroll
                for (int c = 0; c < 4; ++c) { u32x2 w; w.x = cvt_pk_bf16(oacc[c][0] * inv, oacc[c][1] * inv); w.y = cvt_pk_bf16(oacc[c][2] * inv, oacc[c][3] * inv); *(u32x2*)(op + 16 * c) = w; }
            }
        }
        for (int gp = 0; gp < 2; ++gp) {
            __syncthreads();
            for (int i = tid; i < 2 * 143 * 16; i += NTHREADS) { const int gi = i / (143 * 16), ii = i % (143 * 16), row = ii >> 4, ch = ii & 15; const int tok = t0 - 15 + row, g = 2 * gp + gi;
                u32x4 zv = (u32x4){0u, 0u, 0u, 0u};
                if (row >= 15 || !first) zv = *(const u32x4*)(proj + (size_t)tok * NA + COL_PZ + g * 128 + ch * 8);
                LAS float* zd = (LAS float*)F.lds + gi * (143 * 128) + row * 128 + ch * 8;
                *(LAS f32x4*)zd = (f32x4){bf_lo(zv.x), bf_hi(zv.x), bf_lo(zv.y), bf_hi(zv.y)}; *(LAS f32x4*)(zd + 4) = (f32x4){bf_lo(zv.z), bf_hi(zv.z), bf_lo(zv.w), bf_hi(zv.w)}; }
            __syncthreads();
#pragma unroll 1
            for (int gi = 0; gi < 2; ++gi) { const int g = 2 * gp + gi, w = 2 << g; const LAS float* Zs = (const LAS float*)F.lds + gi * (143 * 128);
                const int c2 = tid & 63, seg = tid >> 6;
                const int tb = seg * 16; float sa = 0.f, sb = 0.f;
                for (int j = 1; j < w; ++j) { const f32x2 z = *(const LAS f32x2*)(Zs + (tb + 15 - j) * 128 + 2 * c2); sa += z[0]; sb += z[1]; }
                const int posb = (nb % (SEQ / 128)) * 128;
                for (int tt = 0; tt < 16; ++tt) { const int t = tb + tt, r = t + 15;
                    const f32x2 z = *(const LAS f32x2*)(Zs + r * 128 + 2 * c2); sa += z[0]; sb += z[1];
                    const int pos = posb + t; const float icnt = 1.0f / (float)((pos + 1 < w) ? pos + 1 : w);
                    *(unsigned*)(mix + (size_t)(t0 + t) * MIXW + 512 + g * 128 + 2 * c2) = cvt_pk_bf16(sa * icnt - z[0], sb * icnt - z[1]);
                    const f32x2 zo = *(const LAS f32x2*)(Zs + (r - w + 1) * 128 + 2 * c2); sa -= zo[0]; sb -= zo[1]; } }
        }
        __syncthreads();
        for (int tt = 0; tt < 16; ++tt) { const int t = wave * 16 + tt; const u32x4 g4 = *(const u32x4*)(proj + (size_t)(t0 + t) * NA + COL_GV + lane * 8);
            const float a[8] = {bf_lo(g4.x), bf_hi(g4.x), bf_lo(g4.y), bf_hi(g4.y), bf_lo(g4.z), bf_hi(g4.z), bf_lo(g4.w), bf_hi(g4.w)}; float ss = 0.f;
#pragma unroll
            for (int j = 0; j < 8; ++j) ss += a[j] * a[j];
            ss = wave_sum(ss); if (lane == 0) rs[t] = 1.0f / sqrtf(ss * (1.0f / 512.0f) + EPS); }
        const bf16_t* Wsp = (const bf16_t*)(p.ws + WS_WSP);
        __syncthreads();
        for (int i = tid; i < 4 * 128 * 16; i += NTHREADS) { const int g = i >> 11, s = (i >> 4) & 127, ch = i & 15; const u32x4 g4 = *(const u32x4*)(proj + (size_t)(t0 + s) * NA + COL_GV + g * 128 + ch * 8);
            const float r = rs[s]; const float* gn = p.in[I_VGAIN] + l * 512 + g * 128 + ch * 8; const f32x4 ga = *(const f32x4*)gn, gb = *(const f32x4*)(gn + 4);
            u32x4 w; w.x = cvt_pk_bf16(bf_lo(g4.x) * r * ga[0], bf_hi(g4.x) * r * ga[1]); w.y = cvt_pk_bf16(bf_lo(g4.y) * r * ga[2], bf_hi(g4.y) * r * ga[3]);
            w.z = cvt_pk_bf16(bf_lo(g4.z) * r * gb[0], bf_hi(g4.z) * r * gb[1]); w.w = cvt_pk_bf16(bf_lo(g4.w) * r * gb[2], bf_hi(g4.w) * r * gb[3]);
            *(LAS u32x4*)(F.lds + g * (128 * VNSTR) + s * VNSTR + ch * 16) = w; }
        __syncthreads();
        for (int g = 0; g < 4; ++g) {
            LAS unsigned char* Vn = F.lds + g * (128 * VNSTR);
            const int T = wave; f32x4 acc[8];
#pragma unroll
            for (int c = 0; c < 8; ++c) acc[c] = (f32x4){0.f, 0.f, 0.f, 0.f};
            const bf16_t* wrow = Wsp + (((size_t)l * 4 + g) * 128 + 16 * T + fr) * 128 + 8 * fq;
            const unsigned vnb = (unsigned)(size_t)Vn;
#pragma unroll 1
            for (int u = 0; u <= (T >> 1); ++u) {
                const bf16x8 wf = *(const bf16x8*)(wrow + 32 * u);
                const unsigned addrA = vnb + (unsigned)((32 * u + 8 * fq + (fr >> 2)) * VNSTR + (4 * (fr & 3)) * 2);
#pragma unroll
                for (int hf = 0; hf < 2; ++hf) { s16x4 lo[4], hi[4]; tr_read8(addrA + hf * 128, addrA + hf * 128 + 4 * VNSTR, lo, hi);
#pragma unroll
                    for (int c = 0; c < 4; ++c) acc[hf * 4 + c] = __builtin_amdgcn_mfma_f32_16x16x32_bf16(cat44(lo[c], hi[c]), wf, acc[hf * 4 + c], 0, 0, 0); }
            }
            const int t = 16 * T + fr; const float bs = p.in[I_BSP][(l * 4 + g) * 128 + t];
            const bf16_t* up = proj + (size_t)(t0 + t) * NA + COL_GU + g * 128 + 4 * fq; bf16_t* op = mix + (size_t)(t0 + t) * MIXW + 1024 + g * 128 + 4 * fq;
#pragma unroll
            for (int c = 0; c < 8; ++c) { const u32x2 uw = *(const u32x2*)(up + 16 * c);
                u32x2 w; w.x = cvt_pk_bf16(bf_lo(uw.x) * (acc[c][0] + bs), bf_hi(uw.x) * (acc[c][1] + bs)); w.y = cvt_pk_bf16(bf_lo(uw.y) * (acc[c][2] + bs), bf_hi(uw.y) * (acc[c][3] + bs));
                *(u32x2*)(op + 16 * c) = w; }
        }
    }
}

__device__ __forceinline__ unsigned ordkey(unsigned bits) { return bits ^ ((unsigned)((int)bits >> 31) | 0x80000000u); }
__device__ __forceinline__ unsigned unord(unsigned k) { return (k & 0x80000000u) ? (k ^ 0x80000000u) : ~k; }
#define TK_SORT16(S) do { { const unsigned h_ = max(S[0], S[1]), l_ = min(S[0], S[1]); S[0] = h_; S[1] = l_; } { const unsigned h_ = max(S[2], S[3]), l_ = min(S[2], S[3]); S[2] = h_; S[3] = l_; } { const unsigned h_ = max(S[0], S[2]), l_ = min(S[0], S[2]); S[0] = h_; S[2] = l_; } { const unsigned h_ = max(S[1], S[3]), l_ = min(S[1], S[3]); S[1] = h_; S[3] = l_; } { const unsigned h_ = max(S[1], S[2]), l_ = min(S[1], S[2]); S[1] = h_; S[2] = l_; } { const unsigned h_ = max(S[4], S[5]), l_ = min(S[4], S[5]); S[4] = h_; S[5] = l_; } { const unsigned h_ = max(S[6], S[7]), l_ = min(S[6], S[7]); S[6] = h_; S[7] = l_; } { const unsigned h_ = max(S[4], S[6]), l_ = min(S[4], S[6]); S[4] = h_; S[6] = l_; } { const unsigned h_ = max(S[5], S[7]), l_ = min(S[5], S[7]); S[5] = h_; S[7] = l_; } { const unsigned h_ = max(S[5], S[6]), l_ = min(S[5], S[6]); S[5] = h_; S[6] = l_; } { const unsigned h_ = max(S[0], S[4]), l_ = min(S[0], S[4]); S[0] = h_; S[4] = l_; } { const unsigned h_ = max(S[2], S[6]), l_ = min(S[2], S[6]); S[2] = h_; S[6] = l_; } { const unsigned h_ = max(S[2], S[4]), l_ = min(S[2], S[4]); S[2] = h_; S[4] = l_; } { const unsigned h_ = max(S[1], S[5]), l_ = min(S[1], S[5]); S[1] = h_; S[5] = l_; } { const unsigned h_ = max(S[3], S[7]), l_ = min(S[3], S[7]); S[3] = h_; S[7] = l_; } { const unsigned h_ = max(S[3], S[5]), l_ = min(S[3], S[5]); S[3] = h_; S[5] = l_; } { const unsigned h_ = max(S[1], S[2]), l_ = min(S[1], S[2]); S[1] = h_; S[2] = l_; } { const unsigned h_ = max(S[3], S[4]), l_ = min(S[3], S[4]); S[3] = h_; S[4] = l_; } { const unsigned h_ = max(S[5], S[6]), l_ = min(S[5], S[6]); S[5] = h_; S[6] = l_; } { const unsigned h_ = max(S[8], S[9]), l_ = min(S[8], S[9]); S[8] = h_; S[9] = l_; } { const unsigned h_ = max(S[10], S[11]), l_ = min(S[10], S[11]); S[10] = h_; S[11] = l_; } { const unsigned h_ = max(S[8], S[10]), l_ = min(S[8], S[10]); S[8] = h_; S[10] = l_; } { const unsigned h_ = max(S[9], S[11]), l_ = min(S[9], S[11]); S[9] = h_; S[11] = l_; } { const unsigned h_ = max(S[9], S[10]), l_ = min(S[9], S[10]); S[9] = h_; S[10] = l_; } { const unsigned h_ = max(S[12], S[13]), l_ = min(S[12], S[13]); S[12] = h_; S[13] = l_; } { const unsigned h_ = max(S[14], S[15]), l_ = min(S[14], S[15]); S[14] = h_; S[15] = l_; } { const unsigned h_ = max(S[12], S[14]), l_ = min(S[12], S[14]); S[12] = h_; S[14] = l_; } { const unsigned h_ = max(S[13], S[15]), l_ = min(S[13], S[15]); S[13] = h_; S[15] = l_; } { const unsigned h_ = max(S[13], S[14]), l_ = min(S[13], S[14]); S[13] = h_; S[14] = l_; } { const unsigned h_ = max(S[8], S[12]), l_ = min(S[8], S[12]); S[8] = h_; S[12] = l_; } { const unsigned h_ = max(S[10], S[14]), l_ = min(S[10], S[14]); S[10] = h_; S[14] = l_; } { const unsigned h_ = max(S[10], S[12]), l_ = min(S[10], S[12]); S[10] = h_; S[12] = l_; } { const unsigned h_ = max(S[9], S[13]), l_ = min(S[9], S[13]); S[9] = h_; S[13] = l_; } { const unsigned h_ = max(S[11], S[15]), l_ = min(S[11], S[15]); S[11] = h_; S[15] = l_; } { const unsigned h_ = max(S[11], S[13]), l_ = min(S[11], S[13]); S[11] = h_; S[13] = l_; } { const unsigned h_ = max(S[9], S[10]), l_ = min(S[9], S[10]); S[9] = h_; S[10] = l_; } { const unsigned h_ = max(S[11], S[12]), l_ = min(S[11], S[12]); S[11] = h_; S[12] = l_; } { const unsigned h_ = max(S[13], S[14]), l_ = min(S[13], S[14]); S[13] = h_; S[14] = l_; } { const unsigned h_ = max(S[0], S[8]), l_ = min(S[0], S[8]); S[0] = h_; S[8] = l_; } { const unsigned h_ = max(S[4], S[12]), l_ = min(S[4], S[12]); S[4] = h_; S[12] = l_; } { const unsigned h_ = max(S[4], S[8]), l_ = min(S[4], S[8]); S[4] = h_; S[8] = l_; } { const unsigned h_ = max(S[2], S[10]), l_ = min(S[2], S[10]); S[2] = h_; S[10] = l_; } { const unsigned h_ = max(S[6], S[14]), l_ = min(S[6], S[14]); S[6] = h_; S[14] = l_; } { const unsigned h_ = max(S[6], S[10]), l_ = min(S[6], S[10]); S[6] = h_; S[10] = l_; } { const unsigned h_ = max(S[2], S[4]), l_ = min(S[2], S[4]); S[2] = h_; S[4] = l_; } { const unsigned h_ = max(S[6], S[8]), l_ = min(S[6], S[8]); S[6] = h_; S[8] = l_; } { const unsigned h_ = max(S[10], S[12]), l_ = min(S[10], S[12]); S[10] = h_; S[12] = l_; } { const unsigned h_ = max(S[1], S[9]), l_ = min(S[1], S[9]); S[1] = h_; S[9] = l_; } { const unsigned h_ = max(S[5], S[13]), l_ = min(S[5], S[13]); S[5] = h_; S[13] = l_; } { const unsigned h_ = max(S[5], S[9]), l_ = min(S[5], S[9]); S[5] = h_; S[9] = l_; } { const unsigned h_ = max(S[3], S[11]), l_ = min(S[3], S[11]); S[3] = h_; S[11] = l_; } { const unsigned h_ = max(S[7], S[15]), l_ = min(S[7], S[15]); S[7] = h_; S[15] = l_; } { const unsigned h_ = max(S[7], S[11]), l_ = min(S[7], S[11]); S[7] = h_; S[11] = l_; } { const unsigned h_ = max(S[3], S[5]), l_ = min(S[3], S[5]); S[3] = h_; S[5] = l_; } { const unsigned h_ = max(S[7], S[9]), l_ = min(S[7], S[9]); S[7] = h_; S[9] = l_; } { const unsigned h_ = max(S[11], S[13]), l_ = min(S[11], S[13]); S[11] = h_; S[13] = l_; } { const unsigned h_ = max(S[1], S[2]), l_ = min(S[1], S[2]); S[1] = h_; S[2] = l_; } { const unsigned h_ = max(S[3], S[4]), l_ = min(S[3], S[4]); S[3] = h_; S[4] = l_; } { const unsigned h_ = max(S[5], S[6]), l_ = min(S[5], S[6]); S[5] = h_; S[6] = l_; } { const unsigned h_ = max(S[7], S[8]), l_ = min(S[7], S[8]); S[7] = h_; S[8] = l_; } { const unsigned h_ = max(S[9], S[10]), l_ = min(S[9], S[10]); S[9] = h_; S[10] = l_; } { const unsigned h_ = max(S[11], S[12]), l_ = min(S[11], S[12]); S[11] = h_; S[12] = l_; } { const unsigned h_ = max(S[13], S[14]), l_ = min(S[13], S[14]); S[13] = h_; S[14] = l_; } } while (0)
#define TK_MERGE16(L, S) do { L[0] = max(L[0], S[15]); L[1] = max(L[1], S[14]); L[2] = max(L[2], S[13]); L[3] = max(L[3], S[12]); L[4] = max(L[4], S[11]); L[5] = max(L[5], S[10]); L[6] = max(L[6], S[9]); L[7] = max(L[7], S[8]); L[8] = max(L[8], S[7]); L[9] = max(L[9], S[6]); L[10] = max(L[10], S[5]); L[11] = max(L[11], S[4]); L[12] = max(L[12], S[3]); L[13] = max(L[13], S[2]); L[14] = max(L[14], S[1]); L[15] = max(L[15], S[0]); { const unsigned h_ = max(L[0], L[8]), l_ = min(L[0], L[8]); L[0] = h_; L[8] = l_; } { const unsigned h_ = max(L[1], L[9]), l_ = min(L[1], L[9]); L[1] = h_; L[9] = l_; } { const unsigned h_ = max(L[2], L[10]), l_ = min(L[2], L[10]); L[2] = h_; L[10] = l_; } { const unsigned h_ = max(L[3], L[11]), l_ = min(L[3], L[11]); L[3] = h_; L[11] = l_; } { const unsigned h_ = max(L[4], L[12]), l_ = min(L[4], L[12]); L[4] = h_; L[12] = l_; } { const unsigned h_ = max(L[5], L[13]), l_ = min(L[5], L[13]); L[5] = h_; L[13] = l_; } { const unsigned h_ = max(L[6], L[14]), l_ = min(L[6], L[14]); L[6] = h_; L[14] = l_; } { const unsigned h_ = max(L[7], L[15]), l_ = min(L[7], L[15]); L[7] = h_; L[15] = l_; } { const unsigned h_ = max(L[0], L[4]), l_ = min(L[0], L[4]); L[0] = h_; L[4] = l_; } { const unsigned h_ = max(L[1], L[5]), l_ = min(L[1], L[5]); L[1] = h_; L[5] = l_; } { const unsigned h_ = max(L[2], L[6]), l_ = min(L[2], L[6]); L[2] = h_; L[6] = l_; } { const unsigned h_ = max(L[3], L[7]), l_ = min(L[3], L[7]); L[3] = h_; L[7] = l_; } { const unsigned h_ = max(L[8], L[12]), l_ = min(L[8], L[12]); L[8] = h_; L[12] = l_; } { const unsigned h_ = max(L[9], L[13]), l_ = min(L[9], L[13]); L[9] = h_; L[13] = l_; } { const unsigned h_ = max(L[10], L[14]), l_ = min(L[10], L[14]); L[10] = h_; L[14] = l_; } { const unsigned h_ = max(L[11], L[15]), l_ = min(L[11], L[15]); L[11] = h_; L[15] = l_; } { const unsigned h_ = max(L[0], L[2]), l_ = min(L[0], L[2]); L[0] = h_; L[2] = l_; } { const unsigned h_ = max(L[1], L[3]), l_ = min(L[1], L[3]); L[1] = h_; L[3] = l_; } { const unsigned h_ = max(L[4], L[6]), l_ = min(L[4], L[6]); L[4] = h_; L[6] = l_; } { const unsigned h_ = max(L[5], L[7]), l_ = min(L[5], L[7]); L[5] = h_; L[7] = l_; } { const unsigned h_ = max(L[8], L[10]), l_ = min(L[8], L[10]); L[8] = h_; L[10] = l_; } { const unsigned h_ = max(L[9], L[11]), l_ = min(L[9], L[11]); L[9] = h_; L[11] = l_; } { const unsigned h_ = max(L[12], L[14]), l_ = min(L[12], L[14]); L[12] = h_; L[14] = l_; } { const unsigned h_ = max(L[13], L[15]), l_ = min(L[13], L[15]); L[13] = h_; L[15] = l_; } { const unsigned h_ = max(L[0], L[1]), l_ = min(L[0], L[1]); L[0] = h_; L[1] = l_; } { const unsigned h_ = max(L[2], L[3]), l_ = min(L[2], L[3]); L[2] = h_; L[3] = l_; } { const unsigned h_ = max(L[4], L[5]), l_ = min(L[4], L[5]); L[4] = h_; L[5] = l_; } { const unsigned h_ = max(L[6], L[7]), l_ = min(L[6], L[7]); L[6] = h_; L[7] = l_; } { const unsigned h_ = max(L[8], L[9]), l_ = min(L[8], L[9]); L[8] = h_; L[9] = l_; } { const unsigned h_ = max(L[10], L[11]), l_ = min(L[10], L[11]); L[10] = h_; L[11] = l_; } { const unsigned h_ = max(L[12], L[13]), l_ = min(L[12], L[13]); L[12] = h_; L[13] = l_; } { const unsigned h_ = max(L[14], L[15]), l_ = min(L[14], L[15]); L[14] = h_; L[15] = l_; } } while (0)
__device__ __forceinline__ void phase_topk(const Params& p, const Frame& F0, int l) {
    const Frame F = local_frame(F0);
    const int lane = F.lane, wave = F.wave;
    LAS float* tile = (LAS float*)(F.lds + wave * 8448);
    LAS unsigned char* itab = (LAS unsigned char*)(F.lds + 8 * 8448 + wave * 64 * 36 + lane * 36);
    const float* scores = (const float*)(p.ws + WS_SCORES);
    const float* rowsq = (const float*)(p.ws + WS_ROWSQP) + (size_t)l * NTOK * 16;
    unsigned* seli = (unsigned*)(p.ws + WS_SELI); float* selg = (float*)(p.ws + WS_SELG);
    const int gw = blockIdx.x * NWAVES + wave, NGW = F.G * NWAVES;
    const int row_l = lane >> 3, cg_l = lane & 7;
    const bf16_t* scores_b = (const bf16_t*)(p.ws + WS_SCORES);
    u32x4 cur[8];
    if (gw < NTOK * 8 / 64) {
#pragma unroll
        for (int i = 0; i < 8; ++i) cur[i] = *(const u32x4*)(scores_b + ((size_t)gw * 64 + 8 * i + row_l) * 256 + cg_l * 8);
    }
    LAS unsigned* tileu = (LAS unsigned*)tile;
    for (int grp = gw; grp < NTOK * 8 / 64; grp += NGW) {
        const size_t item0 = (size_t)grp * 64;
        unsigned L1[16], L2[16];
#pragma unroll
        for (int j = 0; j < 16; ++j) { L1[j] = 0u; L2[j] = 0u; }
#pragma unroll 1
        for (int ch = 0; ch < 4; ++ch) {
#pragma unroll
            for (int i = 0; i < 8; ++i) { LAS unsigned* d = tileu + (8 * i + row_l) * 33 + cg_l * 4; d[0] = cur[i].x; d[1] = cur[i].y; d[2] = cur[i].z; d[3] = cur[i].w; }
            {
                const bool more = (ch < 3) || (grp + NGW < NTOK * 8 / 64);
                const size_t nitem0 = (ch < 3) ? item0 : (size_t)(grp + NGW) * 64; const int nch = (ch < 3) ? ch + 1 : 0;
                if (more) {
#pragma unroll
                    for (int i = 0; i < 8; ++i) cur[i] = *(const u32x4*)(scores_b + (nitem0 + 8 * i + row_l) * 256 + nch * 64 + cg_l * 8);
                }
            }
            __builtin_amdgcn_wave_barrier(); asm volatile("s_waitcnt lgkmcnt(0)" ::: "memory");
#pragma unroll
            for (int qd = 0; qd < 4; ++qd) { unsigned S[16];
#pragma unroll
                for (int j = 0; j < 8; ++j) { const unsigned w = tileu[lane * 33 + 8 * qd + j]; const unsigned idx = (unsigned)((ch & 1) * 64 + 16 * qd + 2 * j);
                    S[2 * j] = ordkey((w << 16) | idx); S[2 * j + 1] = ordkey((w & 0xffff0000u) | (idx + 1u)); }
                TK_SORT16(S);
                if (ch < 2) TK_MERGE16(L1, S); else TK_MERGE16(L2, S); }
            __builtin_amdgcn_wave_barrier(); asm volatile("s_waitcnt lgkmcnt(0)" ::: "memory");
        }
        float f1[16], f2[16];
#pragma unroll
        for (int k = 0; k < 16; ++k) { const unsigned b1 = unord(L1[k]), b2 = unord(L2[k]); f1[k] = __uint_as_float(b1); f2[k] = __uint_as_float(b2); itab[k] = (unsigned char)(b1 & 127u); itab[16 + k] = (unsigned char)(b2 & 127u); }
        unsigned T[16];
        { T[0] = ordkey((__float_as_uint(f1[0] + f2[0]) & 0xffffff00u) | 0u); T[1] = ordkey((__float_as_uint(f1[0] + f2[1]) & 0xffffff00u) | 1u); T[2] = ordkey((__float_as_uint(f1[0] + f2[2]) & 0xffffff00u) | 2u); T[3] = ordkey((__float_as_uint(f1[0] + f2[3]) & 0xffffff00u) | 3u); T[4] = ordkey((__float_as_uint(f1[0] + f2[4]) & 0xffffff00u) | 4u); T[5] = ordkey((__float_as_uint(f1[0] + f2[5]) & 0xffffff00u) | 5u); T[6] = ordkey((__float_as_uint(f1[0] + f2[6]) & 0xffffff00u) | 6u); T[7] = ordkey((__float_as_uint(f1[0] + f2[7]) & 0xffffff00u) | 7u); T[8] = ordkey((__float_as_uint(f1[0] + f2[8]) & 0xffffff00u) | 8u); T[9] = ordkey((__float_as_uint(f1[0] + f2[9]) & 0xffffff00u) | 9u); T[10] = ordkey((__float_as_uint(f1[0] + f2[10]) & 0xffffff00u) | 10u); T[11] = ordkey((__float_as_uint(f1[0] + f2[11]) & 0xffffff00u) | 11u); T[12] = ordkey((__float_as_uint(f1[0] + f2[12]) & 0xffffff00u) | 12u); T[13] = ordkey((__float_as_uint(f1[0] + f2[13]) & 0xffffff00u) | 13u); T[14] = ordkey((__float_as_uint(f1[0] + f2[14]) & 0xffffff00u) | 14u); T[15] = ordkey((__float_as_uint(f1[0] + f2[15]) & 0xffffff00u) | 15u); TK_SORT16(T); }
        { unsigned S[16]; S[0] = ordkey((__float_as_uint(f1[1] + f2[0]) & 0xffffff00u) | 16u); S[1] = ordkey((__float_as_uint(f1[1] + f2[1]) & 0xffffff00u) | 17u); S[2] = ordkey((__float_as_uint(f1[1] + f2[2]) & 0xffffff00u) | 18u); S[3] = ordkey((__float_as_uint(f1[1] + f2[3]) & 0xffffff00u) | 19u); S[4] = ordkey((__float_as_uint(f1[1] + f2[4]) & 0xffffff00u) | 20u); S[5] = ordkey((__float_as_uint(f1[1] + f2[5]) & 0xffffff00u) | 21u); S[6] = ordkey((__float_as_uint(f1[1] + f2[6]) & 0xffffff00u) | 22u); S[7] = ordkey((__float_as_uint(f1[1] + f2[7]) & 0xffffff00u) | 23u); S[8] = ordkey((__float_as_uint(f1[2] + f2[0]) & 0xffffff00u) | 32u); S[9] = ordkey((__float_as_uint(f1[2] + f2[1]) & 0xffffff00u) | 33u); S[10] = ordkey((__float_as_uint(f1[2] + f2[2]) & 0xffffff00u) | 34u); S[11] = ordkey((__float_as_uint(f1[2] + f2[3]) & 0xffffff00u) | 35u); S[12] = ordkey((__float_as_uint(f1[2] + f2[4]) & 0xffffff00u) | 36u); S[13] = ordkey((__float_as_uint(f1[3] + f2[0]) & 0xffffff00u) | 48u); S[14] = ordkey((__float_as_uint(f1[3] + f2[1]) & 0xffffff00u) | 49u); S[15] = ordkey((__float_as_uint(f1[3] + f2[2]) & 0xffffff00u) | 50u); TK_SORT16(S); TK_MERGE16(T, S); }
        { unsigned S[16]; S[0] = ordkey((__float_as_uint(f1[3] + f2[3]) & 0xffffff00u) | 51u); S[1] = ordkey((__float_as_uint(f1[4] + f2[0]) & 0xffffff00u) | 64u); S[2] = ordkey((__float_as_uint(f1[4] + f2[1]) & 0xffffff00u) | 65u); S[3] = ordkey((__float_as_uint(f1[4] + f2[2]) & 0xffffff00u) | 66u); S[4] = ordkey((__float_as_uint(f1[5] + f2[0]) & 0xffffff00u) | 80u); S[5] = ordkey((__float_as_uint(f1[5] + f2[1]) & 0xffffff00u) | 81u); S[6] = ordkey((__float_as_uint(f1[6] + f2[0]) & 0xffffff00u) | 96u); S[7] = ordkey((__float_as_uint(f1[6] + f2[1]) & 0xffffff00u) | 97u); S[8] = ordkey((__float_as_uint(f1[7] + f2[0]) & 0xffffff00u) | 112u); S[9] = ordkey((__float_as_uint(f1[7] + f2[1]) & 0xffffff00u) | 113u); S[10] = ordkey((__float_as_uint(f1[8] + f2[0]) & 0xffffff00u) | 128u); S[11] = ordkey((__float_as_uint(f1[9] + f2[0]) & 0xffffff00u) | 144u); S[12] = ordkey((__float_as_uint(f1[10] + f2[0]) & 0xffffff00u) | 160u); S[13] = ordkey((__float_as_uint(f1[11] + f2[0]) & 0xffffff00u) | 176u); S[14] = ordkey((__float_as_uint(f1[12] + f2[0]) & 0xffffff00u) | 192u); S[15] = ordkey((__float_as_uint(f1[13] + f2[0]) & 0xffffff00u) | 208u); TK_SORT16(S); TK_MERGE16(T, S); }
        { unsigned x = ordkey((__float_as_uint(f1[14] + f2[0]) & 0xffffff00u) | 224u);
#pragma unroll
            for (int k = 0; k < 16; ++k) { const unsigned hi = max(T[k], x); x = min(T[k], x); T[k] = hi; } }
        { unsigned x = ordkey((__float_as_uint(f1[15] + f2[0]) & 0xffffff00u) | 240u);
#pragma unroll
            for (int k = 0; k < 16; ++k) { const unsigned hi = max(T[k], x); x = min(T[k], x); T[k] = hi; } }
        asm volatile("s_waitcnt lgkmcnt(0)" ::: "memory");
        const size_t item = item0 + lane; const int tok = (int)(item >> 3);
        const float rstd = 1.0f / sqrtf(row_sumsq(rowsq, tok) * (1.0f / DM) + EPS);
        float e[16], se = 0.f; unsigned P[16];
        const float t0v = __uint_as_float(unord(T[0]));
#pragma unroll
        for (int k = 0; k < 16; ++k) { const unsigned b = unord(T[k]); e[k] = __expf((__uint_as_float(b) - t0v) * rstd); se += e[k];
            const unsigned code = b & 255u; P[k] = ((unsigned)itab[code >> 4] << 7) | (unsigned)itab[16 + (code & 15u)]; }
        const float inv = 1.0f / se;
        u32x4* di = (u32x4*)(seli + item * 16); f32x4* dg = (f32x4*)(selg + item * 16);
#pragma unroll
        for (int k4 = 0; k4 < 4; ++k4) { di[k4] = (u32x4){P[4 * k4], P[4 * k4 + 1], P[4 * k4 + 2], P[4 * k4 + 3]};
            dg[k4] = (f32x4){e[4 * k4] * inv, e[4 * k4 + 1] * inv, e[4 * k4 + 2] * inv, e[4 * k4 + 3] * inv}; }
        asm volatile("s_waitcnt lgkmcnt(0)" ::: "memory");
    }
}

__device__ __forceinline__ void fp8x16_to_f32(const u32x4 w, float (&f)[16]) {
#pragma unroll
    for (int q = 0; q < 4; ++q) { const f32x2 lo = __builtin_amdgcn_cvt_pk_f32_fp8((int)w[q], false), hi = __builtin_amdgcn_cvt_pk_f32_fp8((int)w[q], true);
        f[4 * q] = lo[0]; f[4 * q + 1] = lo[1]; f[4 * q + 2] = hi[0]; f[4 * q + 3] = hi[1]; }
}
template <int CTRL> __device__ __forceinline__ float dpp_f(float v) { return __uint_as_float(__builtin_amdgcn_update_dpp(0u, __float_as_uint(v), CTRL, 0xF, 0xF, true)); }
#ifndef MERGE_STAGGER
#define MERGE_STAGGER 0
#endif
#ifndef VB
#define VB 16
#endif
#ifndef G_RSH
#define G_RSH 10
#endif
#ifndef GATHER_SWEEP_BARRIER
#define GATHER_SWEEP_BARRIER 2
#endif
constexpr int GT = 4;
__device__ __forceinline__ void phase_gather(const Params& p, const Frame& F0, int l, const XcdBarrier& bar, bool use_bar, bool dry = false, unsigned emask = 0xffffffffu) {
    const Frame F = local_frame(F0);
    const int lane = F.lane;
    const unsigned char* ET = p.ws + WS_EXP + (size_t)l * NEXP * 2 * DM;
    const f32x2* SC = (const f32x2*)(p.ws + WS_ESCALE) + (size_t)l * NEXP;
    const bf16_t* xb = (const bf16_t*)(p.ws + WS_XB);
    const float* rowsq = (const float*)(p.ws + WS_ROWSQP) + (size_t)l * NTOK * 16;
    const unsigned* seli = (const unsigned*)(p.ws + WS_SELI); const float* selg = (const float*)(p.ws + WS_SELG);
    const float* gain = p.in[I_FFGAIN] + l * DM + lane * 16;
    LAS u32x2* sortl = (LAS u32x2*)(F.lds + F.wave * (GT * 1024));
    LAS float* cfl = (LAS float*)(F.lds + NWAVES * (GT * 1024) + F.wave * (GT * 512));
    LAS u32x4* h2l = (LAS u32x4*)(F.lds + NWAVES * (GT * 1536) + F.wave * (GT * 1024));
    LAS float* h2sl = (LAS float*)(F.lds + NWAVES * (GT * 2560) + F.wave * 64);
    const bool dsel0 = (lane & 1) != 0, dsel1 = (lane & 2) != 0, ondiag = (((lane & 15) >> 2) == (lane >> 4));
    const bool b2 = (lane & 4) != 0, b1 = (lane & 2) != 0, b0 = (lane & 1) != 0;
    const int mym = (b2 ? 4 : 0) + (b0 ? 2 : 0) + (b1 ? 1 : 0);
    const int gw = blockIdx.x * NWAVES + F.wave, NGW = F.G * NWAVES;
    const int nsweep = NTOK / (NGW * GT);
    for (int sw = 0; sw < nsweep; ++sw) {
        if (sw > 0 && use_bar && GATHER_SWEEP_BARRIER) { if (GATHER_SWEEP_BARRIER == 2) xcd_align(bar); else xcd_barrier(bar); }
        const int tok0 = (sw * NGW + gw) * GT;
        int cur[GT];
#pragma unroll
        for (int tk = 0; tk < GT; ++tk) { const int tok = tok0 + tk;
            const float rstd = 1.0f / sqrtf(row_sumsq(rowsq, tok) * (1.0f / DM) + EPS);
            const u32x4 xw0 = *(const u32x4*)(xb + (size_t)tok * DM + lane * 16), xw1 = *(const u32x4*)(xb + (size_t)tok * DM + lane * 16 + 8);
            const f32x4 g0 = *(const f32x4*)gain, g1 = *(const f32x4*)(gain + 4), g2 = *(const f32x4*)(gain + 8), g3 = *(const f32x4*)(gain + 12);
            float hv[16] = {bf_lo(xw0.x) * rstd * g0[0], bf_hi(xw0.x) * rstd * g0[1], bf_lo(xw0.y) * rstd * g0[2], bf_hi(xw0.y) * rstd * g0[3], bf_lo(xw0.z) * rstd * g1[0], bf_hi(xw0.z) * rstd * g1[1], bf_lo(xw0.w) * rstd * g1[2], bf_hi(xw0.w) * rstd * g1[3],
                            bf_lo(xw1.x) * rstd * g2[0], bf_hi(xw1.x) * rstd * g2[1], bf_lo(xw1.y) * rstd * g2[2], bf_hi(xw1.y) * rstd * g2[3], bf_lo(xw1.z) * rstd * g3[0], bf_hi(xw1.z) * rstd * g3[1], bf_lo(xw1.w) * rstd * g3[2], bf_hi(xw1.w) * rstd * g3[3]};
            float hm = 0.f;
#pragma unroll
            for (int j = 0; j < 16; ++j) hm = fmaxf(hm, fabsf(hv[j]));
#pragma unroll
            for (int of = 1; of < 64; of <<= 1) hm = fmaxf(hm, __shfl_xor(hm, of));
            const float hinv = hm > 0.f ? 7.5f / hm : 0.f; if (lane == 0) h2sl[tk] = hm * (1.0f / 7.5f);
            {
                f32x16 xe, xo;
#pragma unroll
                for (int j = 0; j < 8; ++j) { xe[j] = hv[2 * j] * hinv; xo[j] = hv[2 * j + 1] * hinv; }
#pragma unroll
                for (int i = 8; i < 16; ++i) { xe[i] = 0.f; xo[i] = 0.f; }
                const u32x6 w6 = __builtin_amdgcn_cvt_scalef32_2xpk16_fp6_f32(xe, xo, 1.0f);
                h2l[tk * 64 + lane] = (u32x4){w6[0], w6[1], w6[2], 0u}; }
            const unsigned i0 = seli[(size_t)tok * 128 + lane] & emask, i1 = seli[(size_t)tok * 128 + 64 + lane] & emask;
            const float q0 = selg[(size_t)tok * 128 + lane], q1 = selg[(size_t)tok * 128 + 64 + lane];
            const unsigned ep0 = i0 >> G_RSH, ep1 = i1 >> G_RSH; unsigned pos0 = 0, pos1 = 0, base = 0;
#pragma unroll
            for (unsigned ep = 0; ep < (16384u >> G_RSH); ++ep) { const unsigned long long m0 = __ballot(ep0 == ep), m1 = __ballot(ep1 == ep);
                const unsigned c0 = __builtin_amdgcn_mbcnt_hi((unsigned)(m0 >> 32), __builtin_amdgcn_mbcnt_lo((unsigned)m0, 0u)), c1 = __builtin_amdgcn_mbcnt_hi((unsigned)(m1 >> 32), __builtin_amdgcn_mbcnt_lo((unsigned)m1, 0u));
                const unsigned n0 = (unsigned)__popcll(m0), n1 = (unsigned)__popcll(m1);
                pos0 = (ep0 == ep) ? base + c0 : pos0; pos1 = (ep1 == ep) ? base + n0 + c1 : pos1; base += n0 + n1; }
            sortl[tk * 128 + pos0] = (u32x2){i0, __float_as_uint(q0)}; sortl[tk * 128 + pos1] = (u32x2){i1, __float_as_uint(q1)}; cur[tk] = 0; }
        __builtin_amdgcn_wave_barrier(); asm volatile("s_waitcnt lgkmcnt(0)" ::: "memory");
        unsigned ord;
        {   const unsigned first = sortl[(lane >> 4) * 128 + 8 * (lane & 15)].x;
            const unsigned key = (((first >> G_RSH) * GT + (unsigned)(lane >> 4)) << 4) | (unsigned)(lane & 15);
            unsigned rank = 0;
#pragma unroll 8
            for (int m = 0; m < 64; ++m) { const unsigned km = __builtin_amdgcn_readlane(key, m); rank += (km < key) ? 1u : 0u; }
            ord = (unsigned)__builtin_amdgcn_ds_permute((int)(rank << 2), (int)lane); }
        asm volatile("s_waitcnt lgkmcnt(0)" ::: "memory");
        {
            u32x3 ub[2][8]; f32x2 bsc[2]; float bmg[2]; int bid[2];
#define G_ISSUE_U(n, s) do { const int id_ = __builtin_amdgcn_readlane(ord, (n)); bid[s] = id_; const u32x2 ent_ = sortl[(id_ >> 4) * 128 + 8 * (id_ & 15) + mym]; bmg[s] = __uint_as_float(ent_.y); \
            _Pragma("unroll") for (int i_ = 0; i_ < 8; ++i_) { const unsigned e_ = __builtin_amdgcn_readlane(ent_.x, ((i_ & 4) ? 4 : 0) + ((i_ & 1) ? 2 : 0) + ((i_ & 2) ? 1 : 0)); ub[s][i_] = *(const u32x3*)(ET + (size_t)e_ * UROW + lane * 12); } \
            bsc[s] = SC[ent_.x]; } while (0)
#define G_COMPUTE_U(s) do { const int tk_ = bid[s] >> 4, b_ = bid[s] & 15; const u32x4 hq_ = h2l[tk_ * 64 + lane]; const float hs_ = h2sl[tk_]; \
            const i32x8 hb0_ = {(int)hq_.x, (int)hq_.y, (int)hq_.z, 0, 0, 0, 0, 0}, hb1_ = {0, 0, 0, (int)hq_.x, (int)hq_.y, (int)hq_.z, 0, 0};     \
            float d_[8]; \
            _Pragma("unroll") for (int hf_ = 0; hf_ < 2; ++hf_) { f32x4 acc4_[4]; \
                _Pragma("unroll") for (int i_ = 0; i_ < 4; i_ += 2) { const u32x3 w0_ = ub[s][4 * hf_ + i_], w1_ = ub[s][4 * hf_ + i_ + 1]; \
                    const i32x8 a_ = {(int)w0_.x, (int)w0_.y, (int)w0_.z, (int)w1_.x, (int)w1_.y, (int)w1_.z, 0, 0};     \
                    acc4_[i_] = __builtin_amdgcn_mfma_scale_f32_16x16x128_f8f6f4(a_, hb0_, (f32x4){0.f, 0.f, 0.f, 0.f}, 2, 2, 0, 0, 0, 0); \
                    acc4_[i_ + 1] = __builtin_amdgcn_mfma_scale_f32_16x16x128_f8f6f4(a_, hb1_, (f32x4){0.f, 0.f, 0.f, 0.f}, 2, 2, 0, 0, 0, 0); } \
                _Pragma("unroll") for (int i_ = 0; i_ < 4; ++i_) { const float lo2_ = dsel0 ? acc4_[i_][1] : acc4_[i_][0], hi2_ = dsel0 ? acc4_[i_][3] : acc4_[i_][2]; const float v_ = dsel1 ? hi2_ : lo2_; d_[4 * hf_ + i_] = ondiag ? v_ : 0.f; } } \
            float a4_[4], c2_[2]; \
            _Pragma("unroll") for (int j_ = 0; j_ < 4; ++j_) { const float keep_ = b2 ? d_[j_ + 4] : d_[j_], send_ = b2 ? d_[j_] : d_[j_ + 4]; a4_[j_] = keep_ + dpp_f<0x141>(send_); } \
            _Pragma("unroll") for (int j_ = 0; j_ < 2; ++j_) { const float keep_ = b0 ? a4_[j_ + 2] : a4_[j_], send_ = b0 ? a4_[j_] : a4_[j_ + 2]; c2_[j_] = keep_ + dpp_f<0xB1>(send_); } \
            float dm_; { const float keep_ = b1 ? c2_[1] : c2_[0], send_ = b1 ? c2_[0] : c2_[1]; dm_ = keep_ + dpp_f<0x4E>(send_); } \
            dm_ += dpp_f<0x128>(dm_); \
            { const auto s16_ = __builtin_amdgcn_permlane16_swap(__float_as_uint(dm_), __float_as_uint(dm_), false, false); dm_ = __uint_as_float(s16_[0]) + __uint_as_float(s16_[1]); } \
            { const auto s32_ = __builtin_amdgcn_permlane32_swap(__float_as_uint(dm_), __float_as_uint(dm_), false, false); dm_ = __uint_as_float(s32_[0]) + __uint_as_float(s32_[1]); } \
            const float cf_ = bmg[s] * gelu_tanh(dm_ * bsc[s][0] * hs_) * bsc[s][1]; \
            if (lane < 8) cfl[tk_ * 128 + 8 * b_ + mym] = cf_; } while (0)
            G_ISSUE_U(0, 0);
#pragma unroll 1
            for (int n = 0; n < GT * 16; n += 2) {
                G_ISSUE_U(n + 1, 1); G_COMPUTE_U(0);
                if (n + 2 < GT * 16) G_ISSUE_U(n + 2, 0);
                G_COMPUTE_U(1);
            }
#undef G_ISSUE_U
#undef G_COMPUTE_U
        }
        __builtin_amdgcn_wave_barrier(); asm volatile("s_waitcnt lgkmcnt(0)" ::: "memory");
        f32x2 o2[GT][8];
#pragma unroll
        for (int tk = 0; tk < GT; ++tk) { cur[tk] = 0;
#pragma unroll
            for (int j = 0; j < 8; ++j) o2[tk][j] = (f32x2){0.f, 0.f}; }
#pragma unroll 1
        for (int r = 0; r < (16384 >> G_RSH); ++r) {
#pragma unroll
            for (int tk = 0; tk < GT; ++tk) {
                while (cur[tk] < 128 / VB) {
                    const int b = cur[tk]; const unsigned ex = sortl[tk * 128 + VB * b + (lane & (VB - 1))].x;
                    unsigned e[VB];
                    e[0] = __builtin_amdgcn_readlane(ex, 0);
                    if ((int)(e[0] >> G_RSH) > r) break;
                    cur[tk] = b + 1;
#pragma unroll
                    for (int i = 1; i < VB; ++i) e[i] = __builtin_amdgcn_readlane(ex, i);
                    u32x4 vv[VB];
#pragma unroll
                    for (int i = 0; i < VB; ++i) { vv[i] = *(const u32x4*)(ET + (size_t)(NEXP + e[i]) * DM + lane * 16); if (VB > 8) asm volatile("" ::: "memory"); }
                    f32x4 cq[VB / 4];
#pragma unroll
                    for (int q = 0; q < VB / 4; ++q) cq[q] = *(const LAS f32x4*)(cfl + tk * 128 + VB * b + 4 * q);
#pragma unroll
                    for (int i = 0; i < VB; ++i) { const float ci = cq[i >> 2][i & 3];
                        if (VB > 8 && (i & 1) == 0) {
                            asm volatile("" : "+v"(vv[i]), "+v"(vv[i + 1]), "+v"(o2[tk][0]), "+v"(o2[tk][1]), "+v"(o2[tk][2]), "+v"(o2[tk][3]), "+v"(o2[tk][4]), "+v"(o2[tk][5]), "+v"(o2[tk][6]), "+v"(o2[tk][7])); }
                        float f[16]; fp8x16_to_f32(vv[i], f);
#pragma unroll
                        for (int j = 0; j < 8; ++j) o2[tk][j] += (f32x2){ci, ci} * (f32x2){f[2 * j], f[2 * j + 1]}; }
                }
            }
        }
        float o[GT][16];
#pragma unroll
        for (int tk = 0; tk < GT; ++tk)
#pragma unroll
            for (int j = 0; j < 8; ++j) { o[tk][2 * j] = o2[tk][j][0]; o[tk][2 * j + 1] = o2[tk][j][1]; }
        int dry_v = dry ? 1 : 0; asm volatile("" : "+v"(dry_v)); const int dry_l = __builtin_amdgcn_readfirstlane(dry_v);
        bf16_t* xbo = dry_l ? (bf16_t*)(p.ws + WS_SCRATCH) : (bf16_t*)(p.ws + WS_XB);
        float* outp = dry_l ? (float*)(p.ws + WS_SCRATCH) : p.out;
        float* rstdo = dry_l ? (float*)(p.ws + WS_SCRATCH + 130 * MiB) : (float*)(p.ws + WS_RSTD);
#pragma unroll
        for (int tk = 0; tk < GT; ++tk) { const int tok = tok0 + tk;
            const u32x4 xw0 = *(const u32x4*)(xb + (size_t)tok * DM + lane * 16), xw1 = *(const u32x4*)(xb + (size_t)tok * DM + lane * 16 + 8);
            float* ot = o[tk];
            ot[0] += bf_lo(xw0.x); ot[1] += bf_hi(xw0.x); ot[2] += bf_lo(xw0.y); ot[3] += bf_hi(xw0.y); ot[4] += bf_lo(xw0.z); ot[5] += bf_hi(xw0.z); ot[6] += bf_lo(xw0.w); ot[7] += bf_hi(xw0.w);
            ot[8] += bf_lo(xw1.x); ot[9] += bf_hi(xw1.x); ot[10] += bf_lo(xw1.y); ot[11] += bf_hi(xw1.y); ot[12] += bf_lo(xw1.z); ot[13] += bf_hi(xw1.z); ot[14] += bf_lo(xw1.w); ot[15] += bf_hi(xw1.w);
            float ss = 0.f;
#pragma unroll
            for (int i = 0; i < 16; ++i) ss += ot[i] * ot[i];
            ss = wave_sum(ss);
            const float r2 = 1.0f / sqrtf(ss * (1.0f / DM) + EPS);
            if (l + 1 < DEPTH) {
                u32x4 w0, w1; w0.x = cvt_pk_bf16(ot[0], ot[1]); w0.y = cvt_pk_bf16(ot[2], ot[3]); w0.z = cvt_pk_bf16(ot[4], ot[5]); w0.w = cvt_pk_bf16(ot[6], ot[7]);
                w1.x = cvt_pk_bf16(ot[8], ot[9]); w1.y = cvt_pk_bf16(ot[10], ot[11]); w1.z = cvt_pk_bf16(ot[12], ot[13]); w1.w = cvt_pk_bf16(ot[14], ot[15]);
                *(u32x4*)(xbo + (size_t)tok * DM + lane * 16) = w0; *(u32x4*)(xbo + (size_t)tok * DM + lane * 16 + 8) = w1;
                if (lane == 0) rstdo[(size_t)(l + 1) * NTOK + tok] = r2;
            } else {
                const float* fg = p.in[I_FGAIN] + lane * 16; float* dst = outp + (size_t)tok * DM + lane * 16;
#pragma unroll
                for (int q = 0; q < 4; ++q) { const f32x4 gq = *(const f32x4*)(fg + 4 * q);
                    *(f32x4*)(dst + 4 * q) = (f32x4){ot[4 * q] * r2 * gq[0], ot[4 * q + 1] * r2 * gq[1], ot[4 * q + 2] * r2 * gq[2], ot[4 * q + 3] * r2 * gq[3]}; }
            }
        }
    }
}

constexpr int PH_PER_LAYER = 8, N_PHASES = 1 + DEPTH * PH_PER_LAYER;
__global__ void __launch_bounds__(NTHREADS, 2) mk_fwd(Params p) {
    extern __shared__ __attribute__((aligned(16))) unsigned char lds_raw[];
    Frame F; F.lds = (LAS unsigned char*)lds_raw; F.tid = threadIdx.x; F.lane = F.tid & 63; F.wave = __builtin_amdgcn_readfirstlane(F.tid >> 6);
    F.G = gridDim.x; { const int bx = blockIdx.x; F.vcu = (F.G % 8 == 0) ? (bx % 8) * (F.G / 8) + bx / 8 : bx; }
    volatile LAS unsigned* misc = (volatile LAS unsigned*)(F.lds + LDS_MISC);
    if (F.tid < 64) misc[F.tid] = 0u;
    __syncthreads();
    unsigned* ctl = (unsigned*)(p.ws + WS_CTL);
    XcdBarrier bar; bar.bar = ctl + CTL_BAR_WORD; bar.x = 0; bar.st = nullptr;
    const bool one_launch = (p.ph_hi - p.ph_lo) > 1;
    if (one_launch) bar = xcd_barrier_post(ctl + CTL_BAR_WORD, misc);
    const int lo = p.ph_lo, hi = p.ph_hi;
#define IN(k) (lo <= (k) && (k) < hi)
#define SEAM(k) do { if (IN(k) && IN((k) + 1)) xcd_barrier(bar); } while (0)
    bf16_t* xb = (bf16_t*)(p.ws + WS_XB);
    if (IN(0)) { for (int rp = 0; rp < p.rep[8]; ++rp) phase_prologue(p, F); SEAM(0); }
    for (int l = 0; l < DEPTH; ++l) {
        const int b = 1 + l * PH_PER_LAYER;
        const float* rstd_a = (const float*)(p.ws + WS_RSTD) + (size_t)l * NTOK;
        if (IN(b + 0)) {
            pg8::Gemm g{xb, (const bf16_t*)(p.ws + WS_WTIN) + (size_t)l * NIN * DM, DM, DM, DM, 0, 0};
            pg8::TileOrder<1> S; S.init(NTOK, NA, F.G, (int)blockIdx.x);
            EpiProjA E{(bf16_t*)(p.ws + WS_PROJA), rstd_a};
            for (int rp = 0; rp < p.rep[0]; ++rp) pg8::gemm_phase(F.lds, g, S, E, F.wave);
            SEAM(b + 0);
        }
        if (IN(b + 1)) {
#if defined(MIX_SIMPLE)
            phase_mix_simple(p, F, l);
#else
            for (int rp = 0; rp < p.rep[1]; ++rp) phase_mix(p, F, l);
#endif
            __syncthreads();
        }
        if (IN(b + 2)) {
            pg8::Gemm g{xb, (const bf16_t*)(p.ws + WS_WTIN) + ((size_t)l * NIN + NA) * DM, DM, DM, DM, 0, 0};
            pg8::TileOrder<1> S; S.init(NTOK, NG, F.G, (int)blockIdx.x);
            EpiGates E{(unsigned char*)(p.ws + WS_GATES), rstd_a, p.in[I_BGATE] + l * NG};
            for (int rp = 0; rp < p.rep[2]; ++rp) pg8::gemm_phase(F.lds, g, S, E, F.wave);
            SEAM(b + 2);
        }
        if (IN(b + 3)) {
            pg8::Gemm g{(const bf16_t*)p.out, (const bf16_t*)(p.ws + WS_WTBR) + (size_t)l * 3 * DM * 512, MIXW, 512, 512, (size_t)512 * 2, (size_t)DM * 512 * 2};
            pg8::TileOrder<3> S; S.init(NTOK, DM, F.G, (int)blockIdx.x);
            EpiMerge E{(const unsigned char*)(p.ws + WS_GATES), (bf16_t*)(p.ws + WS_MERGED), 0};
            if (MERGE_STAGGER) { const unsigned long long t0_ = __builtin_amdgcn_s_memrealtime(), d_ = (unsigned long long)((blockIdx.x >> 3) & 3u) * MERGE_STAGGER;
                while (__builtin_amdgcn_s_memrealtime() - t0_ < d_) __builtin_amdgcn_s_sleep(8); }
            for (int rp = 0; rp < p.rep[3]; ++rp) { E.cheap = (rp + 1 < p.rep[3]) ? p.rep[10] : 0; pg8::gemm_phase(F.lds, g, S, E, F.wave); }
            SEAM(b + 3);
        }
        if (IN(b + 4)) {
            pg8::Gemm g{(const bf16_t*)(p.ws + WS_MERGED), (const bf16_t*)(p.ws + WS_WTOUT) + (size_t)l * DM * DM, DM, DM, DM, 0, 0};
            pg8::TileOrder<1> S; S.init(NTOK, DM, F.G, (int)blockIdx.x);
            for (int rp = 0; rp < p.rep[4]; ++rp) { EpiResid E{xb, (float*)(p.ws + WS_ROWSQP) + (size_t)l * NTOK * 16, (rp + 1 < p.rep[4]) ? (bf16_t*)(p.ws + WS_GATES) : xb}; pg8::gemm_phase(F.lds, g, S, E, F.wave); }
            SEAM(b + 4);
        }
        if (IN(b + 5)) {
            pg8::Gemm g{xb, (const bf16_t*)(p.ws + WS_WEFF) + (size_t)l * PQ * DM, DM, DM, DM, 0, 0};
            pg8::TileOrder<1> S; S.init(NTOK, PQ, F.G, (int)blockIdx.x);
            EpiScores E{(bf16_t*)(p.ws + WS_SCORES)};
            for (int rp = 0; rp < p.rep[5]; ++rp) pg8::gemm_phase(F.lds, g, S, E, F.wave);
            SEAM(b + 5);
        }
        if (IN(b + 6)) { for (int rp = 0; rp < p.rep[6]; ++rp) phase_topk(p, F, l); SEAM(b + 6); }
        if (IN(b + 7)) { for (int rp = 0; rp < p.rep[7]; ++rp) { const bool dry = rp + 1 < p.rep[7]; phase_gather(p, F, l, bar, one_launch, dry, (dry && p.rep[9]) ? 1023u : 0xffffffffu); } SEAM(b + 7); }
    }
#undef IN
#undef SEAM
}

extern "C" void kernel_launch(void* const* d_in, const int* in_sizes, int n_in, void* d_out, int out_size, void* d_ws, size_t ws_size, hipStream_t stream) {
    static int grid = 0;
    if (grid == 0) {
        if (n_in != 22 || out_size != NTOK * DM || ws_size < WS_END) { fprintf(stderr, "kernel_launch: unexpected shapes (n_in %d, out %d, ws %zu)\n", n_in, out_size, ws_size); grid = -1; return; }
        int dev = 0, cus = 0, per_cu = 0;
        if (hipGetDevice(&dev) != hipSuccess || hipDeviceGetAttribute(&cus, hipDeviceAttributeMultiprocessorCount, dev) != hipSuccess) { grid = -1; return; }
        if (hipFuncSetAttribute((const void*)mk_fwd, hipFuncAttributeMaxDynamicSharedMemorySize, LDS_BYTES) != hipSuccess) { fprintf(stderr, "kernel_launch: hipFuncSetAttribute failed\n"); grid = -1; return; }
        if (hipOccupancyMaxActiveBlocksPerMultiprocessor(&per_cu, (const void*)mk_fwd, NTHREADS, LDS_BYTES) != hipSuccess || per_cu < 1) { fprintf(stderr, "kernel_launch: occupancy query says %d\n", per_cu); }
        (void)hipGetLastError();
        grid = cus;
    }
    if (grid < 0) return;
    (void)hipMemsetAsync((char*)d_ws + WS_CTL, 0, CTL_ZERO_BYTES, stream);
    Params p; memset(&p, 0, sizeof(p));
    for (int i = 0; i < 22; ++i) p.in[i] = (const float*)d_in[i];
    p.out = (float*)d_out; p.ws = (unsigned char*)d_ws;
    for (int i = 0; i < 12; ++i) p.rep[i] = 1;
    for (int i = 0; i < 9; ++i) if (PD(i)) p.rep[i] = 2;
    p.rep[9] = 0; if (PD(9)) { p.rep[7] = 2; p.rep[9] = 1; }
    p.rep[10] = 0; if (PD(10)) { p.rep[3] = 2; p.rep[10] = 1; }
#if MK_N_LAUNCHES == 1
    p.ph_lo = 0; p.ph_hi = N_PHASES; p.li = 0;
    hipLaunchKernelGGL(mk_fwd, dim3(grid), dim3(NTHREADS), LDS_BYTES, stream, p);
#else
    for (int ph = 0; ph < N_PHASES; ++ph) { p.ph_lo = ph; p.ph_hi = ph + 1; p.li = ph; hipLaunchKernelGGL(mk_fwd, dim3(grid), dim3(NTHREADS), LDS_BYTES, stream, p); }
#endif
}
```
